# Optimizing an MI355X kernel written in HIP

```python
import math
import jax, jax.numpy as jnp
from jax import lax
import numpy as np

D_MODEL = 1024
BATCH = 2
SEQ = 8192
DEPTH = 2

CHUNK = 64
HG_HEADS = 4
HG_DK = 128
HG_DV = 128
HG_KWIDTH = HG_HEADS * HG_DK
HG_VWIDTH = HG_HEADS * HG_DV
GDN_HEADS = 4
GDN_DK = 128
GDN_DV = 128
GDN_QK = GDN_HEADS * GDN_DK
GDN_V = GDN_HEADS * GDN_DV
CONV_K = 4
PEER_HEADS = 8
PEER_DKEY = 256
PEER_NKEYS = 128
PEER_TOPK = 16
PEER_EXPERTS = PEER_NKEYS * PEER_NKEYS
PEER_BLOCK = 128
EPS = 1e-6
IN_SIZES = (HG_KWIDTH, HG_KWIDTH, HG_VWIDTH, HG_VWIDTH, 2 * GDN_QK + GDN_V, GDN_V, GDN_HEADS, GDN_HEADS, D_MODEL, D_MODEL)
IN_COLS = sum(IN_SIZES)

kernel_name = "hybrid_hgrn2_gdn_peer_adaln"


def _offsets(sizes):
    offs, acc = [], 0
    for s in sizes[:-1]:
        acc += s
        offs.append(acc)
    return offs


def rmsnorm(x, g):
    xf = x.astype(jnp.float32)
    y = xf * lax.rsqrt(jnp.mean(xf * xf, axis=-1, keepdims=True) + EPS)
    return (y * g.astype(jnp.float32)).astype(x.dtype)


def l2norm(x):
    return x * lax.rsqrt(jnp.sum(x * x, axis=-1, keepdims=True) + EPS)


def to_chunks(t):
    B, S, H, d = t.shape
    return t.reshape(B, S // CHUNK, CHUNK, H, d).transpose(1, 0, 3, 2, 4)


def from_chunks(t):
    nC, B, H, C, d = t.shape
    return t.transpose(1, 0, 3, 2, 4).reshape(B, nC * C, H, d)


def causal_conv(x, w):
    return lax.conv_general_dilated(x, w[:, None, :], window_strides=(1,), padding=[(CONV_K - 1, 0)],
                                    dimension_numbers=('NWC', 'WIO', 'NWC'), feature_group_count=x.shape[-1])


def hgrn2(q, f, i, g, lb, norm_g):
    B, S, _ = q.shape
    fgate = lb + (1.0 - lb) * jax.nn.sigmoid(f)
    logf = jnp.log(fgate)
    k = 1.0 - fgate
    q = jax.nn.silu(q)
    qc = to_chunks(q.reshape(B, S, HG_HEADS, HG_DK))
    kc = to_chunks(k.reshape(B, S, HG_HEADS, HG_DK))
    lc = to_chunks(logf.reshape(B, S, HG_HEADS, HG_DK))
    vc = to_chunks(i.reshape(B, S, HG_HEADS, HG_DV))
    causal = jnp.tril(jnp.ones((CHUNK, CHUNK), dtype=bool))[:, :, None]

    def step(state, inp):
        qq, kk, ll, vv = inp
        b = jnp.cumsum(ll, axis=2)
        o = jnp.einsum('bhtk,bhkv->bhtv', qq * jnp.exp(b), state)
        diff = jnp.where(causal, b[:, :, :, None, :] - b[:, :, None, :, :], -jnp.inf)
        att = jnp.sum(qq[:, :, :, None, :] * kk[:, :, None, :, :] * jnp.exp(diff), axis=-1)
        o = o + jnp.einsum('bhts,bhsv->bhtv', att, vv)
        b_last = b[:, :, -1:, :]
        state = jnp.exp(b_last[:, :, 0, :])[..., None] * state + jnp.einsum('bhsk,bhsv->bhkv', kk * jnp.exp(b_last - b), vv)
        return state, o

    state0 = jnp.zeros((B, HG_HEADS, HG_DK, HG_DV), jnp.float32)
    _, o = lax.scan(step, state0, (qc, kc, lc, vc))
    o = from_chunks(o)
    o = rmsnorm(o, norm_g) * jax.nn.silu(g.reshape(B, S, HG_HEADS, HG_DV))
    return o.reshape(B, S, HG_VWIDTH)


def gated_deltanet(qkv, g, beta_raw, a_raw, conv_w, a_log, dt_bias, norm_g):
    B, S, _ = qkv.shape
    qkv = jax.nn.silu(causal_conv(qkv, conv_w))
    q, k, v = jnp.split(qkv, [GDN_QK, 2 * GDN_QK], axis=-1)
    q = l2norm(q.reshape(B, S, GDN_HEADS, GDN_DK)) * (GDN_DK ** -0.5)
    k = l2norm(k.reshape(B, S, GDN_HEADS, GDN_DK))
    v = v.reshape(B, S, GDN_HEADS, GDN_DV)
    beta = jax.nn.sigmoid(beta_raw)
    logdec = -jnp.exp(a_log) * jax.nn.softplus(a_raw + dt_bias)
    qc, kc, vc = to_chunks(q), to_chunks(k), to_chunks(v)
    bc = to_chunks(beta[..., None])[..., 0]
    b = jnp.cumsum(to_chunks(logdec[..., None])[..., 0], axis=-1)
    causal = jnp.tril(jnp.ones((CHUNK, CHUNK), dtype=bool))
    strict = jnp.tril(jnp.ones((CHUNK, CHUNK), dtype=bool), k=-1)
    dec = jnp.exp(jnp.where(causal, b[..., :, None] - b[..., None, :], -jnp.inf))
    kb = kc * bc[..., None]
    a_mat = jnp.where(strict, jnp.einsum('nbhid,nbhjd->nbhij', kb, kc) * dec, 0.0)
    u = lax.linalg.triangular_solve(a_mat, vc * bc[..., None], left_side=True, lower=True, unit_diagonal=True)
    w = lax.linalg.triangular_solve(a_mat, kb * jnp.exp(b)[..., None], left_side=True, lower=True, unit_diagonal=True)
    aqk = jnp.einsum('nbhid,nbhjd->nbhij', qc, kc) * dec
    qe = qc * jnp.exp(b)[..., None]
    kd = kc * jnp.exp(b[..., -1:] - b)[..., None]
    b_last = jnp.exp(b[..., -1])

    def step(state, inp):
        uu, ww, aa, qq, kk, bl = inp
        v_new = uu - jnp.einsum('bhck,bhkv->bhcv', ww, state)
        o = jnp.einsum('bhck,bhkv->bhcv', qq, state) + jnp.einsum('bhcs,bhsv->bhcv', aa, v_new)
        state = bl[..., None, None] * state + jnp.einsum('bhsk,bhsv->bhkv', kk, v_new)
        return state, o

    state0 = jnp.zeros((B, GDN_HEADS, GDN_DK, GDN_DV), jnp.float32)
    _, o = lax.scan(step, state0, (u, w, aqk, qe, kd, b_last))
    o = from_chunks(o)
    o = rmsnorm(o, norm_g) * jax.nn.silu(g.reshape(B, S, GDN_HEADS, GDN_DV))
    return o.reshape(B, S, GDN_V)


def token_mixer(h, lb, w_in, hg_norm_g, conv_w, a_log, dt_bias, gdn_norm_g, w_br_hg, w_br_gdn, w_out):
    dt = h.dtype
    proj = (h @ w_in).astype(jnp.float32)
    hq, hf, hi, hg, qkv, gg, beta_raw, a_raw, gate_hg, gate_gdn = jnp.split(proj, _offsets(IN_SIZES), axis=-1)
    y_hg = hgrn2(hq, hf, hi, hg, lb, hg_norm_g)
    y_gdn = gated_deltanet(qkv, gg, beta_raw, a_raw, conv_w.astype(jnp.float32),
                           a_log.astype(jnp.float32), dt_bias.astype(jnp.float32), gdn_norm_g)
    merged = (jax.nn.sigmoid(gate_hg).astype(dt) * (y_hg.astype(dt) @ w_br_hg)
              + jax.nn.sigmoid(gate_gdn).astype(dt) * (y_gdn.astype(dt) @ w_br_gdn))
    return merged @ w_out


def peer(h, wq, subkeys, u_tab, v_tab):
    B, S, D = h.shape
    hb = h.reshape(B * S // PEER_BLOCK, PEER_BLOCK, D)

    def block(xb):
        P = xb.shape[0]
        q = (xb @ wq).reshape(P, PEER_HEADS, 2, PEER_DKEY // 2)
        sc = jnp.einsum('phzd,hznd->phzn', q, subkeys)
        sv, si = lax.top_k(sc, PEER_TOPK)
        cand = (sv[:, :, 0, :, None] + sv[:, :, 1, None, :]).reshape(P, PEER_HEADS, PEER_TOPK * PEER_TOPK)
        cidx = (si[:, :, 0, :, None] * PEER_NKEYS + si[:, :, 1, None, :]).reshape(P, PEER_HEADS, PEER_TOPK * PEER_TOPK)
        top_s, top_c = lax.top_k(cand, PEER_TOPK)
        experts = jnp.take_along_axis(cidx, top_c, axis=-1)
        gate = jax.nn.softmax(top_s.astype(jnp.float32), axis=-1).astype(xb.dtype)
        ue = jnp.take(u_tab, experts, axis=0)
        ve = jnp.take(v_tab, experts, axis=0)
        act = jax.nn.gelu(jnp.einsum('pd,phkd->phk', xb, ue), approximate=False) * gate
        return jnp.einsum('phk,phkd->pd', act, ve)

    return lax.map(block, hb).reshape(B, S, D)


def setup_inputs(seed: int = 0) -> dict:
    key = jax.random.key(seed)
    ks = jax.random.split(key, 24)
    f32 = jnp.float32
    nrm = lambda k, shp, s: (jax.random.normal(k, shp, f32) * s)
    dt = jnp.exp(jax.random.uniform(ks[10], (DEPTH, GDN_HEADS), f32, minval=math.log(1e-3), maxval=math.log(1e-1)))
    return {
        'x': nrm(ks[0], (BATCH, SEQ, D_MODEL), 1.0),
        'c': nrm(ks[1], (BATCH, D_MODEL), 1.0),
        'ada_w': nrm(ks[2], (DEPTH, D_MODEL, 6 * D_MODEL), 0.5 * D_MODEL ** -0.5),
        'ada_b': nrm(ks[3], (DEPTH, 6 * D_MODEL), 0.01),
        'norm1_g': 1.0 + nrm(ks[4], (DEPTH, D_MODEL), 0.02),
        'norm2_g': 1.0 + nrm(ks[5], (DEPTH, D_MODEL), 0.02),
        'final_g': 1.0 + nrm(ks[6], (D_MODEL,), 0.02),
        'w_in': nrm(ks[7], (DEPTH, D_MODEL, IN_COLS), D_MODEL ** -0.5),
        'hg_lb_logits': nrm(ks[8], (DEPTH, HG_KWIDTH), 0.5),
        'hg_norm_g': 1.0 + nrm(ks[9], (DEPTH, HG_DV), 0.02),
        'gdn_conv_w': nrm(ks[11], (DEPTH, CONV_K, 2 * GDN_QK + GDN_V), CONV_K ** -0.5),
        'gdn_a_log': jnp.log(jax.random.uniform(ks[12], (DEPTH, GDN_HEADS), f32, minval=1.0, maxval=16.0)),
        'gdn_dt_bias': dt + jnp.log(-jnp.expm1(-dt)),
        'gdn_norm_g': 1.0 + nrm(ks[13], (DEPTH, GDN_DV), 0.02),
        'w_branch_hg': nrm(ks[14], (DEPTH, HG_VWIDTH, D_MODEL), HG_VWIDTH ** -0.5),
        'w_branch_gdn': nrm(ks[15], (DEPTH, GDN_V, D_MODEL), GDN_V ** -0.5),
        'w_out': nrm(ks[16], (DEPTH, D_MODEL, D_MODEL), D_MODEL ** -0.5),
        'peer_wq': nrm(ks[17], (DEPTH, D_MODEL, PEER_HEADS * PEER_DKEY), D_MODEL ** -0.5),
        'peer_subkeys': nrm(ks[18], (DEPTH, PEER_HEADS, 2, PEER_NKEYS, PEER_DKEY // 2), (PEER_DKEY // 2) ** -0.5),
        'peer_u': nrm(ks[19], (DEPTH, PEER_EXPERTS, D_MODEL), D_MODEL ** -0.5),
        'peer_v': nrm(ks[20], (DEPTH, PEER_EXPERTS, D_MODEL), PEER_HEADS ** -0.5),
    }


def reference(x, c, ada_w, ada_b, norm1_g, norm2_g, final_g, w_in, hg_lb_logits, hg_norm_g,
              gdn_conv_w, gdn_a_log, gdn_dt_bias, gdn_norm_g, w_branch_hg, w_branch_gdn, w_out,
              peer_wq, peer_subkeys, peer_u, peer_v):
    sm = jax.nn.softmax(hg_lb_logits.astype(jnp.float32), axis=0)
    lower_bounds = jnp.cumsum(sm, axis=0) - sm[0:1]
    cond = jax.nn.silu(c)
    for l in range(DEPTH):
        mod = (cond @ ada_w[l] + ada_b[l])[:, None, :]
        sh1, sc1, gt1, sh2, sc2, gt2 = jnp.split(mod, 6, axis=-1)
        h = rmsnorm(x, norm1_g[l]) * (1.0 + sc1) + sh1
        y = token_mixer(h, lower_bounds[l], w_in[l], hg_norm_g[l], gdn_conv_w[l], gdn_a_log[l], gdn_dt_bias[l],
                        gdn_norm_g[l], w_branch_hg[l], w_branch_gdn[l], w_out[l])
        x = x + gt1 * y.astype(x.dtype)
        h = rmsnorm(x, norm2_g[l]) * (1.0 + sc2) + sh2
        x = x + gt2 * peer(h, peer_wq[l], peer_subkeys[l], peer_u[l], peer_v[l]).astype(x.dtype)
    return rmsnorm(x, final_g)
```

```cpp
#include <hip/hip_runtime.h>
#include <cstdio>
#include <cstdint>

#define DI __device__ __forceinline__
#define LAS __attribute__((address_space(3)))
#define GAS __attribute__((address_space(1)))
typedef unsigned short bf16_t;
typedef short bf16x8 __attribute__((ext_vector_type(8)));
typedef short s16x4 __attribute__((ext_vector_type(4)));
typedef float f32x2 __attribute__((ext_vector_type(2)));
typedef float f32x4 __attribute__((ext_vector_type(4)));
typedef float f32x16 __attribute__((ext_vector_type(16)));
typedef unsigned u32x2 __attribute__((ext_vector_type(2)));
typedef unsigned u32x4 __attribute__((ext_vector_type(4)));
typedef __bf16 bf16x2_t __attribute__((ext_vector_type(2)));
typedef LAS unsigned char* lptr;

constexpr int BATCH = 2, SEQ = 8192, D = 1024, M = BATCH * SEQ, DEPTH = 2;
constexpr int NPROJ = 6144;
constexpr int IN_COLS = 6152;
constexpr int NCHUNK = SEQ / 64;
constexpr int NQ = 2048;
constexpr int NEXP = 16384;
constexpr float EPS = 1e-6f;
constexpr int PC_HQ = 0, PC_HF = 512, PC_HI = 1024, PC_HG = 1536, PC_QKV = 2048, PC_GG = 3584, PC_GATE = 4096;

constexpr size_t MiB = 1u << 20;
constexpr size_t WS_CTL = 0, CTL_ZERO_BYTES = 256 * 1024;
constexpr size_t WS_MOD = 1 * MiB;
constexpr size_t WS_SMALL = WS_MOD + 512 * 1024;
constexpr size_t WS_SMALL1 = 512 * 1024;
constexpr size_t WS_WIN = 2 * MiB;
constexpr size_t WS_WBR = 26 * MiB;
constexpr size_t WS_WOUT = 30 * MiB;
constexpr size_t WS_WQ = 34 * MiB;
constexpr size_t WS_SK = 42 * MiB;
constexpr size_t WS_PROJ = 43 * MiB;
constexpr size_t WS_Y = 235 * MiB;
constexpr size_t WS_SCR = 267 * MiB;
constexpr size_t WS_UV = WS_SCR;
constexpr size_t WS_H = WS_SCR + 64 * MiB;
constexpr size_t WS_MERGED = WS_SCR + 96 * MiB;
constexpr size_t WS_ROUTE = WS_SCR + 128 * MiB;
constexpr size_t WS_ACT = WS_SCR + 144 * MiB;
constexpr size_t WS_MT = WS_SCR;
constexpr size_t WS_NN = WS_SCR + 32 * MiB;
constexpr size_t WS_QT = WS_SCR + 96 * MiB;
constexpr size_t WS_OP = WS_SCR + 128 * MiB;
constexpr size_t WS_SS = WS_SCR + 160 * MiB;
constexpr size_t WS_DL = WS_SCR + 224 * MiB;
constexpr size_t WS_U6 = 492 * MiB;
constexpr size_t WS_END = 512 * MiB;
static_assert(WS_DL + 1 * MiB <= WS_END && WS_ROUTE + 16 * MiB <= WS_END, "ws map");

constexpr int LDS_SCRATCH = 147456;
constexpr int LDS_CTL_OFF = LDS_SCRATCH;
constexpr int LDS_BYTES = LDS_SCRATCH + 1024;
constexpr int NWAVES = 8, NTHR = 512;

DI unsigned pk2(float lo, float hi) { f32x2 v = {lo, hi}; bf16x2_t b = __builtin_convertvector(v, bf16x2_t); return __builtin_bit_cast(unsigned, b); }
DI float bf_lo(unsigned u) { return __uint_as_float(u << 16); }
DI float bf_hi(unsigned u) { return __uint_as_float(u & 0xffff0000u); }
DI float bf1(bf16_t u) { return __uint_as_float(((unsigned)u) << 16); }
DI bf16_t f2bf(float f) { return (bf16_t)(pk2(f, 0.f) & 0xffffu); }
DI float sigmoidf_(float x) { return __builtin_amdgcn_rcpf(1.0f + __expf(-x)); }
DI float siluf_(float x) { return x * __builtin_amdgcn_rcpf(1.0f + __expf(-x)); }
template <int MSK> DI float shx(float v, int lane) {
    if constexpr (MSK < 32) return __int_as_float(__builtin_amdgcn_ds_swizzle(__float_as_int(v), (MSK << 10) | 0x1f));
    else return __int_as_float(__builtin_amdgcn_ds_bpermute((lane ^ 32) << 2, __float_as_int(v)));
}
#ifndef WSUM_DPP
#define WSUM_DPP 1
#endif
template <int CTRL> DI float dpp_f(float v) { return __int_as_float(__builtin_amdgcn_update_dpp(0, __float_as_int(v), CTRL, 0xf, 0xf, false)); }
DI float wave_sum(float v, int lane) {
#if WSUM_DPP
    v += dpp_f<0xB1>(v); v += dpp_f<0x4E>(v); v += dpp_f<0x124>(v); v += dpp_f<0x128>(v); v += shx<16>(v, lane); v += shx<32>(v, lane);
#else
    v += shx<1>(v, lane); v += shx<2>(v, lane); v += shx<4>(v, lane); v += shx<8>(v, lane); v += shx<16>(v, lane); v += shx<32>(v, lane);
#endif
    return v;
}
#define LDS_WAIT() asm volatile("s_waitcnt lgkmcnt(0)" ::: "memory")
#define VM_WAIT() asm volatile("s_waitcnt vmcnt(0)" ::: "memory")
#define MFMA32(a, b, c) __builtin_amdgcn_mfma_f32_32x32x16_bf16((a), (b), (c), 0, 0, 0)
DI int crow(int i, int h) { return (i & 3) + 8 * (i >> 2) + 4 * h; }
DI f32x16 zero16() { f32x16 z;
#pragma unroll
    for (int i = 0; i < 16; ++i) z[i] = 0.f; return z; }

DI bf16x8 fragK(lptr base, int ldb, int row0, int k0, int lane) {
    return *(const LAS bf16x8*)(base + (row0 + (lane & 31)) * ldb + (k0 + 8 * (lane >> 5)) * 2);
}
typedef short v4i16_t __attribute__((ext_vector_type(4)));
DI bf16x8 fragT(lptr base, int ldb, int k0, int n0, int lane) {
    const int h = lane >> 5, blk = (lane >> 4) & 1, q = (lane & 15) >> 2, p = lane & 3;
    lptr a = base + (k0 + 8 * h + q) * ldb + (n0 + 16 * blk) * 2 + 8 * p;
    const v4i16_t lo = __builtin_amdgcn_ds_read_tr16_b64_v4i16((LAS v4i16_t*)a);
    const v4i16_t hi = __builtin_amdgcn_ds_read_tr16_b64_v4i16((LAS v4i16_t*)(a + 4 * ldb));
    return (bf16x8){lo[0], lo[1], lo[2], lo[3], hi[0], hi[1], hi[2], hi[3]};
}
DI void storeT_bf16(const f32x16& c, lptr base, int ldb, int col0, int row0, int lane) {
    lptr p = base + (col0 + (lane & 31)) * ldb + (row0 + 4 * (lane >> 5)) * 2;
#pragma unroll
    for (int g = 0; g < 4; ++g) { u32x2 v; v.x = pk2(c[4 * g], c[4 * g + 1]); v.y = pk2(c[4 * g + 2], c[4 * g + 3]); *(LAS u32x2*)(p + 16 * g) = v; }
}
DI void pack_tile(const f32x16& c, u32x4& lo, u32x4& hi) {
    lo.x = pk2(c[0], c[1]); lo.y = pk2(c[2], c[3]); lo.z = pk2(c[4], c[5]); lo.w = pk2(c[6], c[7]);
    hi.x = pk2(c[8], c[9]); hi.y = pk2(c[10], c[11]); hi.z = pk2(c[12], c[13]); hi.w = pk2(c[14], c[15]);
}
DI f32x16 unpack_tile(const u32x4& lo, const u32x4& hi) {
    f32x16 c;
    c[0] = bf_lo(lo.x); c[1] = bf_hi(lo.x); c[2] = bf_lo(lo.y); c[3] = bf_hi(lo.y); c[4] = bf_lo(lo.z); c[5] = bf_hi(lo.z); c[6] = bf_lo(lo.w); c[7] = bf_hi(lo.w);
    c[8] = bf_lo(hi.x); c[9] = bf_hi(hi.x); c[10] = bf_lo(hi.y); c[11] = bf_hi(hi.y); c[12] = bf_lo(hi.z); c[13] = bf_hi(hi.z); c[14] = bf_lo(hi.w); c[15] = bf_hi(hi.w);
    return c;
}
#ifndef WT_ALL
#define WT_ALL 1
#endif
DI void st16_wt(void* p, const u32x4 v) {
#if WT_ALL
#ifdef WT_NT
    asm volatile("global_store_dwordx4 %0, %1, off sc0 sc1 nt\n\ts_nop 1" :: "v"(p), "v"(v) : "memory");
#else
    asm volatile("global_store_dwordx4 %0, %1, off sc0 sc1\n\ts_nop 1" :: "v"(p), "v"(v) : "memory");
#endif
#else
    *(u32x4*)p = v;
#endif
}
DI void st16f_wt(void* p, const f32x4 v) { st16_wt(p, __builtin_bit_cast(u32x4, v)); }
DI void st8_wt(void* p, const u32x2 v) {
#if WT_ALL
    asm volatile("global_store_dwordx2 %0, %1, off sc0 sc1" :: "v"(p), "v"(v) : "memory");
#else
    *(u32x2*)p = v;
#endif
}
#ifndef WT_TILE
#define WT_TILE 0
#endif
#ifndef WT_CHAIN
#define WT_CHAIN 0
#endif
DI void gstore_tile(unsigned char* tb, int lane, const f32x16& c) { u32x4 lo, hi; pack_tile(c, lo, hi); unsigned char* p = tb + lane * 32;
    if (WT_TILE == 2) { __builtin_nontemporal_store(lo, (u32x4*)p); __builtin_nontemporal_store(hi, (u32x4*)(p + 16)); }
    else if (WT_TILE) { st16_wt(p, lo); st16_wt(p + 16, hi); } else { *(u32x4*)p = lo; *(u32x4*)(p + 16) = hi; } }
DI void gload_tile(const unsigned char* tb, int lane, u32x4& lo, u32x4& hi) { const u32x4* p = (const u32x4*)(tb + lane * 32); lo = p[0]; hi = p[1]; }
#define AS_BF8(v) __builtin_bit_cast(bf16x8, (v))
#define MK_SINGLE 1
#define DBG_STOP 0
#define DBG_SEL 0
#define DBG_G 0
#define DBG_NOMIX 0
#define REP_MASK 0
#define NREPA 1

namespace pg8 {
constexpr int BM = 256, BK = 64, HALF = 128, HTB = HALF * BK * 2, STAGE_BYTES = 8 * HTB, NXCD = 8, WGM = 8;
__host__ __device__ __forceinline__ int lds_byte(int r, int c) { const int st = (r >> 4) * 2 + (c >> 5), rr = r & 15, cc = c & 31, ob = rr * 64 + cc * 2; return st * 1024 + (ob ^ (((ob >> 9) & 1) << 5)); }
__host__ __device__ __forceinline__ void stage_rc(int b, int& R, int& C) { const int st = b / 1024, sb = b % 1024, swz = sb ^ (((sb >> 9) & 1) << 5); R = (st >> 1) * 16 + swz / 64; C = (st & 1) * 32 + (swz % 64) / 2; }
__host__ __device__ __forceinline__ int perm32(int rho) { const int n = rho >> 4, i = rho & 15; return 8 * (i >> 2) + 4 * n + (i & 3); }

struct Unit { int pm, pn, pass; };
struct Gemm { const bf16_t* A; const bf16_t* Bt; int M, N, K, lda, ldb; size_t passA, passB; };

struct StaticOrder {
    int nM, nN, nwg, G, c;
    __host__ __device__ void init(int M_, int N_, int G_, int c_) { nM = M_ / BM; nN = N_ / BM; nwg = nM * nN; G = G_; c = c_; }
    __host__ __device__ bool next(int i, Unit& u) const {
        const long L = (long)i * G + c; if (L >= nwg) return false;
        int wgid = (int)L; { const int q = nwg / NXCD, r = nwg % NXCD, xcd = wgid % NXCD, off = wgid / NXCD; wgid = (xcd < r ? xcd * (q + 1) : r * (q + 1) + (xcd - r) * q) + off; }
        const int nig = WGM * nN, gid = wgid / nig, fm = gid * WGM, gsz = (nM - fm) < WGM ? (nM - fm) : WGM;
        u.pm = fm + ((wgid % nig) % gsz); u.pn = (wgid % nig) / gsz; u.pass = 0; return true;
    }
};
struct TwoPassOrder {
    StaticOrder S;
    __host__ __device__ bool next(int i, Unit& u) const { if (!S.next(i >> 1, u)) return false; u.pass = i & 1; return true; }
};

#ifndef EPI_WT
#define EPI_WT 1
#endif
#define ST16(bit_, p_, v_) do { if ((EPI_WT >> (bit_)) & 1) st16_wt(p_, v_); else *(u32x4*)(p_) = (v_); } while (0)
struct EpiBf16 {
    static constexpr bool PERM = true;
    bf16_t* O; int ldc;
    __device__ __forceinline__ void operator()(const f32x4 (&acc)[2][2][4][2], const Unit& u, int wr, int wc, int fr, int fq) const {
        const int row0 = u.pm * BM + wr * 64 + fr; const int col0 = u.pn * BM + wc * 32 + 8 * fq;
#pragma unroll
        for (int ai = 0; ai < 2; ++ai)
#pragma unroll
            for (int m = 0; m < 4; ++m) { bf16_t* rowp = O + (size_t)(row0 + ai * HALF + m * 16) * ldc + col0;
#pragma unroll
                for (int bj = 0; bj < 2; ++bj) { const f32x4 v0 = acc[ai][bj][m][0], v1 = acc[ai][bj][m][1];
                    u32x4 w; w.x = pk2(v0[0], v0[1]); w.y = pk2(v0[2], v0[3]); w.z = pk2(v1[0], v1[1]); w.w = pk2(v1[2], v1[3]);
                    ST16(0, rowp + bj * HALF, w); } }
    }
};
struct EpiGate {
    static constexpr bool PERM = true;
    bf16_t* O; int ldc; const bf16_t* G; int ldg; int goff;
    __device__ __forceinline__ void operator()(const f32x4 (&acc)[2][2][4][2], const Unit& u, int wr, int wc, int fr, int fq) const {
        const int row0 = u.pm * BM + wr * 64 + fr; const int col0 = u.pn * BM + wc * 32 + 8 * fq; const int gofs = goff + u.pass * ldc; const bool add = u.pass != 0;
#pragma unroll
        for (int ai = 0; ai < 2; ++ai)
#pragma unroll
            for (int m = 0; m < 4; ++m) { const size_t row = (size_t)(row0 + ai * HALF + m * 16);
#pragma unroll
                for (int bj = 0; bj < 2; ++bj) { const f32x4 v0 = acc[ai][bj][m][0], v1 = acc[ai][bj][m][1];
                    const u32x4 g = *(const u32x4*)(G + row * ldg + gofs + col0 + bj * HALF);
                    bf16_t* op = O + row * ldc + col0 + bj * HALF;
                    u32x4 p = (u32x4){0u, 0u, 0u, 0u}; if (add) p = *(const u32x4*)op;
                    float o[8];
                    o[0] = v0[0] * sigmoidf_(bf_lo(g.x)); o[1] = v0[1] * sigmoidf_(bf_hi(g.x)); o[2] = v0[2] * sigmoidf_(bf_lo(g.y)); o[3] = v0[3] * sigmoidf_(bf_hi(g.y));
                    o[4] = v1[0] * sigmoidf_(bf_lo(g.z)); o[5] = v1[1] * sigmoidf_(bf_hi(g.z)); o[6] = v1[2] * sigmoidf_(bf_lo(g.w)); o[7] = v1[3] * sigmoidf_(bf_hi(g.w));
                    o[0] += bf_lo(p.x); o[1] += bf_hi(p.x); o[2] += bf_lo(p.y); o[3] += bf_hi(p.y); o[4] += bf_lo(p.z); o[5] += bf_hi(p.z); o[6] += bf_lo(p.w); o[7] += bf_hi(p.w);
                    u32x4 w; w.x = pk2(o[0], o[1]); w.y = pk2(o[2], o[3]); w.z = pk2(o[4], o[5]); w.w = pk2(o[6], o[7]);
                    if (((EPI_WT >> 3) & 1) && add) st16_wt(op, w); else ST16(1, op, w); }
                if (m & 1) asm volatile("" ::: "memory"); }
    }
};
struct EpiResid {
    static constexpr bool PERM = false;
    const float* base; float* out; const float* gt;
    __device__ __forceinline__ void operator()(const f32x4 (&acc)[2][2][4][2], const Unit& u, int wr, int wc, int fr, int fq) const {
        const int col0 = u.pn * BM + wc * 32 + 4 * fq; const float* g = gt + (u.pm >= (SEQ / BM) ? 6 * D : 0);
        f32x4 gv[2][2];
#pragma unroll
        for (int bj = 0; bj < 2; ++bj)
#pragma unroll
            for (int n = 0; n < 2; ++n) { gv[bj][n] = *(const f32x4*)(g + col0 + bj * HALF + n * 16); if (DBG_NOMIX) gv[bj][n] = (f32x4){0.f, 0.f, 0.f, 0.f}; }
#pragma unroll
        for (int ai = 0; ai < 2; ++ai)
#pragma unroll
            for (int m = 0; m < 4; ++m) { const size_t off = (size_t)(u.pm * BM + ai * HALF + wr * 64 + m * 16 + fr) * D + col0;
#pragma unroll
                for (int bj = 0; bj < 2; ++bj)
#pragma unroll
                    for (int n = 0; n < 2; ++n) { const f32x4 bs = *(const f32x4*)(base + off + bj * HALF + n * 16);
                        const f32x4 r_ = bs + gv[bj][n] * acc[ai][bj][m][n]; ST16(2, out + off + bj * HALF + n * 16, __builtin_bit_cast(u32x4, r_)); }
                if (m & 1) asm volatile("" ::: "memory"); }
    }
};

template <class Epi, class Sched>
__device__ __forceinline__ void gemm_phase(lptr lds, const Gemm g, const Sched& S, const Epi& E, const int tid) {
    const int wid = __builtin_amdgcn_readfirstlane(tid >> 6), lane = tid & 63, wr = wid >> 2, wc = wid & 3, fr = lane & 15, fq = lane >> 4;
    const int K = g.K, nt = K / BK;
    unsigned voffA[2], voffB[2];
#pragma unroll
    for (int i = 0; i < 2; ++i) { int R, C; stage_rc(tid * 16 + i * 8192, R, C); const int Rb = Epi::PERM ? ((R & ~31) + perm32(R & 31)) : R;
        voffA[i] = (unsigned)(R * g.lda + C) * 2u; voffB[i] = (unsigned)(Rb * g.ldb + C) * 2u; }
    const size_t kstep = (size_t)(BK * 2);
    const size_t hstepA = (size_t)HALF * g.lda * 2, hstepB = (size_t)HALF * g.ldb * 2;
    const size_t tstepA = 2 * hstepA, tstepB = 2 * hstepB;
    const unsigned ldsw = (unsigned)wid * 1024u;
    const int aoff = lds_byte(wr * 64 + fr, fq * 8), boff = lds_byte(wc * 32 + fr, fq * 8);
#define PG8_SA(b, h) (((b) * 2 + (h)) * HTB)
#define PG8_SB(b, h) ((4 + (b) * 2 + (h)) * HTB)
#define PG8_STAGE(bufoff, gbase, voff) do { _Pragma("unroll") for (int _i = 0; _i < 2; ++_i) \
        __builtin_amdgcn_global_load_lds((const unsigned*)((const char*)(gbase) + (voff)[_i]), (LAS unsigned*)(lds + (bufoff) + ldsw + _i * 8192), 16, 0, 0); } while (0)
#define PG8_LDA(dst, b, h) do { _Pragma("unroll") for (int m = 0; m < 4; ++m) _Pragma("unroll") for (int k = 0; k < 2; ++k) dst[m][k] = *(const LAS bf16x8*)(lds + PG8_SA(b, h) + aoff + m * 2048 + k * 1024); } while (0)
#define PG8_LDB(dst, b, h) do { _Pragma("unroll") for (int n = 0; n < 2; ++n) _Pragma("unroll") for (int k = 0; k < 2; ++k) dst[n][k] = *(const LAS bf16x8*)(lds + PG8_SB(b, h) + boff + n * 2048 + k * 1024); } while (0)
#define PG8_MMA(ai, bj, At, Bt) do { __builtin_amdgcn_s_setprio(1); _Pragma("unroll") for (int m = 0; m < 4; ++m) _Pragma("unroll") for (int n = 0; n < 2; ++n) _Pragma("unroll") for (int k = 0; k < 2; ++k) \
        acc[ai][bj][m][n] = __builtin_amdgcn_mfma_f32_16x16x32_bf16(Bt[n][k], At[m][k], acc[ai][bj][m][n], 0, 0, 0); __builtin_amdgcn_s_setprio(0); } while (0)
#define PG8_WAIT_V(n) asm volatile("s_waitcnt vmcnt(" #n ")" ::: "memory")
#define PG8_WAIT_L(n) asm volatile("s_waitcnt lgkmcnt(" #n ")" ::: "memory")
#define PG8_BAR __builtin_amdgcn_s_barrier()
#define PG8_SCHED __builtin_amdgcn_sched_barrier(0)
    Unit cur, nxt; int ui = 0;
    if (!S.next(0, cur)) return;
    f32x4 acc[2][2][4][2];
#pragma unroll
    for (int a = 0; a < 2; ++a)
#pragma unroll
        for (int b = 0; b < 2; ++b)
#pragma unroll
            for (int m = 0; m < 4; ++m)
#pragma unroll
                for (int n = 0; n < 2; ++n) acc[a][b][m][n] = (f32x4){0.f, 0.f, 0.f, 0.f};
    bf16x8 At[4][2], B0[2][2], B1[2][2];
    const char* cA = (const char*)(g.A + cur.pass * g.passA) + (size_t)cur.pm * tstepA; const char* cB = (const char*)(g.Bt + cur.pass * g.passB) + (size_t)cur.pn * tstepB;
    PG8_STAGE(PG8_SB(0, 0), cB, voffB); PG8_STAGE(PG8_SB(0, 1), cB + hstepB, voffB); PG8_STAGE(PG8_SA(0, 0), cA, voffA); PG8_STAGE(PG8_SA(0, 1), cA + hstepA, voffA);
    if (wr == 1) PG8_BAR;
    PG8_WAIT_V(2); PG8_BAR;
    PG8_STAGE(PG8_SB(1, 0), cB + kstep, voffB); PG8_STAGE(PG8_SA(1, 0), cA + kstep, voffA); PG8_STAGE(PG8_SB(1, 1), cB + hstepB + kstep, voffB);
    PG8_WAIT_V(6); PG8_BAR;
    for (;;) {
        const bool has_next = S.next(ui + 1, nxt);
        const char* nA = has_next ? (const char*)(g.A + nxt.pass * g.passA) + (size_t)nxt.pm * tstepA : cA; const char* nB = has_next ? (const char*)(g.Bt + nxt.pass * g.passB) + (size_t)nxt.pn * tstepB : cB;
        for (int t = 0; t < nt; t += 2) {
            const bool last = (t == nt - 2);
            const char* a1 = cA + (size_t)(t + 1) * kstep;
            const char* a2 = last ? nA : cA + (size_t)(t + 2) * kstep; const char* b2 = last ? nB : cB + (size_t)(t + 2) * kstep;
            const char* a3 = a2 + kstep; const char* b3 = b2 + kstep;
            PG8_LDB(B0, 0, 0); PG8_LDB(B1, 0, 1); PG8_SCHED; PG8_LDA(At, 0, 0); PG8_STAGE(PG8_SA(1, 1), a1 + hstepA, voffA);
            PG8_WAIT_V(8); PG8_WAIT_L(0); PG8_BAR; PG8_MMA(0, 0, At, B0); PG8_MMA(0, 1, At, B1); PG8_BAR; PG8_SCHED;
            PG8_LDA(At, 0, 1); PG8_STAGE(PG8_SB(0, 0), b2, voffB); PG8_STAGE(PG8_SB(0, 1), b2 + hstepB, voffB); PG8_STAGE(PG8_SA(0, 0), a2, voffA);
            PG8_WAIT_V(8); PG8_WAIT_L(0); PG8_BAR; PG8_MMA(1, 0, At, B0); PG8_MMA(1, 1, At, B1); PG8_BAR; PG8_SCHED;
            PG8_LDB(B0, 1, 0); PG8_LDB(B1, 1, 1); PG8_SCHED; PG8_LDA(At, 1, 0); PG8_STAGE(PG8_SA(0, 1), a2 + hstepA, voffA);
            PG8_WAIT_V(8); PG8_WAIT_L(0); PG8_BAR; PG8_MMA(0, 0, At, B0); PG8_MMA(0, 1, At, B1); PG8_BAR; PG8_SCHED;
            PG8_LDA(At, 1, 1); PG8_STAGE(PG8_SB(1, 0), b3, voffB); PG8_STAGE(PG8_SB(1, 1), b3 + hstepB, voffB); PG8_STAGE(PG8_SA(1, 0), a3, voffA);
            PG8_WAIT_V(8); PG8_WAIT_L(0); PG8_BAR; PG8_MMA(1, 0, At, B0); PG8_MMA(1, 1, At, B1); PG8_BAR; PG8_SCHED;
        }
        if (wr == 0) PG8_BAR;
        E(acc, cur, wr, wc, fr, fq);
        if (!has_next) break;
#pragma unroll
        for (int a = 0; a < 2; ++a)
#pragma unroll
            for (int b = 0; b < 2; ++b)
#pragma unroll
                for (int m = 0; m < 4; ++m)
#pragma unroll
                    for (int n = 0; n < 2; ++n) acc[a][b][m][n] = (f32x4){0.f, 0.f, 0.f, 0.f};
        cur = nxt; cA = nA; cB = nB; ++ui;
        if (wr == 1) PG8_BAR;
    }
    PG8_WAIT_V(0);
    PG8_BAR;
#undef PG8_SA
#undef PG8_SB
#undef PG8_STAGE
#undef PG8_LDA
#undef PG8_LDB
#undef PG8_MMA
#undef PG8_WAIT_V
#undef PG8_WAIT_L
#undef PG8_BAR
#undef PG8_SCHED
}
}

#define XB_TMO      128
#define XB_XCNT(j)  (256  + 64 * (j))
#define XB_XSUB(j)  (1280 + 64 * (j))
#define XB_XGEN(j)  (2304 + 64 * (j))
#define XB_TOP      3328
#define XB_TOPGEN   3392
#define XCD_BAR_WORDS 3456
#define XB_SPIN_CAP (1u << 20)
DI unsigned xb_rfl(unsigned v) { return (unsigned)__builtin_amdgcn_readfirstlane((int)v); }
DI unsigned xb_ld(unsigned* p)              { return xb_rfl(__hip_atomic_load(p, __ATOMIC_RELAXED, __HIP_MEMORY_SCOPE_AGENT)); }
DI unsigned xb_add(unsigned* p, unsigned v) {
    unsigned old; unsigned long long sv;
    asm volatile("s_mov_b64 %1, exec\n\ts_mov_b64 exec, 1\n\tglobal_atomic_add %0, %2, %3, off sc0\n\ts_waitcnt vmcnt(0)\n\ts_mov_b64 exec, %1"
                 : "=&v"(old), "=&s"(sv) : "v"(p), "v"(v) : "memory");
    return xb_rfl(old);
}
DI unsigned xb_xcc_id() { return (unsigned)__builtin_amdgcn_s_getreg((3 << 11) | 20) & 0xFu; }
#define XB_SPIN(cond, bar) do { unsigned _sp = 0; while (cond) { __builtin_amdgcn_s_sleep(1); \
    if ((++_sp & 255u) == 0u) { if (xb_ld(&(bar)[XB_TMO])) break; if (_sp > XB_SPIN_CAP) { (void)xb_add(&(bar)[XB_TMO], 1u); break; } } } } while (0)
struct XcdBarrier { unsigned* bar; unsigned x; volatile LAS unsigned* st; };
DI void xcd_barrier_post(unsigned* bar, int wave_) {
    if (wave_ == 0) (void)xb_add(&bar[XB_XCNT(xb_xcc_id())], 1u);
}
DI void xcd_barrier_complete(unsigned* bar, unsigned x, unsigned& nloc, unsigned& nx) {
    const unsigned G = gridDim.x * gridDim.y * gridDim.z;
    unsigned sum, cnt, mine, sp = 0u;
    for (;;) {
        sum = 0u; cnt = 0u; mine = 0u;
#pragma unroll
        for (unsigned j = 0; j < 16; ++j) { const unsigned c = xb_ld(&bar[XB_XCNT(j)]); sum += c; cnt += (c > 0u) ? 1u : 0u; mine = (j == x) ? c : mine; }
        if (sum == G) break;
        __builtin_amdgcn_s_sleep(1);
        if ((++sp & 255u) == 0u) { if (xb_ld(&bar[XB_TMO])) break; if (sp > XB_SPIN_CAP) { (void)xb_add(&bar[XB_TMO], 1u); break; } }
    }
    nloc = mine > 0u ? mine : 1u; nx = cnt > 0u ? cnt : 1u;
}
DI void xcd_barrier(const XcdBarrier& b, const int wave_) {
    asm volatile("s_waitcnt vmcnt(0)" ::: "memory");
    __syncthreads();
    if (wave_ == 0) {
        unsigned* bar = b.bar;
        __builtin_amdgcn_s_waitcnt(0);
        unsigned nloc = xb_rfl(b.st[0]), nx = xb_rfl(b.st[1]);
        if (nloc == 0u) { xcd_barrier_complete(bar, b.x, nloc, nx); b.st[0] = nloc; b.st[1] = nx; }
        const unsigned old = xb_add(&bar[XB_XSUB(b.x)], 1u);
        const unsigned gen = old / nloc;
        if (old + 1u == (gen + 1u) * nloc) {
            __builtin_amdgcn_fence(__ATOMIC_RELEASE, "agent");
            asm volatile("s_waitcnt vmcnt(0)" ::: "memory");
            const unsigned og = xb_add(&bar[XB_TOP], 1u);
            const unsigned tg = og / nx;
            if (og + 1u == (tg + 1u) * nx) (void)xb_add(&bar[XB_TOPGEN], 1u);
            else XB_SPIN(xb_ld(&bar[XB_TOPGEN]) == tg, bar);
            __builtin_amdgcn_fence(__ATOMIC_ACQUIRE, "agent");
            asm volatile("s_waitcnt vmcnt(0)" ::: "memory");
        } else {
            XB_SPIN(xb_ld(&bar[XB_TOPGEN]) == gen, bar);
            __builtin_amdgcn_fence(__ATOMIC_ACQUIRE, "agent");
            asm volatile("s_waitcnt vmcnt(0)" ::: "memory");
        }
    }
    __syncthreads();
}

struct Args {
    const float* in[21]; float* out; unsigned char* ws; int ph_lo, ph_hi;
};
struct Frame {
    lptr lds;
    int tid, lane, wave, vcu, G;
    unsigned char* ws;
    const float* const* in;
};

DI void transpose_item(const float* W, int N, int src_col0, bf16_t* WT, int ldt, int dst_row0, int k0, LAS float* scr, int lane) {
    { const int c4 = lane & 7, r8 = lane >> 3; f32x4 t[8];
#pragma unroll
      for (int i = 0; i < 8; ++i) t[i] = *(const f32x4*)(W + (size_t)(k0 + 8 * i + r8) * N + src_col0 + 4 * c4);
#pragma unroll
      for (int i = 0; i < 8; ++i) { LAS float* d = scr + (8 * i + r8) * 33 + 4 * c4; d[0] = t[i].x; d[1] = t[i].y; d[2] = t[i].z; d[3] = t[i].w; } }
    LDS_WAIT(); asm volatile("" ::: "memory");
    const int c = lane & 7;
#pragma unroll
    for (int j = 0; j < 4; ++j) { const int n = (lane >> 3) + 8 * j; const LAS float* s = scr + (8 * c) * 33 + n;
        u32x4 o; o.x = pk2(s[0 * 33], s[1 * 33]); o.y = pk2(s[2 * 33], s[3 * 33]); o.z = pk2(s[4 * 33], s[5 * 33]); o.w = pk2(s[6 * 33], s[7 * 33]);
        *(u32x4*)(WT + (size_t)(dst_row0 + n) * ldt + k0 + 8 * c) = o; }
    LDS_WAIT(); asm volatile("" ::: "memory");
}
DI void cvt_stream(const float* src, bf16_t* dst, size_t n, int gw, int ngw, int lane) {
    const size_t n8 = n / 8;
    for (size_t i = (size_t)gw * 64 + lane; i < n8; i += (size_t)ngw * 64) {
        const f32x4 a = ((const f32x4*)src)[2 * i], b = ((const f32x4*)src)[2 * i + 1];
        u32x4 o; o.x = pk2(a[0], a[1]); o.y = pk2(a[2], a[3]); o.z = pk2(b[0], b[1]); o.w = pk2(b[2], b[3]);
        ((u32x4*)dst)[i] = o;
    }
}
DI void mod_item(const float* c, const float* ada_w, const float* ada_b, float* mod, int item, lptr lds, int tid) {
    const int l = item / 96, n0 = (item % 96) * 64;
    const int wave = tid >> 6, lane = tid & 63, cq = lane & 15, rsub = lane >> 4;
    LAS float* sc = (LAS float*)lds;
    LAS float* part = (LAS float*)(lds + 8192);
    for (int i = tid; i < 2 * D; i += NTHR) sc[i] = siluf_(c[i]);
    __syncthreads();
    const float* W = ada_w + (size_t)l * D * (6 * D) + n0 + 4 * cq;
    f32x4 a0 = {0.f, 0.f, 0.f, 0.f}, a1 = {0.f, 0.f, 0.f, 0.f};
#pragma unroll 8
    for (int i = 0; i < 32; ++i) { const int k = wave * 128 + i * 4 + rsub; const f32x4 w = *(const f32x4*)(W + (size_t)k * (6 * D));
        a0 += w * sc[k]; a1 += w * sc[D + k]; }
    LAS f32x4* pp = (LAS f32x4*)part;
    pp[((wave * 4 + rsub) * 2 + 0) * 16 + cq] = a0; pp[((wave * 4 + rsub) * 2 + 1) * 16 + cq] = a1;
    __syncthreads();
    if (tid < 128) { const int b = tid >> 6, col = tid & 63; float s = 0.f;
#pragma unroll
        for (int w = 0; w < 32; ++w) s += part[(w * 2 + b) * 64 + col];
        mod[((size_t)l * BATCH + b) * (6 * D) + n0 + col] = s + ada_b[(size_t)l * 6 * D + n0 + col]; }
    __syncthreads();
}

struct RowMod { f32x4 a[4], b[4]; };
DI void load_rowmod(RowMod& R, const float* g, const float* sc, const float* sh, int lane) {
#pragma unroll
    for (int j = 0; j < 4; ++j) { const f32x4 gv = ((const f32x4*)g)[lane + 64 * j], sv = ((const f32x4*)sc)[lane + 64 * j]; R.a[j] = gv * (sv + 1.0f); R.b[j] = ((const f32x4*)sh)[lane + 64 * j]; }
}
template <bool SIDE, bool H8 = false> DI void row_finish(const f32x4 (&v)[4], const RowMod& R, bf16_t* hrow, float* small_row, const LAS float* wsm, int lane, unsigned* h8row = nullptr, float* hsp = nullptr) {
    float s = 0.f;
#pragma unroll
    for (int j = 0; j < 4; ++j) s += (v[j].x * v[j].x + v[j].y * v[j].y) + (v[j].z * v[j].z + v[j].w * v[j].w);
    const float rstd = 1.0f / sqrtf(wave_sum(s, lane) * (1.0f / D) + EPS);
    f32x4 y[4];
#pragma unroll
    for (int j = 0; j < 4; ++j) { y[j] = v[j] * rstd * R.a[j] + R.b[j];
        u32x2 o; o.x = pk2(y[j].x, y[j].y); o.y = pk2(y[j].z, y[j].w); ((u32x2*)hrow)[lane + 64 * j] = o; }
    if (H8) {
        float am = 0.f;
#pragma unroll
        for (int j = 0; j < 4; ++j) am = fmaxf(fmaxf(am, fmaxf(fabsf(y[j].x), fabsf(y[j].y))), fmaxf(fabsf(y[j].z), fabsf(y[j].w)));
        am = fmaxf(am, shx<1>(am, lane)); am = fmaxf(am, shx<2>(am, lane)); am = fmaxf(am, shx<4>(am, lane)); am = fmaxf(am, shx<8>(am, lane)); am = fmaxf(am, shx<16>(am, lane)); am = fmaxf(am, shx<32>(am, lane));
        am = fmaxf(am, 1e-20f);
        const float sc = 127.0f / am;
#pragma unroll
        for (int j = 0; j < 4; ++j) {
            const int q0 = (int)__builtin_rintf(y[j].x * sc), q1 = (int)__builtin_rintf(y[j].y * sc), q2 = (int)__builtin_rintf(y[j].z * sc), q3 = (int)__builtin_rintf(y[j].w * sc);
            h8row[lane + 64 * j] = (unsigned)(q0 & 0xff) | ((unsigned)(q1 & 0xff) << 8) | ((unsigned)(q2 & 0xff) << 16) | ((unsigned)q3 << 24); }
        if (lane == 0) *hsp = am * (1.0f / 127.0f);
    }
    if (SIDE) {
        float p[8];
#pragma unroll
        for (int c = 0; c < 8; ++c) { float a = 0.f;
#pragma unroll
            for (int j = 0; j < 4; ++j) { const f32x4 w = ((const LAS f32x4*)(wsm + c * D))[lane + 64 * j]; a += (y[j].x * w.x + y[j].y * w.y) + (y[j].z * w.z + y[j].w * w.w); }
            p[c] = wave_sum(a, lane);
            if (c & 1) __builtin_amdgcn_sched_barrier(0); }
        if (lane < 8) { float r = p[0];
#pragma unroll
            for (int c = 1; c < 8; ++c) r = (lane == c) ? p[c] : r;
            small_row[lane] = r; }
    }
}
DI void stage_wsmall(const float* w_in_l, LAS float* wsm, int tid) {
    for (int i = tid; i < 8 * D; i += NTHR) { const int k = i >> 3, c = i & 7; wsm[c * D + k] = w_in_l[(size_t)k * IN_COLS + 4096 + c]; }
    __syncthreads();
}

#ifndef CHAIN_DUAL
#define CHAIN_DUAL 0
#endif
#ifndef CHAIN_OWN
#define CHAIN_OWN 1
#endif
#define WG_BAR() do { asm volatile("s_waitcnt lgkmcnt(0)" ::: "memory"); __builtin_amdgcn_s_barrier(); asm volatile("" ::: "memory"); } while (0)
constexpr int TILE_B = 2048;
constexpr int LDA_ = 272, LDT_ = 144;

struct MixP {
    const bf16_t* PROJ; const float* SMALL; const float* convw; const float* alog; const float* dtb; const float* lbl; int l;
    unsigned char* MT; unsigned char* NN; unsigned char* QT; unsigned char* OP; unsigned char* SS; float* DL;
};

DI void passA_gdn(lptr L, int tid_in, const MixP& P, int bh, int c) {
    int tid = tid_in; asm volatile("" : "+v"(tid));
    constexpr int R_KN = 0, R_QN = 18432, R_QE = 36864, R_VB = 54272, R_KBE = 71680, R_KD = 89088, R_AM = 106496, R_T = 123904, R_AQK = 133120, R_MISC = 142336, R_A10 = 144448;
    constexpr int R_UT = R_KN, R_WT = R_QN, R_D0 = R_KN, R_D1 = R_KN + 2560, R_XT = R_KN + 5120;
    const int lane = tid & 63, w = __builtin_amdgcn_readfirstlane(tid >> 6), r = lane & 31, hh = lane >> 5;
    const int b = bh >> 2, h = bh & 3; const size_t row0 = (size_t)b * SEQ + 64 * c;
    LAS float* sb = (LAS float*)(L + R_MISC); LAS float* sbeta = sb + 64; LAS float* seb = sb + 128; LAS float* sekd = sb + 192; LAS float* ssq = sb + 256; LAS float* sbl = sb + 384;
    WG_BAR();
    constexpr int RAWQ = R_AM, RAWK = R_T, RAWV = R_KD;
    const int cgx = tid & 15, sg = tid >> 4;
    {
        u32x4 raw[7];
#pragma unroll
        for (int j = 0; j < 7; ++j) { const int idx = tid + 512 * j, rr = idx / 48, rem = idx - 48 * rr, ty = rem >> 4, cc = rem & 15;
            raw[j] = (u32x4){0u, 0u, 0u, 0u};
            if (idx < 67 * 48 && 64 * c + rr - 3 >= 0) raw[j] = *(const u32x4*)(P.PROJ + (row0 + rr - 3) * NPROJ + PC_QKV + ty * 512 + h * 128 + cc * 8); }
        if (tid < 64) {
            const float* sm = P.SMALL + (row0 + tid) * 8;
            const float beta = sigmoidf_(sm[h]); const float x = sm[4 + h] + P.dtb[h];
            const float sp = x > 20.f ? x : __logf(1.0f + __expf(x));
            float bb = -__expf(P.alog[h]) * sp;
#pragma unroll
            for (int o = 1; o < 64; o <<= 1) { const float n = __int_as_float(__builtin_amdgcn_ds_bpermute((lane - o) << 2, __float_as_int(bb))); if (lane >= o) bb += n; }
            const float blast = __int_as_float(__builtin_amdgcn_readlane(__float_as_int(bb), 63));
            sb[tid] = bb; sbeta[tid] = beta; seb[tid] = __expf(bb); sekd[tid] = __expf(blast - bb); if (tid == 0) sbl[0] = __expf(blast);
        } else if (tid < 192) ssq[tid - 64] = 0.f;
#pragma unroll
        for (int j = 0; j < 7; ++j) { const int idx = tid + 512 * j, rr = idx / 48, rem = idx - 48 * rr, ty = rem >> 4, cc = rem & 15;
            if (idx < 67 * 48) *(LAS u32x4*)(L + (ty == 0 ? RAWQ : ty == 1 ? RAWK : RAWV) + rr * 256 + cc * 16) = raw[j]; }
    }
    WG_BAR();
    float val[3][2][8];
#pragma unroll
    for (int ty = 0; ty < 3; ++ty) {
        const int ch = ty * 512 + h * 128 + cgx * 8;
        f32x4 w[4][2];
#pragma unroll
        for (int j = 0; j < 4; ++j) { w[j][0] = *(const f32x4*)(P.convw + j * 1536 + ch); w[j][1] = *(const f32x4*)(P.convw + j * 1536 + ch + 4); }
        lptr rb = L + (ty == 0 ? RAWQ : ty == 1 ? RAWK : RAWV) + (2 * sg) * 256 + cgx * 16;
        u32x4 xr[5];
#pragma unroll
        for (int j = 0; j < 5; ++j) xr[j] = *(const LAS u32x4*)(rb + j * 256);
#pragma unroll
        for (int q = 0; q < 2; ++q) {
            float a[8];
#pragma unroll
            for (int e = 0; e < 8; ++e) a[e] = 0.f;
#pragma unroll
            for (int j = 0; j < 4; ++j) { const u32x4 x = xr[q + j];
                a[0] += bf_lo(x.x) * w[j][0].x; a[1] += bf_hi(x.x) * w[j][0].y; a[2] += bf_lo(x.y) * w[j][0].z; a[3] += bf_hi(x.y) * w[j][0].w;
                a[4] += bf_lo(x.z) * w[j][1].x; a[5] += bf_hi(x.z) * w[j][1].y; a[6] += bf_lo(x.w) * w[j][1].z; a[7] += bf_hi(x.w) * w[j][1].w; }
            float ss = 0.f;
#pragma unroll
            for (int e = 0; e < 8; ++e) { const float v = siluf_(a[e]); val[ty][q][e] = v; ss += v * v; }
            if (ty < 2) __hip_atomic_fetch_add(&ssq[ty * 64 + 2 * sg + q], ss, __ATOMIC_RELAXED, __HIP_MEMORY_SCOPE_WORKGROUP);
        }
    }
    WG_BAR();
#pragma unroll
    for (int ty = 0; ty < 3; ++ty)
#pragma unroll
        for (int q = 0; q < 2; ++q) {
            const int s = 2 * sg + q; const int off = s * LDA_ + cgx * 16;
            float f1, f2 = 0.f, f3 = 0.f;
            if (ty == 0) { f1 = 1.0f / sqrtf(ssq[s] + EPS) * 0.08838834764831845f; f2 = f1 * seb[s]; }
            else if (ty == 1) { f1 = 1.0f / sqrtf(ssq[64 + s] + EPS); f2 = f1 * sbeta[s] * seb[s]; f3 = f1 * sekd[s]; }
            else f1 = sbeta[s];
#define VA(e) val[ty][q][e]
            { u32x4 o; o.x = pk2(VA(0) * f1, VA(1) * f1); o.y = pk2(VA(2) * f1, VA(3) * f1); o.z = pk2(VA(4) * f1, VA(5) * f1); o.w = pk2(VA(6) * f1, VA(7) * f1); *(LAS u32x4*)(L + (ty == 0 ? R_QN : ty == 1 ? R_KN : R_VB) + off) = o; }
            if (ty < 2) { u32x4 o; o.x = pk2(VA(0) * f2, VA(1) * f2); o.y = pk2(VA(2) * f2, VA(3) * f2); o.z = pk2(VA(4) * f2, VA(5) * f2); o.w = pk2(VA(6) * f2, VA(7) * f2); *(LAS u32x4*)(L + (ty == 0 ? R_QE : R_KBE) + off) = o; }
            if (ty == 1) { u32x4 o; o.x = pk2(VA(0) * f3, VA(1) * f3); o.y = pk2(VA(2) * f3, VA(3) * f3); o.z = pk2(VA(4) * f3, VA(5) * f3); o.w = pk2(VA(6) * f3, VA(7) * f3); *(LAS u32x4*)(L + R_KD + off) = o; }
#undef VA
        }
    WG_BAR();
    {
        const int tl = w & 3, ta = tl >> 1, tb = tl & 1;
        f32x16 acc = zero16();
        lptr Bsrc = L + (w < 4 ? R_KN : R_QN);
#pragma unroll
        for (int s8 = 0; s8 < 8; ++s8) acc = MFMA32(fragK(L + R_KN, LDA_, 32 * ta, 16 * s8, lane), fragK(Bsrc, LDA_, 32 * tb, 16 * s8, lane), acc);
        const int ci = 32 * tb + r; const float bcol = sb[ci];
        if (w < 4) {
            const float bet = sbeta[ci];
#pragma unroll
            for (int g = 0; g < 4; ++g) { f32x4 o;
#pragma unroll
                for (int e = 0; e < 4; ++e) { const int jj = 32 * ta + 8 * g + 4 * hh + e; o[e] = (jj < ci) ? bet * acc[4 * g + e] * __expf(bcol - sb[jj]) : 0.f; }
                *(LAS f32x4*)(L + R_AM + ci * 272 + (32 * ta + 8 * g + 4 * hh) * 4) = o;
                if (ta == 0 && tb == 1) { u32x2 v; v.x = pk2(o[0], o[1]); v.y = pk2(o[2], o[3]); *(LAS u32x2*)(L + R_A10 + r * 80 + (8 * g + 4 * hh) * 2) = v; } }
        } else {
            f32x16 o;
#pragma unroll
            for (int i = 0; i < 16; ++i) { const int ss_ = 32 * ta + crow(i, hh); o[i] = (ss_ <= ci) ? acc[i] * __expf(bcol - sb[ss_]) : 0.f; }
            storeT_bf16(o, L + R_AQK, LDT_, 32 * tb, 32 * ta, lane);
        }
    }
    WG_BAR();
#ifdef PROBE_S3X
    for (int rep3_ = 0; rep3_ < 2; ++rep3_)
#endif
    if (w == 0) {
        const int blk = hh, cc = r;
        float x[32];
#pragma unroll
        for (int i = 0; i < 32; ++i) x[i] = 0.f;
        f32x4 rowc[8], rown[8];
#pragma unroll
        for (int i = 0; i < 32; ++i) {
            if (i + 1 < 32) { const LAS f32x4* an = (const LAS f32x4*)(L + R_AM + (32 * blk + i + 1) * 272 + (32 * blk) * 4);
#pragma unroll
                for (int jq = 0; jq < (i + 4) / 4; ++jq) rown[jq] = an[jq]; }
            float a = (i == cc) ? 1.f : 0.f;
#pragma unroll
            for (int jq = 0; jq < (i + 3) / 4; ++jq) { const f32x4 a4 = rowc[jq]; a -= (a4.x * x[4 * jq] + a4.y * x[4 * jq + 1]) + (a4.z * x[4 * jq + 2] + a4.w * x[4 * jq + 3]); }
            x[i] = a;
#pragma unroll
            for (int jq = 0; jq < 8; ++jq) rowc[jq] = rown[jq];
            __builtin_amdgcn_sched_barrier(0);
        }
#pragma unroll
        for (int i = 0; i < 32; ++i) { const bf16_t v = f2bf(x[i]);
            *(LAS bf16_t*)(L + (blk ? R_D1 : R_D0) + i * 80 + cc * 2) = v;
            *(LAS bf16_t*)(L + R_T + (32 * blk + i) * LDT_ + (32 * blk + cc) * 2) = v; }
#pragma unroll
        for (int i = 0; i < 16; ++i) *(LAS bf16_t*)(L + R_T + (16 * blk + i) * LDT_ + (32 + cc) * 2) = 0;
        LDS_WAIT();
        f32x16 xa = zero16();
#pragma unroll
        for (int s2 = 0; s2 < 2; ++s2) xa = MFMA32(fragK(L + R_A10, 80, 0, 16 * s2, lane), fragT(L + R_D0, 80, 16 * s2, 0, lane), xa);
        storeT_bf16(xa, L + R_XT, 80, 0, 0, lane);
        LDS_WAIT();
        f32x16 t10 = zero16();
#pragma unroll
        for (int s2 = 0; s2 < 2; ++s2) t10 = MFMA32(fragK(L + R_XT, 80, 0, 16 * s2, lane), fragK(L + R_D1, 80, 0, 16 * s2, lane), t10);
#pragma unroll
        for (int i = 0; i < 16; ++i) t10[i] = -t10[i];
        storeT_bf16(t10, L + R_T, LDT_, 32, 0, lane);
    }
    WG_BAR();
#pragma unroll
    for (int q = 0; q < 2; ++q) {
        const int id = 2 * w + q, which = id >> 3, ti = (id >> 2) & 1, di = id & 3;
        f32x16 acc = zero16();
        lptr Bsrc = L + (which ? R_KBE : R_VB);
#pragma unroll
        for (int s4 = 0; s4 < 4; ++s4) acc = MFMA32(fragK(L + R_T, LDT_, 32 * ti, 16 * s4, lane), fragT(Bsrc, LDA_, 16 * s4, 32 * di, lane), acc);
        storeT_bf16(acc, L + (which ? R_WT : R_UT), LDT_, 32 * di, 32 * ti, lane);
    }
    WG_BAR();
    const size_t itg = (size_t)1024 + bh * 128 + c, itm = (size_t)bh * 128 + c;
    const float bl = sbl[0];
#pragma unroll 1
    for (int q = 0; q < 6; ++q) {
        const int t = w + 8 * q;
        f32x16 acc = zero16();
        if (q < 2) {
            const int rt = t >> 2, dt = t & 3;
#pragma unroll
            for (int s4 = 0; s4 < 4; ++s4) acc = MFMA32(fragT(L + R_KD, LDA_, 16 * s4, 32 * rt, lane), fragK(L + R_UT, LDT_, 32 * dt, 16 * s4, lane), acc);
            gstore_tile(P.NN + (itg * 16 + rt * 4 + dt) * TILE_B, lane, acc);
        } else if (q < 4) {
            const int t2 = t - 16, kt = t2 >> 2, rt = t2 & 3;
#pragma unroll
            for (int s4 = 0; s4 < 4; ++s4) acc = MFMA32(fragK(L + R_WT, LDT_, 32 * kt, 16 * s4, lane), fragT(L + R_KD, LDA_, 16 * s4, 32 * rt, lane), acc);
#pragma unroll
            for (int i = 0; i < 16; ++i) acc[i] = ((kt == rt) && (crow(i, hh) == r) ? bl : 0.f) - acc[i];
            gstore_tile(P.MT + (itm * 16 + kt * 4 + rt) * TILE_B, lane, acc);
        } else if (q == 4) {
            const int t2 = t - 32, tt = t2 >> 2, dt = t2 & 3;
#pragma unroll
            for (int s4 = 0; s4 < 4; ++s4) acc = MFMA32(fragK(L + R_AQK, LDT_, 32 * tt, 16 * s4, lane), fragK(L + R_UT, LDT_, 32 * dt, 16 * s4, lane), acc);
            gstore_tile(P.OP + (itg * 8 + tt * 4 + dt) * TILE_B, lane, acc);
        } else {
            const int t2 = t - 40, kt = t2 >> 1, tt = t2 & 1;
#pragma unroll
            for (int s4 = 0; s4 < 4; ++s4) acc = MFMA32(fragK(L + R_WT, LDT_, 32 * kt, 16 * s4, lane), fragK(L + R_AQK, LDT_, 32 * tt, 16 * s4, lane), acc);
#pragma unroll
            for (int g = 0; g < 4; ++g) { const u32x2 qv = *(const LAS u32x2*)(L + R_QE + (32 * tt + r) * LDA_ + (32 * kt + 8 * g + 4 * hh) * 2);
                acc[4 * g] = bf_lo(qv.x) - acc[4 * g]; acc[4 * g + 1] = bf_hi(qv.x) - acc[4 * g + 1]; acc[4 * g + 2] = bf_lo(qv.y) - acc[4 * g + 2]; acc[4 * g + 3] = bf_hi(qv.y) - acc[4 * g + 3]; }
            gstore_tile(P.QT + (itg * 8 + kt * 2 + tt) * TILE_B, lane, acc);
        }
    }
}

DI void passA_hgrn(lptr L, int tid_in, const MixP& P, int bh, int c) {
    int tid = tid_in; asm volatile("" : "+v"(tid));
    constexpr int R_QT = 0, R_KTA = 17408, R_KTB = 34816, R_QE = 43520, R_KD = 60928, R_VV = 78336, R_ATT = 95744, R_TOT = 104960, R_REF = 107008;
    const int lane = tid & 63, w = __builtin_amdgcn_readfirstlane(tid >> 6), r = lane & 31, hh = lane >> 5;
    const int b = bh >> 2, h = bh & 3; const size_t row0 = (size_t)b * SEQ + 64 * c;
    const int k = tid & 127, qr = tid >> 7;
    LAS float* tot = (LAS float*)(L + R_TOT); LAS float* ref = (LAS float*)(L + R_REF);
    float lb = 0.f;
    if (P.l > 0) lb = sigmoidf_(P.lbl[512 + h * 128 + k] - P.lbl[h * 128 + k]);
    WG_BAR();
    float bloc[16], kk_[16]; float run = 0.f;
    bf16_t hfr[16], hqr[16];
    {
        const bf16_t* pf = P.PROJ + (row0 + 16 * qr) * NPROJ + PC_HF + h * 128 + k;
        const bf16_t* pq = P.PROJ + (row0 + 16 * qr) * NPROJ + PC_HQ + h * 128 + k;
#pragma unroll
        for (int i = 0; i < 16; ++i) hfr[i] = pf[(size_t)i * NPROJ];
#pragma unroll
        for (int i = 0; i < 16; ++i) hqr[i] = pq[(size_t)i * NPROJ];
        u32x4 vraw[2];
#pragma unroll
        for (int q = 0; q < 2; ++q) { const int ch = tid + 512 * q, row = ch >> 4, cc = ch & 15; vraw[q] = *(const u32x4*)(P.PROJ + (row0 + row) * NPROJ + PC_HI + h * 128 + cc * 8); }
        asm volatile("" ::: "memory");
#pragma unroll
        for (int i = 0; i < 16; ++i) { const float hf = bf1(hfr[i]); const float fg = lb + (1.0f - lb) * sigmoidf_(hf); run += __logf(fg); bloc[i] = run; kk_[i] = 1.0f - fg; }
        tot[qr * 128 + k] = run;
#pragma unroll
        for (int q = 0; q < 2; ++q) { const int ch = tid + 512 * q, row = ch >> 4, cc = ch & 15; *(LAS u32x4*)(L + R_VV + row * LDA_ + cc * 16) = vraw[q]; }
    }
    WG_BAR();
    float off = 0.f, blast = 0.f;
#pragma unroll
    for (int q = 0; q < 4; ++q) { const float t_ = tot[q * 128 + k]; blast += t_; if (q < qr) off += t_; }
#pragma unroll
    for (int i = 0; i < 16; ++i) bloc[i] += off;
    if (qr == 0) ref[k] = bloc[0];
    if (qr == 2) ref[128 + k] = bloc[0];
    WG_BAR();
    {
        const float ref0 = ref[k], ref1 = ref[128 + k]; const float rf = (qr < 2) ? ref0 : ref1;
#pragma unroll
        for (int i = 0; i < 16; ++i) { const int t = 16 * qr + i; const float q_ = siluf_(bf1(hqr[i])); const float bt = bloc[i];
            *(LAS bf16_t*)(L + R_QE + t * LDA_ + k * 2) = f2bf(q_ * __expf(bt));
            *(LAS bf16_t*)(L + R_KD + t * LDA_ + k * 2) = f2bf(kk_[i] * __expf(blast - bt));
            *(LAS bf16_t*)(L + R_QT + t * LDA_ + k * 2) = f2bf(q_ * __expf(fminf(bt - rf, 80.f)));
            *(LAS bf16_t*)(L + R_KTA + t * LDA_ + k * 2) = f2bf(kk_[i] * __expf(fminf(rf - bt, 80.f)));
            if (qr < 2) *(LAS bf16_t*)(L + R_KTB + t * LDA_ + k * 2) = f2bf(kk_[i] * __expf(ref1 - bt)); }
        if (qr == 0) { const int kt = k >> 5, kr = k & 31, h2 = (kr >> 2) & 1, i2 = (kr & 3) + 4 * (kr >> 3);
            P.DL[(((size_t)bh * 128 + c) * 4 + kt) * 32 + h2 * 16 + i2] = __expf(blast); }
    }
    WG_BAR();
    const size_t it = (size_t)bh * 128 + c;
    if (w < 3) {
        const int sa = (w == 2) ? 32 : 0, tb = (w == 0) ? 0 : 32;
        lptr Asrc = L + (w == 1 ? R_KTB : R_KTA);
        f32x16 acc = zero16();
#pragma unroll
        for (int s8 = 0; s8 < 8; ++s8) acc = MFMA32(fragK(Asrc, LDA_, sa, 16 * s8, lane), fragK(L + R_QT, LDA_, tb, 16 * s8, lane), acc);
        if (w != 1) {
#pragma unroll
            for (int i = 0; i < 16; ++i) acc[i] = (crow(i, hh) <= r) ? acc[i] : 0.f; }
        storeT_bf16(acc, L + R_ATT, LDT_, tb, sa, lane);
    } else if (w == 3) {
        storeT_bf16(zero16(), L + R_ATT, LDT_, 0, 32, lane);
    } else {
#pragma unroll
        for (int q = 0; q < 4; ++q) { const int t = (w - 4) * 4 + q, rt = t >> 2, dt = t & 3;
            f32x16 acc = zero16();
#pragma unroll
            for (int s4 = 0; s4 < 4; ++s4) acc = MFMA32(fragT(L + R_KD, LDA_, 16 * s4, 32 * rt, lane), fragT(L + R_VV, LDA_, 16 * s4, 32 * dt, lane), acc);
            gstore_tile(P.NN + (it * 16 + rt * 4 + dt) * TILE_B, lane, acc); }
    }
    {
        const int kt = w >> 1, tt = w & 1; u32x2 g[4];
#pragma unroll
        for (int q = 0; q < 4; ++q) g[q] = *(const LAS u32x2*)(L + R_QE + (32 * tt + r) * LDA_ + (32 * kt + 8 * q + 4 * hh) * 2);
        u32x4* p = (u32x4*)(P.QT + (it * 8 + kt * 2 + tt) * TILE_B + lane * 32);
        if (WT_TILE == 2) { __builtin_nontemporal_store((u32x4){g[0].x, g[0].y, g[1].x, g[1].y}, p); __builtin_nontemporal_store((u32x4){g[2].x, g[2].y, g[3].x, g[3].y}, p + 1); }
        else if (WT_TILE) { st16_wt(p, (u32x4){g[0].x, g[0].y, g[1].x, g[1].y}); st16_wt(p + 1, (u32x4){g[2].x, g[2].y, g[3].x, g[3].y}); }
        else { p[0] = (u32x4){g[0].x, g[0].y, g[1].x, g[1].y}; p[1] = (u32x4){g[2].x, g[2].y, g[3].x, g[3].y}; }
    }
    WG_BAR();
    {
        const int tt = w >> 2, dt = w & 3;
        f32x16 acc = zero16();
#pragma unroll
        for (int s4 = 0; s4 < 4; ++s4) acc = MFMA32(fragK(L + R_ATT, LDT_, 32 * tt, 16 * s4, lane), fragT(L + R_VV, LDA_, 16 * s4, 32 * dt, lane), acc);
        gstore_tile(P.OP + (it * 8 + tt * 4 + dt) * TILE_B, lane, acc);
    }
}

DI void passB_gdn(lptr L, int tid, const MixP& P, int j) {
    const int lane = tid & 63, w = __builtin_amdgcn_readfirstlane(tid >> 6);
    const int bh = j >> 2, dt = j & 3;
    if (w > 4) {
#pragma unroll 1
        for (int c = 0; c < 128; ++c) WG_BAR();
        return;
    }
    if (w == 4) {
        unsigned char* SSb = P.SS + ((size_t)1024 + bh * 128) * 16 * TILE_B + dt * TILE_B + lane * 32;
#pragma unroll
        for (int kt = 0; kt < 4; ++kt) { u32x4* ps = (u32x4*)(SSb + kt * 8192); ps[0] = (u32x4){0u, 0u, 0u, 0u}; ps[1] = (u32x4){0u, 0u, 0u, 0u}; }
#pragma unroll 1
        for (int c = 0; c < 128; ++c) {
            WG_BAR();
            if (c < 127) {
                if (CHAIN_OWN) __builtin_amdgcn_s_sleep(3);
                lptr xb = L + (c & 1) * 8192;
#pragma unroll
                for (int kt = 0; kt < 4; ++kt) { const LAS u32x4* px = (const LAS u32x4*)(xb + kt * 2048 + lane * 32); const u32x4 a = px[0], b = px[1];
                    unsigned char* ps = SSb + (size_t)(c + 1) * 32768 + kt * 8192; if (WT_CHAIN) { st16_wt(ps, a); st16_wt(ps + 16, b); } else { *(u32x4*)ps = a; *(u32x4*)(ps + 16) = b; } }
            }
        }
        return;
    }
    const int rt = w;
    const unsigned char* MTb = P.MT + ((size_t)bh * 128) * 16 * TILE_B + rt * TILE_B + lane * 32;
    const unsigned char* NNb = P.NN + ((size_t)1024 + bh * 128) * 16 * TILE_B + (rt * 4 + dt) * TILE_B + lane * 32;
    u32x4 A[4][4][2], Nn[4][2];
    u32x4 Sb[4][2], mylo, myhi;
#pragma unroll
    for (int kt = 0; kt < 4; ++kt) { Sb[kt][0] = (u32x4){0u, 0u, 0u, 0u}; Sb[kt][1] = (u32x4){0u, 0u, 0u, 0u}; }
#define PB_LOAD(buf, cc) do { const unsigned char* pa = MTb + (size_t)(cc) * 32768; _Pragma("unroll") for (int kt = 0; kt < 4; ++kt) { A[buf][kt][0] = *(const u32x4*)(pa + kt * 8192); A[buf][kt][1] = *(const u32x4*)(pa + kt * 8192 + 16); } \
        const unsigned char* pn = NNb + (size_t)(cc) * 32768; Nn[buf][0] = *(const u32x4*)pn; Nn[buf][1] = *(const u32x4*)(pn + 16); } while (0)
#define PB_STEP(buf, cc) do { \
        f32x16 acc = unpack_tile(Nn[buf][0], Nn[buf][1]); \
        if (CHAIN_DUAL) { f32x16 ac2 = zero16();   \
            _Pragma("unroll") for (int kt = 0; kt < 4; ++kt) { acc = MFMA32(AS_BF8(A[buf][kt][0]), AS_BF8(Sb[kt][0]), acc); ac2 = MFMA32(AS_BF8(A[buf][kt][1]), AS_BF8(Sb[kt][1]), ac2); } \
            _Pragma("unroll") for (int i = 0; i < 16; ++i) acc[i] += ac2[i]; } \
        else { _Pragma("unroll") for (int kt = 0; kt < 4; ++kt) { acc = MFMA32(AS_BF8(A[buf][kt][0]), AS_BF8(Sb[kt][0]), acc); acc = MFMA32(AS_BF8(A[buf][kt][1]), AS_BF8(Sb[kt][1]), acc); } } \
        pack_tile(acc, mylo, myhi); \
        lptr xb = L + ((cc) & 1) * 8192; \
        { LAS u32x4* px = (LAS u32x4*)(xb + rt * 2048 + lane * 32); px[0] = mylo; px[1] = myhi; } \
        WG_BAR(); \
        _Pragma("unroll") for (int kt = 0; kt < 4; ++kt) { if (CHAIN_OWN && kt == rt) { Sb[kt][0] = mylo; Sb[kt][1] = myhi; }   \
            else { const LAS u32x4* px = (const LAS u32x4*)(xb + kt * 2048 + lane * 32); Sb[kt][0] = px[0]; Sb[kt][1] = px[1]; } } \
        __builtin_amdgcn_sched_barrier(0);   } while (0)
    PB_LOAD(0, 0); PB_LOAD(1, 1); PB_LOAD(2, 2);
#pragma unroll 1
    for (int c = 0; c < 124; c += 4) {
        PB_LOAD(3, c + 3); PB_STEP(0, c);
        PB_LOAD(0, c + 4); PB_STEP(1, c + 1);
        PB_LOAD(1, c + 5); PB_STEP(2, c + 2);
        PB_LOAD(2, c + 6); PB_STEP(3, c + 3);
    }
    PB_LOAD(3, 127); PB_STEP(0, 124); PB_STEP(1, 125); PB_STEP(2, 126); PB_STEP(3, 127);
#undef PB_LOAD
#undef PB_STEP
}
DI void passB_hgrn(int lane, const MixP& P, int item) {
    const int half = item & 1, tile = (item >> 1) & 15, bh = item >> 5, kt = tile >> 2, hh = lane >> 5;
    const unsigned char* NNb = P.NN + ((size_t)bh * 128) * 16 * TILE_B + tile * TILE_B + lane * 32 + half * 16;
    unsigned char* SSb = P.SS + ((size_t)bh * 128) * 16 * TILE_B + tile * TILE_B + lane * 32 + half * 16;
    const float* DLb = P.DL + (((size_t)bh * 128) * 4 + kt) * 32 + hh * 16 + half * 8;
    float S[8];
#pragma unroll
    for (int e = 0; e < 8; ++e) S[e] = 0.f;
    u32x4 nA[8]; f32x4 dA[8][2]; u32x4 so[8];
#define HB_LOAD(nb, db, c0) do { _Pragma("unroll") for (int i = 0; i < 8; ++i) { nb[i] = *(const u32x4*)(NNb + (size_t)((c0) + i) * 32768); \
        const f32x4* pd = (const f32x4*)(DLb + (size_t)((c0) + i) * 128); db[i][0] = pd[0]; db[i][1] = pd[1]; } } while (0)
#define HB_RUN(nb, db) do { _Pragma("unroll") for (int i = 0; i < 8; ++i) { \
        so[i].x = pk2(S[0], S[1]); so[i].y = pk2(S[2], S[3]); so[i].z = pk2(S[4], S[5]); so[i].w = pk2(S[6], S[7]); \
        const u32x4 n = nb[i]; \
        S[0] = S[0] * db[i][0][0] + bf_lo(n.x); S[1] = S[1] * db[i][0][1] + bf_hi(n.x); S[2] = S[2] * db[i][0][2] + bf_lo(n.y); S[3] = S[3] * db[i][0][3] + bf_hi(n.y); \
        S[4] = S[4] * db[i][1][0] + bf_lo(n.z); S[5] = S[5] * db[i][1][1] + bf_hi(n.z); S[6] = S[6] * db[i][1][2] + bf_lo(n.w); S[7] = S[7] * db[i][1][3] + bf_hi(n.w); } } while (0)
#define HB_STORE(c0) do { _Pragma("unroll") for (int i = 0; i < 8; ++i) { if (WT_CHAIN) st16_wt(SSb + (size_t)((c0) + i) * 32768, so[i]); else *(u32x4*)(SSb + (size_t)((c0) + i) * 32768) = so[i]; } } while (0)
    HB_LOAD(nA, dA, 0);
#pragma unroll 1
    for (int c = 0; c < 128; c += 8) {
        HB_RUN(nA, dA); if (c + 8 < 128) HB_LOAD(nA, dA, c + 8); HB_STORE(c);
    }
#undef HB_LOAD
#undef HB_RUN
#undef HB_STORE
}

struct PCLoad { u32x4 ol, oh, ql[4], qh[4], sl[4], sh_[4]; bf16_t g[16]; };
DI void passC_load(PCLoad& T, int lane, int w, const MixP& P, int it) {
    const int r = lane & 31, hh = lane >> 5, tt = w >> 2, dt = w & 3;
    const int br = it >> 10, bhc = it & 1023, bh = bhc >> 7, c = bhc & 127, b = bh >> 2, h = bh & 3;
    const size_t row0 = (size_t)b * SEQ + 64 * c;
    gload_tile(P.OP + ((size_t)it * 8 + tt * 4 + dt) * TILE_B, lane, T.ol, T.oh);
#pragma unroll
    for (int kt = 0; kt < 4; ++kt) { gload_tile(P.QT + ((size_t)it * 8 + kt * 2 + tt) * TILE_B, lane, T.ql[kt], T.qh[kt]); gload_tile(P.SS + ((size_t)it * 16 + kt * 4 + dt) * TILE_B, lane, T.sl[kt], T.sh_[kt]); }
    const int gcol = (br ? PC_GG : PC_HG) + h * 128 + 32 * dt + r;
#pragma unroll
    for (int i = 0; i < 16; ++i) T.g[i] = P.PROJ[(row0 + 32 * tt + crow(i, hh)) * NPROJ + gcol];
    __builtin_amdgcn_sched_barrier(0);
}
DI void passC_finish(const PCLoad& T, lptr L, int lane, int w, int it, int par, const float* ng_h, const float* ng_g, bf16_t* Y) {
    const int r = lane & 31, hh = lane >> 5, tt = w >> 2, dt = w & 3;
    const int br = it >> 10, bhc = it & 1023, bh = bhc >> 7, c = bhc & 127, b = bh >> 2, h = bh & 3;
    const size_t row0 = (size_t)b * SEQ + 64 * c;
    f32x16 acc = unpack_tile(T.ol, T.oh);
#pragma unroll
    for (int kt = 0; kt < 4; ++kt) { acc = MFMA32(AS_BF8(T.ql[kt]), AS_BF8(T.sl[kt]), acc); acc = MFMA32(AS_BF8(T.qh[kt]), AS_BF8(T.sh_[kt]), acc); }
    LAS float* ps = (LAS float*)(L + par * 1024);
#pragma unroll
    for (int i = 0; i < 16; ++i) { float s = acc[i] * acc[i];
        s += shx<1>(s, lane); s += shx<2>(s, lane); s += shx<4>(s, lane); s += shx<8>(s, lane); s += shx<16>(s, lane);
        if (r == 0) ps[dt * 64 + 32 * tt + crow(i, hh)] = s; }
    WG_BAR();
    const int d = 32 * dt + r; const float ng = (br ? ng_g : ng_h)[d];
#pragma unroll
    for (int i = 0; i < 16; ++i) { const int t = 32 * tt + crow(i, hh);
        const float tot = (ps[t] + ps[64 + t]) + (ps[128 + t] + ps[192 + t]);
        const float rstd = 1.0f / sqrtf(tot * (1.0f / 128.0f) + EPS);
        Y[(row0 + t) * D + br * 512 + h * 128 + d] = f2bf(acc[i] * rstd * ng * siluf_(bf1(T.g[i]))); }
}

DI void passC_wave(int lane, const MixP& P, int it, int tt, const float* ng_h, const float* ng_g, bf16_t* Y) {
    const int r = lane & 31, hh = lane >> 5;
    const int br = it >> 10, bhc = it & 1023, bh = bhc >> 7, c = bhc & 127, b = bh >> 2, h = bh & 3;
    const size_t rowb = (size_t)b * SEQ + 64 * c + 32 * tt;
    u32x4 ql[4], qh[4];
#pragma unroll
    for (int kt = 0; kt < 4; ++kt) gload_tile(P.QT + ((size_t)it * 8 + kt * 2 + tt) * TILE_B, lane, ql[kt], qh[kt]);
    u32x4 ol[2], oh[2], sl[2][4], sh_[2][4];
#define PC_LD(buf, dt) do { gload_tile(P.OP + ((size_t)it * 8 + tt * 4 + (dt)) * TILE_B, lane, ol[buf], oh[buf]); \
        _Pragma("unroll") for (int kt = 0; kt < 4; ++kt) gload_tile(P.SS + ((size_t)it * 16 + kt * 4 + (dt)) * TILE_B, lane, sl[buf][kt], sh_[buf][kt]); } while (0)
    f32x16 acc[4];
    PC_LD(0, 0);
#pragma unroll
    for (int dt = 0; dt < 4; ++dt) {
        if (dt < 3) PC_LD((dt + 1) & 1, dt + 1);
        __builtin_amdgcn_sched_barrier(0);
        f32x16 a = unpack_tile(ol[dt & 1], oh[dt & 1]);
#pragma unroll
        for (int kt = 0; kt < 4; ++kt) { a = MFMA32(AS_BF8(ql[kt]), AS_BF8(sl[dt & 1][kt]), a); a = MFMA32(AS_BF8(qh[kt]), AS_BF8(sh_[dt & 1][kt]), a); }
        acc[dt] = a;
    }
#undef PC_LD
    const bf16_t* gp = P.PROJ + rowb * NPROJ + (br ? PC_GG : PC_HG) + h * 128 + r;
    bf16_t g0[16], g1[16];
#pragma unroll
    for (int i = 0; i < 16; ++i) g0[i] = gp[(size_t)crow(i, hh) * NPROJ];
    float rstd[16];
#pragma unroll
    for (int i = 0; i < 16; ++i) { float s = (acc[0][i] * acc[0][i] + acc[1][i] * acc[1][i]) + (acc[2][i] * acc[2][i] + acc[3][i] * acc[3][i]);
        s += shx<1>(s, lane); s += shx<2>(s, lane); s += shx<4>(s, lane); s += shx<8>(s, lane); s += shx<16>(s, lane);
        rstd[i] = 1.0f / sqrtf(s * (1.0f / 128.0f) + EPS); }
    const float* ngp = (br ? ng_g : ng_h) + r;
    bf16_t* yp = Y + rowb * D + br * 512 + h * 128 + r;
#pragma unroll
    for (int dt = 0; dt < 4; ++dt) {
        if (dt < 3) {
#pragma unroll
            for (int i = 0; i < 16; ++i) { const bf16_t v = gp[(size_t)crow(i, hh) * NPROJ + 32 * (dt + 1)]; if (dt & 1) g0[i] = v; else g1[i] = v; } }
        const float ng = ngp[32 * dt];
#pragma unroll
        for (int i = 0; i < 16; ++i) { const bf16_t gv = (dt & 1) ? g1[i] : g0[i];
            yp[(size_t)crow(i, hh) * D + 32 * dt] = f2bf(acc[dt][i] * rstd[i] * ng * siluf_(bf1(gv))); }
    }
}

DI float selh(int hm, float a0, float a1) { return __int_as_float((__float_as_int(a0) & ~hm) | (__float_as_int(a1) & hm)); }
DI float max3f_(float a, float b, float c) { return fmaxf(fmaxf(a, b), c); }
#define CE_(a, b) { const float t_ = fmaxf(a, b); b = fminf(a, b); a = t_; }
#define SORT16_(P, B) do {   \
    CE_(P[(B) + 0], P[(B) + 13]); CE_(P[(B) + 1], P[(B) + 12]); CE_(P[(B) + 2], P[(B) + 15]); CE_(P[(B) + 3], P[(B) + 14]); CE_(P[(B) + 4], P[(B) + 8]); CE_(P[(B) + 5], P[(B) + 6]); CE_(P[(B) + 7], P[(B) + 11]); CE_(P[(B) + 9], P[(B) + 10]); \
    CE_(P[(B) + 0], P[(B) + 5]); CE_(P[(B) + 1], P[(B) + 7]); CE_(P[(B) + 2], P[(B) + 9]); CE_(P[(B) + 3], P[(B) + 4]); CE_(P[(B) + 6], P[(B) + 13]); CE_(P[(B) + 8], P[(B) + 14]); CE_(P[(B) + 10], P[(B) + 15]); CE_(P[(B) + 11], P[(B) + 12]); \
    CE_(P[(B) + 0], P[(B) + 1]); CE_(P[(B) + 2], P[(B) + 3]); CE_(P[(B) + 4], P[(B) + 5]); CE_(P[(B) + 6], P[(B) + 8]); CE_(P[(B) + 7], P[(B) + 9]); CE_(P[(B) + 10], P[(B) + 11]); CE_(P[(B) + 12], P[(B) + 13]); CE_(P[(B) + 14], P[(B) + 15]); \
    CE_(P[(B) + 0], P[(B) + 2]); CE_(P[(B) + 1], P[(B) + 3]); CE_(P[(B) + 4], P[(B) + 10]); CE_(P[(B) + 5], P[(B) + 11]); CE_(P[(B) + 6], P[(B) + 7]); CE_(P[(B) + 8], P[(B) + 9]); CE_(P[(B) + 12], P[(B) + 14]); CE_(P[(B) + 13], P[(B) + 15]); \
    CE_(P[(B) + 1], P[(B) + 2]); CE_(P[(B) + 3], P[(B) + 12]); CE_(P[(B) + 4], P[(B) + 6]); CE_(P[(B) + 5], P[(B) + 7]); CE_(P[(B) + 8], P[(B) + 10]); CE_(P[(B) + 9], P[(B) + 11]); CE_(P[(B) + 13], P[(B) + 14]); \
    CE_(P[(B) + 1], P[(B) + 4]); CE_(P[(B) + 2], P[(B) + 6]); CE_(P[(B) + 5], P[(B) + 8]); CE_(P[(B) + 7], P[(B) + 10]); CE_(P[(B) + 9], P[(B) + 13]); CE_(P[(B) + 11], P[(B) + 14]); \
    CE_(P[(B) + 2], P[(B) + 4]); CE_(P[(B) + 3], P[(B) + 6]); CE_(P[(B) + 9], P[(B) + 12]); CE_(P[(B) + 11], P[(B) + 13]); \
    CE_(P[(B) + 3], P[(B) + 5]); CE_(P[(B) + 6], P[(B) + 8]); CE_(P[(B) + 7], P[(B) + 9]); CE_(P[(B) + 10], P[(B) + 12]); \
    CE_(P[(B) + 3], P[(B) + 4]); CE_(P[(B) + 5], P[(B) + 6]); CE_(P[(B) + 7], P[(B) + 8]); CE_(P[(B) + 9], P[(B) + 10]); CE_(P[(B) + 11], P[(B) + 12]); \
    CE_(P[(B) + 6], P[(B) + 7]); CE_(P[(B) + 8], P[(B) + 9]); \
} while (0)
#define MERGE16_(P, B) do { \
    CE_(P[(B) + 0], P[(B) + 8]); CE_(P[(B) + 1], P[(B) + 9]); CE_(P[(B) + 2], P[(B) + 10]); CE_(P[(B) + 3], P[(B) + 11]); CE_(P[(B) + 4], P[(B) + 12]); CE_(P[(B) + 5], P[(B) + 13]); CE_(P[(B) + 6], P[(B) + 14]); CE_(P[(B) + 7], P[(B) + 15]); \
    CE_(P[(B) + 0], P[(B) + 4]); CE_(P[(B) + 1], P[(B) + 5]); CE_(P[(B) + 2], P[(B) + 6]); CE_(P[(B) + 3], P[(B) + 7]); CE_(P[(B) + 8], P[(B) + 12]); CE_(P[(B) + 9], P[(B) + 13]); CE_(P[(B) + 10], P[(B) + 14]); CE_(P[(B) + 11], P[(B) + 15]); \
    CE_(P[(B) + 0], P[(B) + 2]); CE_(P[(B) + 1], P[(B) + 3]); CE_(P[(B) + 4], P[(B) + 6]); CE_(P[(B) + 5], P[(B) + 7]); CE_(P[(B) + 8], P[(B) + 10]); CE_(P[(B) + 9], P[(B) + 11]); CE_(P[(B) + 12], P[(B) + 14]); CE_(P[(B) + 13], P[(B) + 15]); \
    CE_(P[(B) + 0], P[(B) + 1]); CE_(P[(B) + 2], P[(B) + 3]); CE_(P[(B) + 4], P[(B) + 5]); CE_(P[(B) + 6], P[(B) + 7]); CE_(P[(B) + 8], P[(B) + 9]); CE_(P[(B) + 10], P[(B) + 11]); CE_(P[(B) + 12], P[(B) + 13]); CE_(P[(B) + 14], P[(B) + 15]); \
} while (0)
#define SORT32_(P, B) do { \
    CE_(P[(B) + 0], P[(B) + 1]); CE_(P[(B) + 3], P[(B) + 2]); CE_(P[(B) + 4], P[(B) + 5]); CE_(P[(B) + 7], P[(B) + 6]); CE_(P[(B) + 8], P[(B) + 9]); CE_(P[(B) + 11], P[(B) + 10]); CE_(P[(B) + 12], P[(B) + 13]); CE_(P[(B) + 15], P[(B) + 14]); \
    CE_(P[(B) + 16], P[(B) + 17]); CE_(P[(B) + 19], P[(B) + 18]); CE_(P[(B) + 20], P[(B) + 21]); CE_(P[(B) + 23], P[(B) + 22]); CE_(P[(B) + 24], P[(B) + 25]); CE_(P[(B) + 27], P[(B) + 26]); CE_(P[(B) + 28], P[(B) + 29]); CE_(P[(B) + 31], P[(B) + 30]); \
    CE_(P[(B) + 0], P[(B) + 2]); CE_(P[(B) + 1], P[(B) + 3]); CE_(P[(B) + 6], P[(B) + 4]); CE_(P[(B) + 7], P[(B) + 5]); CE_(P[(B) + 8], P[(B) + 10]); CE_(P[(B) + 9], P[(B) + 11]); CE_(P[(B) + 14], P[(B) + 12]); CE_(P[(B) + 15], P[(B) + 13]); \
    CE_(P[(B) + 16], P[(B) + 18]); CE_(P[(B) + 17], P[(B) + 19]); CE_(P[(B) + 22], P[(B) + 20]); CE_(P[(B) + 23], P[(B) + 21]); CE_(P[(B) + 24], P[(B) + 26]); CE_(P[(B) + 25], P[(B) + 27]); CE_(P[(B) + 30], P[(B) + 28]); CE_(P[(B) + 31], P[(B) + 29]); \
    CE_(P[(B) + 0], P[(B) + 1]); CE_(P[(B) + 2], P[(B) + 3]); CE_(P[(B) + 5], P[(B) + 4]); CE_(P[(B) + 7], P[(B) + 6]); CE_(P[(B) + 8], P[(B) + 9]); CE_(P[(B) + 10], P[(B) + 11]); CE_(P[(B) + 13], P[(B) + 12]); CE_(P[(B) + 15], P[(B) + 14]); \
    CE_(P[(B) + 16], P[(B) + 17]); CE_(P[(B) + 18], P[(B) + 19]); CE_(P[(B) + 21], P[(B) + 20]); CE_(P[(B) + 23], P[(B) + 22]); CE_(P[(B) + 24], P[(B) + 25]); CE_(P[(B) + 26], P[(B) + 27]); CE_(P[(B) + 29], P[(B) + 28]); CE_(P[(B) + 31], P[(B) + 30]); \
    CE_(P[(B) + 0], P[(B) + 4]); CE_(P[(B) + 1], P[(B) + 5]); CE_(P[(B) + 2], P[(B) + 6]); CE_(P[(B) + 3], P[(B) + 7]); CE_(P[(B) + 12], P[(B) + 8]); CE_(P[(B) + 13], P[(B) + 9]); CE_(P[(B) + 14], P[(B) + 10]); CE_(P[(B) + 15], P[(B) + 11]); \
    CE_(P[(B) + 16], P[(B) + 20]); CE_(P[(B) + 17], P[(B) + 21]); CE_(P[(B) + 18], P[(B) + 22]); CE_(P[(B) + 19], P[(B) + 23]); CE_(P[(B) + 28], P[(B) + 24]); CE_(P[(B) + 29], P[(B) + 25]); CE_(P[(B) + 30], P[(B) + 26]); CE_(P[(B) + 31], P[(B) + 27]); \
    CE_(P[(B) + 0], P[(B) + 2]); CE_(P[(B) + 1], P[(B) + 3]); CE_(P[(B) + 4], P[(B) + 6]); CE_(P[(B) + 5], P[(B) + 7]); CE_(P[(B) + 10], P[(B) + 8]); CE_(P[(B) + 11], P[(B) + 9]); CE_(P[(B) + 14], P[(B) + 12]); CE_(P[(B) + 15], P[(B) + 13]); \
    CE_(P[(B) + 16], P[(B) + 18]); CE_(P[(B) + 17], P[(B) + 19]); CE_(P[(B) + 20], P[(B) + 22]); CE_(P[(B) + 21], P[(B) + 23]); CE_(P[(B) + 26], P[(B) + 24]); CE_(P[(B) + 27], P[(B) + 25]); CE_(P[(B) + 30], P[(B) + 28]); CE_(P[(B) + 31], P[(B) + 29]); \
    CE_(P[(B) + 0], P[(B) + 1]); CE_(P[(B) + 2], P[(B) + 3]); CE_(P[(B) + 4], P[(B) + 5]); CE_(P[(B) + 6], P[(B) + 7]); CE_(P[(B) + 9], P[(B) + 8]); CE_(P[(B) + 11], P[(B) + 10]); CE_(P[(B) + 13], P[(B) + 12]); CE_(P[(B) + 15], P[(B) + 14]); \
    CE_(P[(B) + 16], P[(B) + 17]); CE_(P[(B) + 18], P[(B) + 19]); CE_(P[(B) + 20], P[(B) + 21]); CE_(P[(B) + 22], P[(B) + 23]); CE_(P[(B) + 25], P[(B) + 24]); CE_(P[(B) + 27], P[(B) + 26]); CE_(P[(B) + 29], P[(B) + 28]); CE_(P[(B) + 31], P[(B) + 30]); \
    CE_(P[(B) + 0], P[(B) + 8]); CE_(P[(B) + 1], P[(B) + 9]); CE_(P[(B) + 2], P[(B) + 10]); CE_(P[(B) + 3], P[(B) + 11]); CE_(P[(B) + 4], P[(B) + 12]); CE_(P[(B) + 5], P[(B) + 13]); CE_(P[(B) + 6], P[(B) + 14]); CE_(P[(B) + 7], P[(B) + 15]); \
    CE_(P[(B) + 24], P[(B) + 16]); CE_(P[(B) + 25], P[(B) + 17]); CE_(P[(B) + 26], P[(B) + 18]); CE_(P[(B) + 27], P[(B) + 19]); CE_(P[(B) + 28], P[(B) + 20]); CE_(P[(B) + 29], P[(B) + 21]); CE_(P[(B) + 30], P[(B) + 22]); CE_(P[(B) + 31], P[(B) + 23]); \
    CE_(P[(B) + 0], P[(B) + 4]); CE_(P[(B) + 1], P[(B) + 5]); CE_(P[(B) + 2], P[(B) + 6]); CE_(P[(B) + 3], P[(B) + 7]); CE_(P[(B) + 8], P[(B) + 12]); CE_(P[(B) + 9], P[(B) + 13]); CE_(P[(B) + 10], P[(B) + 14]); CE_(P[(B) + 11], P[(B) + 15]); \
    CE_(P[(B) + 20], P[(B) + 16]); CE_(P[(B) + 21], P[(B) + 17]); CE_(P[(B) + 22], P[(B) + 18]); CE_(P[(B) + 23], P[(B) + 19]); CE_(P[(B) + 28], P[(B) + 24]); CE_(P[(B) + 29], P[(B) + 25]); CE_(P[(B) + 30], P[(B) + 26]); CE_(P[(B) + 31], P[(B) + 27]); \
    CE_(P[(B) + 0], P[(B) + 2]); CE_(P[(B) + 1], P[(B) + 3]); CE_(P[(B) + 4], P[(B) + 6]); CE_(P[(B) + 5], P[(B) + 7]); CE_(P[(B) + 8], P[(B) + 10]); CE_(P[(B) + 9], P[(B) + 11]); CE_(P[(B) + 12], P[(B) + 14]); CE_(P[(B) + 13], P[(B) + 15]); \
    CE_(P[(B) + 18], P[(B) + 16]); CE_(P[(B) + 19], P[(B) + 17]); CE_(P[(B) + 22], P[(B) + 20]); CE_(P[(B) + 23], P[(B) + 21]); CE_(P[(B) + 26], P[(B) + 24]); CE_(P[(B) + 27], P[(B) + 25]); CE_(P[(B) + 30], P[(B) + 28]); CE_(P[(B) + 31], P[(B) + 29]); \
    CE_(P[(B) + 0], P[(B) + 1]); CE_(P[(B) + 2], P[(B) + 3]); CE_(P[(B) + 4], P[(B) + 5]); CE_(P[(B) + 6], P[(B) + 7]); CE_(P[(B) + 8], P[(B) + 9]); CE_(P[(B) + 10], P[(B) + 11]); CE_(P[(B) + 12], P[(B) + 13]); CE_(P[(B) + 14], P[(B) + 15]); \
    CE_(P[(B) + 17], P[(B) + 16]); CE_(P[(B) + 19], P[(B) + 18]); CE_(P[(B) + 21], P[(B) + 20]); CE_(P[(B) + 23], P[(B) + 22]); CE_(P[(B) + 25], P[(B) + 24]); CE_(P[(B) + 27], P[(B) + 26]); CE_(P[(B) + 29], P[(B) + 28]); CE_(P[(B) + 31], P[(B) + 30]); \
    CE_(P[(B) + 0], P[(B) + 16]); CE_(P[(B) + 1], P[(B) + 17]); CE_(P[(B) + 2], P[(B) + 18]); CE_(P[(B) + 3], P[(B) + 19]); CE_(P[(B) + 4], P[(B) + 20]); CE_(P[(B) + 5], P[(B) + 21]); CE_(P[(B) + 6], P[(B) + 22]); CE_(P[(B) + 7], P[(B) + 23]); \
    CE_(P[(B) + 8], P[(B) + 24]); CE_(P[(B) + 9], P[(B) + 25]); CE_(P[(B) + 10], P[(B) + 26]); CE_(P[(B) + 11], P[(B) + 27]); CE_(P[(B) + 12], P[(B) + 28]); CE_(P[(B) + 13], P[(B) + 29]); CE_(P[(B) + 14], P[(B) + 30]); CE_(P[(B) + 15], P[(B) + 31]); \
    CE_(P[(B) + 0], P[(B) + 8]); CE_(P[(B) + 1], P[(B) + 9]); CE_(P[(B) + 2], P[(B) + 10]); CE_(P[(B) + 3], P[(B) + 11]); CE_(P[(B) + 4], P[(B) + 12]); CE_(P[(B) + 5], P[(B) + 13]); CE_(P[(B) + 6], P[(B) + 14]); CE_(P[(B) + 7], P[(B) + 15]); \
    CE_(P[(B) + 16], P[(B) + 24]); CE_(P[(B) + 17], P[(B) + 25]); CE_(P[(B) + 18], P[(B) + 26]); CE_(P[(B) + 19], P[(B) + 27]); CE_(P[(B) + 20], P[(B) + 28]); CE_(P[(B) + 21], P[(B) + 29]); CE_(P[(B) + 22], P[(B) + 30]); CE_(P[(B) + 23], P[(B) + 31]); \
    CE_(P[(B) + 0], P[(B) + 4]); CE_(P[(B) + 1], P[(B) + 5]); CE_(P[(B) + 2], P[(B) + 6]); CE_(P[(B) + 3], P[(B) + 7]); CE_(P[(B) + 8], P[(B) + 12]); CE_(P[(B) + 9], P[(B) + 13]); CE_(P[(B) + 10], P[(B) + 14]); CE_(P[(B) + 11], P[(B) + 15]); \
    CE_(P[(B) + 16], P[(B) + 20]); CE_(P[(B) + 17], P[(B) + 21]); CE_(P[(B) + 18], P[(B) + 22]); CE_(P[(B) + 19], P[(B) + 23]); CE_(P[(B) + 24], P[(B) + 28]); CE_(P[(B) + 25], P[(B) + 29]); CE_(P[(B) + 26], P[(B) + 30]); CE_(P[(B) + 27], P[(B) + 31]); \
    CE_(P[(B) + 0], P[(B) + 2]); CE_(P[(B) + 1], P[(B) + 3]); CE_(P[(B) + 4], P[(B) + 6]); CE_(P[(B) + 5], P[(B) + 7]); CE_(P[(B) + 8], P[(B) + 10]); CE_(P[(B) + 9], P[(B) + 11]); CE_(P[(B) + 12], P[(B) + 14]); CE_(P[(B) + 13], P[(B) + 15]); \
    CE_(P[(B) + 16], P[(B) + 18]); CE_(P[(B) + 17], P[(B) + 19]); CE_(P[(B) + 20], P[(B) + 22]); CE_(P[(B) + 21], P[(B) + 23]); CE_(P[(B) + 24], P[(B) + 26]); CE_(P[(B) + 25], P[(B) + 27]); CE_(P[(B) + 28], P[(B) + 30]); CE_(P[(B) + 29], P[(B) + 31]); \
    CE_(P[(B) + 0], P[(B) + 1]); CE_(P[(B) + 2], P[(B) + 3]); CE_(P[(B) + 4], P[(B) + 5]); CE_(P[(B) + 6], P[(B) + 7]); CE_(P[(B) + 8], P[(B) + 9]); CE_(P[(B) + 10], P[(B) + 11]); CE_(P[(B) + 12], P[(B) + 13]); CE_(P[(B) + 14], P[(B) + 15]); \
    CE_(P[(B) + 16], P[(B) + 17]); CE_(P[(B) + 18], P[(B) + 19]); CE_(P[(B) + 20], P[(B) + 21]); CE_(P[(B) + 22], P[(B) + 23]); CE_(P[(B) + 24], P[(B) + 25]); CE_(P[(B) + 26], P[(B) + 27]); CE_(P[(B) + 28], P[(B) + 29]); CE_(P[(B) + 30], P[(B) + 31]); \
} while (0)

DI void top16_of_128(float (&p)[64], float (&out)[16], int lane) {
    SORT16_(p, 0); SORT16_(p, 16); SORT16_(p, 32); SORT16_(p, 48);
#pragma unroll
    for (int i = 0; i < 16; ++i) { p[i] = fmaxf(p[i], p[31 - i]); p[32 + i] = fmaxf(p[32 + i], p[63 - i]); }
    MERGE16_(p, 0); MERGE16_(p, 32);
#pragma unroll
    for (int i = 0; i < 16; ++i) p[i] = fmaxf(p[i], p[47 - i]);
    MERGE16_(p, 0);
    float q[16];
#pragma unroll
    for (int i = 0; i < 16; ++i) q[i] = shx<32>(p[15 - i], lane);
#pragma unroll
    for (int i = 0; i < 16; ++i) p[i] = fmaxf(p[i], q[i]);
    MERGE16_(p, 0);
#pragma unroll
    for (int i = 0; i < 16; ++i) out[i] = p[i];
}
DI void route_q_load(bf16x8 (&bq)[8], const bf16_t* Q, int head, int tile, int z, int lane) {
    const bf16_t* qrow = Q + ((size_t)tile * 32 + (lane & 31)) * NQ + head * 256 + z * 128 + 8 * (lane >> 5);
#pragma unroll
    for (int s8 = 0; s8 < 8; ++s8) bq[s8] = *(const bf16x8*)(qrow + 16 * s8);
}
DI void peer_route_tile(lptr L, int lane, int wave, const bf16_t* Q, int head, int tile, u32x2* route, bf16x8 (&bq0)[8], int next_tile) {
    const int r = lane & 31, hh = lane >> 5;
    const size_t tok = (size_t)tile * 32 + r;
    float top[2][16];
    bf16x8 bq1[8];
    route_q_load(bq1, Q, head, tile, 1, lane);
    __builtin_amdgcn_sched_barrier(0);
#pragma unroll
    for (int z = 0; z < 2; ++z) {
        bf16x8 bq[8];
#pragma unroll
        for (int s8 = 0; s8 < 8; ++s8) bq[s8] = z ? bq1[s8] : bq0[s8];
        float p[64];
#pragma unroll
        for (int m = 0; m < 4; ++m) { f32x16 acc = zero16();
#pragma unroll
            for (int s8 = 0; s8 < 8; ++s8) acc = MFMA32(fragK(L + z * 34816, 272, 32 * m, 16 * s8, lane), bq[s8], acc);
#pragma unroll
            for (int i = 0; i < 16; ++i) p[m * 16 + i] = __int_as_float((__float_as_int(acc[i]) & ~0x7f) | (32 * m + crow(i, hh)));
            __builtin_amdgcn_sched_barrier(0); }
        if (z == 1 && next_tile >= 0) { route_q_load(bq0, Q, head, next_tile, 0, lane); __builtin_amdgcn_sched_barrier(0); }
        top16_of_128(p, top[z], lane);
    }
    float cand[50];
#define CAND_ROW(i, off) _Pragma("unroll") for (int j = 0; j < 16 / ((i) + 1); ++j) { const float s = top[0][i] + top[1][j]; \
        cand[(off) + j] = __int_as_float((__float_as_int(s) & ~0xff) | ((i) * 16 + j)); }
    CAND_ROW(0, 0) CAND_ROW(1, 16) CAND_ROW(2, 24) CAND_ROW(3, 29) CAND_ROW(4, 33) CAND_ROW(5, 36) CAND_ROW(6, 38) CAND_ROW(7, 40)
    CAND_ROW(8, 42) CAND_ROW(9, 43) CAND_ROW(10, 44) CAND_ROW(11, 45) CAND_ROW(12, 46) CAND_ROW(13, 47) CAND_ROW(14, 48) CAND_ROW(15, 49)
#undef CAND_ROW
    float c32[32];
#pragma unroll
    for (int m = 0; m < 25; ++m) c32[m] = selh(-hh, cand[2 * m], cand[2 * m + 1]);
#pragma unroll
    for (int m = 25; m < 32; ++m) c32[m] = -INFINITY;
    SORT32_(c32, 0);
    float win[16];
    {
        float q[16];
#pragma unroll
        for (int i = 0; i < 16; ++i) q[i] = shx<32>(c32[15 - i], lane);
#pragma unroll
        for (int i = 0; i < 16; ++i) c32[i] = fmaxf(c32[i], q[i]);
        MERGE16_(c32, 0);
#pragma unroll
        for (int i = 0; i < 16; ++i) win[i] = c32[i];
    }
    LAS unsigned* tb = (LAS unsigned*)(L + 69632 + wave * 4352) + r * 33 + 16 * hh;
#pragma unroll
    for (int q = 0; q < 16; ++q) tb[q] = (unsigned)__float_as_int(selh(-hh, top[0][q], top[1][q])) & 0x7fu;
    float e[16], sum = 0.f;
#pragma unroll
    for (int q = 0; q < 16; ++q) { e[q] = __expf(win[q] - win[0]); sum += e[q]; }
    const float inv = 1.0f / sum;
    LDS_WAIT();
    const LAS unsigned* tr_ = (const LAS unsigned*)(L + 69632 + wave * 4352) + r * 33;
    u32x2* ro = route + (tok * 8 + head) * 16 + 8 * hh;
#pragma unroll
    for (int q = 0; q < 8; ++q) {
        const float wv = selh(-hh, win[q], win[8 + q]); const float ev = selh(-hh, e[q], e[8 + q]);
        const int id = __float_as_int(wv) & 0xff;
        const unsigned n0 = tr_[id >> 4], n1 = tr_[16 + (id & 15)];
        u32x2 o; o.x = n0 * 128u + n1; o.y = (unsigned)__float_as_int(ev * inv); ro[q] = o;
    }
    LDS_WAIT();
}
DI void peer_route_unit(lptr L, int tid, int pm, int head, const bf16_t* Q, const bf16_t* SK, u32x2* route) {
    const int lane = tid & 63, wave = __builtin_amdgcn_readfirstlane(tid >> 6);
    __syncthreads();
    for (int i = tid; i < 2 * 128 * 16; i += NTHR) { const int z = i >> 11, n = (i >> 4) & 127, cc = i & 15;
        *(LAS u32x4*)(L + z * 34816 + n * 272 + cc * 16) = *(const u32x4*)(SK + ((size_t)(head * 2 + z) * 128 + n) * 128 + cc * 8); }
    __syncthreads();
    bf16x8 bq0[8]; route_q_load(bq0, Q, head, pm * 8 + wave, 0, lane);
    peer_route_tile(L, lane, wave, Q, head, pm * 8 + wave, route, bq0, -1);
}
DI void peer_route_phase(lptr L, int tid, int vcu, const bf16_t* Q, const bf16_t* SK  , u32x2* route) {
    const int lane = tid & 63, wave = __builtin_amdgcn_readfirstlane(tid >> 6);
    const int head = vcu & 7, base = vcu >> 3;
    __syncthreads();
    for (int i = tid; i < 2 * 128 * 16; i += NTHR) { const int z = i >> 11, n = (i >> 4) & 127, cc = i & 15;
        *(LAS u32x4*)(L + z * 34816 + n * 272 + cc * 16) = *(const u32x4*)(SK + ((size_t)(head * 2 + z) * 128 + n) * 128 + cc * 8); }
    __syncthreads();
    bf16x8 bq0[8];
    route_q_load(bq0, Q, head, base * 16 + wave * 2, 0, lane);
#pragma unroll 1
    for (int i = 0; i < 2; ++i) peer_route_tile(L, lane, wave, Q, head, base * 16 + wave * 2 + i, route, bq0, i == 0 ? base * 16 + wave * 2 + 1 : -1);
}

DI float erf_as(float x) {
    const float ax = fabsf(x), t = __builtin_amdgcn_rcpf(1.0f + 0.3275911f * ax);
    const float poly = t * (0.254829592f + t * (-0.284496736f + t * (1.421413741f + t * (-1.453152027f + t * 1.061405429f))));
    const float r = 1.0f - poly * __expf(-ax * ax);
    return __builtin_copysignf(r, x);
}
DI float gelu_exact(float x) { return 0.5f * x * (1.0f + erf_as(x * 0.70710678118654752f)); }
struct GatherP {
    const bf16_t* H; const u32x2* route; const unsigned char* U; const unsigned char* V; float* X; const float* gt2;
    int last; const float* ng; const float* nsc; const float* nsh;
    bf16_t* Hout; float* small; const LAS float* wsm; float* out;
    const unsigned char* H8; const float* HS;
};
constexpr float U8_SCALE = 256.0f, V8_SCALE = 16.0f;
DI void cvt_stream_fp8(const float* src, unsigned char* dst, size_t n, float scale, int gw, int ngw, int lane) {
    const size_t n16 = n / 16, stride = (size_t)ngw * 64;
    for (size_t i0 = (size_t)gw * 64 + lane; i0 < n16; i0 += 4 * stride) {
        f32x4 a[4][4];
#pragma unroll
        for (int u = 0; u < 4; ++u) { const size_t i = i0 + u * stride;
#pragma unroll
            for (int q = 0; q < 4; ++q) a[u][q] = (i < n16) ? ((const f32x4*)src)[4 * i + q] : (f32x4){0.f, 0.f, 0.f, 0.f}; }
#pragma unroll
        for (int u = 0; u < 4; ++u) { const size_t i = i0 + u * stride; u32x4 o;
#pragma unroll
            for (int q = 0; q < 4; ++q) { f32x4 v = a[u][q] * scale;
#pragma unroll
                for (int e = 0; e < 4; ++e) v[e] = fminf(fmaxf(v[e], -448.f), 448.f);
                int p = 0; p = __builtin_amdgcn_cvt_pk_fp8_f32(v[0], v[1], p, false); p = __builtin_amdgcn_cvt_pk_fp8_f32(v[2], v[3], p, true); o[q] = (unsigned)p; }
            if (i < n16) ((u32x4*)dst)[i] = o; }
    }
}
DI void fp8x16_to_f32(const u32x4& v, float (&f)[16]) {
    const unsigned d0 = v.x, d1 = v.y, d2 = v.z, d3 = v.w;
    f32x2 t;
    t = __builtin_amdgcn_cvt_pk_f32_fp8((int)d0, false); f[0] = t.x; f[1] = t.y; t = __builtin_amdgcn_cvt_pk_f32_fp8((int)d0, true); f[2] = t.x; f[3] = t.y;
    t = __builtin_amdgcn_cvt_pk_f32_fp8((int)d1, false); f[4] = t.x; f[5] = t.y; t = __builtin_amdgcn_cvt_pk_f32_fp8((int)d1, true); f[6] = t.x; f[7] = t.y;
    t = __builtin_amdgcn_cvt_pk_f32_fp8((int)d2, false); f[8] = t.x; f[9] = t.y; t = __builtin_amdgcn_cvt_pk_f32_fp8((int)d2, true); f[10] = t.x; f[11] = t.y;
    t = __builtin_amdgcn_cvt_pk_f32_fp8((int)d3, false); f[12] = t.x; f[13] = t.y; t = __builtin_amdgcn_cvt_pk_f32_fp8((int)d3, true); f[14] = t.x; f[15] = t.y;
}
#ifndef DBG_G
#define DBG_G 0
#endif
DI void peer_gather_token(const GatherP& P, size_t m, int lane) {
    float hv[16];
    { const bf16_t* hrow = P.H + m * D + 16 * lane; const u32x4 a = *(const u32x4*)hrow, b = *(const u32x4*)(hrow + 8);
      hv[0] = bf_lo(a.x); hv[1] = bf_hi(a.x); hv[2] = bf_lo(a.y); hv[3] = bf_hi(a.y); hv[4] = bf_lo(a.z); hv[5] = bf_hi(a.z); hv[6] = bf_lo(a.w); hv[7] = bf_hi(a.w);
      hv[8] = bf_lo(b.x); hv[9] = bf_hi(b.x); hv[10] = bf_lo(b.y); hv[11] = bf_hi(b.y); hv[12] = bf_lo(b.z); hv[13] = bf_hi(b.z); hv[14] = bf_lo(b.w); hv[15] = bf_hi(b.w); }
    float o[16];
#pragma unroll
    for (int e = 0; e < 16; ++e) o[e] = 0.f;
    const u32x2* rt = P.route + m * 128 + (lane & 7);
#pragma unroll 1
    for (int bt = 0; bt < 16; ++bt) {
        const u32x2 re = rt[bt * 8];
        const int idx = (int)re.x; const float gate = __int_as_float((int)re.y);
        u32x4 uu[8], vv[8];
#pragma unroll
        for (int e = 0; e < 8; ++e) {
            const size_t ro = (size_t)__builtin_amdgcn_readlane(idx, e) * D + 16 * lane;
            uu[e] = *(const u32x4*)(P.U + ro); vv[e] = *(const u32x4*)(P.V + ro);
        }
        float p[8];
#pragma unroll
        for (int e = 0; e < 8; ++e) { float uf[16]; fp8x16_to_f32(uu[e], uf); float a0 = 0.f, a1 = 0.f;
#pragma unroll
            for (int k = 0; k < 16; k += 2) { a0 += hv[k] * uf[k]; a1 += hv[k + 1] * uf[k + 1]; }
            p[e] = a0 + a1; }
        float p4[4], p2[2], p1;
        { const bool up = (lane & 4) != 0;
#pragma unroll
          for (int q = 0; q < 4; ++q) { const float keep = up ? p[q + 4] : p[q], send = up ? p[q] : p[q + 4]; p4[q] = keep + shx<4>(send, lane); } }
        { const bool up = (lane & 2) != 0;
#pragma unroll
          for (int q = 0; q < 2; ++q) { const float keep = up ? p4[q + 2] : p4[q], send = up ? p4[q] : p4[q + 2]; p2[q] = keep + shx<2>(send, lane); } }
        { const bool up = (lane & 1) != 0; const float keep = up ? p2[1] : p2[0], send = up ? p2[0] : p2[1]; p1 = keep + shx<1>(send, lane); }
        p1 += shx<8>(p1, lane); p1 += shx<16>(p1, lane); p1 += shx<32>(p1, lane);
        const float act = gelu_exact(p1 * (1.0f / U8_SCALE)) * gate * (1.0f / V8_SCALE);
#pragma unroll
        for (int e = 0; e < 8; ++e) { const float a = __int_as_float(__builtin_amdgcn_readlane(__float_as_int(act), e)); float vf[16]; fp8x16_to_f32(vv[e], vf);
#pragma unroll
            for (int k = 0; k < 16; ++k) o[k] += a * vf[k]; }
    }
    const int bidx = (m >= (size_t)SEQ) ? 1 : 0;
    float* xr = P.X + m * D + 16 * lane; const float* g2 = P.gt2 + bidx * 6 * D + 16 * lane;
    float xn[16]; float ss = 0.f;
#pragma unroll
    for (int q = 0; q < 4; ++q) { const f32x4 xv = *(const f32x4*)(xr + 4 * q), gv = *(const f32x4*)(g2 + 4 * q);
#pragma unroll
        for (int e = 0; e < 4; ++e) { const float v = xv[e] + gv[e] * o[q * 4 + e]; xn[q * 4 + e] = v; ss += v * v; } }
    const float rstd = 1.0f / sqrtf(wave_sum(ss, lane) * (1.0f / D) + EPS);
    if (P.last) {
#pragma unroll
        for (int q = 0; q < 4; ++q) { const f32x4 gv = *(const f32x4*)(P.ng + 16 * lane + 4 * q); f32x4 r;
#pragma unroll
            for (int e = 0; e < 4; ++e) r[e] = xn[q * 4 + e] * rstd * gv[e];
            *(f32x4*)(P.out + m * D + 16 * lane + 4 * q) = r; }
    } else {
        float y[16];
#pragma unroll
        for (int q = 0; q < 4; ++q) { const int col = 16 * lane + 4 * q;
            const f32x4 gv = *(const f32x4*)(P.ng + col), sc = *(const f32x4*)(P.nsc + bidx * 6 * D + col), sh = *(const f32x4*)(P.nsh + bidx * 6 * D + col);
            *(f32x4*)(xr + 4 * q) = (f32x4){xn[q * 4], xn[q * 4 + 1], xn[q * 4 + 2], xn[q * 4 + 3]};
#pragma unroll
            for (int e = 0; e < 4; ++e) y[q * 4 + e] = xn[q * 4 + e] * rstd * gv[e] * (1.0f + sc[e]) + sh[e]; }
        bf16_t* ho = P.Hout + m * D + 16 * lane;
        { u32x4 w; w.x = pk2(y[0], y[1]); w.y = pk2(y[2], y[3]); w.z = pk2(y[4], y[5]); w.w = pk2(y[6], y[7]); *(u32x4*)ho = w; }
        { u32x4 w; w.x = pk2(y[8], y[9]); w.y = pk2(y[10], y[11]); w.z = pk2(y[12], y[13]); w.w = pk2(y[14], y[15]); *(u32x4*)(ho + 8) = w; }
        float pr[8];
#pragma unroll
        for (int c = 0; c < 8; ++c) { float a = 0.f;
#pragma unroll
            for (int q = 0; q < 4; ++q) { const f32x4 wv = *(const LAS f32x4*)(P.wsm + c * D + 16 * lane + 4 * q);
                a += (y[q * 4] * wv.x + y[q * 4 + 1] * wv.y) + (y[q * 4 + 2] * wv.z + y[q * 4 + 3] * wv.w); }
            pr[c] = wave_sum(a, lane); }
        if (lane < 8) { float rr = pr[0];
#pragma unroll
            for (int c = 1; c < 8; ++c) rr = (lane == c) ? pr[c] : rr;
            P.small[m * 8 + lane] = rr; }
    }
}

DI void peer_u_pass(lptr L, int tid, int bx, const bf16_t* H, const u32x2* route, const unsigned char* U8, float* ACT) {
    const int lane = tid & 63, wave = __builtin_amdgcn_readfirstlane(tid >> 6);
    const unsigned x = (unsigned)bx & 7u; const int wx = (bx >> 3) * 8 + wave;
    LAS unsigned* list = (LAS unsigned*)(L + wave * 2048);
    u32x2 e0 = route[(size_t)wx * 128 + lane], e1 = route[(size_t)wx * 128 + 64 + lane];
    u32x4 ha = *(const u32x4*)(H + (size_t)wx * D + 16 * lane), hb = *(const u32x4*)(H + (size_t)wx * D + 16 * lane + 8);
#pragma unroll 1
    for (int t = wx; t < M; t += 256) {
        float hv[16];
        hv[0] = bf_lo(ha.x); hv[1] = bf_hi(ha.x); hv[2] = bf_lo(ha.y); hv[3] = bf_hi(ha.y); hv[4] = bf_lo(ha.z); hv[5] = bf_hi(ha.z); hv[6] = bf_lo(ha.w); hv[7] = bf_hi(ha.w);
        hv[8] = bf_lo(hb.x); hv[9] = bf_hi(hb.x); hv[10] = bf_lo(hb.y); hv[11] = bf_hi(hb.y); hv[12] = bf_lo(hb.z); hv[13] = bf_hi(hb.z); hv[14] = bf_lo(hb.w); hv[15] = bf_hi(hb.w);
        const bool own0 = (e0.x & 7u) == x, own1 = (e1.x & 7u) == x;
        const unsigned long long m0 = __ballot(own0), m1 = __ballot(own1);
        const int n0 = __popcll(m0), n = n0 + __popcll(m1);
        const int p0 = (int)__builtin_amdgcn_mbcnt_hi((unsigned)(m0 >> 32), __builtin_amdgcn_mbcnt_lo((unsigned)m0, 0u));
        const int p1 = n0 + (int)__builtin_amdgcn_mbcnt_hi((unsigned)(m1 >> 32), __builtin_amdgcn_mbcnt_lo((unsigned)m1, 0u));
        if (own0) { list[p0] = e0.x; list[136 + p0] = e0.y; list[272 + p0] = (unsigned)lane; }
        if (own1) { list[p1] = e1.x; list[136 + p1] = e1.y; list[272 + p1] = (unsigned)(lane + 64); }
        if (lane < 8) { list[n + lane] = x; list[136 + n + lane] = 0u; list[272 + n + lane] = 0xffffffffu; }
        const int tn = t + 256;
        if (tn < M) { e0 = route[(size_t)tn * 128 + lane]; e1 = route[(size_t)tn * 128 + 64 + lane];
                      ha = *(const u32x4*)(H + (size_t)tn * D + 16 * lane); hb = *(const u32x4*)(H + (size_t)tn * D + 16 * lane + 8); }
        LDS_WAIT();
#pragma unroll 1
        for (int b0 = 0; b0 < n; b0 += 8) {
            const unsigned idx = list[b0 + (lane & 7)]; const float gate = __uint_as_float(list[136 + b0 + (lane & 7)]); const unsigned kk = list[272 + b0 + (lane & 7)];
            u32x4 uu[8];
#pragma unroll
            for (int e = 0; e < 8; ++e) uu[e] = *(const u32x4*)(U8 + (size_t)__builtin_amdgcn_readlane((int)idx, e) * D + 16 * lane);
            float p[8];
#pragma unroll
            for (int e = 0; e < 8; ++e) { float uf[16]; fp8x16_to_f32(uu[e], uf); float a0 = 0.f, a1 = 0.f;
#pragma unroll
                for (int k = 0; k < 16; k += 2) { a0 += hv[k] * uf[k]; a1 += hv[k + 1] * uf[k + 1]; }
                p[e] = a0 + a1; }
            float p4[4], p2[2], p1;
            { const bool up = (lane & 4) != 0;
#pragma unroll
              for (int q = 0; q < 4; ++q) { const float keep = up ? p[q + 4] : p[q], send = up ? p[q] : p[q + 4]; p4[q] = keep + shx<4>(send, lane); } }
            { const bool up = (lane & 2) != 0;
#pragma unroll
              for (int q = 0; q < 2; ++q) { const float keep = up ? p4[q + 2] : p4[q], send = up ? p4[q] : p4[q + 2]; p2[q] = keep + shx<2>(send, lane); } }
            { const bool up = (lane & 1) != 0; const float keep = up ? p2[1] : p2[0], send = up ? p2[0] : p2[1]; p1 = keep + shx<1>(send, lane); }
            p1 += shx<8>(p1, lane); p1 += shx<16>(p1, lane); p1 += shx<32>(p1, lane);
            const float act = gelu_exact(p1 * (1.0f / U8_SCALE)) * gate * (1.0f / V8_SCALE);
            if (lane < 8 && kk != 0xffffffffu) ACT[(size_t)t * 128 + kk] = act;
        }
        LDS_WAIT();
    }
}
DI void peer_v_pass(int tid, int bx, const u32x2* route, const float* ACT, const unsigned char* V8, float* X, const float* gt2) {
    const int lane = tid & 63, wave = __builtin_amdgcn_readfirstlane(tid >> 6);
    const int x = bx & 7, wx = (bx >> 3) * 8 + wave, es = lane >> 3, ch = lane & 7, col0 = 128 * x + 16 * ch;
    unsigned re[16]; float aa[16];
#pragma unroll
    for (int i = 0; i < 16; ++i) { const unsigned o_ = (unsigned)(wx * 128 + 8 * i + es); re[i] = route[o_].x; aa[i] = ACT[o_]; }
#pragma unroll 1
    for (int t = wx; t < M; t += 256) {
        u32x4 vv[16];
#pragma unroll
        for (int i = 0; i < 16; ++i) vv[i] = *(const u32x4*)(V8 + (re[i] * 1024u + (unsigned)col0));
        float ac[16];
#pragma unroll
        for (int i = 0; i < 16; ++i) ac[i] = aa[i];
        const int tn = t + 256;
        if (tn < M) {
#pragma unroll
            for (int i = 0; i < 16; ++i) { const unsigned o_ = (unsigned)(tn * 128 + 8 * i + es); re[i] = route[o_].x; aa[i] = ACT[o_]; } }
        float o[16];
#pragma unroll
        for (int k = 0; k < 16; ++k) o[k] = 0.f;
#pragma unroll
        for (int i = 0; i < 16; ++i) { float vf[16]; fp8x16_to_f32(vv[i], vf);
#pragma unroll
            for (int k = 0; k < 16; ++k) o[k] += ac[i] * vf[k];
            if ((i & 3) == 3) __builtin_amdgcn_sched_barrier(0); }
#pragma unroll
        for (int k = 0; k < 16; ++k) { o[k] += shx<8>(o[k], lane); o[k] += shx<16>(o[k], lane); o[k] += shx<32>(o[k], lane); }
        if (es == 0) { float* xr = X + (size_t)t * D + col0; const float* g2 = gt2 + (t >= SEQ ? 6 * D : 0) + col0;
#pragma unroll
            for (int q = 0; q < 4; ++q) { const f32x4 xv = *(const f32x4*)(xr + 4 * q), gv = *(const f32x4*)(g2 + 4 * q);
                *(f32x4*)(xr + 4 * q) = (f32x4){xv[0] + gv[0] * o[4 * q], xv[1] + gv[1] * o[4 * q + 1], xv[2] + gv[2] * o[4 * q + 2], xv[3] + gv[3] * o[4 * q + 3]}; } }
    }
}
DI void row_final(const f32x4 (&v)[4], const float* g, float* orow, int lane) {
    float s = 0.f;
#pragma unroll
    for (int j = 0; j < 4; ++j) s += (v[j].x * v[j].x + v[j].y * v[j].y) + (v[j].z * v[j].z + v[j].w * v[j].w);
    const float rstd = 1.0f / sqrtf(wave_sum(s, lane) * (1.0f / D) + EPS);
#pragma unroll
    for (int j = 0; j < 4; ++j) ((f32x4*)orow)[lane + 64 * j] = v[j] * rstd * ((const f32x4*)g)[lane + 64 * j];
}

constexpr float U6_SCALE = 54.0f, V6_SCALE = 4.75f;
constexpr int ROW6 = 768;
typedef unsigned v6u_t __attribute__((ext_vector_type(6)));
typedef float v32f_t __attribute__((ext_vector_type(32)));
DI unsigned enc_e2m3(float x) {
    const float a = fminf(fabsf(x), 7.5f);
    const float inv = a < 2.0f ? 8.0f : (a < 4.0f ? 4.0f : 2.0f);
    const unsigned add = a < 2.0f ? 0u : (a < 4.0f ? 8u : 16u);
    const unsigned c = (unsigned)__builtin_rintf(a * inv) + add;
    return (c > 31u ? 31u : c) | ((__float_as_uint(x) >> 26) & 32u);
}
DI void cvt_stream_fp6(const float* src, unsigned char* dst, float scale, int gw, int ngw, int lane) {
    constexpr int NGRP = NEXP * 32;
    for (int g = gw * 64 + lane; g < NGRP; g += ngw * 64) {
        const int row = g >> 5, lp = g & 31;
        const f32x4* p = (const f32x4*)(src + (size_t)g * 32);
        f32x4 v[8];
#pragma unroll
        for (int q = 0; q < 8; ++q) v[q] = __builtin_nontemporal_load(p + q);
        unsigned cd[32];
#pragma unroll
        for (int q = 0; q < 8; ++q)
#pragma unroll
            for (int e = 0; e < 4; ++e) cd[4 * q + e] = enc_e2m3(v[q][e] * scale);
        unsigned w[6];
#pragma unroll
        for (int d = 0; d < 6; ++d) { unsigned acc = 0u;
#pragma unroll
            for (int i = 0; i < 32; ++i) { const int lo = 6 * i - 32 * d;
                if (lo > -6 && lo < 32) acc |= (lo >= 0) ? (cd[i] << lo) : (cd[i] >> (-lo)); }
            w[d] = acc; }
        unsigned char* rp = dst + (size_t)row * ROW6;
        *(u32x4*)(rp + 16 * lp) = (u32x4){w[0], w[1], w[2], w[3]};
        *(u32x2*)(rp + 512 + 8 * lp) = (u32x2){w[4], w[5]};
    }
}
#ifndef PROBE_DUP
#define PROBE_DUP 0
#endif
#ifndef GATHER_DPP
#define GATHER_DPP 1
#endif
#ifndef GATHER_DEPTH
#define GATHER_DEPTH 2
#endif
#ifndef GATHER_INPLACE
#define GATHER_INPLACE 0
#endif
#ifndef GATHER_BP
#define GATHER_BP 12
#endif
#ifndef GATHER_PIPE
#define GATHER_PIPE 2
#endif
#ifndef TAB_UI4
#define TAB_UI4 1
#endif
#ifndef TAB_U4
#define TAB_U4 1
#endif
#ifndef TAB_V4
#define TAB_V4 1
#endif
constexpr float U4_SCALE = 67.0f, V4_SCALE = 5.94f;
constexpr int ROW4 = 512;
constexpr float UI_SCALE = 96.0f;
constexpr float UT_SCALE = TAB_UI4 ? UI_SCALE : TAB_U4 ? U4_SCALE : U6_SCALE, VT_SCALE = TAB_V4 ? V4_SCALE : V6_SCALE;
constexpr int ROWU = TAB_U4 ? ROW4 : ROW6, ROWV = TAB_V4 ? ROW4 : ROW6;
typedef float v2f_t __attribute__((ext_vector_type(2)));
DI unsigned enc_e2m1(float x) {
    const float a = fminf(fabsf(x), 6.0f);
    const float inv = a < 2.0f ? 2.0f : (a < 4.0f ? 1.0f : 0.5f);
    const unsigned add = a < 2.0f ? 0u : (a < 4.0f ? 2u : 4u);
    const unsigned c = (unsigned)__builtin_rintf(a * inv) + add;
    return (c > 7u ? 7u : c) | ((__float_as_uint(x) >> 28) & 8u);
}
DI void cvt_stream_fp4(const float* src, unsigned char* dst, float scale, int gw, int ngw, int lane) {
    constexpr int NGRP = NEXP * 32;
    for (int g = gw * 64 + lane; g < NGRP; g += ngw * 64) {
        const int row = g >> 5, lp = g & 31;
        const f32x4* p = (const f32x4*)(src + (size_t)g * 32);
        f32x4 v[8];
#pragma unroll
        for (int q = 0; q < 8; ++q) v[q] = __builtin_nontemporal_load(p + q);
        unsigned w[4];
#pragma unroll
        for (int d = 0; d < 4; ++d) { unsigned acc = 0u;
#pragma unroll
            for (int i = 0; i < 8; ++i) acc |= enc_e2m1(v[2 * d + (i >> 2)][i & 3] * scale) << (4 * i);
            w[d] = acc; }
        *(u32x4*)(dst + (size_t)row * ROW4 + 16 * lp) = (u32x4){w[0], w[1], w[2], w[3]};
    }
}
DI unsigned enc_u4(float x) { const float t = __builtin_floorf(x + 8.0f); return (unsigned)fminf(fmaxf(t, 0.f), 15.f); }
DI void cvt_stream_u4(const float* src, unsigned char* dst, float scale, int gw, int ngw, int lane) {
    constexpr int NGRP = NEXP * 32;
    for (int g = gw * 64 + lane; g < NGRP; g += ngw * 64) {
        const int row = g >> 5, lp = g & 31;
        const f32x4* p = (const f32x4*)(src + (size_t)g * 32);
        f32x4 v[8];
#pragma unroll
        for (int q = 0; q < 8; ++q) v[q] = __builtin_nontemporal_load(p + q);
        unsigned w[4];
#pragma unroll
        for (int d = 0; d < 4; ++d) { unsigned acc = 0u;
#pragma unroll
            for (int e = 0; e < 8; ++e) acc |= enc_u4(v[2 * d + (e >> 2)][e & 3] * scale) << (e < 4 ? 8 * e : 8 * (e - 4) + 4);
            w[d] = acc; }
        *(u32x4*)(dst + (size_t)row * ROW4 + 16 * lp) = (u32x4){w[0], w[1], w[2], w[3]};
    }
}
DI int udot_i4(const u32x4 a, const u32x4 (&h8)[2]) {
    int a0 = 0, a1 = 0;
#pragma unroll
    for (int q = 0; q < 4; ++q) {
        const unsigned lo = a[q] & 0x0f0f0f0fu, hi = (a[q] >> 4) & 0x0f0f0f0fu;
        a0 = __builtin_amdgcn_sdot4((int)h8[q >> 1][2 * (q & 1)], (int)lo, a0, false);
        a1 = __builtin_amdgcn_sdot4((int)h8[q >> 1][2 * (q & 1) + 1], (int)hi, a1, false);
    }
    return a0 + a1;
}
DI void dec_fp4x32(const u32x4 a, float (&f)[32]) {
#pragma unroll
    for (int q = 0; q < 4; ++q) {
        const v2f_t t0 = __builtin_amdgcn_cvt_scalef32_pk_f32_fp4(a[q], 1.0f, 0), t1 = __builtin_amdgcn_cvt_scalef32_pk_f32_fp4(a[q], 1.0f, 1),
                    t2 = __builtin_amdgcn_cvt_scalef32_pk_f32_fp4(a[q], 1.0f, 2), t3 = __builtin_amdgcn_cvt_scalef32_pk_f32_fp4(a[q], 1.0f, 3);
        f[8 * q] = t0[0]; f[8 * q + 1] = t0[1]; f[8 * q + 2] = t1[0]; f[8 * q + 3] = t1[1]; f[8 * q + 4] = t2[0]; f[8 * q + 5] = t2[1]; f[8 * q + 6] = t3[0]; f[8 * q + 7] = t3[1];
    }
}
DI void cvt_stream_tab(const float* src, unsigned char* dst, int kind, float scale, int gw, int ngw, int lane) {
    if (kind == 2) cvt_stream_u4(src, dst, scale, gw, ngw, lane); else if (kind == 1) cvt_stream_fp4(src, dst, scale, gw, ngw, lane); else cvt_stream_fp6(src, dst, scale, gw, ngw, lane);
}
template <int CTRL> DI float dppf(float v) { return __int_as_float(__builtin_amdgcn_update_dpp(0, __float_as_int(v), CTRL, 0xf, 0xf, false)); }
DI unsigned pick_swz(int v, int j) {
    switch (j) { case 0: return (unsigned)__builtin_amdgcn_ds_swizzle(v, 0 << 5); case 1: return (unsigned)__builtin_amdgcn_ds_swizzle(v, 1 << 5);
                 case 2: return (unsigned)__builtin_amdgcn_ds_swizzle(v, 2 << 5); default: return (unsigned)__builtin_amdgcn_ds_swizzle(v, 3 << 5); }
}
DI unsigned pick_half(int v, int j, int half) { const int a0 = __builtin_amdgcn_readlane(v, j), a1 = __builtin_amdgcn_readlane(v, 32 + j); return (unsigned)(half ? a1 : a0); }
typedef __bf16 bf2v_t __attribute__((ext_vector_type(2)));
DI float udot_fp4(const u32x4 a, const u32x4 (&hq)[4]) {
    float a0 = 0.f, a1 = 0.f;
#pragma unroll
    for (int qq = 0; qq < 2; ++qq) {
        bf2v_t t[8];
#pragma unroll
        for (int q = 0; q < 2; ++q) {
            t[4 * q + 0] = __builtin_amdgcn_cvt_scalef32_pk_bf16_fp4(a[2 * qq + q], 1.0f, 0); t[4 * q + 1] = __builtin_amdgcn_cvt_scalef32_pk_bf16_fp4(a[2 * qq + q], 1.0f, 1);
            t[4 * q + 2] = __builtin_amdgcn_cvt_scalef32_pk_bf16_fp4(a[2 * qq + q], 1.0f, 2); t[4 * q + 3] = __builtin_amdgcn_cvt_scalef32_pk_bf16_fp4(a[2 * qq + q], 1.0f, 3); }
        asm volatile("" : "+v"(t[0]), "+v"(t[1]), "+v"(t[2]), "+v"(t[3]), "+v"(t[4]), "+v"(t[5]), "+v"(t[6]), "+v"(t[7]));
#pragma unroll
        for (int q = 0; q < 2; ++q) {
            a0 = __builtin_amdgcn_fdot2_f32_bf16(__builtin_bit_cast(bf2v_t, (unsigned)hq[2 * qq + q][0]), t[4 * q + 0], a0, false);
            a1 = __builtin_amdgcn_fdot2_f32_bf16(__builtin_bit_cast(bf2v_t, (unsigned)hq[2 * qq + q][1]), t[4 * q + 1], a1, false);
            a0 = __builtin_amdgcn_fdot2_f32_bf16(__builtin_bit_cast(bf2v_t, (unsigned)hq[2 * qq + q][2]), t[4 * q + 2], a0, false);
            a1 = __builtin_amdgcn_fdot2_f32_bf16(__builtin_bit_cast(bf2v_t, (unsigned)hq[2 * qq + q][3]), t[4 * q + 3], a1, false); }
    }
    return a0 + a1;
}
typedef __bf16 bf32v_t __attribute__((ext_vector_type(32)));
DI float udot_fp6(const u32x4 a, const u32x2 b, const u32x4 (&hq)[4]) {
    const v6u_t w = {a.x, a.y, a.z, a.w, b.x, b.y}; const bf32v_t uf = __builtin_amdgcn_cvt_scalef32_pk32_bf16_fp6(w, 1.0f);
    float a0 = 0.f, a1 = 0.f;
#pragma unroll
    for (int q = 0; q < 4; ++q) {
        a0 = __builtin_amdgcn_fdot2_f32_bf16(__builtin_bit_cast(bf2v_t, (unsigned)hq[q][0]), (bf2v_t){uf[8 * q], uf[8 * q + 1]}, a0, false);
        a1 = __builtin_amdgcn_fdot2_f32_bf16(__builtin_bit_cast(bf2v_t, (unsigned)hq[q][1]), (bf2v_t){uf[8 * q + 2], uf[8 * q + 3]}, a1, false);
        a0 = __builtin_amdgcn_fdot2_f32_bf16(__builtin_bit_cast(bf2v_t, (unsigned)hq[q][2]), (bf2v_t){uf[8 * q + 4], uf[8 * q + 5]}, a0, false);
        a1 = __builtin_amdgcn_fdot2_f32_bf16(__builtin_bit_cast(bf2v_t, (unsigned)hq[q][3]), (bf2v_t){uf[8 * q + 6], uf[8 * q + 7]}, a1, false);
    }
    return a0 + a1;
}
DI void peer_gather_token6(const GatherP& P, size_t m, int lane) {
    const int lp = lane & 31, half = lane >> 5;
    u32x4 hq[4];
    { const u32x4* hr = (const u32x4*)(P.H + m * D + 32 * lp);
#pragma unroll
      for (int q = 0; q < 4; ++q) hq[q] = hr[q]; }
    float o[32];
#pragma unroll
    for (int e = 0; e < 32; ++e) o[e] = 0.f;
    float zero_ = 0.f; asm volatile("" : "+v"(zero_));
    const unsigned lp16 = 16u * (unsigned)lp, lp8 = 8u * (unsigned)lp;
    const int bpbase = half << 7;
    const int eself = 2 * (lane & 3) + half;
    const u32x2* rt = P.route + m * 128 + eself;
#if TAB_U4
#define G_UDOT(ua1, ub1) udot_fp4(ua1, hq)
#else
#define G_UDOT(ua1, ub1) udot_fp6(ua1, ub1, hq)
#endif
#define G_PICKB(v_, j_) ((unsigned)__builtin_amdgcn_ds_bpermute(bpbase + 4 * (j_), (int)(v_)))
#define G_PICKR(v_, j_) pick_half((int)(v_), (j_), half)
#define G_PICKS(v_, j_) pick_swz((int)(v_), (j_))
#define G_PICKA(v_, j_) ((GATHER_BP & 4) ? G_PICKS(v_, j_) : (GATHER_BP & 1) ? G_PICKB(v_, j_) : G_PICKR(v_, j_))
#define G_PICKI(v_, j_) ((GATHER_BP & 8) ? G_PICKS(v_, j_) : (GATHER_BP & 2) ? G_PICKB(v_, j_) : G_PICKR(v_, j_))
#if GATHER_DPP
#define GX1(v_) dppf<0xB1>(v_)
#define GX2(v_) dppf<0x4E>(v_)
#define GR4(v_) dppf<0x124>(v_)
#define GR8(v_) dppf<0x128>(v_)
#else
#define GX1(v_) shx<1>(v_, lane)
#define GX2(v_) shx<2>(v_, lane)
#define GR4(v_) shx<4>(v_, lane)
#define GR8(v_) shx<8>(v_, lane)
#endif
#define G_LOAD(ua_, ub_, va_, vb_, re_) do { const int idx_ = (int)(re_).x; _Pragma("unroll") for (int j = 0; j < 4; ++j) { \
            const unsigned ie = G_PICKI(idx_, j);      \
            const unsigned uo = ie * (unsigned)ROWU + lp16, vo = ie * (unsigned)ROWV + lp16;     \
            ua_[j] = *(const u32x4*)(P.U + uo); if (!TAB_U4) ub_[j] = *(const u32x2*)(P.U + (ie * (unsigned)ROWU + 512u + lp8)); \
            va_[j] = *(const u32x4*)(P.V + vo); if (!TAB_V4) vb_[j] = *(const u32x2*)(P.V + (ie * (unsigned)ROWV + 512u + lp8)); } } while (0)
#define G_COMP(ua_, ub_, va_, vb_, re_) do { const float gate = __int_as_float((int)(re_).y); \
        float p[4]; \
        _Pragma("unroll") for (int j = 0; j < 4; ++j) { p[j] = G_UDOT(ua_[j], ub_[j]); if (PROBE_DUP) { u32x4 t_ = ua_[j]; asm volatile("" : "+v"(t_)); p[j] += zero_ * G_UDOT(t_, ub_[j]); } } \
          \
        float p2[2], p1; \
        { const bool up = (lane & 2) != 0; \
          _Pragma("unroll") for (int q = 0; q < 2; ++q) { const float keep = up ? p[q + 2] : p[q], send = up ? p[q] : p[q + 2]; p2[q] = keep + GX2(send); } } \
        { const bool up = (lane & 1) != 0; const float keep = up ? p2[1] : p2[0], send = up ? p2[0] : p2[1]; p1 = keep + GX1(send); } \
        p1 += GR4(p1); p1 += GR8(p1); p1 += shx<16>(p1, lane); \
        const float act = gelu_exact(p1 * (1.0f / UT_SCALE)) * gate * (1.0f / VT_SCALE); \
        _Pragma("unroll") for (int j = 0; j < 4; ++j) { \
            const float a = __int_as_float((int)G_PICKA(__float_as_int(act), j)); \
            float vf[32]; \
            if (TAB_V4) dec_fp4x32(va_[j], vf); \
            else { const v6u_t w = {va_[j].x, va_[j].y, va_[j].z, va_[j].w, vb_[j].x, vb_[j].y}; const v32f_t t = __builtin_amdgcn_cvt_scalef32_pk32_f32_fp6(w, 1.0f); \
                _Pragma("unroll") for (int k = 0; k < 32; ++k) vf[k] = t[k]; } \
            _Pragma("unroll") for (int k = 0; k < 32; ++k) o[k] += a * vf[k]; } } while (0)
#if GATHER_PIPE
    u32x4 uaA[4], vaA[4], uaB[4], vaB[4]; u32x2 ubA[4], vbA[4], ubB[4], vbB[4];
    u32x2 re0 = rt[0], re1 = rt[8];
    G_LOAD(uaA, ubA, vaA, vbA, re0);
#pragma unroll 1
    for (int bt = 0; bt < 16; bt += 2) {
        u32x2 re2 = re0, re3 = re1;
        if (bt < 14) { re2 = rt[(bt + 2) * 8]; re3 = rt[(bt + 3) * 8]; }
        G_LOAD(uaB, ubB, vaB, vbB, re1);
        __builtin_amdgcn_sched_barrier(0);
        G_COMP(uaA, ubA, vaA, vbA, re0);
        if (bt < 14) G_LOAD(uaA, ubA, vaA, vbA, re2);
        __builtin_amdgcn_sched_barrier(0);
        G_COMP(uaB, ubB, vaB, vbB, re1);
        re0 = re2; re1 = re3;
    }
#else
    u32x2 re_next = rt[0];
#pragma unroll 1
    for (int bt = 0; bt < 16; ++bt) {
        const u32x2 re = re_next;
        if (bt < 15) re_next = rt[(bt + 1) * 8];
        u32x4 ua[4], va[4]; u32x2 ub[4], vb[4];
        G_LOAD(ua, ub, va, vb, re);
        G_COMP(ua, ub, va, vb, re);
    }
#endif
#undef G_LOAD
#undef G_COMP
#undef G_UDOT
#undef G_PICKA
#undef G_PICKI
#undef G_PICKB
#undef GX1
#undef GX2
#undef GR4
#undef GR8
#undef G_PICKS
#undef G_PICKR
    float oc[16];
#pragma unroll
    for (int k = 0; k < 16; ++k) { const float lo_ = o[k] + shx<32>(o[k], lane), hi_ = o[16 + k] + shx<32>(o[16 + k], lane); oc[k] = half ? hi_ : lo_; }
    const int bidx = (m >= (size_t)SEQ) ? 1 : 0; const int cbase = 32 * lp + 16 * half;
    float* xr = P.X + m * D + cbase; const float* g2 = P.gt2 + bidx * 6 * D + cbase;
    float xn[16]; float ss = 0.f;
#pragma unroll
    for (int q = 0; q < 4; ++q) { const f32x4 xv = *(const f32x4*)(xr + 4 * q), gv = *(const f32x4*)(g2 + 4 * q);
#pragma unroll
        for (int e = 0; e < 4; ++e) { const float v = xv[e] + gv[e] * oc[q * 4 + e]; xn[q * 4 + e] = v; ss += v * v; } }
    const float rstd = 1.0f / sqrtf(wave_sum(ss, lane) * (1.0f / D) + EPS);
    if (P.last) {
#pragma unroll
        for (int q = 0; q < 4; ++q) { const f32x4 gv = *(const f32x4*)(P.ng + cbase + 4 * q); f32x4 r;
#pragma unroll
            for (int e = 0; e < 4; ++e) r[e] = xn[q * 4 + e] * rstd * gv[e];
            *(f32x4*)(P.out + m * D + cbase + 4 * q) = r; }
    } else {
        float y[16];
#pragma unroll
        for (int q = 0; q < 4; ++q) { const int col = cbase + 4 * q;
            const f32x4 gv = *(const f32x4*)(P.ng + col), sc = *(const f32x4*)(P.nsc + bidx * 6 * D + col), sh = *(const f32x4*)(P.nsh + bidx * 6 * D + col);
            *(f32x4*)(xr + 4 * q) = (f32x4){xn[q * 4], xn[q * 4 + 1], xn[q * 4 + 2], xn[q * 4 + 3]};
#pragma unroll
            for (int e = 0; e < 4; ++e) y[q * 4 + e] = xn[q * 4 + e] * rstd * gv[e] * (1.0f + sc[e]) + sh[e]; }
        bf16_t* ho = P.Hout + m * D + cbase;
        { u32x4 w; w.x = pk2(y[0], y[1]); w.y = pk2(y[2], y[3]); w.z = pk2(y[4], y[5]); w.w = pk2(y[6], y[7]); *(u32x4*)ho = w; }
        { u32x4 w; w.x = pk2(y[8], y[9]); w.y = pk2(y[10], y[11]); w.z = pk2(y[12], y[13]); w.w = pk2(y[14], y[15]); *(u32x4*)(ho + 8) = w; }
        float pr[8];
#pragma unroll
        for (int c = 0; c < 8; ++c) { float a = 0.f;
#pragma unroll
            for (int q = 0; q < 4; ++q) { const f32x4 wv = *(const LAS f32x4*)(P.wsm + c * D + cbase + 4 * q);
                a += (y[q * 4] * wv.x + y[q * 4 + 1] * wv.y) + (y[q * 4 + 2] * wv.z + y[q * 4 + 3] * wv.w); }
            pr[c] = wave_sum(a, lane);
            if (c & 1) __builtin_amdgcn_sched_barrier(0); }
        if (lane < 8) { float rr = pr[0];
#pragma unroll
            for (int c = 1; c < 8; ++c) rr = (lane == c) ? pr[c] : rr;
            P.small[m * 8 + lane] = rr; }
    }
}

constexpr int GC_OFF = 32768;
DI void stage_gather_consts(const GatherP& P, lptr L, int tid) {
    LAS float* gc = (LAS float*)(L + GC_OFF);
    for (int i = tid; i < 2 * D; i += NTHR) { const int b = i >> 10, c = i & (D - 1);
        gc[i] = P.gt2[b * 6 * D + c];
        gc[2 * D + i] = P.last ? P.ng[c] : P.ng[c] * (1.0f + P.nsc[b * 6 * D + c]);
        gc[4 * D + i] = P.last ? 0.f : P.nsh[b * 6 * D + c]; }
    __syncthreads();
}
DI void gather_finish(const GatherP& P, lptr L, size_t m, int lane, float (&o)[32], const f32x4 (&xv4)[4]) {
    const int lp = lane & 31, half = lane >> 5;
    float oc[16];
#pragma unroll
    for (int k = 0; k < 16; ++k) { const float lo_ = o[k] + shx<32>(o[k], lane), hi_ = o[16 + k] + shx<32>(o[16 + k], lane); oc[k] = half ? hi_ : lo_; }
    const int bidx = (m >= (size_t)SEQ) ? 1 : 0; const int cbase = 32 * lp + 16 * half;
    const LAS float* gc = (const LAS float*)(L + GC_OFF) + bidx * D + cbase;
    float* xr = P.X + m * D + cbase;
    float xn[16]; float ss = 0.f;
#pragma unroll
    for (int q = 0; q < 4; ++q) { const f32x4 gv = *(const LAS f32x4*)(gc + 4 * q);
#pragma unroll
        for (int e = 0; e < 4; ++e) { const float v = xv4[q][e] + gv[e] * oc[q * 4 + e]; xn[q * 4 + e] = v; ss += v * v; } }
    const float rstd = 1.0f / sqrtf(wave_sum(ss, lane) * (1.0f / D) + EPS);
    if (P.last) {
#pragma unroll
        for (int q = 0; q < 4; ++q) { const f32x4 gv = *(const LAS f32x4*)(gc + 2 * D + 4 * q); f32x4 r;
#pragma unroll
            for (int e = 0; e < 4; ++e) r[e] = xn[q * 4 + e] * rstd * gv[e];
            *(f32x4*)(P.out + m * D + cbase + 4 * q) = r; }
    } else {
        float y[16];
#pragma unroll
        for (int q = 0; q < 4; ++q) {
            const f32x4 ga = *(const LAS f32x4*)(gc + 2 * D + 4 * q), sh = *(const LAS f32x4*)(gc + 4 * D + 4 * q);
            *(f32x4*)(xr + 4 * q) = (f32x4){xn[q * 4], xn[q * 4 + 1], xn[q * 4 + 2], xn[q * 4 + 3]};
#pragma unroll
            for (int e = 0; e < 4; ++e) y[q * 4 + e] = xn[q * 4 + e] * rstd * ga[e] + sh[e]; }
        bf16_t* ho = P.Hout + m * D + cbase;
        { u32x4 w; w.x = pk2(y[0], y[1]); w.y = pk2(y[2], y[3]); w.z = pk2(y[4], y[5]); w.w = pk2(y[6], y[7]); *(u32x4*)ho = w; }
        { u32x4 w; w.x = pk2(y[8], y[9]); w.y = pk2(y[10], y[11]); w.z = pk2(y[12], y[13]); w.w = pk2(y[14], y[15]); *(u32x4*)(ho + 8) = w; }
        float pr[8];
#pragma unroll
        for (int c = 0; c < 8; ++c) { float a = 0.f;
#pragma unroll
            for (int q = 0; q < 4; ++q) { const f32x4 wv = *(const LAS f32x4*)(P.wsm + c * D + cbase + 4 * q);
                a += (y[q * 4] * wv.x + y[q * 4 + 1] * wv.y) + (y[q * 4 + 2] * wv.z + y[q * 4 + 3] * wv.w); }
            pr[c] = wave_sum(a, lane);
            if (c & 1) __builtin_amdgcn_sched_barrier(0); }
        if (lane < 8) { float rr = pr[0];
#pragma unroll
            for (int c = 1; c < 8; ++c) rr = (lane == c) ? pr[c] : rr;
            P.small[m * 8 + lane] = rr; }
    }
}
#ifdef GATHER_NT
#define GNT(p_) __builtin_nontemporal_load(p_)
#else
#define GNT(p_) (*(p_))
#endif
DI void peer_gather_wave(const GatherP& P, lptr L, int gw, int ngw, int lane) {
    const int lp = lane & 31, half = lane >> 5;
    float zero_ = 0.f; asm volatile("" : "+v"(zero_));
    const unsigned lp16 = 16u * (unsigned)lp, lp8 = 8u * (unsigned)lp;
    const int bpbase = half << 7;
    const int eself = 2 * (lane & 3) + half;
    size_t m = (size_t)gw;
#if TAB_UI4
    u32x4 hq[2]; float uinv, hcorr;
#define G_HLOAD(hq_, uinv_, hcorr_, m_) do { const u32x4* hr_ = (const u32x4*)(P.H8 + (m_) * D + 32 * lp); hq_[0] = hr_[0]; hq_[1] = hr_[1]; uinv_ = P.HS[(m_)] * (1.0f / UI_SCALE); } while (0)
#define G_HCORR(hq_, hcorr_) do { int s_ = 0; _Pragma("unroll") for (int q_ = 0; q_ < 8; ++q_) s_ = __builtin_amdgcn_sdot4((int)hq_[q_ >> 2][q_ & 3], 0x01010101, s_, false); hcorr_ = 7.5f * (float)s_; } while (0)
#define G_UDOT(ua1, ub1) ((float)udot_i4(ua1, hq) - hcorr)
    constexpr int NHQ = 2;
    G_HLOAD(hq, uinv, hcorr, m); G_HCORR(hq, hcorr);
#else
    u32x4 hq[4]; const float uinv = 1.0f / UT_SCALE;
    { const u32x4* hr = (const u32x4*)(P.H + m * D + 32 * lp);
#pragma unroll
      for (int q = 0; q < 4; ++q) hq[q] = GNT(hr + q); }
    constexpr int NHQ = 4;
#if TAB_U4
#define G_UDOT(ua1, ub1) udot_fp4(ua1, hq)
#else
#define G_UDOT(ua1, ub1) udot_fp6(ua1, ub1, hq)
#endif
#endif
    const u32x2* rt = P.route + m * 128 + eself;
#define G_PICKB(v_, j_) ((unsigned)__builtin_amdgcn_ds_bpermute(bpbase + 4 * (j_), (int)(v_)))
#define G_PICKR(v_, j_) pick_half((int)(v_), (j_), half)
#define G_PICKS(v_, j_) pick_swz((int)(v_), (j_))
#define G_PICKA(v_, j_) ((GATHER_BP & 4) ? G_PICKS(v_, j_) : (GATHER_BP & 1) ? G_PICKB(v_, j_) : G_PICKR(v_, j_))
#define G_PICKI(v_, j_) ((GATHER_BP & 8) ? G_PICKS(v_, j_) : (GATHER_BP & 2) ? G_PICKB(v_, j_) : G_PICKR(v_, j_))
#if GATHER_DPP
#define GX1(v_) dppf<0xB1>(v_)
#define GX2(v_) dppf<0x4E>(v_)
#define GR4(v_) dppf<0x124>(v_)
#define GR8(v_) dppf<0x128>(v_)
#else
#define GX1(v_) shx<1>(v_, lane)
#define GX2(v_) shx<2>(v_, lane)
#define GR4(v_) shx<4>(v_, lane)
#define GR8(v_) shx<8>(v_, lane)
#endif
#define G_LOAD(ua_, ub_, va_, vb_, re_) do { const int idx_ = (int)(re_).x; _Pragma("unroll") for (int j = 0; j < 4; ++j) { \
            const unsigned ie = G_PICKI(idx_, j);      \
            const unsigned uo = ie * (unsigned)ROWU + lp16, vo = ie * (unsigned)ROWV + lp16;     \
            ua_[j] = *(const u32x4*)(P.U + uo); if (!TAB_U4) ub_[j] = *(const u32x2*)(P.U + (ie * (unsigned)ROWU + 512u + lp8)); \
            va_[j] = *(const u32x4*)(P.V + vo); if (!TAB_V4) vb_[j] = *(const u32x2*)(P.V + (ie * (unsigned)ROWV + 512u + lp8)); } } while (0)
#define G_COMP(ua_, ub_, va_, vb_, re_) do { const float gate = __int_as_float((int)(re_).y); \
        float p[4]; \
        _Pragma("unroll") for (int j = 0; j < 4; ++j) { p[j] = G_UDOT(ua_[j], ub_[j]); if (PROBE_DUP) { u32x4 t_ = ua_[j]; asm volatile("" : "+v"(t_)); p[j] += zero_ * G_UDOT(t_, ub_[j]); } } \
          \
        float p2[2], p1; \
        { const bool up = (lane & 2) != 0; \
          _Pragma("unroll") for (int q = 0; q < 2; ++q) { const float keep = up ? p[q + 2] : p[q], send = up ? p[q] : p[q + 2]; p2[q] = keep + GX2(send); } } \
        { const bool up = (lane & 1) != 0; const float keep = up ? p2[1] : p2[0], send = up ? p2[0] : p2[1]; p1 = keep + GX1(send); } \
        p1 += GR4(p1); p1 += GR8(p1); p1 += shx<16>(p1, lane); \
        const float act = gelu_exact(p1 * uinv) * gate * (1.0f / VT_SCALE); \
        _Pragma("unroll") for (int j = 0; j < 4; ++j) { \
            const float a = __int_as_float((int)G_PICKA(__float_as_int(act), j)); \
            if (TAB_V4 && !GATHER_INPLACE) { float vf[32]; dec_fp4x32(va_[j], vf); \
                _Pragma("unroll") for (int k = 0; k < 16; ++k) { o2[k][0] += a * vf[2 * k]; o2[k][1] += a * vf[2 * k + 1]; } } \
            else if (TAB_V4) { const v2f_t aa = {a, a}; \
                  \
                _Pragma("unroll") for (int q = 0; q < 4; ++q) { \
                    const v2f_t t0 = __builtin_amdgcn_cvt_scalef32_pk_f32_fp4(va_[j][q], 1.0f, 0), t1 = __builtin_amdgcn_cvt_scalef32_pk_f32_fp4(va_[j][q], 1.0f, 1), \
                                t2 = __builtin_amdgcn_cvt_scalef32_pk_f32_fp4(va_[j][q], 1.0f, 2), t3 = __builtin_amdgcn_cvt_scalef32_pk_f32_fp4(va_[j][q], 1.0f, 3); \
                    asm("v_pk_fma_f32 %0, %1, %2, %0" : "+v"(o2[4 * q + 0]) : "v"(t0), "v"(aa)); asm("v_pk_fma_f32 %0, %1, %2, %0" : "+v"(o2[4 * q + 1]) : "v"(t1), "v"(aa)); \
                    asm("v_pk_fma_f32 %0, %1, %2, %0" : "+v"(o2[4 * q + 2]) : "v"(t2), "v"(aa)); asm("v_pk_fma_f32 %0, %1, %2, %0" : "+v"(o2[4 * q + 3]) : "v"(t3), "v"(aa)); } } \
            else { float vf[32]; const v6u_t w = {va_[j].x, va_[j].y, va_[j].z, va_[j].w, vb_[j].x, vb_[j].y}; const v32f_t t = __builtin_amdgcn_cvt_scalef32_pk32_f32_fp6(w, 1.0f); \
                _Pragma("unroll") for (int k = 0; k < 32; ++k) vf[k] = t[k]; \
                _Pragma("unroll") for (int k = 0; k < 16; ++k) { o2[k][0] += a * vf[2 * k]; o2[k][1] += a * vf[2 * k + 1]; } } } } while (0)
#if GATHER_DEPTH == 3
    u32x4 uaA[4], vaA[4], uaB[4], vaB[4], uaC[4], vaC[4]; u32x2 ubA[4], vbA[4], ubB[4], vbB[4], ubC[4], vbC[4];
    u32x2 reA = GNT(rt), reB = GNT(rt + 8), reC = GNT(rt + 16), rp;
    G_LOAD(uaA, ubA, vaA, vbA, reA); G_LOAD(uaB, ubB, vaB, vbB, reB);
#pragma unroll 1
    for (;;) {
        const size_t mn = m + (size_t)ngw; const bool more = mn < (size_t)M;
        const u32x2* rtn = P.route + (more ? mn : m) * 128 + eself;
        v2f_t o2[16];
#pragma unroll
        for (int e = 0; e < 16; ++e) o2[e] = (v2f_t){0.f, 0.f};
        f32x4 xv4[4]; u32x4 hqn[NHQ]; float uinvn = 0.f;
#define G_STEP(XL, XC, REL, REC, rpsrc) do { G_LOAD(ua##XL, ub##XL, va##XL, vb##XL, REL); rp = GNT(rpsrc); __builtin_amdgcn_sched_barrier(0); \
            G_COMP(ua##XC, ub##XC, va##XC, vb##XC, REC); REC = rp; __builtin_amdgcn_sched_barrier(0); } while (0)
#pragma unroll 1
        for (int k = 0; k < 12; k += 3) {
            G_STEP(C, A, reC, reA, rt + (k + 3) * 8);
            G_STEP(A, B, reA, reB, rt + (k + 4) * 8);
            G_STEP(B, C, reB, reC, rt + (k + 5) * 8);
        }
        G_STEP(C, A, reC, reA, rt + 15 * 8);
        G_STEP(A, B, reA, reB, rtn);
        if (more) { G_STEP(B, C, reB, reC, rtn + 8); } else { rp = reC; G_COMP(uaC, ubC, vaC, vbC, reC); }
        if (more) { G_STEP(C, A, reC, reA, rtn + 16); } else { G_COMP(uaA, ubA, vaA, vbA, reA); }
#undef G_STEP
        { const float* xr = P.X + m * D + 32 * lp + 16 * half;
#pragma unroll
          for (int q = 0; q < 4; ++q) xv4[q] = GNT((const f32x4*)(xr + 4 * q)); }
#if TAB_UI4
        if (more) { float hc_; G_HLOAD(hqn, uinvn, hc_, mn); }
#else
        if (more) { const u32x4* hr = (const u32x4*)(P.H + mn * D + 32 * lp);
#pragma unroll
            for (int q = 0; q < 4; ++q) hqn[q] = GNT(hr + q); }
#endif
        __builtin_amdgcn_sched_barrier(0);
        float o[32];
#pragma unroll
        for (int e = 0; e < 16; ++e) { o[2 * e] = o2[e][0]; o[2 * e + 1] = o2[e][1]; }
        gather_finish(P, L, m, lane, o, xv4);
        if (!more) break;
        m = mn; rt = rtn;
        { const u32x2 t0 = reB, t1 = reC, t2 = reA; reA = t0; reB = t1; reC = t2; }
#pragma unroll
        for (int j = 0; j < 4; ++j) { uaA[j] = uaB[j]; vaA[j] = vaB[j]; uaB[j] = uaC[j]; vaB[j] = vaC[j]; if (!TAB_U4 && !TAB_UI4) { ubA[j] = ubB[j]; ubB[j] = ubC[j]; } if (!TAB_V4) { vbA[j] = vbB[j]; vbB[j] = vbC[j]; } }
#pragma unroll
        for (int q = 0; q < NHQ; ++q) hq[q] = hqn[q];
#if TAB_UI4
        uinv = uinvn; G_HCORR(hq, hcorr);
#endif
    }
#else
    u32x4 uaA[4], vaA[4], uaB[4], vaB[4]; u32x2 ubA[4], vbA[4], ubB[4], vbB[4];
    u32x2 re0 = GNT(rt), re1 = GNT(rt + 8);
    G_LOAD(uaA, ubA, vaA, vbA, re0);
#pragma unroll 1
    for (;;) {
        const size_t mn = m + (size_t)ngw; const bool more = mn < (size_t)M;
        const u32x2* rtn = P.route + (more ? mn : m) * 128 + eself;
        const u32x2 re0n = GNT(rtn), re1n = GNT(rtn + 8);
        v2f_t o2[16];
#pragma unroll
        for (int e = 0; e < 16; ++e) o2[e] = (v2f_t){0.f, 0.f};
        f32x4 xv4[4]; u32x4 hqn[NHQ]; float uinvn = 0.f;
#pragma unroll 1
        for (int bt = 0; bt < 16; bt += 2) {
            u32x2 re2 = re0, re3 = re1;
            if (bt < 14) { re2 = GNT(rt + (bt + 2) * 8); re3 = GNT(rt + (bt + 3) * 8); }
            G_LOAD(uaB, ubB, vaB, vbB, re1);
            __builtin_amdgcn_sched_barrier(0);
            G_COMP(uaA, ubA, vaA, vbA, re0);
            if (bt < 14) G_LOAD(uaA, ubA, vaA, vbA, re2);
            else if (more) G_LOAD(uaA, ubA, vaA, vbA, re0n);
            __builtin_amdgcn_sched_barrier(0);
            G_COMP(uaB, ubB, vaB, vbB, re1);
            re0 = re2; re1 = re3;
        }
        { const float* xr = P.X + m * D + 32 * lp + 16 * half;
#pragma unroll
          for (int q = 0; q < 4; ++q) xv4[q] = GNT((const f32x4*)(xr + 4 * q)); }
#if TAB_UI4
        if (more) { float hc_; G_HLOAD(hqn, uinvn, hc_, mn); }
#else
        if (more) { const u32x4* hr = (const u32x4*)(P.H + mn * D + 32 * lp);
#pragma unroll
            for (int q = 0; q < 4; ++q) hqn[q] = GNT(hr + q); }
#endif
        __builtin_amdgcn_sched_barrier(0);
        float o[32];
#pragma unroll
        for (int e = 0; e < 16; ++e) { o[2 * e] = o2[e][0]; o[2 * e + 1] = o2[e][1]; }
        gather_finish(P, L, m, lane, o, xv4);
        if (!more) break;
        m = mn; rt = rtn; re0 = re0n; re1 = re1n;
#pragma unroll
        for (int q = 0; q < NHQ; ++q) hq[q] = hqn[q];
#if TAB_UI4
        uinv = uinvn; G_HCORR(hq, hcorr);
#endif
    }
#endif
#undef G_LOAD
#undef G_COMP
#undef G_UDOT
#undef G_HLOAD
#undef G_HCORR
#undef G_PICKA
#undef G_PICKI
#undef G_PICKB
#undef GX1
#undef GX2
#undef GR4
#undef GR8
#undef G_PICKS
#undef G_PICKR
}

constexpr int GA_OFF = GC_OFF + 24576;
DI void peer_gather_split(const GatherP& P, lptr L, int gw, int ngw, int lane, int wave) {
    const int lp = lane & 31, half = lane >> 5;
    const unsigned lp16 = 16u * (unsigned)lp;
    const int eself = 2 * (lane & 3) + half;
    LAS float* actw = (LAS float*)(L + GA_OFF) + wave * 1024;
#define RT_AT(g_) (P.route + ((size_t)gw + (size_t)((g_) >> 4) * (size_t)ngw) * 128 + eself + ((g_) & 15) * 8)
#define ROW_LOAD(x_, tab_, row_, re_) do { const int idx_ = (int)(re_).x; _Pragma("unroll") for (int j = 0; j < 4; ++j) { \
        const unsigned ie = pick_swz(idx_, j); x_[j] = *(const u32x4*)((tab_) + (ie * (unsigned)(row_) + lp16)); } } while (0)
    {
        u32x4 hq[2], hqn[2]; float uinv, uinvn = 0.f, hcorr; float gA = 0.f, gB = 0.f;
#define S_HLOAD(hq_, uinv_, m_) do { const u32x4* hr_ = (const u32x4*)(P.H8 + (m_) * D + 32 * lp); hq_[0] = hr_[0]; hq_[1] = hr_[1]; uinv_ = P.HS[(m_)] * (1.0f / UI_SCALE); } while (0)
#define S_HCORR(hq_, hcorr_) do { int s_ = 0; _Pragma("unroll") for (int q_ = 0; q_ < 8; ++q_) s_ = __builtin_amdgcn_sdot4((int)hq_[q_ >> 2][q_ & 3], 0x01010101, s_, false); hcorr_ = 7.5f * (float)s_; } while (0)
        S_HLOAD(hq, uinv, (size_t)gw); S_HCORR(hq, hcorr);
        u32x4 u0[4], u1[4], u2[4], u3[4], u4[4], u5[4], u6[4], u7[4];
        u32x2 r0 = *RT_AT(0), r1 = *RT_AT(1), r2 = *RT_AT(2), r3 = *RT_AT(3), r4 = *RT_AT(4), r5 = *RT_AT(5), r6 = *RT_AT(6), r7 = *RT_AT(7), rp;
        ROW_LOAD(u0, P.U, ROW4, r0); ROW_LOAD(u1, P.U, ROW4, r1); ROW_LOAD(u2, P.U, ROW4, r2); ROW_LOAD(u3, P.U, ROW4, r3);
        ROW_LOAD(u4, P.U, ROW4, r4); ROW_LOAD(u5, P.U, ROW4, r5); ROW_LOAD(u6, P.U, ROW4, r6);
#define U_STEP(XL, RL, XC, RC, gc) do { \
            if ((gc) + 7 < 128) ROW_LOAD(XL, P.U, ROW4, RL); \
            rp = ((gc) + 8 < 128) ? *RT_AT((gc) + 8) : RC; \
            __builtin_amdgcn_sched_barrier(0); \
            float p[4]; \
            _Pragma("unroll") for (int j = 0; j < 4; ++j) p[j] = (float)udot_i4(XC[j], hq) - hcorr; \
            float p2[2], p1; \
            { const bool up = (lane & 2) != 0; \
              _Pragma("unroll") for (int q = 0; q < 2; ++q) { const float keep = up ? p[q + 2] : p[q], send = up ? p[q] : p[q + 2]; p2[q] = keep + dppf<0x4E>(send); } } \
            { const bool up = (lane & 1) != 0; const float keep = up ? p2[1] : p2[0], send = up ? p2[0] : p2[1]; p1 = keep + dppf<0xB1>(send); } \
            p1 += dppf<0x124>(p1); p1 += dppf<0x128>(p1); p1 += shx<16>(p1, lane); \
            if (lp < 4) actw[((gc) >> 4) * 128 + ((gc) & 15) * 8 + eself] = p1 * uinv; \
            RC = rp; } while (0)
#pragma unroll 1
        for (int g = 0; g < 128; g += 8) {
            const int bt0 = g & 15; const int k = g >> 4; const size_t mk = (size_t)gw + (size_t)k * (size_t)ngw;
            if (bt0 == 0 && g > 0) { hq[0] = hqn[0]; hq[1] = hqn[1]; uinv = uinvn; S_HCORR(hq, hcorr); }
            if (bt0 == 0) {
                gA = __int_as_float((int)P.route[mk * 128 + lane].y); gB = __int_as_float((int)P.route[mk * 128 + 64 + lane].y);
                if (g + 16 < 128) S_HLOAD(hqn, uinvn, mk + (size_t)ngw); }
            U_STEP(u7, r7, u0, r0, g + 0); U_STEP(u0, r0, u1, r1, g + 1); U_STEP(u1, r1, u2, r2, g + 2); U_STEP(u2, r2, u3, r3, g + 3);
            U_STEP(u3, r3, u4, r4, g + 4); U_STEP(u4, r4, u5, r5, g + 5); U_STEP(u5, r5, u6, r6, g + 6); U_STEP(u6, r6, u7, r7, g + 7);
            if (bt0 == 8) {
                LDS_WAIT();
                LAS float* at = actw + k * 128;
                const float v0 = at[lane], v1 = at[64 + lane];
                at[lane] = gelu_exact(v0) * gA * (1.0f / VT_SCALE); at[64 + lane] = gelu_exact(v1) * gB * (1.0f / VT_SCALE);
            }
        }
#undef U_STEP
#undef S_HLOAD
#undef S_HCORR
    }
    LDS_WAIT();
    {
        u32x4 v0[4], v1[4], v2[4], v3[4];
        u32x2 r0 = *RT_AT(0), r1 = *RT_AT(1), r2 = *RT_AT(2), r3 = *RT_AT(3), rp;
        ROW_LOAD(v0, P.V, ROW4, r0); ROW_LOAD(v1, P.V, ROW4, r1); ROW_LOAD(v2, P.V, ROW4, r2);
        v2f_t o2[16];
#pragma unroll
        for (int e = 0; e < 16; ++e) o2[e] = (v2f_t){0.f, 0.f};
        f32x4 xv4[4];
#define V_STEP(XL, RL, XC, RC, gc) do { \
            if ((gc) + 3 < 128) ROW_LOAD(XL, P.V, ROW4, RL); \
            rp = ((gc) + 4 < 128) ? *RT_AT((gc) + 4) : RC; \
            __builtin_amdgcn_sched_barrier(0); \
            { const LAS float* ab = actw + ((gc) >> 4) * 128 + ((gc) & 15) * 8 + half; \
              _Pragma("unroll") for (int j = 0; j < 4; ++j) { const float a = ab[2 * j]; \
                _Pragma("unroll") for (int q = 0; q < 4; ++q) { \
                    const v2f_t t0 = __builtin_amdgcn_cvt_scalef32_pk_f32_fp4(XC[j][q], 1.0f, 0), t1 = __builtin_amdgcn_cvt_scalef32_pk_f32_fp4(XC[j][q], 1.0f, 1), \
                                t2 = __builtin_amdgcn_cvt_scalef32_pk_f32_fp4(XC[j][q], 1.0f, 2), t3 = __builtin_amdgcn_cvt_scalef32_pk_f32_fp4(XC[j][q], 1.0f, 3); \
                    o2[4 * q + 0] += t0 * a; o2[4 * q + 1] += t1 * a; o2[4 * q + 2] += t2 * a; o2[4 * q + 3] += t3 * a; } } } \
            RC = rp; } while (0)
#pragma unroll 1
        for (int g = 0; g < 128; g += 4) {
            const int bt0 = g & 15; const int k = g >> 4; const size_t mk = (size_t)gw + (size_t)k * (size_t)ngw;
            V_STEP(v3, r3, v0, r0, g + 0);
            if (bt0 == 12) { const float* xr = P.X + mk * D + 32 * lp + 16 * half;
#pragma unroll
                for (int q = 0; q < 4; ++q) xv4[q] = *(const f32x4*)(xr + 4 * q); }
            V_STEP(v0, r0, v1, r1, g + 1);
            V_STEP(v1, r1, v2, r2, g + 2);
            V_STEP(v2, r2, v3, r3, g + 3);
            if (bt0 == 12) {
                float o[32];
#pragma unroll
                for (int e = 0; e < 16; ++e) { o[2 * e] = o2[e][0]; o[2 * e + 1] = o2[e][1]; o2[e] = (v2f_t){0.f, 0.f}; }
                gather_finish(P, L, mk, lane, o, xv4);
            }
        }
#undef V_STEP
    }
#undef ROW_LOAD
#undef RT_AT
}

#ifndef MK_SINGLE
#define MK_SINGLE 0
#endif
#ifndef TABLE_FP6
#define TABLE_FP6 1
#endif
#ifndef GATHER_MODE
#define GATHER_MODE 0
#endif
#ifndef MIX_SPLIT
#define MIX_SPLIT 0
#endif
constexpr int SH = MIX_SPLIT;
constexpr int NSLOT = (GATHER_MODE ? 12 : 10) + MIX_SPLIT;
constexpr int NPHASE = 2 + NSLOT * DEPTH;
constexpr int PH_ALL = (1 << (2 + NSLOT)) - 1;
enum { I_X = 0, I_C, I_ADAW, I_ADAB, I_N1G, I_N2G, I_FING, I_WIN, I_LBL, I_HGNG, I_CONVW, I_ALOG, I_DTB, I_GDNNG, I_WBH, I_WBG, I_WOUT, I_WQ, I_SK, I_U, I_V };

DI int lane_id_() { unsigned m_ = ~0u; asm volatile("" : "+s"(m_)); return (int)__builtin_amdgcn_mbcnt_hi(m_, __builtin_amdgcn_mbcnt_lo(m_, 0u)); }
template <int PHM> __global__ void __launch_bounds__(NTHR, 2) trunk_fwd(Args args) {
    extern __shared__ __attribute__((aligned(16))) unsigned char lds_raw[];
    lptr L = (lptr)lds_raw;
    const int tid0 = threadIdx.x, wave = __builtin_amdgcn_readfirstlane(tid0 >> 6);
#if MK_SINGLE
    constexpr int G = 256;
#else
    const int G = gridDim.x;
#endif
    const int bx = blockIdx.x; const int vcu = (G % 8 == 0) ? (bx % 8) * (G / 8) + bx / 8 : bx;
    const int gw = vcu * NWAVES + wave, NGW = G * NWAVES;
    unsigned char* ws0 = args.ws;
#if MK_SINGLE
    constexpr int lo = 0, hi = NPHASE;
#else
    const int lo = args.ph_lo, hi = args.ph_hi;
#endif
    volatile LAS unsigned* MISC = (volatile LAS unsigned*)(L + LDS_CTL_OFF);
    for (int u = tid0; u < (LDS_BYTES - LDS_CTL_OFF) / 4; u += NTHR) ((LAS unsigned*)(L + LDS_CTL_OFF))[u] = 0u;
    __syncthreads();
#if MK_SINGLE
    xcd_barrier_post((unsigned*)(ws0 + WS_CTL) + 4096, wave);
#define GRID_BAR() do { unsigned* bp_ = (unsigned*)(args.ws + WS_CTL) + 4096; asm volatile("" : "+s"(bp_)); XcdBarrier b_; b_.bar = bp_; b_.x = xb_xcc_id(); b_.st = (volatile LAS unsigned*)(L + LDS_CTL_OFF) + 8; xcd_barrier(b_, wave); } while (0)
#else
#define GRID_BAR() do {} while (0)
#endif
#define PH_MASK PHM
#ifndef REP_MASK
#define REP_MASK 0
#endif
#ifndef NREPA
#define NREPA 1
#endif
#define NREP(j) (1 + (((REP_MASK) >> (j)) & 1))
#define IN(k) (lo <= (k) && (k) < hi)
#define INL(j) ((((PH_MASK) >> (2 + (j))) & 1) && IN(pb + (j)))
#define IN0(k) ((((PH_MASK) >> (k)) & 1) && IN(k))
#define PHASE_BEGIN() size_t kz = 0; int tid = wave * 64 + lane_id_(); asm volatile("" : "+s"(kz), "+v"(tid)); unsigned char* ws = args.ws + kz; const int lane = tid & 63
#define INP(i) (args.in[i] + kz)
#define SEAM(k) do { if (IN(k) && IN((k) + 1)) GRID_BAR(); } while (0)

#define P_MOD   ((float*)(ws + WS_MOD))
#define P_SMALL ((float*)(ws + WS_SMALL))
#define P_SMALLL(l) ((float*)(ws + ((l) ? WS_SMALL1 : WS_SMALL)))
#define P_WIN   ((bf16_t*)(ws + WS_WIN))
#define P_WBR   ((bf16_t*)(ws + WS_WBR))
#define P_WOUT  ((bf16_t*)(ws + WS_WOUT))
#define P_WQ    ((bf16_t*)(ws + WS_WQ))
#define P_SK    ((bf16_t*)(ws + WS_SK))
#define P_PROJ  ((bf16_t*)(ws + WS_PROJ))
#define P_Y     ((bf16_t*)(ws + WS_Y))
#define P_U     ((unsigned char*)(ws + (TABLE_FP6 ? WS_U6 : WS_UV)))
#define P_V     (TABLE_FP6 ? (unsigned char*)(ws + WS_WIN + (size_t)l * 12 * MiB) : (unsigned char*)(ws + WS_UV) + (size_t)NEXP * D)
#define P_H     ((bf16_t*)(ws + WS_H))
#define P_MERGED ((bf16_t*)(ws + WS_MERGED))
#define P_H8    ((unsigned char*)(ws + WS_Y))
#define P_HS    ((float*)(ws + WS_Y + 16 * MiB))
#define P_ROUTE ((u32x2*)(ws + WS_ROUTE))
#define MIXP_INIT(MP, l) MixP MP; MP.PROJ = P_PROJ; MP.SMALL = P_SMALLL(l); MP.convw = INP(I_CONVW) + (size_t)(l) * 4 * 1536; MP.alog = INP(I_ALOG) + (l) * 4; MP.dtb = INP(I_DTB) + (l) * 4; MP.lbl = INP(I_LBL); MP.l = (l); \
        MP.MT = ws + WS_MT; MP.NN = ws + WS_NN; MP.QT = ws + WS_QT; MP.OP = ws + WS_OP; MP.SS = ws + WS_SS; MP.DL = (float*)(ws + WS_DL)

    for (int rep_ = 0; rep_ < NREP(10); ++rep_) if (IN0(0)) { if (rep_) GRID_BAR();
        PHASE_BEGIN();
        if (vcu < 192) mod_item(INP(I_C), INP(I_ADAW), INP(I_ADAB), P_MOD, vcu, L, tid);
        LAS float* scr = (LAS float*)(L + wave * 16384);
        constexpr int IT_WIN = 16 * 192, IT_WBR = 8 * 32, IT_WOUT = 16 * 32, IT_WQ = 16 * 64, IT_L = IT_WIN + 2 * IT_WBR + IT_WOUT + IT_WQ;
        for (int it = gw; it < DEPTH * IT_L; it += NGW) {
            const int l = it / IT_L; int r = it - l * IT_L;
            if (r < IT_WIN) { const int kb = r / 192, nb = r % 192, n0 = 32 * nb; transpose_item(INP(I_WIN) + (size_t)l * D * IN_COLS, IN_COLS, n0 + (n0 >= 4096 ? 8 : 0), P_WIN + (size_t)l * NPROJ * D, D, n0, 64 * kb, scr, lane); continue; } r -= IT_WIN;
            if (r < IT_WBR) { const int kb = r / 32, nb = r % 32; transpose_item(INP(I_WBH) + (size_t)l * 512 * D, D, 32 * nb, P_WBR + ((size_t)l * 2 + 0) * D * 512, 512, 32 * nb, 64 * kb, scr, lane); continue; } r -= IT_WBR;
            if (r < IT_WBR) { const int kb = r / 32, nb = r % 32; transpose_item(INP(I_WBG) + (size_t)l * 512 * D, D, 32 * nb, P_WBR + ((size_t)l * 2 + 1) * D * 512, 512, 32 * nb, 64 * kb, scr, lane); continue; } r -= IT_WBR;
            if (r < IT_WOUT) { const int kb = r / 32, nb = r % 32; transpose_item(INP(I_WOUT) + (size_t)l * D * D, D, 32 * nb, P_WOUT + (size_t)l * D * D, D, 32 * nb, 64 * kb, scr, lane); continue; } r -= IT_WOUT;
            { const int kb = r / 64, nb = r % 64; transpose_item(INP(I_WQ) + (size_t)l * D * NQ, NQ, 32 * nb, P_WQ + (size_t)l * NQ * D, D, 32 * nb, 64 * kb, scr, lane); }
        }
        cvt_stream(INP(I_SK), P_SK, (size_t)DEPTH * 8 * 2 * 128 * 128, gw, NGW, lane);
    }
    SEAM(0);
    for (int rep_ = 0; rep_ < NREP(11); ++rep_) if (IN0(1)) { if (rep_) GRID_BAR();
        PHASE_BEGIN();
        LAS float* wsm = (LAS float*)L;
        stage_wsmall(INP(I_WIN), wsm, tid);
        const float* x = INP(I_X); float* mod = P_MOD;
        for (int bb = 0; bb < BATCH; ++bb) {
            RowMod R; load_rowmod(R, INP(I_N1G), mod + (size_t)bb * 6 * D + D, mod + (size_t)bb * 6 * D, lane);
            for (int m = bb * SEQ + gw; m < (bb + 1) * SEQ; m += NGW) {
                f32x4 v[4];
#pragma unroll
                for (int j = 0; j < 4; ++j) v[j] = ((const f32x4*)(x + (size_t)m * D))[lane + 64 * j];
                row_finish<true>(v, R, P_H + (size_t)m * D, P_SMALL + (size_t)m * 8, wsm, lane);
            }
        }
    }
    SEAM(1);
#ifdef EXTRA_BARS
#ifndef EB_RT
#define EB_RT 0
#endif
    for (int eb_ = 0; eb_ < EXTRA_BARS + EB_RT; ++eb_) GRID_BAR();
#endif
#pragma unroll 1
    for (int l = 0; l < DEPTH; ++l) {
        const int pb = 2 + NSLOT * l;
        for (int rep_ = 0; rep_ < NREP(0); ++rep_) if (INL(0)) { if (rep_) GRID_BAR();
            PHASE_BEGIN();
            pg8::Gemm g{P_H, P_WIN + (size_t)l * NPROJ * D, M, NPROJ, D, D, D, 0, 0}; pg8::StaticOrder S; S.init(M, NPROJ, G, bx);
            pg8::EpiBf16 E{P_PROJ, NPROJ};
            pg8::gemm_phase(L, g, S, E, tid);
        }
        SEAM(pb + 0);
#if MIX_SPLIT
        if (INL(1)) {
            PHASE_BEGIN(); MIXP_INIT(MP, l);
            for (int i = vcu; i < 1024; i += G) passA_gdn(L, tid, MP, i >> 7, i & 127);
        }
        SEAM(pb + 1);
        if (INL(2)) {
            PHASE_BEGIN(); MIXP_INIT(MP, l);
            const int vx = vcu & 31, xq = vcu >> 5;
            if (vx < 4) passB_gdn(L, tid, MP, xq * 4 + vx);
            else {
                const int widx = (vx - 4) * 8 + xq;
                for (int i = widx; i < 1024; i += 224) passA_hgrn(L, tid, MP, i >> 7, i & 127);
                cvt_stream_tab(INP(I_U) + (size_t)l * NEXP * D, P_U, TAB_UI4 ? 2 : TAB_U4, UT_SCALE, widx * 8 + wave, 224 * 8, lane);
            }
        }
        SEAM(pb + 2);
        if (INL(3)) {
            PHASE_BEGIN(); MIXP_INIT(MP, l);
            const float* ngh = INP(I_HGNG) + l * 128; const float* ngg = INP(I_GDNNG) + l * 128;
            int tl = tid; asm volatile("" : "+v"(tl)); const int ln = tl & 63;
            if (wave == 0) passB_hgrn(ln, MP, vcu);
            else {
                const int w7 = vcu * 7 + (wave - 1);
#pragma unroll 1
                for (int t = w7; t < 2048; t += 1792) passC_wave(ln, MP, 1024 + (t >> 1), t & 1, ngh, ngg, P_Y);
                cvt_stream_tab(INP(I_V) + (size_t)l * NEXP * D, P_V, TAB_V4, VT_SCALE, w7, 1792, ln);
            }
        }
        SEAM(pb + 3);
        if (INL(4)) {
            PHASE_BEGIN(); MIXP_INIT(MP, l);
            const float* ngh = INP(I_HGNG) + l * 128; const float* ngg = INP(I_GDNNG) + l * 128;
            int tl = tid; asm volatile("" : "+v"(tl)); const int ln = tl & 63;
            passC_wave(ln, MP, gw >> 1, gw & 1, ngh, ngg, P_Y);
        }
        SEAM(pb + 4);
#else
        for (int rep_ = 0; rep_ < NREP(1); ++rep_) if (INL(1)) { if (rep_) GRID_BAR();
            PHASE_BEGIN(); MIXP_INIT(MP, l);
            for (int i2 = vcu; i2 < (NREPA == 2 ? 4096 : NREPA == 3 ? 3072 : NREPA == 4 ? 3072 : 2048); i2 += G) { const int i = (NREPA == 3 && i2 >= 2048) ? i2 - 1024 : (i2 & 2047);
                const int br = i >> 10, bhc = i & 1023;
                if (br) passA_gdn(L, tid, MP, bhc >> 7, bhc & 127); else passA_hgrn(L, tid, MP, bhc >> 7, bhc & 127);
            }
        }
        SEAM(pb + 1);
        for (int rep_ = 0; rep_ < NREP(2); ++rep_) if (INL(2)) { if (rep_) GRID_BAR();
            PHASE_BEGIN(); MIXP_INIT(MP, l);
            const int vx = vcu & 31, xq = vcu >> 5;
            if (vx < 4) passB_gdn(L, tid, MP, xq * 4 + vx);
            else if (vx < 20 && wave < 2) { passB_hgrn(lane, MP, ((vx - 4) * 8 + xq) * 2 + wave);
#ifdef PROBE_H2X
                passB_hgrn(lane, MP, ((vx - 4) * 8 + xq) * 2 + wave);
#endif
            }
#if TABLE_FP6
            else {
                if (rep_ == 0) { const int cw = (vx >= 20) ? (xq * 12 + vx - 20) * 8 + wave : 768 + ((vx - 4) * 8 + xq) * 6 + (wave - 2);
                cvt_stream_tab(INP(I_U) + (size_t)l * NEXP * D, P_U, TAB_UI4 ? 2 : TAB_U4, UT_SCALE, cw, 1536, lane);
                cvt_stream_tab(INP(I_V) + (size_t)l * NEXP * D, P_V, TAB_V4, VT_SCALE, cw, 1536, lane); }
            }
#endif
        }
        SEAM(pb + 2);
        for (int rep_ = 0; rep_ < NREP(3); ++rep_) if (INL(3)) { if (rep_) GRID_BAR();
            PHASE_BEGIN(); MIXP_INIT(MP, l);
            const float* ngh = INP(I_HGNG) + l * 128; const float* ngg = INP(I_GDNNG) + l * 128;
            int tl = tid; asm volatile("" : "+v"(tl)); const int ln = tl & 63, wv = __builtin_amdgcn_readfirstlane(tl >> 6);
#pragma unroll 1
            for (int j = 0; j < 2; ++j) passC_wave(ln, MP, (gw >> 1) + 1024 * j, gw & 1, ngh, ngg, P_Y);
        }
        SEAM(pb + 3);
#endif
        for (int rep_ = 0; rep_ < NREP(4); ++rep_) if (INL(4 + SH)) { if (rep_) GRID_BAR();
            PHASE_BEGIN();
            pg8::TwoPassOrder S; S.S.init(M, D, G, bx);
            pg8::Gemm g{P_Y, P_WBR + (size_t)l * 2 * D * 512, M, D, 512, D, 512, (size_t)512, (size_t)D * 512};
            pg8::EpiGate E{P_MERGED, D, P_PROJ, NPROJ, PC_GATE};
            pg8::gemm_phase(L, g, S, E, tid);
        }
        SEAM(pb + 4 + SH);
        for (int rep_ = 0; rep_ < NREP(5); ++rep_) if (INL(5 + SH)) { if (rep_) GRID_BAR();
            PHASE_BEGIN();
            float* X = args.out;
            pg8::Gemm g{P_MERGED, P_WOUT + (size_t)l * D * D, M, D, D, D, D, 0, 0}; pg8::StaticOrder S; S.init(M, D, G, bx);
            pg8::EpiResid E{l == 0 ? INP(I_X) : (const float*)X, X, P_MOD + (size_t)l * BATCH * 6 * D + 2 * D};
            pg8::gemm_phase(L, g, S, E, tid);
#if !TABLE_FP6
            cvt_stream_fp8(INP(I_U) + (size_t)l * NEXP * D, P_U, (size_t)NEXP * D, U8_SCALE, gw, NGW, lane);
            cvt_stream_fp8(INP(I_V) + (size_t)l * NEXP * D, P_V, (size_t)NEXP * D, V8_SCALE, gw, NGW, lane);
#endif
        }
        SEAM(pb + 5 + SH);
        for (int rep_ = 0; rep_ < NREP(6); ++rep_) if (INL(6 + SH)) { if (rep_) GRID_BAR();
            PHASE_BEGIN();
            const float* X = args.out; const float* modl = P_MOD + (size_t)l * BATCH * 6 * D;
            for (int bb = 0; bb < BATCH; ++bb) {
                RowMod R; load_rowmod(R, INP(I_N2G) + l * D, modl + (size_t)bb * 6 * D + 4 * D, modl + (size_t)bb * 6 * D + 3 * D, lane);
                for (int m = bb * SEQ + gw; m < (bb + 1) * SEQ; m += NGW) {
                    f32x4 v[4];
#pragma unroll
                    for (int j = 0; j < 4; ++j) v[j] = ((const f32x4*)(X + (size_t)m * D))[lane + 64 * j];
                    row_finish<false, TAB_UI4 != 0>(v, R, P_H + (size_t)m * D, nullptr, nullptr, lane, (unsigned*)(P_H8 + (size_t)m * D), P_HS + m);
                }
            }
        }
        SEAM(pb + 6 + SH);
        for (int rep_ = 0; rep_ < NREP(7); ++rep_) if (INL(7 + SH)) { if (rep_) GRID_BAR();
            PHASE_BEGIN();
            pg8::Gemm g{P_H, P_WQ + (size_t)l * NQ * D, M, NQ, D, D, D, 0, 0}; pg8::StaticOrder S; S.init(M, NQ, G, bx);
            pg8::EpiBf16 E{P_PROJ, NQ};
            pg8::gemm_phase(L, g, S, E, tid);
        }
        SEAM(pb + 7 + SH);
        for (int rep_ = 0; rep_ < NREP(8); ++rep_) if (INL(8 + SH)) { if (rep_) GRID_BAR(); PHASE_BEGIN(); peer_route_phase(L, tid, vcu, P_PROJ, P_SK + (size_t)l * 8 * 2 * 128 * 128, P_ROUTE); }
        SEAM(pb + 8 + SH);
#if GATHER_MODE == 0
        for (int rep_ = 0; rep_ < NREP(9); ++rep_) if (INL(9 + SH)) { if (rep_) GRID_BAR();
            PHASE_BEGIN();
            float* mod = P_MOD;
            GatherP GP; GP.H = P_H; GP.route = P_ROUTE; GP.U = P_U; GP.V = P_V; GP.X = args.out; GP.gt2 = mod + (size_t)l * BATCH * 6 * D + 5 * D; GP.last = (l == DEPTH - 1);
            LAS float* wsm = (LAS float*)L;
            if (GP.last) { GP.ng = INP(I_FING); GP.nsc = nullptr; GP.nsh = nullptr; }
            else { GP.ng = INP(I_N1G) + (l + 1) * D; GP.nsc = mod + (size_t)(l + 1) * BATCH * 6 * D + D; GP.nsh = mod + (size_t)(l + 1) * BATCH * 6 * D;
                   stage_wsmall(INP(I_WIN) + (size_t)(l + 1) * D * IN_COLS, wsm, tid); }
            GP.Hout = P_H; GP.small = P_SMALLL(l + 1); GP.wsm = wsm; GP.out = args.out; GP.H8 = P_H8; GP.HS = P_HS;
#if TABLE_FP6
#if GATHER_PIPE == 3
            stage_gather_consts(GP, L, tid);
            peer_gather_split(GP, L, gw, NGW, lane, wave);
#elif GATHER_PIPE == 2
            stage_gather_consts(GP, L, tid);
            peer_gather_wave(GP, L, gw, NGW, lane);
#else
            for (int m = gw; m < M; m += NGW) peer_gather_token6(GP, (size_t)m, lane);
#endif
#else
            for (int m = gw; m < M; m += NGW) peer_gather_token(GP, (size_t)m, lane);
#endif
        }
        if (l + 1 < DEPTH) SEAM(pb + 9 + SH);
#else
        if (INL(9 + SH)) { PHASE_BEGIN(); int bxl = bx; asm volatile("" : "+s"(bxl)); peer_u_pass(L, tid, bxl, P_H, P_ROUTE, P_U, (float*)(ws + WS_ACT)); }
        SEAM(pb + 9 + SH);
        if (INL(10 + SH)) { PHASE_BEGIN(); int bxl = bx; asm volatile("" : "+s"(bxl)); peer_v_pass(tid, bxl, P_ROUTE, (const float*)(ws + WS_ACT), P_V, args.out, P_MOD + (size_t)l * BATCH * 6 * D + 5 * D); }
        SEAM(pb + 10 + SH);
        if (INL(11 + SH)) {
            PHASE_BEGIN();
            float* X = args.out; float* mod = P_MOD;
            if (l == DEPTH - 1) {
                const float* fg = INP(I_FING);
#pragma unroll 1
                for (int m = gw; m < M; m += NGW) { f32x4 v[4];
#pragma unroll
                    for (int j = 0; j < 4; ++j) v[j] = ((const f32x4*)(X + (size_t)m * D))[lane + 64 * j];
                    row_final(v, fg, X + (size_t)m * D, lane); }
            } else {
                LAS float* wsm = (LAS float*)L;
                stage_wsmall(INP(I_WIN) + (size_t)(l + 1) * D * IN_COLS, wsm, tid);
                const float* modn = mod + (size_t)(l + 1) * BATCH * 6 * D;
#pragma unroll 1
                for (int bb = 0; bb < BATCH; ++bb) {
                    RowMod R; load_rowmod(R, INP(I_N1G) + (l + 1) * D, modn + (size_t)bb * 6 * D + D, modn + (size_t)bb * 6 * D, lane);
#pragma unroll 1
                    for (int m = bb * SEQ + gw; m < (bb + 1) * SEQ; m += NGW) { f32x4 v[4];
#pragma unroll
                        for (int j = 0; j < 4; ++j) v[j] = ((const f32x4*)(X + (size_t)m * D))[lane + 64 * j];
                        row_finish<true>(v, R, P_H + (size_t)m * D, P_SMALLL(l + 1) + (size_t)m * 8, wsm, lane); }
                }
            }
        }
        if (l + 1 < DEPTH) SEAM(pb + 11 + SH);
#endif
    }
#undef IN
#undef SEAM
}

#ifndef DBG_STOP
#define DBG_STOP 0
#endif
#ifndef DBG_SEL
#define DBG_SEL 0
#endif
#if DBG_STOP || defined(DUMP_OFF)
__global__ void dbg_dump(float* out, const unsigned short* a, size_t na, const unsigned short* b, size_t nb, const float* xf) {
    const size_t i = (size_t)blockIdx.x * blockDim.x + threadIdx.x; if (i >= (size_t)M * D) return;
    float v = 0.f;
#ifdef DUMP_VAL
    if (a) { for (size_t j = i; j < na; j += (size_t)M * D) { float t = __uint_as_float((unsigned)a[j] << 16); if (!(fabsf(t) < 1e30f)) t = 1e30f; v += t; } }
#else
    if (a) { for (size_t j = i; j < na; j += (size_t)M * D) v += (float)a[j] * (1.0f / 65536.0f); }
#endif
    if (b) { for (size_t j = i; j < nb; j += (size_t)M * D) v += (float)b[j] * (1.0f / 65536.0f); }
    if (xf) { float t = xf[i]; unsigned u = __float_as_uint(t); v += (float)(u >> 16) * (1.0f / 65536.0f) + (float)(u & 0xffffu) * (1.0f / 65536.0f); }
    out[i] = v;
}
#endif
#if DBG_STOP
__global__ void dbg_route_check(const bf16_t* Q, const bf16_t* SK, const u32x2* route, unsigned* counter) {
    extern __shared__ float sh[];
    const int tid = threadIdx.x; float* my = sh + tid * 400;
    const int gid = blockIdx.x * 64 + tid, t = gid >> 3, h = gid & 7;
    for (int z = 0; z < 2; ++z) for (int n = 0; n < 128; ++n) { float a = 0.f;
        for (int d = 0; d < 128; ++d) a += bf1(Q[(size_t)t * NQ + h * 256 + z * 128 + d]) * bf1(SK[((size_t)(h * 2 + z) * 128 + n) * 128 + d]);
        my[z * 128 + n] = a; }
    float* av = my + 256; int* ai = (int*)(my + 288);
    for (int z = 0; z < 2; ++z) for (int r = 0; r < 16; ++r) { int bi = 0; float bv = -INFINITY;
        for (int n = 0; n < 128; ++n) if (my[z * 128 + n] > bv) { bv = my[z * 128 + n]; bi = n; }
        av[z * 16 + r] = bv; ai[z * 16 + r] = bi; my[z * 128 + bi] = -INFINITY; }
    unsigned char* used = (unsigned char*)(my + 320);
    for (int k = 0; k < 256; ++k) used[k] = 0;
    int mism = 0;
    int ex[16];
    for (int r = 0; r < 16; ++r) { int bi = 0; float bv = -INFINITY;
        for (int k = 0; k < 256; ++k) if (!used[k]) { const float v = av[k >> 4] + av[16 + (k & 15)]; if (v > bv) { bv = v; bi = k; } }
        used[bi] = 1; my[r] = __int_as_float(ai[bi >> 4] * 128 + ai[16 + (bi & 15)]); }
    for (int k = 0; k < 16; ++k) { const int e = (int)route[((size_t)t * 8 + h) * 16 + k].x; bool f = false;
        for (int r = 0; r < 16; ++r) f = f || (__float_as_int(my[r]) == e);
        mism += f ? 0 : 1; }
    atomicAdd(counter, (unsigned)mism);
}
__global__ void dbg_gather_check(const bf16_t* H, const u32x2* route, const bf16_t* U, const bf16_t* V, const float* O, float* acc2  ) {
    __shared__ float red[256]; __shared__ float actv;
    const int t = blockIdx.x, tid = threadIdx.x;
    float o[4] = {0.f, 0.f, 0.f, 0.f};
    for (int k = 0; k < 128; ++k) {
        const u32x2 re = route[(size_t)t * 128 + k]; const size_t ro = (size_t)re.x * D;
        float p = 0.f; for (int j = 0; j < 4; ++j) p += bf1(H[(size_t)t * D + tid * 4 + j]) * bf1(U[ro + tid * 4 + j]);
        red[tid] = p; __syncthreads();
        for (int s_ = 128; s_ > 0; s_ >>= 1) { if (tid < s_) red[tid] += red[tid + s_]; __syncthreads(); }
        if (tid == 0) { const float x = red[0]; actv = 0.5f * x * (1.0f + erff(x * 0.70710678118654752f)) * __int_as_float((int)re.y); }
        __syncthreads();
        const float a = actv;
        for (int j = 0; j < 4; ++j) o[j] += a * bf1(V[ro + tid * 4 + j]);
        __syncthreads();
    }
    float e = 0.f, r = 0.f;
    for (int j = 0; j < 4; ++j) { const float g = O[(size_t)t * D + tid * 4 + j]; e += (g - o[j]) * (g - o[j]); r += o[j] * o[j]; }
    atomicAdd(acc2, e); atomicAdd(acc2 + 1, r);
}
__global__ void dbg_mixer_check(const bf16_t* PROJ, const float* SMALLp, const float* convw, const float* alog, const float* dtb, const float* ngh, const float* ngg, const bf16_t* Y, float* acc2, int T0, const float* lbl, int lay) {
    extern __shared__ float dsh[];
    float* qs = dsh; float* ks = dsh + 128; float* fs = dsh + 256; float* red = dsh + 384; float* SS_ = dsh + 512;
    const int br = blockIdx.x >> 3, bh = blockIdx.x & 7, b = bh >> 2, h = bh & 3, tid = threadIdx.x;
#define S_(k) SS_[(k) * 128 + tid]
    for (int k = 0; k < 128; ++k) S_(k) = 0.f;
    float err = 0.f, ref = 0.f;
    for (int t = 0; t < T0; ++t) {
        const size_t row = (size_t)b * SEQ + t; const bf16_t* pr = PROJ + row * NPROJ;
        float o = 0.f, gate;
        if (br == 0) {
            const float lb_ = lay ? sigmoidf_(lbl[512 + h * 128 + tid] - lbl[h * 128 + tid]) : 0.f;
            qs[tid] = siluf_(bf1(pr[PC_HQ + h * 128 + tid])); fs[tid] = lb_ + (1.0f - lb_) * sigmoidf_(bf1(pr[PC_HF + h * 128 + tid]));
            const float iv = bf1(pr[PC_HI + h * 128 + tid]); gate = bf1(pr[PC_HG + h * 128 + tid]);
            __syncthreads();
#pragma unroll 4
            for (int k = 0; k < 128; ++k) { const float f = fs[k]; const float sv = f * S_(k) + (1.0f - f) * iv; S_(k) = sv; o += qs[k] * sv; }
        } else {
            float c3[3];
#pragma unroll
            for (int ty = 0; ty < 3; ++ty) { const int ch = ty * 512 + h * 128 + tid; float a = 0.f;
                for (int j = 0; j < 4; ++j) if (t - 3 + j >= 0) a += bf1(PROJ[(row - 3 + j) * NPROJ + PC_QKV + ch]) * convw[j * 1536 + ch];
                c3[ty] = siluf_(a); }
            gate = bf1(pr[PC_GG + h * 128 + tid]);
            red[tid] = c3[0] * c3[0]; __syncthreads();
            for (int s_ = 64; s_ > 0; s_ >>= 1) { if (tid < s_) red[tid] += red[tid + s_]; __syncthreads(); }
            const float sq = red[0]; __syncthreads();
            red[tid] = c3[1] * c3[1]; __syncthreads();
            for (int s_ = 64; s_ > 0; s_ >>= 1) { if (tid < s_) red[tid] += red[tid + s_]; __syncthreads(); }
            const float sk = red[0]; __syncthreads();
            qs[tid] = c3[0] / sqrtf(sq + EPS) * 0.08838834764831845f; ks[tid] = c3[1] / sqrtf(sk + EPS);
            const float beta = sigmoidf_(SMALLp[row * 8 + h]); const float x = SMALLp[row * 8 + 4 + h] + dtb[h];
            const float a = __expf(-__expf(alog[h]) * (x > 20.f ? x : log1pf(__expf(x))));
            __syncthreads();
            float kS = 0.f;
#pragma unroll 4
            for (int k = 0; k < 128; ++k) kS += ks[k] * S_(k);
            const float vn = beta * (c3[2] - a * kS);
#pragma unroll 4
            for (int k = 0; k < 128; ++k) { const float sv = a * S_(k) + ks[k] * vn; S_(k) = sv; o += qs[k] * sv; }
        }
        __syncthreads();
        red[tid] = o * o; __syncthreads();
        for (int s_ = 64; s_ > 0; s_ >>= 1) { if (tid < s_) red[tid] += red[tid + s_]; __syncthreads(); }
        const float rstd = 1.0f / sqrtf(red[0] * (1.0f / 128.0f) + EPS);
        const float y = o * rstd * (br ? ngg : ngh)[tid] * siluf_(gate);
        const float g = bf1(Y[row * D + br * 512 + h * 128 + tid]);
        err += (g - y) * (g - y); ref += y * y;
        __syncthreads();
    }
    atomicAdd(acc2 + 2 * br, err); atomicAdd(acc2 + 2 * br + 1, ref);
}
__global__ void dbg_gemm_check(const bf16_t* A, int lda, int K, const float* W, int ldw, int N, int skip_at, int skip, const bf16_t* O, int ldo, float* acc2) {
    const int row = blockIdx.x * 61; if (row >= M) return;
    float err = 0.f, ref = 0.f;
    for (int n = threadIdx.x; n < N; n += blockDim.x) { const int wc = n < skip_at ? n : n + skip; float a = 0.f;
        for (int k = 0; k < K; ++k) a += bf1(A[(size_t)row * lda + k]) * W[(size_t)k * ldw + wc];
        const float g = bf1(O[(size_t)row * ldo + n]); err += (g - a) * (g - a); ref += a * a; }
    atomicAdd(acc2, err); atomicAdd(acc2 + 1, ref);
}
__global__ void dbg_mod_check(const float* c, const float* ada_w, const float* ada_b, const float* mod, float* acc2) {
    const int idx = blockIdx.x * blockDim.x + threadIdx.x; if (idx >= DEPTH * BATCH * 6 * D) return;
    const int l = idx / (BATCH * 6 * D), b = (idx / (6 * D)) % BATCH, n = idx % (6 * D);
    float a = 0.f; for (int k = 0; k < D; ++k) a += siluf_(c[b * D + k]) * ada_w[((size_t)l * D + k) * 6 * D + n];
    a += ada_b[l * 6 * D + n];
    const float g = mod[idx]; atomicAdd(acc2, (g - a) * (g - a)); atomicAdd(acc2 + 1, a * a);
}
__global__ void dbg_row_check(const float* x, const float* g1, const float* mod0, const float* w_in, const bf16_t* H, const float* SMALLp, float* acc2) {
    __shared__ float red[256]; __shared__ float ys[1024];
    const int row = blockIdx.x * 61, tid = threadIdx.x; if (row >= M) return;
    const int b = row >= SEQ; const float* sh = mod0 + (size_t)b * 6 * D; const float* sc = sh + D;
    float s = 0.f; for (int k = tid; k < D; k += 256) { const float v = x[(size_t)row * D + k]; s += v * v; }
    red[tid] = s; __syncthreads();
    for (int s_ = 128; s_ > 0; s_ >>= 1) { if (tid < s_) red[tid] += red[tid + s_]; __syncthreads(); }
    const float rstd = 1.0f / sqrtf(red[0] / D + EPS); __syncthreads();
    float e = 0.f, r = 0.f;
    for (int k = tid; k < D; k += 256) { const float y = x[(size_t)row * D + k] * rstd * g1[k] * (1.0f + sc[k]) + sh[k]; ys[k] = y; const float g = bf1(H[(size_t)row * D + k]); e += (g - y) * (g - y); r += y * y; }
    atomicAdd(acc2 + 2, e); atomicAdd(acc2 + 3, r);
    __syncthreads();
    if (tid < 8) { float a = 0.f; for (int k = 0; k < D; ++k) a += ys[k] * w_in[(size_t)k * IN_COLS + 4096 + tid]; const float g = SMALLp[(size_t)row * 8 + tid]; atomicAdd(acc2 + 4, (g - a) * (g - a)); atomicAdd(acc2 + 5, a * a); }
}
__global__ void dbg_fill3(float* out, const float* acc2) {
    const size_t i = (size_t)blockIdx.x * blockDim.x + threadIdx.x; if (i >= (size_t)M * D) return;
    const float r0 = sqrtf(acc2[0] / fmaxf(acc2[1], 1e-30f)), r1 = sqrtf(acc2[2] / fmaxf(acc2[3], 1e-30f)), r2 = sqrtf(acc2[4] / fmaxf(acc2[5], 1e-30f));
    const float rel = DBG_G == 1 ? r0 : DBG_G == 2 ? r1 : DBG_G == 3 ? r2 : r0 + r1 + r2;
    out[i] = 1.0f + 9.0f * fminf(rel, 1.0f);
}
__global__ void dbg_fill2(float* out, const float* acc2) {
    const size_t i = (size_t)blockIdx.x * blockDim.x + threadIdx.x; if (i >= (size_t)M * D) return;
    const float rel = sqrtf(acc2[0] / fmaxf(acc2[1], 1e-30f));
    out[i] = 1.0f + 9.0f * fminf(rel, 1.0f);
}
__global__ void dbg_fill(float* out, const unsigned* counter, float denom) {
    const size_t i = (size_t)blockIdx.x * blockDim.x + threadIdx.x; if (i >= (size_t)M * D) return;
    out[i] = 1.0f + 9.0f * ((float)counter[0] / denom);
}
#endif
typedef void (*kfun_t)(Args);
static kfun_t kfun(int p) {
#ifdef ONLY_MASK
    return trunk_fwd<ONLY_MASK>;
#endif
    const int b = p < 2 ? p : 2 + (p - 2) % NSLOT;
    switch (b) {
        case 0: return trunk_fwd<0x001>; case 1: return trunk_fwd<0x002>; case 2: return trunk_fwd<0x004>; case 3: return trunk_fwd<0x008>;
        case 4: return trunk_fwd<0x010>; case 5: return trunk_fwd<0x020>; case 6: return trunk_fwd<0x040>; case 7: return trunk_fwd<0x080>;
        case 8: return trunk_fwd<0x100>; case 9: return trunk_fwd<0x200>; case 10: return trunk_fwd<0x400>; case 11: return trunk_fwd<0x800>; case 12: return trunk_fwd<0x1000>; default: return trunk_fwd<0x2000>;
    }
}
extern "C" void kernel_launch(void* const* d_in, const int* in_sizes, int n_in, void* d_out, int out_size, void* d_ws, size_t ws_size, hipStream_t stream) {
    static int grid = 0;
    if (grid == 0) {
        if (n_in != 21 || out_size != M * D || ws_size < WS_END) { fprintf(stderr, "kernel_launch: unexpected problem (n_in %d, out %d, ws %zu); nothing launched\n", n_in, out_size, ws_size); grid = -1; return; }
        int dev = 0, cus = 0;
        if (hipGetDevice(&dev) != hipSuccess || hipDeviceGetAttribute(&cus, hipDeviceAttributeMultiprocessorCount, dev) != hipSuccess) { grid = -1; return; }
#if MK_SINGLE
#ifndef ONLY_MASK
        if (hipFuncSetAttribute((const void*)trunk_fwd<PH_ALL>, hipFuncAttributeMaxDynamicSharedMemorySize, LDS_BYTES) != hipSuccess) { fprintf(stderr, "kernel_launch: hipFuncSetAttribute failed\n"); grid = -1; return; }
#endif
#else
        for (int p = 0; p < 2 + NSLOT; ++p) if (hipFuncSetAttribute((const void*)kfun(p), hipFuncAttributeMaxDynamicSharedMemorySize, LDS_BYTES) != hipSuccess) { fprintf(stderr, "kernel_launch: hipFuncSetAttribute failed\n"); grid = -1; return; }
#endif
        (void)hipGetLastError();
        grid = cus;
        if (MK_SINGLE && grid != 256) { fprintf(stderr, "kernel_launch: built for 256 CUs, device has %d\n", cus); grid = -1; return; }
    }
    if (grid < 0) return;
    Args a{};
    for (int i = 0; i < 21; ++i) a.in[i] = (const float*)d_in[i];
    a.out = (float*)d_out; a.ws = (unsigned char*)d_ws;
#if MK_SINGLE
    (void)hipMemsetAsync((char*)d_ws + WS_CTL, 0, CTL_ZERO_BYTES, stream);
    a.ph_lo = 0; a.ph_hi = NPHASE;
#ifndef ONLY_MASK
    hipLaunchKernelGGL(trunk_fwd<PH_ALL>, dim3(grid), dim3(NTHR), LDS_BYTES, stream, a);
#ifdef DUMP_OFF
    hipLaunchKernelGGL(dbg_dump, dim3((M * D + 255) / 256), dim3(256), 0, stream, (float*)d_out, (const unsigned short*)((unsigned char*)d_ws + (size_t)(DUMP_OFF)), (size_t)(DUMP_BYTES) / 2, (const unsigned short*)nullptr, (size_t)0, (const float*)nullptr);
#endif
#else
    hipLaunchKernelGGL(kfun(0), dim3(grid), dim3(NTHR), LDS_BYTES, stream, a);
#endif
#else
#if DBG_STOP
    for (int p = 0; p < DBG_STOP; ++p) { a.ph_lo = p; a.ph_hi = p + 1; hipLaunchKernelGGL(kfun(p), dim3(grid), dim3(NTHR), LDS_BYTES, stream, a); }
    { const unsigned short* A_ = nullptr; size_t na = 0; const unsigned short* B_ = nullptr; size_t nb = 0; const float* xf = nullptr; unsigned char* w = (unsigned char*)d_ws;
      const int last = DBG_STOP - 1, j = last < 2 ? last : 2 + (last - 2) % 10;
      switch (j) {
        case 0: A_ = (const unsigned short*)(w + WS_MOD); na = (size_t)DEPTH * BATCH * 6 * D * 2; B_ = (const unsigned short*)(w + WS_WIN); nb = (size_t)41 * MiB / 2; break;
        case 1: A_ = (const unsigned short*)(w + WS_H); na = (size_t)M * D; B_ = (const unsigned short*)(w + WS_SMALL); nb = (size_t)M * 8 * 2; break;
        case 2: A_ = (const unsigned short*)(w + WS_PROJ); na = (size_t)M * NPROJ; break;
        case 3: A_ = (const unsigned short*)(w + WS_MT); na = (size_t)160 * MiB / 2; B_ = (const unsigned short*)(w + WS_DL); nb = (size_t)512 * 1024 / 2; break;
        case 4: A_ = (const unsigned short*)(w + WS_SS); na = (size_t)64 * MiB / 2; break;
        case 5: A_ = (const unsigned short*)(w + WS_Y); na = (size_t)M * D; break;
        case 6: A_ = (const unsigned short*)(w + WS_MERGED); na = (size_t)M * D; break;
        case 7: xf = (const float*)d_out; A_ = (const unsigned short*)(w + WS_UV); na = (size_t)64 * MiB / 2; break;
        case 8: A_ = (const unsigned short*)(w + WS_H); na = (size_t)M * D; break;
        case 9: A_ = (const unsigned short*)(w + WS_PROJ); na = (size_t)M * NQ; break;
        case 10: A_ = (const unsigned short*)(w + WS_ROUTE); na = (size_t)16 * MiB / 2; break;
        default:
#if DBG_SEL == 0
            xf = (const float*)d_out;
#elif DBG_SEL == 1
            A_ = (const unsigned short*)(w + WS_H); na = (size_t)M * D;
#else
            A_ = (const unsigned short*)(w + WS_SMALL); na = (size_t)M * 8 * 2;
#endif
            break;
      }
#if DBG_SEL == 3
      A_ = nullptr; B_ = nullptr; na = nb = 0; xf = (const float*)d_out;
#endif
#ifndef DBG_T0
#define DBG_T0 8192
#endif
#if DBG_SEL == 15
      (void)hipMemsetAsync((char*)d_ws + WS_CTL, 0, 256, stream);
      hipLaunchKernelGGL(dbg_mod_check, dim3((DEPTH * BATCH * 6 * D + 255) / 256), dim3(256), 0, stream, (const float*)d_in[I_C], (const float*)d_in[I_ADAW], (const float*)d_in[I_ADAB], (const float*)(w + WS_MOD), (float*)(w + WS_CTL));
      hipLaunchKernelGGL(dbg_row_check, dim3(269), dim3(256), 0, stream, (const float*)d_in[I_X], (const float*)d_in[I_N1G], (const float*)(w + WS_MOD), (const float*)d_in[I_WIN], (const bf16_t*)(w + WS_H), (const float*)(w + WS_SMALL), (float*)(w + WS_CTL));
      hipLaunchKernelGGL(dbg_fill3, dim3((M * D + 255) / 256), dim3(256), 0, stream, (float*)d_out, (const float*)(w + WS_CTL));
#elif DBG_SEL == 14
      (void)hipMemsetAsync((char*)d_ws + WS_CTL, 0, 256, stream);
      { const int last_ = DBG_STOP - 1, j_ = last_ < 2 ? last_ : 2 + (last_ - 2) % 10, lay = (DBG_STOP > 12) ? 1 : 0;
        if (j_ == 2) hipLaunchKernelGGL(dbg_gemm_check, dim3(269), dim3(256), 0, stream, (const bf16_t*)(w + WS_H), D, D, (const float*)d_in[I_WIN] + (size_t)lay * D * IN_COLS, IN_COLS, NPROJ, 4096, 8, (const bf16_t*)(w + WS_PROJ), NPROJ, (float*)(w + WS_CTL));
        else if (j_ == 9) hipLaunchKernelGGL(dbg_gemm_check, dim3(269), dim3(256), 0, stream, (const bf16_t*)(w + WS_H), D, D, (const float*)d_in[I_WQ] + (size_t)lay * D * NQ, NQ, NQ, 1 << 30, 0, (const bf16_t*)(w + WS_PROJ), NQ, (float*)(w + WS_CTL)); }
      hipLaunchKernelGGL(dbg_fill2, dim3((M * D + 255) / 256), dim3(256), 0, stream, (float*)d_out, (const float*)(w + WS_CTL));
#elif DBG_SEL == 11 || DBG_SEL == 12
      (void)hipMemsetAsync((char*)d_ws + WS_CTL, 0, 256, stream);
      hipFuncSetAttribute((const void*)dbg_mixer_check, hipFuncAttributeMaxDynamicSharedMemorySize, (512 + 128 * 128) * 4);
      { const int lay = (DBG_STOP > 12) ? 1 : 0;
      hipLaunchKernelGGL(dbg_mixer_check, dim3(16), dim3(128), (512 + 128 * 128) * 4, stream, (const bf16_t*)(w + WS_PROJ), (const float*)(w + (lay ? WS_SMALL1 : WS_SMALL)), (const float*)d_in[I_CONVW] + lay * 4 * 1536, (const float*)d_in[I_ALOG] + lay * 4, (const float*)d_in[I_DTB] + lay * 4,
                         (const float*)d_in[I_HGNG] + lay * 128, (const float*)d_in[I_GDNNG] + lay * 128, (const bf16_t*)(w + WS_Y), (float*)(w + WS_CTL), DBG_T0, (const float*)d_in[I_LBL], lay); }
      hipLaunchKernelGGL(dbg_fill2, dim3((M * D + 255) / 256), dim3(256), 0, stream, (float*)d_out, (const float*)(w + WS_CTL) + (DBG_SEL == 12 ? 2 : 0));
#elif DBG_SEL == 10
      (void)hipMemsetAsync((char*)d_ws + WS_CTL, 0, 256, stream);
      hipLaunchKernelGGL(dbg_gather_check, dim3(256), dim3(256), 0, stream, (const bf16_t*)(w + WS_H), (const u32x2*)(w + WS_ROUTE), (const bf16_t*)(w + WS_UV), (const bf16_t*)(w + WS_UV) + (size_t)NEXP * D, (const float*)(w + WS_PROJ + 64 * MiB), (float*)(w + WS_CTL));
      hipLaunchKernelGGL(dbg_fill2, dim3((M * D + 255) / 256), dim3(256), 0, stream, (float*)d_out, (const float*)(w + WS_CTL));
#elif DBG_SEL == 9
      (void)hipMemsetAsync((char*)d_ws + WS_CTL, 0, 256, stream);
      hipFuncSetAttribute((const void*)dbg_route_check, hipFuncAttributeMaxDynamicSharedMemorySize, 64 * 400 * 4);
      hipLaunchKernelGGL(dbg_route_check, dim3(256), dim3(64), 64 * 400 * 4, stream, (const bf16_t*)(w + WS_PROJ), (const bf16_t*)(w + WS_SK), (const u32x2*)(w + WS_ROUTE), (unsigned*)(w + WS_CTL));
      hipLaunchKernelGGL(dbg_fill, dim3((M * D + 255) / 256), dim3(256), 0, stream, (float*)d_out, (const unsigned*)(w + WS_CTL), 16384.0f * 16.0f);
#else
      hipLaunchKernelGGL(dbg_dump, dim3((M * D + 255) / 256), dim3(256), 0, stream, (float*)d_out, A_, na, B_, nb, xf);
#endif
    }
#else
    for (int p = 0; p < NPHASE; ++p) { a.ph_lo = p; a.ph_hi = p + 1; hipLaunchKernelGGL(kfun(p), dim3(grid), dim3(NTHR), LDS_BYTES, stream, a); }
#endif
#endif
}
```

```cpp
#include <hip/hip_runtime.h>
#include <cstdio>
#include <cstdint>

#define DI __device__ __forceinline__
#define LAS __attribute__((address_space(3)))
#define GAS __attribute__((address_space(1)))
typedef unsigned short bf16_t;
typedef short bf16x8 __attribute__((ext_vector_type(8)));
typedef short s16x4 __attribute__((ext_vector_type(4)));
typedef float f32x2 __attribute__((ext_vector_type(2)));
typedef float f32x4 __attribute__((ext_vector_type(4)));
typedef float f32x16 __attribute__((ext_vector_type(16)));
typedef unsigned u32x2 __attribute__((ext_vector_type(2)));
typedef unsigned u32x4 __attribute__((ext_vector_type(4)));
typedef __bf16 bf16x2_t __attribute__((ext_vector_type(2)));
typedef LAS unsigned char* lptr;

constexpr int BATCH = 2, SEQ = 8192, D = 1024, M = BATCH * SEQ, DEPTH = 2;
constexpr int NPROJ = 6144;
constexpr int IN_COLS = 6152;
constexpr int NCHUNK = SEQ / 64;
constexpr int NQ = 2048;
constexpr int NEXP = 16384;
constexpr float EPS = 1e-6f;
constexpr int PC_HQ = 0, PC_HF = 512, PC_HI = 1024, PC_HG = 1536, PC_QKV = 2048, PC_GG = 3584, PC_GATE = 4096;

constexpr size_t MiB = 1u << 20;
constexpr size_t WS_CTL = 0, CTL_ZERO_BYTES = 256 * 1024;
constexpr size_t WS_MOD = 1 * MiB;
constexpr size_t WS_SMALL = WS_MOD + 512 * 1024;
constexpr size_t WS_SMALL1 = 512 * 1024;
constexpr size_t WS_WIN = 2 * MiB;
constexpr size_t WS_WBR = 26 * MiB;
constexpr size_t WS_WOUT = 30 * MiB;
constexpr size_t WS_WQ = 34 * MiB;
constexpr size_t WS_SK = 42 * MiB;
constexpr size_t WS_PROJ = 43 * MiB;
constexpr size_t WS_Y = 235 * MiB;
constexpr size_t WS_SCR = 267 * MiB;
constexpr size_t WS_UV = WS_SCR;
constexpr size_t WS_H = WS_SCR + 64 * MiB;
constexpr size_t WS_MERGED = WS_SCR + 96 * MiB;
constexpr size_t WS_ROUTE = WS_SCR + 128 * MiB;
constexpr size_t WS_ACT = WS_SCR + 144 * MiB;
constexpr size_t WS_MT = WS_SCR;
constexpr size_t WS_NN = WS_SCR + 32 * MiB;
constexpr size_t WS_QT = WS_SCR + 96 * MiB;
constexpr size_t WS_OP = WS_SCR + 128 * MiB;
constexpr size_t WS_SS = WS_SCR + 160 * MiB;
constexpr size_t WS_DL = WS_SCR + 224 * MiB;
constexpr size_t WS_U6 = 492 * MiB;
constexpr size_t WS_END = 512 * MiB;
static_assert(WS_DL + 1 * MiB <= WS_END && WS_ROUTE + 16 * MiB <= WS_END, "ws map");

constexpr int LDS_SCRATCH = 147456;
constexpr int LDS_CTL_OFF = LDS_SCRATCH;
constexpr int LDS_BYTES = LDS_SCRATCH + 1024;
constexpr int NWAVES = 8, NTHR = 512;

DI unsigned pk2(float lo, float hi) { f32x2 v = {lo, hi}; bf16x2_t b = __builtin_convertvector(v, bf16x2_t); return __builtin_bit_cast(unsigned, b); }
DI float bf_lo(unsigned u) { return __uint_as_float(u << 16); }
DI float bf_hi(unsigned u) { return __uint_as_float(u & 0xffff0000u); }
DI float bf1(bf16_t u) { return __uint_as_float(((unsigned)u) << 16); }
DI bf16_t f2bf(float f) { return (bf16_t)(pk2(f, 0.f) & 0xffffu); }
DI float sigmoidf_(float x) { return __builtin_amdgcn_rcpf(1.0f + __expf(-x)); }
DI float siluf_(float x) { return x * __builtin_amdgcn_rcpf(1.0f + __expf(-x)); }
template <int MSK> DI float shx(float v, int lane) {
    if constexpr (MSK < 32) return __int_as_float(__builtin_amdgcn_ds_swizzle(__float_as_int(v), (MSK << 10) | 0x1f));
    else return __int_as_float(__builtin_amdgcn_ds_bpermute((lane ^ 32) << 2, __float_as_int(v)));
}
#ifndef WSUM_DPP
#define WSUM_DPP 0
#endif
template <int CTRL> DI float dpp_f(float v) { return __int_as_float(__builtin_amdgcn_update_dpp(0, __float_as_int(v), CTRL, 0xf, 0xf, false)); }
DI float wave_sum(float v, int lane) {
#if WSUM_DPP
    v += dpp_f<0xB1>(v); v += dpp_f<0x4E>(v); v += dpp_f<0x124>(v); v += dpp_f<0x128>(v); v += shx<16>(v, lane); v += shx<32>(v, lane);
#else
    v += shx<1>(v, lane); v += shx<2>(v, lane); v += shx<4>(v, lane); v += shx<8>(v, lane); v += shx<16>(v, lane); v += shx<32>(v, lane);
#endif
    return v;
}
#define LDS_WAIT() asm volatile("s_waitcnt lgkmcnt(0)" ::: "memory")
#define VM_WAIT() asm volatile("s_waitcnt vmcnt(0)" ::: "memory")
#define MFMA32(a, b, c) __builtin_amdgcn_mfma_f32_32x32x16_bf16((a), (b), (c), 0, 0, 0)
DI int crow(int i, int h) { return (i & 3) + 8 * (i >> 2) + 4 * h; }
DI f32x16 zero16() { f32x16 z;
#pragma unroll
    for (int i = 0; i < 16; ++i) z[i] = 0.f; return z; }

DI bf16x8 fragK(lptr base, int ldb, int row0, int k0, int lane) {
    return *(const LAS bf16x8*)(base + (row0 + (lane & 31)) * ldb + (k0 + 8 * (lane >> 5)) * 2);
}
typedef short v4i16_t __attribute__((ext_vector_type(4)));
DI bf16x8 fragT(lptr base, int ldb, int k0, int n0, int lane) {
    const int h = lane >> 5, blk = (lane >> 4) & 1, q = (lane & 15) >> 2, p = lane & 3;
    lptr a = base + (k0 + 8 * h + q) * ldb + (n0 + 16 * blk) * 2 + 8 * p;
    const v4i16_t lo = __builtin_amdgcn_ds_read_tr16_b64_v4i16((LAS v4i16_t*)a);
    const v4i16_t hi = __builtin_amdgcn_ds_read_tr16_b64_v4i16((LAS v4i16_t*)(a + 4 * ldb));
    return (bf16x8){lo[0], lo[1], lo[2], lo[3], hi[0], hi[1], hi[2], hi[3]};
}
DI void storeT_bf16(const f32x16& c, lptr base, int ldb, int col0, int row0, int lane) {
    lptr p = base + (col0 + (lane & 31)) * ldb + (row0 + 4 * (lane >> 5)) * 2;
#pragma unroll
    for (int g = 0; g < 4; ++g) { u32x2 v; v.x = pk2(c[4 * g], c[4 * g + 1]); v.y = pk2(c[4 * g + 2], c[4 * g + 3]); *(LAS u32x2*)(p + 16 * g) = v; }
}
DI void pack_tile(const f32x16& c, u32x4& lo, u32x4& hi) {
    lo.x = pk2(c[0], c[1]); lo.y = pk2(c[2], c[3]); lo.z = pk2(c[4], c[5]); lo.w = pk2(c[6], c[7]);
    hi.x = pk2(c[8], c[9]); hi.y = pk2(c[10], c[11]); hi.z = pk2(c[12], c[13]); hi.w = pk2(c[14], c[15]);
}
DI f32x16 unpack_tile(const u32x4& lo, const u32x4& hi) {
    f32x16 c;
    c[0] = bf_lo(lo.x); c[1] = bf_hi(lo.x); c[2] = bf_lo(lo.y); c[3] = bf_hi(lo.y); c[4] = bf_lo(lo.z); c[5] = bf_hi(lo.z); c[6] = bf_lo(lo.w); c[7] = bf_hi(lo.w);
    c[8] = bf_lo(hi.x); c[9] = bf_hi(hi.x); c[10] = bf_lo(hi.y); c[11] = bf_hi(hi.y); c[12] = bf_lo(hi.z); c[13] = bf_hi(hi.z); c[14] = bf_lo(hi.w); c[15] = bf_hi(hi.w);
    return c;
}
#ifndef WT_ALL
#define WT_ALL 1
#endif
DI void st16_wt(void* p, const u32x4 v) {
#if WT_ALL
#ifdef WT_NT
    asm volatile("global_store_dwordx4 %0, %1, off sc0 sc1 nt\n\ts_nop 1" :: "v"(p), "v"(v) : "memory");
#else
    asm volatile("global_store_dwordx4 %0, %1, off sc0 sc1\n\ts_nop 1" :: "v"(p), "v"(v) : "memory");
#endif
#else
    *(u32x4*)p = v;
#endif
}
DI void st16f_wt(void* p, const f32x4 v) { st16_wt(p, __builtin_bit_cast(u32x4, v)); }
DI void st8_wt(void* p, const u32x2 v) {
#if WT_ALL
    asm volatile("global_store_dwordx2 %0, %1, off sc0 sc1" :: "v"(p), "v"(v) : "memory");
#else
    *(u32x2*)p = v;
#endif
}
#ifndef WT_TILE
#define WT_TILE 0
#endif
#ifndef WT_CHAIN
#define WT_CHAIN 0
#endif
DI void gstore_tile(unsigned char* tb, int lane, const f32x16& c) { u32x4 lo, hi; pack_tile(c, lo, hi); unsigned char* p = tb + lane * 32;
    if (WT_TILE == 2) { __builtin_nontemporal_store(lo, (u32x4*)p); __builtin_nontemporal_store(hi, (u32x4*)(p + 16)); }
    else if (WT_TILE) { st16_wt(p, lo); st16_wt(p + 16, hi); } else { *(u32x4*)p = lo; *(u32x4*)(p + 16) = hi; } }
DI void gload_tile(const unsigned char* tb, int lane, u32x4& lo, u32x4& hi) { const u32x4* p = (const u32x4*)(tb + lane * 32); lo = p[0]; hi = p[1]; }
#define AS_BF8(v) __builtin_bit_cast(bf16x8, (v))
#define MK_SINGLE 1
#define DBG_STOP 0
#define DBG_SEL 0
#define DBG_G 0
#define DBG_NOMIX 0
#define REP_MASK 0
#define NREPA 1

namespace pg8 {
constexpr int BM = 256, BK = 64, HALF = 128, HTB = HALF * BK * 2, STAGE_BYTES = 8 * HTB, NXCD = 8, WGM = 8;
__host__ __device__ __forceinline__ int lds_byte(int r, int c) { const int st = (r >> 4) * 2 + (c >> 5), rr = r & 15, cc = c & 31, ob = rr * 64 + cc * 2; return st * 1024 + (ob ^ (((ob >> 9) & 1) << 5)); }
__host__ __device__ __forceinline__ void stage_rc(int b, int& R, int& C) { const int st = b / 1024, sb = b % 1024, swz = sb ^ (((sb >> 9) & 1) << 5); R = (st >> 1) * 16 + swz / 64; C = (st & 1) * 32 + (swz % 64) / 2; }
__host__ __device__ __forceinline__ int perm32(int rho) { const int n = rho >> 4, i = rho & 15; return 8 * (i >> 2) + 4 * n + (i & 3); }

typedef int i32x4_t __attribute__((ext_vector_type(4)));
template <bool I8> __device__ __forceinline__ f32x4 mma16(const bf16x8 b, const bf16x8 a, const f32x4 c) {
    if constexpr (I8) return __builtin_bit_cast(f32x4, __builtin_amdgcn_mfma_i32_16x16x64_i8(__builtin_bit_cast(i32x4_t, b), __builtin_bit_cast(i32x4_t, a), __builtin_bit_cast(i32x4_t, c), 0, 0, 0));
    else return __builtin_amdgcn_mfma_f32_16x16x32_bf16(b, a, c, 0, 0, 0);
}
struct Unit { int pm, pn, pass; };
struct Gemm { const bf16_t* A; const bf16_t* Bt; int M, N, K, lda, ldb; size_t passA, passB; };

struct StaticOrder {
    int nM, nN, nwg, G, c;
    __host__ __device__ void init(int M_, int N_, int G_, int c_) { nM = M_ / BM; nN = N_ / BM; nwg = nM * nN; G = G_; c = c_; }
    __host__ __device__ bool next(int i, Unit& u) const {
        const long L = (long)i * G + c; if (L >= nwg) return false;
        int wgid = (int)L; { const int q = nwg / NXCD, r = nwg % NXCD, xcd = wgid % NXCD, off = wgid / NXCD; wgid = (xcd < r ? xcd * (q + 1) : r * (q + 1) + (xcd - r) * q) + off; }
        const int nig = WGM * nN, gid = wgid / nig, fm = gid * WGM, gsz = (nM - fm) < WGM ? (nM - fm) : WGM;
        u.pm = fm + ((wgid % nig) % gsz); u.pn = (wgid % nig) / gsz; u.pass = 0; return true;
    }
};
struct TwoPassOrder {
    StaticOrder S;
    __host__ __device__ bool next(int i, Unit& u) const { if (!S.next(i >> 1, u)) return false; u.pass = i & 1; return true; }
};

#ifndef EPI_WT
#define EPI_WT 1
#endif
#define ST16(bit_, p_, v_) do { if ((EPI_WT >> (bit_)) & 1) st16_wt(p_, v_); else *(u32x4*)(p_) = (v_); } while (0)
struct EpiBf16 {
    static constexpr bool PERM = true;
    bf16_t* O; int ldc;
    __device__ __forceinline__ void operator()(const f32x4 (&acc)[2][2][4][2], const Unit& u, int wr, int wc, int fr, int fq) const {
        const int row0 = u.pm * BM + wr * 64 + fr; const int col0 = u.pn * BM + wc * 32 + 8 * fq;
#pragma unroll
        for (int ai = 0; ai < 2; ++ai)
#pragma unroll
            for (int m = 0; m < 4; ++m) { bf16_t* rowp = O + (size_t)(row0 + ai * HALF + m * 16) * ldc + col0;
#pragma unroll
                for (int bj = 0; bj < 2; ++bj) { const f32x4 v0 = acc[ai][bj][m][0], v1 = acc[ai][bj][m][1];
                    u32x4 w; w.x = pk2(v0[0], v0[1]); w.y = pk2(v0[2], v0[3]); w.z = pk2(v1[0], v1[1]); w.w = pk2(v1[2], v1[3]);
                    ST16(0, rowp + bj * HALF, w); } }
    }
};
struct EpiQ8 {
    static constexpr bool PERM = true;
    bf16_t* O; int ldc; const float* rs; const float* cs;
    __device__ __forceinline__ void operator()(const f32x4 (&acc)[2][2][4][2], const Unit& u, int wr, int wc, int fr, int fq) const {
        const int row0 = u.pm * BM + wr * 64 + fr; const int col0 = u.pn * BM + wc * 32 + 8 * fq;
        f32x4 cv[2][2];
#pragma unroll
        for (int bj = 0; bj < 2; ++bj) { cv[bj][0] = *(const f32x4*)(cs + col0 + bj * HALF); cv[bj][1] = *(const f32x4*)(cs + col0 + bj * HALF + 4); }
#pragma unroll
        for (int ai = 0; ai < 2; ++ai)
#pragma unroll
            for (int m = 0; m < 4; ++m) { const int row = row0 + ai * HALF + m * 16; const float r = rs[row]; bf16_t* rowp = O + (size_t)row * ldc + col0;
#pragma unroll
                for (int bj = 0; bj < 2; ++bj) { const i32x4_t a0 = __builtin_bit_cast(i32x4_t, acc[ai][bj][m][0]), a1 = __builtin_bit_cast(i32x4_t, acc[ai][bj][m][1]);
                    const f32x4 v0 = (f32x4){(float)a0[0], (float)a0[1], (float)a0[2], (float)a0[3]} * cv[bj][0] * r, v1 = (f32x4){(float)a1[0], (float)a1[1], (float)a1[2], (float)a1[3]} * cv[bj][1] * r;
                    u32x4 w; w.x = pk2(v0[0], v0[1]); w.y = pk2(v0[2], v0[3]); w.z = pk2(v1[0], v1[1]); w.w = pk2(v1[2], v1[3]);
                    ST16(0, rowp + bj * HALF, w); } }
    }
};
struct EpiGate {
    static constexpr bool PERM = true;
    bf16_t* O; int ldc; const bf16_t* G; int ldg; int goff;
    __device__ __forceinline__ void operator()(const f32x4 (&acc)[2][2][4][2], const Unit& u, int wr, int wc, int fr, int fq) const {
        const int row0 = u.pm * BM + wr * 64 + fr; const int col0 = u.pn * BM + wc * 32 + 8 * fq; const int gofs = goff + u.pass * ldc; const bool add = u.pass != 0;
#pragma unroll
        for (int ai = 0; ai < 2; ++ai)
#pragma unroll
            for (int m = 0; m < 4; ++m) { const size_t row = (size_t)(row0 + ai * HALF + m * 16);
#pragma unroll
                for (int bj = 0; bj < 2; ++bj) { const f32x4 v0 = acc[ai][bj][m][0], v1 = acc[ai][bj][m][1];
                    const u32x4 g = *(const u32x4*)(G + row * ldg + gofs + col0 + bj * HALF);
                    bf16_t* op = O + row * ldc + col0 + bj * HALF;
                    u32x4 p = (u32x4){0u, 0u, 0u, 0u}; if (add) p = *(const u32x4*)op;
                    float o[8];
                    o[0] = v0[0] * sigmoidf_(bf_lo(g.x)); o[1] = v0[1] * sigmoidf_(bf_hi(g.x)); o[2] = v0[2] * sigmoidf_(bf_lo(g.y)); o[3] = v0[3] * sigmoidf_(bf_hi(g.y));
                    o[4] = v1[0] * sigmoidf_(bf_lo(g.z)); o[5] = v1[1] * sigmoidf_(bf_hi(g.z)); o[6] = v1[2] * sigmoidf_(bf_lo(g.w)); o[7] = v1[3] * sigmoidf_(bf_hi(g.w));
                    o[0] += bf_lo(p.x); o[1] += bf_hi(p.x); o[2] += bf_lo(p.y); o[3] += bf_hi(p.y); o[4] += bf_lo(p.z); o[5] += bf_hi(p.z); o[6] += bf_lo(p.w); o[7] += bf_hi(p.w);
                    u32x4 w; w.x = pk2(o[0], o[1]); w.y = pk2(o[2], o[3]); w.z = pk2(o[4], o[5]); w.w = pk2(o[6], o[7]);
                    if (((EPI_WT >> 3) & 1) && add) st16_wt(op, w); else ST16(1, op, w); }
                if (m & 1) asm volatile("" ::: "memory"); }
    }
};
struct EpiResid {
    static constexpr bool PERM = false;
    const float* base; float* out; const float* gt;
    __device__ __forceinline__ void operator()(const f32x4 (&acc)[2][2][4][2], const Unit& u, int wr, int wc, int fr, int fq) const {
        const int col0 = u.pn * BM + wc * 32 + 4 * fq; const float* g = gt + (u.pm >= (SEQ / BM) ? 6 * D : 0);
        f32x4 gv[2][2];
#pragma unroll
        for (int bj = 0; bj < 2; ++bj)
#pragma unroll
            for (int n = 0; n < 2; ++n) { gv[bj][n] = *(const f32x4*)(g + col0 + bj * HALF + n * 16); if (DBG_NOMIX) gv[bj][n] = (f32x4){0.f, 0.f, 0.f, 0.f}; }
#pragma unroll
        for (int ai = 0; ai < 2; ++ai)
#pragma unroll
            for (int m = 0; m < 4; ++m) { const size_t off = (size_t)(u.pm * BM + ai * HALF + wr * 64 + m * 16 + fr) * D + col0;
#pragma unroll
                for (int bj = 0; bj < 2; ++bj)
#pragma unroll
                    for (int n = 0; n < 2; ++n) { const f32x4 bs = *(const f32x4*)(base + off + bj * HALF + n * 16);
                        const f32x4 r_ = bs + gv[bj][n] * acc[ai][bj][m][n]; ST16(2, out + off + bj * HALF + n * 16, __builtin_bit_cast(u32x4, r_)); }
                if (m & 1) asm volatile("" ::: "memory"); }
    }
};

template <class Epi, class Sched, bool I8 = false>
__device__ __forceinline__ void gemm_phase(lptr lds, const Gemm g, const Sched& S, const Epi& E, const int tid) {
    const int wid = __builtin_amdgcn_readfirstlane(tid >> 6), lane = tid & 63, wr = wid >> 2, wc = wid & 3, fr = lane & 15, fq = lane >> 4;
    const int K = g.K, nt = K / BK;
    unsigned voffA[2], voffB[2];
#pragma unroll
    for (int i = 0; i < 2; ++i) { int R, C; stage_rc(tid * 16 + i * 8192, R, C); const int Rb = Epi::PERM ? ((R & ~31) + perm32(R & 31)) : R;
        voffA[i] = (unsigned)(R * g.lda + C) * 2u; voffB[i] = (unsigned)(Rb * g.ldb + C) * 2u; }
    const size_t kstep = (size_t)(BK * 2);
    const size_t hstepA = (size_t)HALF * g.lda * 2, hstepB = (size_t)HALF * g.ldb * 2;
    const size_t tstepA = 2 * hstepA, tstepB = 2 * hstepB;
    const unsigned ldsw = (unsigned)wid * 1024u;
    const int aoff = lds_byte(wr * 64 + fr, fq * 8), boff = lds_byte(wc * 32 + fr, fq * 8);
#define PG8_SA(b, h) (((b) * 2 + (h)) * HTB)
#define PG8_SB(b, h) ((4 + (b) * 2 + (h)) * HTB)
#define PG8_STAGE(bufoff, gbase, voff) do { _Pragma("unroll") for (int _i = 0; _i < 2; ++_i) \
        __builtin_amdgcn_global_load_lds((const unsigned*)((const char*)(gbase) + (voff)[_i]), (LAS unsigned*)(lds + (bufoff) + ldsw + _i * 8192), 16, 0, 0); } while (0)
#define PG8_LDA(dst, b, h) do { _Pragma("unroll") for (int m = 0; m < 4; ++m) _Pragma("unroll") for (int k = 0; k < 2; ++k) dst[m][k] = *(const LAS bf16x8*)(lds + PG8_SA(b, h) + aoff + m * 2048 + k * 1024); } while (0)
#define PG8_LDB(dst, b, h) do { _Pragma("unroll") for (int n = 0; n < 2; ++n) _Pragma("unroll") for (int k = 0; k < 2; ++k) dst[n][k] = *(const LAS bf16x8*)(lds + PG8_SB(b, h) + boff + n * 2048 + k * 1024); } while (0)
#define PG8_MMA(ai, bj, At, Bt) do { __builtin_amdgcn_s_setprio(1); _Pragma("unroll") for (int m = 0; m < 4; ++m) _Pragma("unroll") for (int n = 0; n < 2; ++n) _Pragma("unroll") for (int k = 0; k < 2; ++k) \
        acc[ai][bj][m][n] = mma16<I8>(Bt[n][k], At[m][k], acc[ai][bj][m][n]); __builtin_amdgcn_s_setprio(0); } while (0)
#define PG8_WAIT_V(n) asm volatile("s_waitcnt vmcnt(" #n ")" ::: "memory")
#define PG8_WAIT_L(n) asm volatile("s_waitcnt lgkmcnt(" #n ")" ::: "memory")
#define PG8_BAR __builtin_amdgcn_s_barrier()
#define PG8_SCHED __builtin_amdgcn_sched_barrier(0)
    Unit cur, nxt; int ui = 0;
    if (!S.next(0, cur)) return;
    f32x4 acc[2][2][4][2];
#pragma unroll
    for (int a = 0; a < 2; ++a)
#pragma unroll
        for (int b = 0; b < 2; ++b)
#pragma unroll
            for (int m = 0; m < 4; ++m)
#pragma unroll
                for (int n = 0; n < 2; ++n) acc[a][b][m][n] = (f32x4){0.f, 0.f, 0.f, 0.f};
    bf16x8 At[4][2], B0[2][2], B1[2][2];
    const char* cA = (const char*)(g.A + cur.pass * g.passA) + (size_t)cur.pm * tstepA; const char* cB = (const char*)(g.Bt + cur.pass * g.passB) + (size_t)cur.pn * tstepB;
    PG8_STAGE(PG8_SB(0, 0), cB, voffB); PG8_STAGE(PG8_SB(0, 1), cB + hstepB, voffB); PG8_STAGE(PG8_SA(0, 0), cA, voffA); PG8_STAGE(PG8_SA(0, 1), cA + hstepA, voffA);
    if (wr == 1) PG8_BAR;
    PG8_WAIT_V(2); PG8_BAR;
    PG8_STAGE(PG8_SB(1, 0), cB + kstep, voffB); PG8_STAGE(PG8_SA(1, 0), cA + kstep, voffA); PG8_STAGE(PG8_SB(1, 1), cB + hstepB + kstep, voffB);
    PG8_WAIT_V(6); PG8_BAR;
    for (;;) {
        const bool has_next = S.next(ui + 1, nxt);
        const char* nA = has_next ? (const char*)(g.A + nxt.pass * g.passA) + (size_t)nxt.pm * tstepA : cA; const char* nB = has_next ? (const char*)(g.Bt + nxt.pass * g.passB) + (size_t)nxt.pn * tstepB : cB;
        for (int t = 0; t < nt; t += 2) {
            const bool last = (t == nt - 2);
            const char* a1 = cA + (size_t)(t + 1) * kstep;
            const char* a2 = last ? nA : cA + (size_t)(t + 2) * kstep; const char* b2 = last ? nB : cB + (size_t)(t + 2) * kstep;
            const char* a3 = a2 + kstep; const char* b3 = b2 + kstep;
            PG8_LDB(B0, 0, 0); PG8_LDB(B1, 0, 1); PG8_SCHED; PG8_LDA(At, 0, 0); PG8_STAGE(PG8_SA(1, 1), a1 + hstepA, voffA);
            PG8_WAIT_V(8); PG8_WAIT_L(0); PG8_BAR; PG8_MMA(0, 0, At, B0); PG8_MMA(0, 1, At, B1); PG8_BAR; PG8_SCHED;
            PG8_LDA(At, 0, 1); PG8_STAGE(PG8_SB(0, 0), b2, voffB); PG8_STAGE(PG8_SB(0, 1), b2 + hstepB, voffB); PG8_STAGE(PG8_SA(0, 0), a2, voffA);
            PG8_WAIT_V(8); PG8_WAIT_L(0); PG8_BAR; PG8_MMA(1, 0, At, B0); PG8_MMA(1, 1, At, B1); PG8_BAR; PG8_SCHED;
            PG8_LDB(B0, 1, 0); PG8_LDB(B1, 1, 1); PG8_SCHED; PG8_LDA(At, 1, 0); PG8_STAGE(PG8_SA(0, 1), a2 + hstepA, voffA);
            PG8_WAIT_V(8); PG8_WAIT_L(0); PG8_BAR; PG8_MMA(0, 0, At, B0); PG8_MMA(0, 1, At, B1); PG8_BAR; PG8_SCHED;
            PG8_LDA(At, 1, 1); PG8_STAGE(PG8_SB(1, 0), b3, voffB); PG8_STAGE(PG8_SB(1, 1), b3 + hstepB, voffB); PG8_STAGE(PG8_SA(1, 0), a3, voffA);
            PG8_WAIT_V(8); PG8_WAIT_L(0); PG8_BAR; PG8_MMA(1, 0, At, B0); PG8_MMA(1, 1, At, B1); PG8_BAR; PG8_SCHED;
        }
        if (wr == 0) PG8_BAR;
        E(acc, cur, wr, wc, fr, fq);
        if (!has_next) break;
#pragma unroll
        for (int a = 0; a < 2; ++a)
#pragma unroll
            for (int b = 0; b < 2; ++b)
#pragma unroll
                for (int m = 0; m < 4; ++m)
#pragma unroll
                    for (int n = 0; n < 2; ++n) acc[a][b][m][n] = (f32x4){0.f, 0.f, 0.f, 0.f};
        cur = nxt; cA = nA; cB = nB; ++ui;
        if (wr == 1) PG8_BAR;
    }
    PG8_WAIT_V(0);
    PG8_BAR;
#undef PG8_SA
#undef PG8_SB
#undef PG8_STAGE
#undef PG8_LDA
#undef PG8_LDB
#undef PG8_MMA
#undef PG8_WAIT_V
#undef PG8_WAIT_L
#undef PG8_BAR
#undef PG8_SCHED
}
}

#define XB_TMO      128
#define XB_XCNT(j)  (256  + 64 * (j))
#define XB_XSUB(j)  (1280 + 64 * (j))
#define XB_XGEN(j)  (2304 + 64 * (j))
#define XB_TOP      3328
#define XB_TOPGEN   3392
#define XCD_BAR_WORDS 3456
#define XB_SPIN_CAP (1u << 20)
DI unsigned xb_rfl(unsigned v) { return (unsigned)__builtin_amdgcn_readfirstlane((int)v); }
DI unsigned xb_ld(unsigned* p)              { return xb_rfl(__hip_atomic_load(p, __ATOMIC_RELAXED, __HIP_MEMORY_SCOPE_AGENT)); }
DI unsigned xb_add(unsigned* p, unsigned v) {
    unsigned old; unsigned long long sv;
    asm volatile("s_mov_b64 %1, exec\n\ts_mov_b64 exec, 1\n\tglobal_atomic_add %0, %2, %3, off sc0\n\ts_waitcnt vmcnt(0)\n\ts_mov_b64 exec, %1"
                 : "=&v"(old), "=&s"(sv) : "v"(p), "v"(v) : "memory");
    return xb_rfl(old);
}
DI unsigned xb_xcc_id() { return (unsigned)__builtin_amdgcn_s_getreg((3 << 11) | 20) & 0xFu; }
#ifndef XB_SLEEP
#define XB_SLEEP 1
#endif
#define XB_SPIN(cond, bar) do { unsigned _sp = 0; while (cond) { if (XB_SLEEP) __builtin_amdgcn_s_sleep(1); \
    if ((++_sp & 255u) == 0u) { if (xb_ld(&(bar)[XB_TMO])) break; if (_sp > XB_SPIN_CAP) { (void)xb_add(&(bar)[XB_TMO], 1u); break; } } } } while (0)
struct XcdBarrier { unsigned* bar; unsigned x; volatile LAS unsigned* st; };
DI void xcd_barrier_post(unsigned* bar, int wave_) {
    if (wave_ == 0) (void)xb_add(&bar[XB_XCNT(xb_xcc_id())], 1u);
}
DI void xcd_barrier_complete(unsigned* bar, unsigned x, unsigned& nloc, unsigned& nx) {
    const unsigned G = gridDim.x * gridDim.y * gridDim.z;
    unsigned sum, cnt, mine, sp = 0u;
    for (;;) {
        sum = 0u; cnt = 0u; mine = 0u;
#pragma unroll
        for (unsigned j = 0; j < 16; ++j) { const unsigned c = xb_ld(&bar[XB_XCNT(j)]); sum += c; cnt += (c > 0u) ? 1u : 0u; mine = (j == x) ? c : mine; }
        if (sum == G) break;
        __builtin_amdgcn_s_sleep(1);
        if ((++sp & 255u) == 0u) { if (xb_ld(&bar[XB_TMO])) break; if (sp > XB_SPIN_CAP) { (void)xb_add(&bar[XB_TMO], 1u); break; } }
    }
    nloc = mine > 0u ? mine : 1u; nx = cnt > 0u ? cnt : 1u;
}
DI void xcd_barrier(const XcdBarrier& b, const int wave_) {
    asm volatile("s_waitcnt vmcnt(0)" ::: "memory");
    __syncthreads();
    if (wave_ == 0) {
        unsigned* bar = b.bar;
        __builtin_amdgcn_s_waitcnt(0);
        unsigned nloc = xb_rfl(b.st[0]), nx = xb_rfl(b.st[1]);
        if (nloc == 0u) { xcd_barrier_complete(bar, b.x, nloc, nx); b.st[0] = nloc; b.st[1] = nx; }
        const unsigned old = xb_add(&bar[XB_XSUB(b.x)], 1u);
        const unsigned gen = old / nloc;
        if (old + 1u == (gen + 1u) * nloc) {
            __builtin_amdgcn_fence(__ATOMIC_RELEASE, "agent");
            asm volatile("s_waitcnt vmcnt(0)" ::: "memory");
            const unsigned og = xb_add(&bar[XB_TOP], 1u);
            const unsigned tg = og / nx;
            if (og + 1u == (tg + 1u) * nx) (void)xb_add(&bar[XB_TOPGEN], 1u);
            else XB_SPIN(xb_ld(&bar[XB_TOPGEN]) == tg, bar);
            __builtin_amdgcn_fence(__ATOMIC_ACQUIRE, "agent");
            asm volatile("s_waitcnt vmcnt(0)" ::: "memory");
        } else {
            XB_SPIN(xb_ld(&bar[XB_TOPGEN]) == gen, bar);
            __builtin_amdgcn_fence(__ATOMIC_ACQUIRE, "agent");
            asm volatile("s_waitcnt vmcnt(0)" ::: "memory");
        }
    }
    __syncthreads();
}

struct Args {
    const float* in[21]; float* out; unsigned char* ws; int ph_lo, ph_hi;
};
struct Frame {
    lptr lds;
    int tid, lane, wave, vcu, G;
    unsigned char* ws;
    const float* const* in;
};

DI void transpose_item(const float* W, int N, int src_col0, bf16_t* WT, int ldt, int dst_row0, int k0, LAS float* scr, int lane) {
    { const int c4 = lane & 7, r8 = lane >> 3; f32x4 t[8];
#pragma unroll
      for (int i = 0; i < 8; ++i) t[i] = *(const f32x4*)(W + (size_t)(k0 + 8 * i + r8) * N + src_col0 + 4 * c4);
#pragma unroll
      for (int i = 0; i < 8; ++i) { LAS float* d = scr + (8 * i + r8) * 33 + 4 * c4; d[0] = t[i].x; d[1] = t[i].y; d[2] = t[i].z; d[3] = t[i].w; } }
    LDS_WAIT(); asm volatile("" ::: "memory");
    const int c = lane & 7;
#pragma unroll
    for (int j = 0; j < 4; ++j) { const int n = (lane >> 3) + 8 * j; const LAS float* s = scr + (8 * c) * 33 + n;
        u32x4 o; o.x = pk2(s[0 * 33], s[1 * 33]); o.y = pk2(s[2 * 33], s[3 * 33]); o.z = pk2(s[4 * 33], s[5 * 33]); o.w = pk2(s[6 * 33], s[7 * 33]);
        *(u32x4*)(WT + (size_t)(dst_row0 + n) * ldt + k0 + 8 * c) = o; }
    LDS_WAIT(); asm volatile("" ::: "memory");
}
DI void cvt_stream(const float* src, bf16_t* dst, size_t n, int gw, int ngw, int lane) {
    const size_t n8 = n / 8;
    for (size_t i = (size_t)gw * 64 + lane; i < n8; i += (size_t)ngw * 64) {
        const f32x4 a = ((const f32x4*)src)[2 * i], b = ((const f32x4*)src)[2 * i + 1];
        u32x4 o; o.x = pk2(a[0], a[1]); o.y = pk2(a[2], a[3]); o.z = pk2(b[0], b[1]); o.w = pk2(b[2], b[3]);
        ((u32x4*)dst)[i] = o;
    }
}
DI void mod_item(const float* c, const float* ada_w, const float* ada_b, float* mod, int item, lptr lds, int tid) {
    const int l = item / 96, n0 = (item % 96) * 64;
    const int wave = tid >> 6, lane = tid & 63, cq = lane & 15, rsub = lane >> 4;
    LAS float* sc = (LAS float*)lds;
    LAS float* part = (LAS float*)(lds + 8192);
    for (int i = tid; i < 2 * D; i += NTHR) sc[i] = siluf_(c[i]);
    __syncthreads();
    const float* W = ada_w + (size_t)l * D * (6 * D) + n0 + 4 * cq;
    f32x4 a0 = {0.f, 0.f, 0.f, 0.f}, a1 = {0.f, 0.f, 0.f, 0.f};
#pragma unroll 8
    for (int i = 0; i < 32; ++i) { const int k = wave * 128 + i * 4 + rsub; const f32x4 w = *(const f32x4*)(W + (size_t)k * (6 * D));
        a0 += w * sc[k]; a1 += w * sc[D + k]; }
    LAS f32x4* pp = (LAS f32x4*)part;
    pp[((wave * 4 + rsub) * 2 + 0) * 16 + cq] = a0; pp[((wave * 4 + rsub) * 2 + 1) * 16 + cq] = a1;
    __syncthreads();
    if (tid < 128) { const int b = tid >> 6, col = tid & 63; float s = 0.f;
#pragma unroll
        for (int w = 0; w < 32; ++w) s += part[(w * 2 + b) * 64 + col];
        mod[((size_t)l * BATCH + b) * (6 * D) + n0 + col] = s + ada_b[(size_t)l * 6 * D + n0 + col]; }
    __syncthreads();
}

struct RowMod { f32x4 a[4], b[4]; };
DI void load_rowmod(RowMod& R, const float* g, const float* sc, const float* sh, int lane) {
#pragma unroll
    for (int j = 0; j < 4; ++j) { const f32x4 gv = ((const f32x4*)g)[lane + 64 * j], sv = ((const f32x4*)sc)[lane + 64 * j]; R.a[j] = gv * (sv + 1.0f); R.b[j] = ((const f32x4*)sh)[lane + 64 * j]; }
}
template <bool SIDE, bool H8 = false> DI void row_finish(const f32x4 (&v)[4], const RowMod& R, bf16_t* hrow, float* small_row, const LAS float* wsm, int lane, unsigned* h8row = nullptr, float* hsp = nullptr) {
    float s = 0.f;
#pragma unroll
    for (int j = 0; j < 4; ++j) s += (v[j].x * v[j].x + v[j].y * v[j].y) + (v[j].z * v[j].z + v[j].w * v[j].w);
    const float rstd = 1.0f / sqrtf(wave_sum(s, lane) * (1.0f / D) + EPS);
    f32x4 y[4];
#pragma unroll
    for (int j = 0; j < 4; ++j) { y[j] = v[j] * rstd * R.a[j] + R.b[j];
        u32x2 o; o.x = pk2(y[j].x, y[j].y); o.y = pk2(y[j].z, y[j].w); ((u32x2*)hrow)[lane + 64 * j] = o; }
    if (H8) {
        float am = 0.f;
#pragma unroll
        for (int j = 0; j < 4; ++j) am = fmaxf(fmaxf(am, fmaxf(fabsf(y[j].x), fabsf(y[j].y))), fmaxf(fabsf(y[j].z), fabsf(y[j].w)));
        am = fmaxf(am, shx<1>(am, lane)); am = fmaxf(am, shx<2>(am, lane)); am = fmaxf(am, shx<4>(am, lane)); am = fmaxf(am, shx<8>(am, lane)); am = fmaxf(am, shx<16>(am, lane)); am = fmaxf(am, shx<32>(am, lane));
        am = fmaxf(am, 1e-20f);
        const float sc = 127.0f / am;
#pragma unroll
        for (int j = 0; j < 4; ++j) {
            const int q0 = (int)__builtin_rintf(y[j].x * sc), q1 = (int)__builtin_rintf(y[j].y * sc), q2 = (int)__builtin_rintf(y[j].z * sc), q3 = (int)__builtin_rintf(y[j].w * sc);
            h8row[lane + 64 * j] = (unsigned)(q0 & 0xff) | ((unsigned)(q1 & 0xff) << 8) | ((unsigned)(q2 & 0xff) << 16) | ((unsigned)q3 << 24); }
        if (lane == 0) *hsp = am * (1.0f / 127.0f);
    }
    if (SIDE) {
        float p[8];
#pragma unroll
        for (int c = 0; c < 8; ++c) { float a = 0.f;
#pragma unroll
            for (int j = 0; j < 4; ++j) { const f32x4 w = ((const LAS f32x4*)(wsm + c * D))[lane + 64 * j]; a += (y[j].x * w.x + y[j].y * w.y) + (y[j].z * w.z + y[j].w * w.w); }
            p[c] = wave_sum(a, lane);
            if (c & 1) __builtin_amdgcn_sched_barrier(0); }
        if (lane < 8) { float r = p[0];
#pragma unroll
            for (int c = 1; c < 8; ++c) r = (lane == c) ? p[c] : r;
            small_row[lane] = r; }
    }
}
DI void stage_wsmall(const float* w_in_l, LAS float* wsm, int tid) {
    for (int i = tid; i < 8 * D; i += NTHR) { const int k = i >> 3, c = i & 7; wsm[c * D + k] = w_in_l[(size_t)k * IN_COLS + 4096 + c]; }
    __syncthreads();
}

#ifndef CHAIN_OWN
#define CHAIN_OWN 1
#endif
#define WG_BAR() do { asm volatile("s_waitcnt lgkmcnt(0)" ::: "memory"); __builtin_amdgcn_s_barrier(); asm volatile("" ::: "memory"); } while (0)
constexpr int TILE_B = 2048;
constexpr int LDA_ = 272, LDT_ = 144;

struct MixP {
    const bf16_t* PROJ; const float* SMALL; const float* convw; const float* alog; const float* dtb; const float* lbl; int l;
    unsigned char* MT; unsigned char* NN; unsigned char* QT; unsigned char* OP; unsigned char* SS; float* DL;
};

DI void passA_gdn(lptr L, int tid_in, const MixP& P, int bh, int c) {
    int tid = tid_in; asm volatile("" : "+v"(tid));
    constexpr int R_KN = 0, R_QN = 18432, R_QE = 36864, R_VB = 54272, R_KBE = 71680, R_KD = 89088, R_AM = 106496, R_T = 123904, R_AQK = 133120, R_MISC = 142336, R_A10 = 144448;
    constexpr int R_UT = R_KN, R_WT = R_QN, R_D0 = R_KN, R_D1 = R_KN + 2560, R_XT = R_KN + 5120;
    const int lane = tid & 63, w = __builtin_amdgcn_readfirstlane(tid >> 6), r = lane & 31, hh = lane >> 5;
    const int b = bh >> 2, h = bh & 3; const size_t row0 = (size_t)b * SEQ + 64 * c;
    LAS float* sb = (LAS float*)(L + R_MISC); LAS float* sbeta = sb + 64; LAS float* seb = sb + 128; LAS float* sekd = sb + 192; LAS float* ssq = sb + 256; LAS float* sbl = sb + 384;
    WG_BAR();
    constexpr int RAWQ = R_AM, RAWK = R_T, RAWV = R_KD;
    const int cgx = tid & 15, sg = tid >> 4;
    {
        u32x4 raw[7];
#pragma unroll
        for (int j = 0; j < 7; ++j) { const int idx = tid + 512 * j, rr = idx / 48, rem = idx - 48 * rr, ty = rem >> 4, cc = rem & 15;
            raw[j] = (u32x4){0u, 0u, 0u, 0u};
            if (idx < 67 * 48 && 64 * c + rr - 3 >= 0) raw[j] = *(const u32x4*)(P.PROJ + (row0 + rr - 3) * NPROJ + PC_QKV + ty * 512 + h * 128 + cc * 8); }
        if (tid < 64) {
            const float* sm = P.SMALL + (row0 + tid) * 8;
            const float beta = sigmoidf_(sm[h]); const float x = sm[4 + h] + P.dtb[h];
            const float sp = x > 20.f ? x : __logf(1.0f + __expf(x));
            float bb = -__expf(P.alog[h]) * sp;
#pragma unroll
            for (int o = 1; o < 64; o <<= 1) { const float n = __int_as_float(__builtin_amdgcn_ds_bpermute((lane - o) << 2, __float_as_int(bb))); if (lane >= o) bb += n; }
            const float blast = __int_as_float(__builtin_amdgcn_readlane(__float_as_int(bb), 63));
            sb[tid] = bb; sbeta[tid] = beta; seb[tid] = __expf(bb); sekd[tid] = __expf(blast - bb); if (tid == 0) sbl[0] = __expf(blast);
        } else if (tid < 192) ssq[tid - 64] = 0.f;
#pragma unroll
        for (int j = 0; j < 7; ++j) { const int idx = tid + 512 * j, rr = idx / 48, rem = idx - 48 * rr, ty = rem >> 4, cc = rem & 15;
            if (idx < 67 * 48) *(LAS u32x4*)(L + (ty == 0 ? RAWQ : ty == 1 ? RAWK : RAWV) + rr * 256 + cc * 16) = raw[j]; }
    }
    WG_BAR();
    float val[3][2][8];
#pragma unroll
    for (int ty = 0; ty < 3; ++ty) {
        const int ch = ty * 512 + h * 128 + cgx * 8;
        f32x4 w[4][2];
#pragma unroll
        for (int j = 0; j < 4; ++j) { w[j][0] = *(const f32x4*)(P.convw + j * 1536 + ch); w[j][1] = *(const f32x4*)(P.convw + j * 1536 + ch + 4); }
        lptr rb = L + (ty == 0 ? RAWQ : ty == 1 ? RAWK : RAWV) + (2 * sg) * 256 + cgx * 16;
        u32x4 xr[5];
#pragma unroll
        for (int j = 0; j < 5; ++j) xr[j] = *(const LAS u32x4*)(rb + j * 256);
#pragma unroll
        for (int q = 0; q < 2; ++q) {
            float a[8];
#pragma unroll
            for (int e = 0; e < 8; ++e) a[e] = 0.f;
#pragma unroll
            for (int j = 0; j < 4; ++j) { const u32x4 x = xr[q + j];
                a[0] += bf_lo(x.x) * w[j][0].x; a[1] += bf_hi(x.x) * w[j][0].y; a[2] += bf_lo(x.y) * w[j][0].z; a[3] += bf_hi(x.y) * w[j][0].w;
                a[4] += bf_lo(x.z) * w[j][1].x; a[5] += bf_hi(x.z) * w[j][1].y; a[6] += bf_lo(x.w) * w[j][1].z; a[7] += bf_hi(x.w) * w[j][1].w; }
            float ss = 0.f;
#pragma unroll
            for (int e = 0; e < 8; ++e) { const float v = siluf_(a[e]); val[ty][q][e] = v; ss += v * v; }
            if (ty < 2) __hip_atomic_fetch_add(&ssq[ty * 64 + 2 * sg + q], ss, __ATOMIC_RELAXED, __HIP_MEMORY_SCOPE_WORKGROUP);
        }
    }
    WG_BAR();
#pragma unroll
    for (int ty = 0; ty < 3; ++ty)
#pragma unroll
        for (int q = 0; q < 2; ++q) {
            const int s = 2 * sg + q; const int off = s * LDA_ + cgx * 16;
            float f1, f2 = 0.f, f3 = 0.f;
            if (ty == 0) { f1 = 1.0f / sqrtf(ssq[s] + EPS) * 0.08838834764831845f; f2 = f1 * seb[s]; }
            else if (ty == 1) { f1 = 1.0f / sqrtf(ssq[64 + s] + EPS); f2 = f1 * sbeta[s] * seb[s]; f3 = f1 * sekd[s]; }
            else f1 = sbeta[s];
#define VA(e) val[ty][q][e]
            { u32x4 o; o.x = pk2(VA(0) * f1, VA(1) * f1); o.y = pk2(VA(2) * f1, VA(3) * f1); o.z = pk2(VA(4) * f1, VA(5) * f1); o.w = pk2(VA(6) * f1, VA(7) * f1); *(LAS u32x4*)(L + (ty == 0 ? R_QN : ty == 1 ? R_KN : R_VB) + off) = o; }
            if (ty < 2) { u32x4 o; o.x = pk2(VA(0) * f2, VA(1) * f2); o.y = pk2(VA(2) * f2, VA(3) * f2); o.z = pk2(VA(4) * f2, VA(5) * f2); o.w = pk2(VA(6) * f2, VA(7) * f2); *(LAS u32x4*)(L + (ty == 0 ? R_QE : R_KBE) + off) = o; }
            if (ty == 1) { u32x4 o; o.x = pk2(VA(0) * f3, VA(1) * f3); o.y = pk2(VA(2) * f3, VA(3) * f3); o.z = pk2(VA(4) * f3, VA(5) * f3); o.w = pk2(VA(6) * f3, VA(7) * f3); *(LAS u32x4*)(L + R_KD + off) = o; }
#undef VA
        }
    WG_BAR();
    {
        const int tl = w & 3, ta = tl >> 1, tb = tl & 1;
        f32x16 acc = zero16();
        lptr Bsrc = L + (w < 4 ? R_KN : R_QN);
#pragma unroll
        for (int s8 = 0; s8 < 8; ++s8) acc = MFMA32(fragK(L + R_KN, LDA_, 32 * ta, 16 * s8, lane), fragK(Bsrc, LDA_, 32 * tb, 16 * s8, lane), acc);
        const int ci = 32 * tb + r; const float bcol = sb[ci];
        if (w < 4) {
            const float bet = sbeta[ci];
#pragma unroll
            for (int g = 0; g < 4; ++g) { f32x4 o;
#pragma unroll
                for (int e = 0; e < 4; ++e) { const int jj = 32 * ta + 8 * g + 4 * hh + e; o[e] = (jj < ci) ? bet * acc[4 * g + e] * __expf(bcol - sb[jj]) : 0.f; }
                *(LAS f32x4*)(L + R_AM + ci * 272 + (32 * ta + 8 * g + 4 * hh) * 4) = o;
                if (ta == 0 && tb == 1) { u32x2 v; v.x = pk2(o[0], o[1]); v.y = pk2(o[2], o[3]); *(LAS u32x2*)(L + R_A10 + r * 80 + (8 * g + 4 * hh) * 2) = v; } }
        } else {
            f32x16 o;
#pragma unroll
            for (int i = 0; i < 16; ++i) { const int ss_ = 32 * ta + crow(i, hh); o[i] = (ss_ <= ci) ? acc[i] * __expf(bcol - sb[ss_]) : 0.f; }
            storeT_bf16(o, L + R_AQK, LDT_, 32 * tb, 32 * ta, lane);
        }
    }
    WG_BAR();
    if (w == 0) {
        const int blk = hh, cc = r;
        float x[32];
#pragma unroll
        for (int i = 0; i < 32; ++i) x[i] = 0.f;
        f32x4 rowc[8], rown[8];
#pragma unroll
        for (int i = 0; i < 32; ++i) {
            if (i + 1 < 32) { const LAS f32x4* an = (const LAS f32x4*)(L + R_AM + (32 * blk + i + 1) * 272 + (32 * blk) * 4);
#pragma unroll
                for (int jq = 0; jq < (i + 4) / 4; ++jq) rown[jq] = an[jq]; }
            float a = (i == cc) ? 1.f : 0.f;
#pragma unroll
            for (int jq = 0; jq < (i + 3) / 4; ++jq) { const f32x4 a4 = rowc[jq]; a -= (a4.x * x[4 * jq] + a4.y * x[4 * jq + 1]) + (a4.z * x[4 * jq + 2] + a4.w * x[4 * jq + 3]); }
            x[i] = a;
#pragma unroll
            for (int jq = 0; jq < 8; ++jq) rowc[jq] = rown[jq];
            __builtin_amdgcn_sched_barrier(0);
        }
#pragma unroll
        for (int i = 0; i < 32; ++i) { const bf16_t v = f2bf(x[i]);
            *(LAS bf16_t*)(L + (blk ? R_D1 : R_D0) + i * 80 + cc * 2) = v;
            *(LAS bf16_t*)(L + R_T + (32 * blk + i) * LDT_ + (32 * blk + cc) * 2) = v; }
#pragma unroll
        for (int i = 0; i < 16; ++i) *(LAS bf16_t*)(L + R_T + (16 * blk + i) * LDT_ + (32 + cc) * 2) = 0;
        LDS_WAIT();
        f32x16 xa = zero16();
#pragma unroll
        for (int s2 = 0; s2 < 2; ++s2) xa = MFMA32(fragK(L + R_A10, 80, 0, 16 * s2, lane), fragT(L + R_D0, 80, 16 * s2, 0, lane), xa);
        storeT_bf16(xa, L + R_XT, 80, 0, 0, lane);
        LDS_WAIT();
        f32x16 t10 = zero16();
#pragma unroll
        for (int s2 = 0; s2 < 2; ++s2) t10 = MFMA32(fragK(L + R_XT, 80, 0, 16 * s2, lane), fragK(L + R_D1, 80, 0, 16 * s2, lane), t10);
#pragma unroll
        for (int i = 0; i < 16; ++i) t10[i] = -t10[i];
        storeT_bf16(t10, L + R_T, LDT_, 32, 0, lane);
    }
    WG_BAR();
#pragma unroll
    for (int q = 0; q < 2; ++q) {
        const int id = 2 * w + q, which = id >> 3, ti = (id >> 2) & 1, di = id & 3;
        f32x16 acc = zero16();
        lptr Bsrc = L + (which ? R_KBE : R_VB);
#pragma unroll
        for (int s4 = 0; s4 < 4; ++s4) acc = MFMA32(fragK(L + R_T, LDT_, 32 * ti, 16 * s4, lane), fragT(Bsrc, LDA_, 16 * s4, 32 * di, lane), acc);
        storeT_bf16(acc, L + (which ? R_WT : R_UT), LDT_, 32 * di, 32 * ti, lane);
    }
    WG_BAR();
    const size_t itg = (size_t)1024 + bh * 128 + c, itm = (size_t)bh * 128 + c;
    const float bl = sbl[0];
#pragma unroll 1
    for (int q = 0; q < 6; ++q) {
        const int t = w + 8 * q;
        f32x16 acc = zero16();
        if (q < 2) {
            const int rt = t >> 2, dt = t & 3;
#pragma unroll
            for (int s4 = 0; s4 < 4; ++s4) acc = MFMA32(fragT(L + R_KD, LDA_, 16 * s4, 32 * rt, lane), fragK(L + R_UT, LDT_, 32 * dt, 16 * s4, lane), acc);
            gstore_tile(P.NN + (itg * 16 + rt * 4 + dt) * TILE_B, lane, acc);
        } else if (q < 4) {
            const int t2 = t - 16, kt = t2 >> 2, rt = t2 & 3;
#pragma unroll
            for (int s4 = 0; s4 < 4; ++s4) acc = MFMA32(fragK(L + R_WT, LDT_, 32 * kt, 16 * s4, lane), fragT(L + R_KD, LDA_, 16 * s4, 32 * rt, lane), acc);
#pragma unroll
            for (int i = 0; i < 16; ++i) acc[i] = ((kt == rt) && (crow(i, hh) == r) ? bl : 0.f) - acc[i];
            gstore_tile(P.MT + (itm * 16 + kt * 4 + rt) * TILE_B, lane, acc);
        } else if (q == 4) {
            const int t2 = t - 32, tt = t2 >> 2, dt = t2 & 3;
#pragma unroll
            for (int s4 = 0; s4 < 4; ++s4) acc = MFMA32(fragK(L + R_AQK, LDT_, 32 * tt, 16 * s4, lane), fragK(L + R_UT, LDT_, 32 * dt, 16 * s4, lane), acc);
            gstore_tile(P.OP + (itg * 8 + tt * 4 + dt) * TILE_B, lane, acc);
        } else {
            const int t2 = t - 40, kt = t2 >> 1, tt = t2 & 1;
#pragma unroll
            for (int s4 = 0; s4 < 4; ++s4) acc = MFMA32(fragK(L + R_WT, LDT_, 32 * kt, 16 * s4, lane), fragK(L + R_AQK, LDT_, 32 * tt, 16 * s4, lane), acc);
#pragma unroll
            for (int g = 0; g < 4; ++g) { const u32x2 qv = *(const LAS u32x2*)(L + R_QE + (32 * tt + r) * LDA_ + (32 * kt + 8 * g + 4 * hh) * 2);
                acc[4 * g] = bf_lo(qv.x) - acc[4 * g]; acc[4 * g + 1] = bf_hi(qv.x) - acc[4 * g + 1]; acc[4 * g + 2] = bf_lo(qv.y) - acc[4 * g + 2]; acc[4 * g + 3] = bf_hi(qv.y) - acc[4 * g + 3]; }
            gstore_tile(P.QT + (itg * 8 + kt * 2 + tt) * TILE_B, lane, acc);
        }
    }
}

DI void passA_hgrn(lptr L, int tid_in, const MixP& P, int bh, int c) {
    int tid = tid_in; asm volatile("" : "+v"(tid));
    constexpr int R_QT = 0, R_KTA = 17408, R_KTB = 34816, R_QE = 43520, R_KD = 60928, R_VV = 78336, R_ATT = 95744, R_TOT = 104960, R_REF = 107008;
    const int lane = tid & 63, w = __builtin_amdgcn_readfirstlane(tid >> 6), r = lane & 31, hh = lane >> 5;
    const int b = bh >> 2, h = bh & 3; const size_t row0 = (size_t)b * SEQ + 64 * c;
    const int k = tid & 127, qr = tid >> 7;
    LAS float* tot = (LAS float*)(L + R_TOT); LAS float* ref = (LAS float*)(L + R_REF);
    float lb = 0.f;
    if (P.l > 0) lb = sigmoidf_(P.lbl[512 + h * 128 + k] - P.lbl[h * 128 + k]);
    WG_BAR();
    float bloc[16], kk_[16]; float run = 0.f;
    bf16_t hfr[16], hqr[16];
    {
        const bf16_t* pf = P.PROJ + (row0 + 16 * qr) * NPROJ + PC_HF + h * 128 + k;
        const bf16_t* pq = P.PROJ + (row0 + 16 * qr) * NPROJ + PC_HQ + h * 128 + k;
#pragma unroll
        for (int i = 0; i < 16; ++i) hfr[i] = pf[(size_t)i * NPROJ];
#pragma unroll
        for (int i = 0; i < 16; ++i) hqr[i] = pq[(size_t)i * NPROJ];
        u32x4 vraw[2];
#pragma unroll
        for (int q = 0; q < 2; ++q) { const int ch = tid + 512 * q, row = ch >> 4, cc = ch & 15; vraw[q] = *(const u32x4*)(P.PROJ + (row0 + row) * NPROJ + PC_HI + h * 128 + cc * 8); }
        asm volatile("" ::: "memory");
#pragma unroll
        for (int i = 0; i < 16; ++i) { const float hf = bf1(hfr[i]); const float fg = lb + (1.0f - lb) * sigmoidf_(hf); run += __logf(fg); bloc[i] = run; kk_[i] = 1.0f - fg; }
        tot[qr * 128 + k] = run;
#pragma unroll
        for (int q = 0; q < 2; ++q) { const int ch = tid + 512 * q, row = ch >> 4, cc = ch & 15; *(LAS u32x4*)(L + R_VV + row * LDA_ + cc * 16) = vraw[q]; }
    }
    WG_BAR();
    float off = 0.f, blast = 0.f;
#pragma unroll
    for (int q = 0; q < 4; ++q) { const float t_ = tot[q * 128 + k]; blast += t_; if (q < qr) off += t_; }
#pragma unroll
    for (int i = 0; i < 16; ++i) bloc[i] += off;
    if (qr == 0) ref[k] = bloc[0];
    if (qr == 2) ref[128 + k] = bloc[0];
    WG_BAR();
    {
        const float ref0 = ref[k], ref1 = ref[128 + k]; const float rf = (qr < 2) ? ref0 : ref1;
#pragma unroll
        for (int i = 0; i < 16; ++i) { const int t = 16 * qr + i; const float q_ = siluf_(bf1(hqr[i])); const float bt = bloc[i];
            *(LAS bf16_t*)(L + R_QE + t * LDA_ + k * 2) = f2bf(q_ * __expf(bt));
            *(LAS bf16_t*)(L + R_KD + t * LDA_ + k * 2) = f2bf(kk_[i] * __expf(blast - bt));
            *(LAS bf16_t*)(L + R_QT + t * LDA_ + k * 2) = f2bf(q_ * __expf(fminf(bt - rf, 80.f)));
            *(LAS bf16_t*)(L + R_KTA + t * LDA_ + k * 2) = f2bf(kk_[i] * __expf(fminf(rf - bt, 80.f)));
            if (qr < 2) *(LAS bf16_t*)(L + R_KTB + t * LDA_ + k * 2) = f2bf(kk_[i] * __expf(ref1 - bt)); }
        if (qr == 0) { const int kt = k >> 5, kr = k & 31, h2 = (kr >> 2) & 1, i2 = (kr & 3) + 4 * (kr >> 3);
            P.DL[(((size_t)bh * 128 + c) * 4 + kt) * 32 + h2 * 16 + i2] = __expf(blast); }
    }
    WG_BAR();
    const size_t it = (size_t)bh * 128 + c;
    if (w < 3) {
        const int sa = (w == 2) ? 32 : 0, tb = (w == 0) ? 0 : 32;
        lptr Asrc = L + (w == 1 ? R_KTB : R_KTA);
        f32x16 acc = zero16();
#pragma unroll
        for (int s8 = 0; s8 < 8; ++s8) acc = MFMA32(fragK(Asrc, LDA_, sa, 16 * s8, lane), fragK(L + R_QT, LDA_, tb, 16 * s8, lane), acc);
        if (w != 1) {
#pragma unroll
            for (int i = 0; i < 16; ++i) acc[i] = (crow(i, hh) <= r) ? acc[i] : 0.f; }
        storeT_bf16(acc, L + R_ATT, LDT_, tb, sa, lane);
    } else if (w == 3) {
        storeT_bf16(zero16(), L + R_ATT, LDT_, 0, 32, lane);
    } else {
#pragma unroll
        for (int q = 0; q < 4; ++q) { const int t = (w - 4) * 4 + q, rt = t >> 2, dt = t & 3;
            f32x16 acc = zero16();
#pragma unroll
            for (int s4 = 0; s4 < 4; ++s4) acc = MFMA32(fragT(L + R_KD, LDA_, 16 * s4, 32 * rt, lane), fragT(L + R_VV, LDA_, 16 * s4, 32 * dt, lane), acc);
            gstore_tile(P.NN + (it * 16 + rt * 4 + dt) * TILE_B, lane, acc); }
    }
    {
        const int kt = w >> 1, tt = w & 1; u32x2 g[4];
#pragma unroll
        for (int q = 0; q < 4; ++q) g[q] = *(const LAS u32x2*)(L + R_QE + (32 * tt + r) * LDA_ + (32 * kt + 8 * q + 4 * hh) * 2);
        u32x4* p = (u32x4*)(P.QT + (it * 8 + kt * 2 + tt) * TILE_B + lane * 32);
        if (WT_TILE == 2) { __builtin_nontemporal_store((u32x4){g[0].x, g[0].y, g[1].x, g[1].y}, p); __builtin_nontemporal_store((u32x4){g[2].x, g[2].y, g[3].x, g[3].y}, p + 1); }
        else if (WT_TILE) { st16_wt(p, (u32x4){g[0].x, g[0].y, g[1].x, g[1].y}); st16_wt(p + 1, (u32x4){g[2].x, g[2].y, g[3].x, g[3].y}); }
        else { p[0] = (u32x4){g[0].x, g[0].y, g[1].x, g[1].y}; p[1] = (u32x4){g[2].x, g[2].y, g[3].x, g[3].y}; }
    }
    WG_BAR();
    {
        const int tt = w >> 2, dt = w & 3;
        f32x16 acc = zero16();
#pragma unroll
        for (int s4 = 0; s4 < 4; ++s4) acc = MFMA32(fragK(L + R_ATT, LDT_, 32 * tt, 16 * s4, lane), fragT(L + R_VV, LDA_, 16 * s4, 32 * dt, lane), acc);
        gstore_tile(P.OP + (it * 8 + tt * 4 + dt) * TILE_B, lane, acc);
    }
}

DI void passB_gdn(lptr L, int tid, const MixP& P, int j, int c0 = 0, int c1 = 128) {
    const int lane = tid & 63, w = __builtin_amdgcn_readfirstlane(tid >> 6);
    const int bh = j >> 2, dt = j & 3;
    if (w > 4) {
#pragma unroll 1
        for (int c = c0; c < c1; ++c) WG_BAR();
        return;
    }
    if (w == 4) {
        unsigned char* SSb = P.SS + ((size_t)1024 + bh * 128) * 16 * TILE_B + dt * TILE_B + lane * 32;
#pragma unroll
        for (int kt = 0; kt < 4; ++kt) { if (c0 == 0) { u32x4* ps = (u32x4*)(SSb + kt * 8192); ps[0] = (u32x4){0u, 0u, 0u, 0u}; ps[1] = (u32x4){0u, 0u, 0u, 0u}; } }
#pragma unroll 1
        for (int c = c0; c < c1; ++c) {
            WG_BAR();
            if (c < 127) {
                if (CHAIN_OWN) __builtin_amdgcn_s_sleep(3);
                lptr xb = L + (c & 1) * 8192;
#pragma unroll
                for (int kt = 0; kt < 4; ++kt) { const LAS u32x4* px = (const LAS u32x4*)(xb + kt * 2048 + lane * 32); const u32x4 a = px[0], b = px[1];
                    unsigned char* ps = SSb + (size_t)(c + 1) * 32768 + kt * 8192; if (WT_CHAIN) { st16_wt(ps, a); st16_wt(ps + 16, b); } else { *(u32x4*)ps = a; *(u32x4*)(ps + 16) = b; } }
            }
        }
        return;
    }
    const int rt = w;
    const unsigned char* MTb = P.MT + ((size_t)bh * 128) * 16 * TILE_B + rt * TILE_B + lane * 32;
    const unsigned char* NNb = P.NN + ((size_t)1024 + bh * 128) * 16 * TILE_B + (rt * 4 + dt) * TILE_B + lane * 32;
    u32x4 A[4][4][2], Nn[4][2];
    u32x4 Sb[4][2], mylo, myhi;
#pragma unroll
    for (int kt = 0; kt < 4; ++kt) { Sb[kt][0] = (u32x4){0u, 0u, 0u, 0u}; Sb[kt][1] = (u32x4){0u, 0u, 0u, 0u}; }
    if (c0 > 0) {
        const unsigned char* sr = P.SS + ((size_t)1024 + bh * 128) * 16 * TILE_B + dt * TILE_B + lane * 32 + (size_t)c0 * 32768;
#pragma unroll
        for (int kt = 0; kt < 4; ++kt) { Sb[kt][0] = *(const u32x4*)(sr + kt * 8192); Sb[kt][1] = *(const u32x4*)(sr + kt * 8192 + 16); }
    }
#define PB_LOAD(buf, cc) do { const unsigned char* pa = MTb + (size_t)(cc) * 32768; _Pragma("unroll") for (int kt = 0; kt < 4; ++kt) { A[buf][kt][0] = *(const u32x4*)(pa + kt * 8192); A[buf][kt][1] = *(const u32x4*)(pa + kt * 8192 + 16); } \
        const unsigned char* pn = NNb + (size_t)(cc) * 32768; Nn[buf][0] = *(const u32x4*)pn; Nn[buf][1] = *(const u32x4*)(pn + 16); } while (0)
#define PB_STEP(buf, cc) do { \
        f32x16 acc = unpack_tile(Nn[buf][0], Nn[buf][1]); \
        _Pragma("unroll") for (int kt = 0; kt < 4; ++kt) { acc = MFMA32(AS_BF8(A[buf][kt][0]), AS_BF8(Sb[kt][0]), acc); acc = MFMA32(AS_BF8(A[buf][kt][1]), AS_BF8(Sb[kt][1]), acc); } \
        pack_tile(acc, mylo, myhi); \
        lptr xb = L + ((cc) & 1) * 8192; \
        { LAS u32x4* px = (LAS u32x4*)(xb + rt * 2048 + lane * 32); px[0] = mylo; px[1] = myhi; } \
        WG_BAR(); \
        _Pragma("unroll") for (int kt = 0; kt < 4; ++kt) { if (CHAIN_OWN && kt == rt) { Sb[kt][0] = mylo; Sb[kt][1] = myhi; }   \
            else { const LAS u32x4* px = (const LAS u32x4*)(xb + kt * 2048 + lane * 32); Sb[kt][0] = px[0]; Sb[kt][1] = px[1]; } } \
        __builtin_amdgcn_sched_barrier(0);   } while (0)
#ifdef PROBE_DEPTH2
    PB_LOAD(0, c0); PB_LOAD(1, c0 + 1);
#pragma unroll 1
    for (int c = c0; c < c1 - 4; c += 4) {
        PB_LOAD(2, c + 2); PB_STEP(0, c);
        PB_LOAD(3, c + 3); PB_STEP(1, c + 1);
        PB_LOAD(0, c + 4); PB_STEP(2, c + 2);
        PB_LOAD(1, c + 5); PB_STEP(3, c + 3);
    }
    PB_LOAD(2, c1 - 2); PB_STEP(0, c1 - 4); PB_LOAD(3, c1 - 1); PB_STEP(1, c1 - 3); PB_STEP(2, c1 - 2); PB_STEP(3, c1 - 1);
#else
    PB_LOAD(0, c0); PB_LOAD(1, c0 + 1); PB_LOAD(2, c0 + 2);
#pragma unroll 1
    for (int c = c0; c < c1 - 4; c += 4) {
        PB_LOAD(3, c + 3); PB_STEP(0, c);
        PB_LOAD(0, c + 4); PB_STEP(1, c + 1);
        PB_LOAD(1, c + 5); PB_STEP(2, c + 2);
        PB_LOAD(2, c + 6); PB_STEP(3, c + 3);
    }
    PB_LOAD(3, c1 - 1); PB_STEP(0, c1 - 4); PB_STEP(1, c1 - 3); PB_STEP(2, c1 - 2); PB_STEP(3, c1 - 1);
#endif
#undef PB_LOAD
#undef PB_STEP
}
DI void passB_hgrn(int lane, const MixP& P, int item, int c0 = 0, int c1 = 128) {
    const int half = item & 1, tile = (item >> 1) & 15, bh = item >> 5, kt = tile >> 2, hh = lane >> 5;
    const unsigned char* NNb = P.NN + ((size_t)bh * 128) * 16 * TILE_B + tile * TILE_B + lane * 32 + half * 16;
    unsigned char* SSb = P.SS + ((size_t)bh * 128) * 16 * TILE_B + tile * TILE_B + lane * 32 + half * 16;
    const float* DLb = P.DL + (((size_t)bh * 128) * 4 + kt) * 32 + hh * 16 + half * 8;
    float S[8];
#pragma unroll
    for (int e = 0; e < 8; ++e) S[e] = 0.f;
    if (c0 > 0) { const u32x4 sv = *(const u32x4*)(SSb + (size_t)c0 * 32768);
        S[0] = bf_lo(sv.x); S[1] = bf_hi(sv.x); S[2] = bf_lo(sv.y); S[3] = bf_hi(sv.y); S[4] = bf_lo(sv.z); S[5] = bf_hi(sv.z); S[6] = bf_lo(sv.w); S[7] = bf_hi(sv.w); }
    u32x4 nA[8]; f32x4 dA[8][2]; u32x4 so[8];
#define HB_LOAD(nb, db, c0) do { _Pragma("unroll") for (int i = 0; i < 8; ++i) { nb[i] = *(const u32x4*)(NNb + (size_t)((c0) + i) * 32768); \
        const f32x4* pd = (const f32x4*)(DLb + (size_t)((c0) + i) * 128); db[i][0] = pd[0]; db[i][1] = pd[1]; } } while (0)
#define HB_RUN(nb, db) do { _Pragma("unroll") for (int i = 0; i < 8; ++i) { \
        so[i].x = pk2(S[0], S[1]); so[i].y = pk2(S[2], S[3]); so[i].z = pk2(S[4], S[5]); so[i].w = pk2(S[6], S[7]); \
        const u32x4 n = nb[i]; \
        S[0] = S[0] * db[i][0][0] + bf_lo(n.x); S[1] = S[1] * db[i][0][1] + bf_hi(n.x); S[2] = S[2] * db[i][0][2] + bf_lo(n.y); S[3] = S[3] * db[i][0][3] + bf_hi(n.y); \
        S[4] = S[4] * db[i][1][0] + bf_lo(n.z); S[5] = S[5] * db[i][1][1] + bf_hi(n.z); S[6] = S[6] * db[i][1][2] + bf_lo(n.w); S[7] = S[7] * db[i][1][3] + bf_hi(n.w); } } while (0)
#define HB_STORE(c0) do { _Pragma("unroll") for (int i = 0; i < 8; ++i) { if (WT_CHAIN) st16_wt(SSb + (size_t)((c0) + i) * 32768, so[i]); else *(u32x4*)(SSb + (size_t)((c0) + i) * 32768) = so[i]; } } while (0)
    HB_LOAD(nA, dA, c0);
#pragma unroll 1
    for (int c = c0; c < c1; c += 8) {
        HB_RUN(nA, dA); if (c + 8 < c1) HB_LOAD(nA, dA, c + 8); HB_STORE(c);
    }
    if (c1 < 128) { u32x4 sv; sv.x = pk2(S[0], S[1]); sv.y = pk2(S[2], S[3]); sv.z = pk2(S[4], S[5]); sv.w = pk2(S[6], S[7]);
        *(u32x4*)(SSb + (size_t)c1 * 32768) = sv; }
#undef HB_LOAD
#undef HB_RUN
#undef HB_STORE
}

struct PCLoad { u32x4 ol, oh, ql[4], qh[4], sl[4], sh_[4]; bf16_t g[16]; };
DI void passC_load(PCLoad& T, int lane, int w, const MixP& P, int it) {
    const int r = lane & 31, hh = lane >> 5, tt = w >> 2, dt = w & 3;
    const int br = it >> 10, bhc = it & 1023, bh = bhc >> 7, c = bhc & 127, b = bh >> 2, h = bh & 3;
    const size_t row0 = (size_t)b * SEQ + 64 * c;
    gload_tile(P.OP + ((size_t)it * 8 + tt * 4 + dt) * TILE_B, lane, T.ol, T.oh);
#pragma unroll
    for (int kt = 0; kt < 4; ++kt) { gload_tile(P.QT + ((size_t)it * 8 + kt * 2 + tt) * TILE_B, lane, T.ql[kt], T.qh[kt]); gload_tile(P.SS + ((size_t)it * 16 + kt * 4 + dt) * TILE_B, lane, T.sl[kt], T.sh_[kt]); }
    const int gcol = (br ? PC_GG : PC_HG) + h * 128 + 32 * dt + r;
#pragma unroll
    for (int i = 0; i < 16; ++i) T.g[i] = P.PROJ[(row0 + 32 * tt + crow(i, hh)) * NPROJ + gcol];
    __builtin_amdgcn_sched_barrier(0);
}
DI void passC_finish(const PCLoad& T, lptr L, int lane, int w, int it, int par, const float* ng_h, const float* ng_g, bf16_t* Y) {
    const int r = lane & 31, hh = lane >> 5, tt = w >> 2, dt = w & 3;
    const int br = it >> 10, bhc = it & 1023, bh = bhc >> 7, c = bhc & 127, b = bh >> 2, h = bh & 3;
    const size_t row0 = (size_t)b * SEQ + 64 * c;
    f32x16 acc = unpack_tile(T.ol, T.oh);
#pragma unroll
    for (int kt = 0; kt < 4; ++kt) { acc = MFMA32(AS_BF8(T.ql[kt]), AS_BF8(T.sl[kt]), acc); acc = MFMA32(AS_BF8(T.qh[kt]), AS_BF8(T.sh_[kt]), acc); }
    LAS float* ps = (LAS float*)(L + par * 1024);
#pragma unroll
    for (int i = 0; i < 16; ++i) { float s = acc[i] * acc[i];
        s += shx<1>(s, lane); s += shx<2>(s, lane); s += shx<4>(s, lane); s += shx<8>(s, lane); s += shx<16>(s, lane);
        if (r == 0) ps[dt * 64 + 32 * tt + crow(i, hh)] = s; }
    WG_BAR();
    const int d = 32 * dt + r; const float ng = (br ? ng_g : ng_h)[d];
#pragma unroll
    for (int i = 0; i < 16; ++i) { const int t = 32 * tt + crow(i, hh);
        const float tot = (ps[t] + ps[64 + t]) + (ps[128 + t] + ps[192 + t]);
        const float rstd = 1.0f / sqrtf(tot * (1.0f / 128.0f) + EPS);
        Y[(row0 + t) * D + br * 512 + h * 128 + d] = f2bf(acc[i] * rstd * ng * siluf_(bf1(T.g[i]))); }
}

DI void passC_wave(int lane, const MixP& P, int it, int tt, const float* ng_h, const float* ng_g, bf16_t* Y) {
    const int r = lane & 31, hh = lane >> 5;
    const int br = it >> 10, bhc = it & 1023, bh = bhc >> 7, c = bhc & 127, b = bh >> 2, h = bh & 3;
    const size_t rowb = (size_t)b * SEQ + 64 * c + 32 * tt;
    u32x4 ql[4], qh[4];
#pragma unroll
    for (int kt = 0; kt < 4; ++kt) gload_tile(P.QT + ((size_t)it * 8 + kt * 2 + tt) * TILE_B, lane, ql[kt], qh[kt]);
    u32x4 ol[2], oh[2], sl[2][4], sh_[2][4];
#define PC_LD(buf, dt) do { gload_tile(P.OP + ((size_t)it * 8 + tt * 4 + (dt)) * TILE_B, lane, ol[buf], oh[buf]); \
        _Pragma("unroll") for (int kt = 0; kt < 4; ++kt) gload_tile(P.SS + ((size_t)it * 16 + kt * 4 + (dt)) * TILE_B, lane, sl[buf][kt], sh_[buf][kt]); } while (0)
    f32x16 acc[4];
    PC_LD(0, 0);
#pragma unroll
    for (int dt = 0; dt < 4; ++dt) {
        if (dt < 3) PC_LD((dt + 1) & 1, dt + 1);
        __builtin_amdgcn_sched_barrier(0);
        f32x16 a = unpack_tile(ol[dt & 1], oh[dt & 1]);
#pragma unroll
        for (int kt = 0; kt < 4; ++kt) { a = MFMA32(AS_BF8(ql[kt]), AS_BF8(sl[dt & 1][kt]), a); a = MFMA32(AS_BF8(qh[kt]), AS_BF8(sh_[dt & 1][kt]), a); }
        acc[dt] = a;
    }
#undef PC_LD
    const bf16_t* gp = P.PROJ + rowb * NPROJ + (br ? PC_GG : PC_HG) + h * 128 + r;
    bf16_t g0[16], g1[16];
#pragma unroll
    for (int i = 0; i < 16; ++i) g0[i] = gp[(size_t)crow(i, hh) * NPROJ];
    float rstd[16];
#pragma unroll
    for (int i = 0; i < 16; ++i) { float s = (acc[0][i] * acc[0][i] + acc[1][i] * acc[1][i]) + (acc[2][i] * acc[2][i] + acc[3][i] * acc[3][i]);
        s += shx<1>(s, lane); s += shx<2>(s, lane); s += shx<4>(s, lane); s += shx<8>(s, lane); s += shx<16>(s, lane);
        rstd[i] = 1.0f / sqrtf(s * (1.0f / 128.0f) + EPS); }
    const float* ngp = (br ? ng_g : ng_h) + r;
    bf16_t* yp = Y + rowb * D + br * 512 + h * 128 + r;
#pragma unroll
    for (int dt = 0; dt < 4; ++dt) {
        if (dt < 3) {
#pragma unroll
            for (int i = 0; i < 16; ++i) { const bf16_t v = gp[(size_t)crow(i, hh) * NPROJ + 32 * (dt + 1)]; if (dt & 1) g0[i] = v; else g1[i] = v; } }
        const float ng = ngp[32 * dt];
#pragma unroll
        for (int i = 0; i < 16; ++i) { const bf16_t gv = (dt & 1) ? g1[i] : g0[i];
            yp[(size_t)crow(i, hh) * D + 32 * dt] = f2bf(acc[dt][i] * rstd[i] * ng * siluf_(bf1(gv))); }
    }
}

DI float selh(int hm, float a0, float a1) { return __int_as_float((__float_as_int(a0) & ~hm) | (__float_as_int(a1) & hm)); }
DI float max3f_(float a, float b, float c) { return fmaxf(fmaxf(a, b), c); }
#define CE_(a, b) { const float t_ = fmaxf(a, b); b = fminf(a, b); a = t_; }
#define SORT16_(P, B) do {   \
    CE_(P[(B) + 0], P[(B) + 13]); CE_(P[(B) + 1], P[(B) + 12]); CE_(P[(B) + 2], P[(B) + 15]); CE_(P[(B) + 3], P[(B) + 14]); CE_(P[(B) + 4], P[(B) + 8]); CE_(P[(B) + 5], P[(B) + 6]); CE_(P[(B) + 7], P[(B) + 11]); CE_(P[(B) + 9], P[(B) + 10]); \
    CE_(P[(B) + 0], P[(B) + 5]); CE_(P[(B) + 1], P[(B) + 7]); CE_(P[(B) + 2], P[(B) + 9]); CE_(P[(B) + 3], P[(B) + 4]); CE_(P[(B) + 6], P[(B) + 13]); CE_(P[(B) + 8], P[(B) + 14]); CE_(P[(B) + 10], P[(B) + 15]); CE_(P[(B) + 11], P[(B) + 12]); \
    CE_(P[(B) + 0], P[(B) + 1]); CE_(P[(B) + 2], P[(B) + 3]); CE_(P[(B) + 4], P[(B) + 5]); CE_(P[(B) + 6], P[(B) + 8]); CE_(P[(B) + 7], P[(B) + 9]); CE_(P[(B) + 10], P[(B) + 11]); CE_(P[(B) + 12], P[(B) + 13]); CE_(P[(B) + 14], P[(B) + 15]); \
    CE_(P[(B) + 0], P[(B) + 2]); CE_(P[(B) + 1], P[(B) + 3]); CE_(P[(B) + 4], P[(B) + 10]); CE_(P[(B) + 5], P[(B) + 11]); CE_(P[(B) + 6], P[(B) + 7]); CE_(P[(B) + 8], P[(B) + 9]); CE_(P[(B) + 12], P[(B) + 14]); CE_(P[(B) + 13], P[(B) + 15]); \
    CE_(P[(B) + 1], P[(B) + 2]); CE_(P[(B) + 3], P[(B) + 12]); CE_(P[(B) + 4], P[(B) + 6]); CE_(P[(B) + 5], P[(B) + 7]); CE_(P[(B) + 8], P[(B) + 10]); CE_(P[(B) + 9], P[(B) + 11]); CE_(P[(B) + 13], P[(B) + 14]); \
    CE_(P[(B) + 1], P[(B) + 4]); CE_(P[(B) + 2], P[(B) + 6]); CE_(P[(B) + 5], P[(B) + 8]); CE_(P[(B) + 7], P[(B) + 10]); CE_(P[(B) + 9], P[(B) + 13]); CE_(P[(B) + 11], P[(B) + 14]); \
    CE_(P[(B) + 2], P[(B) + 4]); CE_(P[(B) + 3], P[(B) + 6]); CE_(P[(B) + 9], P[(B) + 12]); CE_(P[(B) + 11], P[(B) + 13]); \
    CE_(P[(B) + 3], P[(B) + 5]); CE_(P[(B) + 6], P[(B) + 8]); CE_(P[(B) + 7], P[(B) + 9]); CE_(P[(B) + 10], P[(B) + 12]); \
    CE_(P[(B) + 3], P[(B) + 4]); CE_(P[(B) + 5], P[(B) + 6]); CE_(P[(B) + 7], P[(B) + 8]); CE_(P[(B) + 9], P[(B) + 10]); CE_(P[(B) + 11], P[(B) + 12]); \
    CE_(P[(B) + 6], P[(B) + 7]); CE_(P[(B) + 8], P[(B) + 9]); \
} while (0)
#define MERGE16_(P, B) do { \
    CE_(P[(B) + 0], P[(B) + 8]); CE_(P[(B) + 1], P[(B) + 9]); CE_(P[(B) + 2], P[(B) + 10]); CE_(P[(B) + 3], P[(B) + 11]); CE_(P[(B) + 4], P[(B) + 12]); CE_(P[(B) + 5], P[(B) + 13]); CE_(P[(B) + 6], P[(B) + 14]); CE_(P[(B) + 7], P[(B) + 15]); \
    CE_(P[(B) + 0], P[(B) + 4]); CE_(P[(B) + 1], P[(B) + 5]); CE_(P[(B) + 2], P[(B) + 6]); CE_(P[(B) + 3], P[(B) + 7]); CE_(P[(B) + 8], P[(B) + 12]); CE_(P[(B) + 9], P[(B) + 13]); CE_(P[(B) + 10], P[(B) + 14]); CE_(P[(B) + 11], P[(B) + 15]); \
    CE_(P[(B) + 0], P[(B) + 2]); CE_(P[(B) + 1], P[(B) + 3]); CE_(P[(B) + 4], P[(B) + 6]); CE_(P[(B) + 5], P[(B) + 7]); CE_(P[(B) + 8], P[(B) + 10]); CE_(P[(B) + 9], P[(B) + 11]); CE_(P[(B) + 12], P[(B) + 14]); CE_(P[(B) + 13], P[(B) + 15]); \
    CE_(P[(B) + 0], P[(B) + 1]); CE_(P[(B) + 2], P[(B) + 3]); CE_(P[(B) + 4], P[(B) + 5]); CE_(P[(B) + 6], P[(B) + 7]); CE_(P[(B) + 8], P[(B) + 9]); CE_(P[(B) + 10], P[(B) + 11]); CE_(P[(B) + 12], P[(B) + 13]); CE_(P[(B) + 14], P[(B) + 15]); \
} while (0)
#define SORT32_(P, B) do { \
    CE_(P[(B) + 0], P[(B) + 1]); CE_(P[(B) + 3], P[(B) + 2]); CE_(P[(B) + 4], P[(B) + 5]); CE_(P[(B) + 7], P[(B) + 6]); CE_(P[(B) + 8], P[(B) + 9]); CE_(P[(B) + 11], P[(B) + 10]); CE_(P[(B) + 12], P[(B) + 13]); CE_(P[(B) + 15], P[(B) + 14]); \
    CE_(P[(B) + 16], P[(B) + 17]); CE_(P[(B) + 19], P[(B) + 18]); CE_(P[(B) + 20], P[(B) + 21]); CE_(P[(B) + 23], P[(B) + 22]); CE_(P[(B) + 24], P[(B) + 25]); CE_(P[(B) + 27], P[(B) + 26]); CE_(P[(B) + 28], P[(B) + 29]); CE_(P[(B) + 31], P[(B) + 30]); \
    CE_(P[(B) + 0], P[(B) + 2]); CE_(P[(B) + 1], P[(B) + 3]); CE_(P[(B) + 6], P[(B) + 4]); CE_(P[(B) + 7], P[(B) + 5]); CE_(P[(B) + 8], P[(B) + 10]); CE_(P[(B) + 9], P[(B) + 11]); CE_(P[(B) + 14], P[(B) + 12]); CE_(P[(B) + 15], P[(B) + 13]); \
    CE_(P[(B) + 16], P[(B) + 18]); CE_(P[(B) + 17], P[(B) + 19]); CE_(P[(B) + 22], P[(B) + 20]); CE_(P[(B) + 23], P[(B) + 21]); CE_(P[(B) + 24], P[(B) + 26]); CE_(P[(B) + 25], P[(B) + 27]); CE_(P[(B) + 30], P[(B) + 28]); CE_(P[(B) + 31], P[(B) + 29]); \
    CE_(P[(B) + 0], P[(B) + 1]); CE_(P[(B) + 2], P[(B) + 3]); CE_(P[(B) + 5], P[(B) + 4]); CE_(P[(B) + 7], P[(B) + 6]); CE_(P[(B) + 8], P[(B) + 9]); CE_(P[(B) + 10], P[(B) + 11]); CE_(P[(B) + 13], P[(B) + 12]); CE_(P[(B) + 15], P[(B) + 14]); \
    CE_(P[(B) + 16], P[(B) + 17]); CE_(P[(B) + 18], P[(B) + 19]); CE_(P[(B) + 21], P[(B) + 20]); CE_(P[(B) + 23], P[(B) + 22]); CE_(P[(B) + 24], P[(B) + 25]); CE_(P[(B) + 26], P[(B) + 27]); CE_(P[(B) + 29], P[(B) + 28]); CE_(P[(B) + 31], P[(B) + 30]); \
    CE_(P[(B) + 0], P[(B) + 4]); CE_(P[(B) + 1], P[(B) + 5]); CE_(P[(B) + 2], P[(B) + 6]); CE_(P[(B) + 3], P[(B) + 7]); CE_(P[(B) + 12], P[(B) + 8]); CE_(P[(B) + 13], P[(B) + 9]); CE_(P[(B) + 14], P[(B) + 10]); CE_(P[(B) + 15], P[(B) + 11]); \
    CE_(P[(B) + 16], P[(B) + 20]); CE_(P[(B) + 17], P[(B) + 21]); CE_(P[(B) + 18], P[(B) + 22]); CE_(P[(B) + 19], P[(B) + 23]); CE_(P[(B) + 28], P[(B) + 24]); CE_(P[(B) + 29], P[(B) + 25]); CE_(P[(B) + 30], P[(B) + 26]); CE_(P[(B) + 31], P[(B) + 27]); \
    CE_(P[(B) + 0], P[(B) + 2]); CE_(P[(B) + 1], P[(B) + 3]); CE_(P[(B) + 4], P[(B) + 6]); CE_(P[(B) + 5], P[(B) + 7]); CE_(P[(B) + 10], P[(B) + 8]); CE_(P[(B) + 11], P[(B) + 9]); CE_(P[(B) + 14], P[(B) + 12]); CE_(P[(B) + 15], P[(B) + 13]); \
    CE_(P[(B) + 16], P[(B) + 18]); CE_(P[(B) + 17], P[(B) + 19]); CE_(P[(B) + 20], P[(B) + 22]); CE_(P[(B) + 21], P[(B) + 23]); CE_(P[(B) + 26], P[(B) + 24]); CE_(P[(B) + 27], P[(B) + 25]); CE_(P[(B) + 30], P[(B) + 28]); CE_(P[(B) + 31], P[(B) + 29]); \
    CE_(P[(B) + 0], P[(B) + 1]); CE_(P[(B) + 2], P[(B) + 3]); CE_(P[(B) + 4], P[(B) + 5]); CE_(P[(B) + 6], P[(B) + 7]); CE_(P[(B) + 9], P[(B) + 8]); CE_(P[(B) + 11], P[(B) + 10]); CE_(P[(B) + 13], P[(B) + 12]); CE_(P[(B) + 15], P[(B) + 14]); \
    CE_(P[(B) + 16], P[(B) + 17]); CE_(P[(B) + 18], P[(B) + 19]); CE_(P[(B) + 20], P[(B) + 21]); CE_(P[(B) + 22], P[(B) + 23]); CE_(P[(B) + 25], P[(B) + 24]); CE_(P[(B) + 27], P[(B) + 26]); CE_(P[(B) + 29], P[(B) + 28]); CE_(P[(B) + 31], P[(B) + 30]); \
    CE_(P[(B) + 0], P[(B) + 8]); CE_(P[(B) + 1], P[(B) + 9]); CE_(P[(B) + 2], P[(B) + 10]); CE_(P[(B) + 3], P[(B) + 11]); CE_(P[(B) + 4], P[(B) + 12]); CE_(P[(B) + 5], P[(B) + 13]); CE_(P[(B) + 6], P[(B) + 14]); CE_(P[(B) + 7], P[(B) + 15]); \
    CE_(P[(B) + 24], P[(B) + 16]); CE_(P[(B) + 25], P[(B) + 17]); CE_(P[(B) + 26], P[(B) + 18]); CE_(P[(B) + 27], P[(B) + 19]); CE_(P[(B) + 28], P[(B) + 20]); CE_(P[(B) + 29], P[(B) + 21]); CE_(P[(B) + 30], P[(B) + 22]); CE_(P[(B) + 31], P[(B) + 23]); \
    CE_(P[(B) + 0], P[(B) + 4]); CE_(P[(B) + 1], P[(B) + 5]); CE_(P[(B) + 2], P[(B) + 6]); CE_(P[(B) + 3], P[(B) + 7]); CE_(P[(B) + 8], P[(B) + 12]); CE_(P[(B) + 9], P[(B) + 13]); CE_(P[(B) + 10], P[(B) + 14]); CE_(P[(B) + 11], P[(B) + 15]); \
    CE_(P[(B) + 20], P[(B) + 16]); CE_(P[(B) + 21], P[(B) + 17]); CE_(P[(B) + 22], P[(B) + 18]); CE_(P[(B) + 23], P[(B) + 19]); CE_(P[(B) + 28], P[(B) + 24]); CE_(P[(B) + 29], P[(B) + 25]); CE_(P[(B) + 30], P[(B) + 26]); CE_(P[(B) + 31], P[(B) + 27]); \
    CE_(P[(B) + 0], P[(B) + 2]); CE_(P[(B) + 1], P[(B) + 3]); CE_(P[(B) + 4], P[(B) + 6]); CE_(P[(B) + 5], P[(B) + 7]); CE_(P[(B) + 8], P[(B) + 10]); CE_(P[(B) + 9], P[(B) + 11]); CE_(P[(B) + 12], P[(B) + 14]); CE_(P[(B) + 13], P[(B) + 15]); \
    CE_(P[(B) + 18], P[(B) + 16]); CE_(P[(B) + 19], P[(B) + 17]); CE_(P[(B) + 22], P[(B) + 20]); CE_(P[(B) + 23], P[(B) + 21]); CE_(P[(B) + 26], P[(B) + 24]); CE_(P[(B) + 27], P[(B) + 25]); CE_(P[(B) + 30], P[(B) + 28]); CE_(P[(B) + 31], P[(B) + 29]); \
    CE_(P[(B) + 0], P[(B) + 1]); CE_(P[(B) + 2], P[(B) + 3]); CE_(P[(B) + 4], P[(B) + 5]); CE_(P[(B) + 6], P[(B) + 7]); CE_(P[(B) + 8], P[(B) + 9]); CE_(P[(B) + 10], P[(B) + 11]); CE_(P[(B) + 12], P[(B) + 13]); CE_(P[(B) + 14], P[(B) + 15]); \
    CE_(P[(B) + 17], P[(B) + 16]); CE_(P[(B) + 19], P[(B) + 18]); CE_(P[(B) + 21], P[(B) + 20]); CE_(P[(B) + 23], P[(B) + 22]); CE_(P[(B) + 25], P[(B) + 24]); CE_(P[(B) + 27], P[(B) + 26]); CE_(P[(B) + 29], P[(B) + 28]); CE_(P[(B) + 31], P[(B) + 30]); \
    CE_(P[(B) + 0], P[(B) + 16]); CE_(P[(B) + 1], P[(B) + 17]); CE_(P[(B) + 2], P[(B) + 18]); CE_(P[(B) + 3], P[(B) + 19]); CE_(P[(B) + 4], P[(B) + 20]); CE_(P[(B) + 5], P[(B) + 21]); CE_(P[(B) + 6], P[(B) + 22]); CE_(P[(B) + 7], P[(B) + 23]); \
    CE_(P[(B) + 8], P[(B) + 24]); CE_(P[(B) + 9], P[(B) + 25]); CE_(P[(B) + 10], P[(B) + 26]); CE_(P[(B) + 11], P[(B) + 27]); CE_(P[(B) + 12], P[(B) + 28]); CE_(P[(B) + 13], P[(B) + 29]); CE_(P[(B) + 14], P[(B) + 30]); CE_(P[(B) + 15], P[(B) + 31]); \
    CE_(P[(B) + 0], P[(B) + 8]); CE_(P[(B) + 1], P[(B) + 9]); CE_(P[(B) + 2], P[(B) + 10]); CE_(P[(B) + 3], P[(B) + 11]); CE_(P[(B) + 4], P[(B) + 12]); CE_(P[(B) + 5], P[(B) + 13]); CE_(P[(B) + 6], P[(B) + 14]); CE_(P[(B) + 7], P[(B) + 15]); \
    CE_(P[(B) + 16], P[(B) + 24]); CE_(P[(B) + 17], P[(B) + 25]); CE_(P[(B) + 18], P[(B) + 26]); CE_(P[(B) + 19], P[(B) + 27]); CE_(P[(B) + 20], P[(B) + 28]); CE_(P[(B) + 21], P[(B) + 29]); CE_(P[(B) + 22], P[(B) + 30]); CE_(P[(B) + 23], P[(B) + 31]); \
    CE_(P[(B) + 0], P[(B) + 4]); CE_(P[(B) + 1], P[(B) + 5]); CE_(P[(B) + 2], P[(B) + 6]); CE_(P[(B) + 3], P[(B) + 7]); CE_(P[(B) + 8], P[(B) + 12]); CE_(P[(B) + 9], P[(B) + 13]); CE_(P[(B) + 10], P[(B) + 14]); CE_(P[(B) + 11], P[(B) + 15]); \
    CE_(P[(B) + 16], P[(B) + 20]); CE_(P[(B) + 17], P[(B) + 21]); CE_(P[(B) + 18], P[(B) + 22]); CE_(P[(B) + 19], P[(B) + 23]); CE_(P[(B) + 24], P[(B) + 28]); CE_(P[(B) + 25], P[(B) + 29]); CE_(P[(B) + 26], P[(B) + 30]); CE_(P[(B) + 27], P[(B) + 31]); \
    CE_(P[(B) + 0], P[(B) + 2]); CE_(P[(B) + 1], P[(B) + 3]); CE_(P[(B) + 4], P[(B) + 6]); CE_(P[(B) + 5], P[(B) + 7]); CE_(P[(B) + 8], P[(B) + 10]); CE_(P[(B) + 9], P[(B) + 11]); CE_(P[(B) + 12], P[(B) + 14]); CE_(P[(B) + 13], P[(B) + 15]); \
    CE_(P[(B) + 16], P[(B) + 18]); CE_(P[(B) + 17], P[(B) + 19]); CE_(P[(B) + 20], P[(B) + 22]); CE_(P[(B) + 21], P[(B) + 23]); CE_(P[(B) + 24], P[(B) + 26]); CE_(P[(B) + 25], P[(B) + 27]); CE_(P[(B) + 28], P[(B) + 30]); CE_(P[(B) + 29], P[(B) + 31]); \
    CE_(P[(B) + 0], P[(B) + 1]); CE_(P[(B) + 2], P[(B) + 3]); CE_(P[(B) + 4], P[(B) + 5]); CE_(P[(B) + 6], P[(B) + 7]); CE_(P[(B) + 8], P[(B) + 9]); CE_(P[(B) + 10], P[(B) + 11]); CE_(P[(B) + 12], P[(B) + 13]); CE_(P[(B) + 14], P[(B) + 15]); \
    CE_(P[(B) + 16], P[(B) + 17]); CE_(P[(B) + 18], P[(B) + 19]); CE_(P[(B) + 20], P[(B) + 21]); CE_(P[(B) + 22], P[(B) + 23]); CE_(P[(B) + 24], P[(B) + 25]); CE_(P[(B) + 26], P[(B) + 27]); CE_(P[(B) + 28], P[(B) + 29]); CE_(P[(B) + 30], P[(B) + 31]); \
} while (0)

DI void top16_of_128(float (&p)[64], float (&out)[16], int lane) {
    SORT16_(p, 0); SORT16_(p, 16); SORT16_(p, 32); SORT16_(p, 48);
#pragma unroll
    for (int i = 0; i < 16; ++i) { p[i] = fmaxf(p[i], p[31 - i]); p[32 + i] = fmaxf(p[32 + i], p[63 - i]); }
    MERGE16_(p, 0); MERGE16_(p, 32);
#pragma unroll
    for (int i = 0; i < 16; ++i) p[i] = fmaxf(p[i], p[47 - i]);
    MERGE16_(p, 0);
    float q[16];
#pragma unroll
    for (int i = 0; i < 16; ++i) q[i] = shx<32>(p[15 - i], lane);
#pragma unroll
    for (int i = 0; i < 16; ++i) p[i] = fmaxf(p[i], q[i]);
    MERGE16_(p, 0);
#pragma unroll
    for (int i = 0; i < 16; ++i) out[i] = p[i];
}
DI void route_q_load(bf16x8 (&bq)[8], const bf16_t* Q, int head, int tile, int z, int lane) {
    const bf16_t* qrow = Q + ((size_t)tile * 32 + (lane & 31)) * NQ + head * 256 + z * 128 + 8 * (lane >> 5);
#pragma unroll
    for (int s8 = 0; s8 < 8; ++s8) bq[s8] = *(const bf16x8*)(qrow + 16 * s8);
}
DI void peer_route_tile(lptr L, int lane, int wave, const bf16_t* Q, int head, int tile, u32x2* route, bf16x8 (&bq0)[8], int next_tile) {
    const int r = lane & 31, hh = lane >> 5;
    const size_t tok = (size_t)tile * 32 + r;
    float top[2][16];
    bf16x8 bq1[8];
    route_q_load(bq1, Q, head, tile, 1, lane);
    __builtin_amdgcn_sched_barrier(0);
#pragma unroll
    for (int z = 0; z < 2; ++z) {
        bf16x8 bq[8];
#pragma unroll
        for (int s8 = 0; s8 < 8; ++s8) bq[s8] = z ? bq1[s8] : bq0[s8];
        float p[64];
#pragma unroll
        for (int m = 0; m < 4; ++m) { f32x16 acc = zero16();
#pragma unroll
            for (int s8 = 0; s8 < 8; ++s8) acc = MFMA32(fragK(L + z * 34816, 272, 32 * m, 16 * s8, lane), bq[s8], acc);
#pragma unroll
            for (int i = 0; i < 16; ++i) p[m * 16 + i] = __int_as_float((__float_as_int(acc[i]) & ~0x7f) | (32 * m + crow(i, hh)));
            __builtin_amdgcn_sched_barrier(0); }
        if (z == 1 && next_tile >= 0) { route_q_load(bq0, Q, head, next_tile, 0, lane); __builtin_amdgcn_sched_barrier(0); }
        top16_of_128(p, top[z], lane);
    }
    float cand[50];
#define CAND_ROW(i, off) _Pragma("unroll") for (int j = 0; j < 16 / ((i) + 1); ++j) { const float s = top[0][i] + top[1][j]; \
        cand[(off) + j] = __int_as_float((__float_as_int(s) & ~0xff) | ((i) * 16 + j)); }
    CAND_ROW(0, 0) CAND_ROW(1, 16) CAND_ROW(2, 24) CAND_ROW(3, 29) CAND_ROW(4, 33) CAND_ROW(5, 36) CAND_ROW(6, 38) CAND_ROW(7, 40)
    CAND_ROW(8, 42) CAND_ROW(9, 43) CAND_ROW(10, 44) CAND_ROW(11, 45) CAND_ROW(12, 46) CAND_ROW(13, 47) CAND_ROW(14, 48) CAND_ROW(15, 49)
#undef CAND_ROW
    float c32[32];
#pragma unroll
    for (int m = 0; m < 25; ++m) c32[m] = selh(-hh, cand[2 * m], cand[2 * m + 1]);
#pragma unroll
    for (int m = 25; m < 32; ++m) c32[m] = -INFINITY;
    SORT32_(c32, 0);
    float win[16];
    {
        float q[16];
#pragma unroll
        for (int i = 0; i < 16; ++i) q[i] = shx<32>(c32[15 - i], lane);
#pragma unroll
        for (int i = 0; i < 16; ++i) c32[i] = fmaxf(c32[i], q[i]);
        MERGE16_(c32, 0);
#pragma unroll
        for (int i = 0; i < 16; ++i) win[i] = c32[i];
    }
    LAS unsigned* tb = (LAS unsigned*)(L + 69632 + wave * 4352) + r * 33 + 16 * hh;
#pragma unroll
    for (int q = 0; q < 16; ++q) tb[q] = (unsigned)__float_as_int(selh(-hh, top[0][q], top[1][q])) & 0x7fu;
    float e[16], sum = 0.f;
#pragma unroll
    for (int q = 0; q < 16; ++q) { e[q] = __expf(win[q] - win[0]); sum += e[q]; }
    const float inv = 1.0f / sum;
    LDS_WAIT();
    const LAS unsigned* tr_ = (const LAS unsigned*)(L + 69632 + wave * 4352) + r * 33;
    u32x2* ro = route + (tok * 8 + head) * 16 + 8 * hh;
#pragma unroll
    for (int q = 0; q < 8; ++q) {
        const float wv = selh(-hh, win[q], win[8 + q]); const float ev = selh(-hh, e[q], e[8 + q]);
        const int id = __float_as_int(wv) & 0xff;
        const unsigned n0 = tr_[id >> 4], n1 = tr_[16 + (id & 15)];
        u32x2 o; o.x = n0 * 128u + n1; o.y = (unsigned)__float_as_int(ev * inv); ro[q] = o;
    }
    LDS_WAIT();
}
DI void peer_route_unit(lptr L, int tid, int pm, int head, const bf16_t* Q, const bf16_t* SK, u32x2* route) {
    const int lane = tid & 63, wave = __builtin_amdgcn_readfirstlane(tid >> 6);
    __syncthreads();
    for (int i = tid; i < 2 * 128 * 16; i += NTHR) { const int z = i >> 11, n = (i >> 4) & 127, cc = i & 15;
        *(LAS u32x4*)(L + z * 34816 + n * 272 + cc * 16) = *(const u32x4*)(SK + ((size_t)(head * 2 + z) * 128 + n) * 128 + cc * 8); }
    __syncthreads();
    bf16x8 bq0[8]; route_q_load(bq0, Q, head, pm * 8 + wave, 0, lane);
    peer_route_tile(L, lane, wave, Q, head, pm * 8 + wave, route, bq0, -1);
}
DI void peer_route_phase(lptr L, int tid, int vcu, const bf16_t* Q, const bf16_t* SK  , u32x2* route) {
    const int lane = tid & 63, wave = __builtin_amdgcn_readfirstlane(tid >> 6);
    const int head = vcu & 7, base = vcu >> 3;
    __syncthreads();
    for (int i = tid; i < 2 * 128 * 16; i += NTHR) { const int z = i >> 11, n = (i >> 4) & 127, cc = i & 15;
        *(LAS u32x4*)(L + z * 34816 + n * 272 + cc * 16) = *(const u32x4*)(SK + ((size_t)(head * 2 + z) * 128 + n) * 128 + cc * 8); }
    __syncthreads();
    bf16x8 bq0[8];
    route_q_load(bq0, Q, head, base * 16 + wave * 2, 0, lane);
#pragma unroll 1
    for (int i = 0; i < 2; ++i) peer_route_tile(L, lane, wave, Q, head, base * 16 + wave * 2 + i, route, bq0, i == 0 ? base * 16 + wave * 2 + 1 : -1);
}

DI float erf_as(float x) {
    const float ax = fabsf(x), t = __builtin_amdgcn_rcpf(1.0f + 0.3275911f * ax);
    const float poly = t * (0.254829592f + t * (-0.284496736f + t * (1.421413741f + t * (-1.453152027f + t * 1.061405429f))));
    const float r = 1.0f - poly * __expf(-ax * ax);
    return __builtin_copysignf(r, x);
}
DI float gelu_exact(float x) { return 0.5f * x * (1.0f + erf_as(x * 0.70710678118654752f)); }
struct GatherP {
    const bf16_t* H; const u32x2* route; const unsigned char* U; const unsigned char* V; float* X; const float* gt2;
    int last; const float* ng; const float* nsc; const float* nsh;
    bf16_t* Hout; float* small; const LAS float* wsm; float* out;
    const unsigned char* H8; const float* HS;
};
constexpr float U8_SCALE = 256.0f, V8_SCALE = 16.0f;
DI void cvt_stream_fp8(const float* src, unsigned char* dst, size_t n, float scale, int gw, int ngw, int lane) {
    const size_t n16 = n / 16, stride = (size_t)ngw * 64;
    for (size_t i0 = (size_t)gw * 64 + lane; i0 < n16; i0 += 4 * stride) {
        f32x4 a[4][4];
#pragma unroll
        for (int u = 0; u < 4; ++u) { const size_t i = i0 + u * stride;
#pragma unroll
            for (int q = 0; q < 4; ++q) a[u][q] = (i < n16) ? ((const f32x4*)src)[4 * i + q] : (f32x4){0.f, 0.f, 0.f, 0.f}; }
#pragma unroll
        for (int u = 0; u < 4; ++u) { const size_t i = i0 + u * stride; u32x4 o;
#pragma unroll
            for (int q = 0; q < 4; ++q) { f32x4 v = a[u][q] * scale;
#pragma unroll
                for (int e = 0; e < 4; ++e) v[e] = fminf(fmaxf(v[e], -448.f), 448.f);
                int p = 0; p = __builtin_amdgcn_cvt_pk_fp8_f32(v[0], v[1], p, false); p = __builtin_amdgcn_cvt_pk_fp8_f32(v[2], v[3], p, true); o[q] = (unsigned)p; }
            if (i < n16) ((u32x4*)dst)[i] = o; }
    }
}
DI void fp8x16_to_f32(const u32x4& v, float (&f)[16]) {
    const unsigned d0 = v.x, d1 = v.y, d2 = v.z, d3 = v.w;
    f32x2 t;
    t = __builtin_amdgcn_cvt_pk_f32_fp8((int)d0, false); f[0] = t.x; f[1] = t.y; t = __builtin_amdgcn_cvt_pk_f32_fp8((int)d0, true); f[2] = t.x; f[3] = t.y;
    t = __builtin_amdgcn_cvt_pk_f32_fp8((int)d1, false); f[4] = t.x; f[5] = t.y; t = __builtin_amdgcn_cvt_pk_f32_fp8((int)d1, true); f[6] = t.x; f[7] = t.y;
    t = __builtin_amdgcn_cvt_pk_f32_fp8((int)d2, false); f[8] = t.x; f[9] = t.y; t = __builtin_amdgcn_cvt_pk_f32_fp8((int)d2, true); f[10] = t.x; f[11] = t.y;
    t = __builtin_amdgcn_cvt_pk_f32_fp8((int)d3, false); f[12] = t.x; f[13] = t.y; t = __builtin_amdgcn_cvt_pk_f32_fp8((int)d3, true); f[14] = t.x; f[15] = t.y;
}
#ifndef DBG_G
#define DBG_G 0
#endif
DI void peer_gather_token(const GatherP& P, size_t m, int lane) {
    float hv[16];
    { const bf16_t* hrow = P.H + m * D + 16 * lane; const u32x4 a = *(const u32x4*)hrow, b = *(const u32x4*)(hrow + 8);
      hv[0] = bf_lo(a.x); hv[1] = bf_hi(a.x); hv[2] = bf_lo(a.y); hv[3] = bf_hi(a.y); hv[4] = bf_lo(a.z); hv[5] = bf_hi(a.z); hv[6] = bf_lo(a.w); hv[7] = bf_hi(a.w);
      hv[8] = bf_lo(b.x); hv[9] = bf_hi(b.x); hv[10] = bf_lo(b.y); hv[11] = bf_hi(b.y); hv[12] = bf_lo(b.z); hv[13] = bf_hi(b.z); hv[14] = bf_lo(b.w); hv[15] = bf_hi(b.w); }
    float o[16];
#pragma unroll
    for (int e = 0; e < 16; ++e) o[e] = 0.f;
    const u32x2* rt = P.route + m * 128 + (lane & 7);
#pragma unroll 1
    for (int bt = 0; bt < 16; ++bt) {
        const u32x2 re = rt[bt * 8];
        const int idx = (int)re.x; const float gate = __int_as_float((int)re.y);
        u32x4 uu[8], vv[8];
#pragma unroll
        for (int e = 0; e < 8; ++e) {
            const size_t ro = (size_t)__builtin_amdgcn_readlane(idx, e) * D + 16 * lane;
            uu[e] = *(const u32x4*)(P.U + ro); vv[e] = *(const u32x4*)(P.V + ro);
        }
        float p[8];
#pragma unroll
        for (int e = 0; e < 8; ++e) { float uf[16]; fp8x16_to_f32(uu[e], uf); float a0 = 0.f, a1 = 0.f;
#pragma unroll
            for (int k = 0; k < 16; k += 2) { a0 += hv[k] * uf[k]; a1 += hv[k + 1] * uf[k + 1]; }
            p[e] = a0 + a1; }
        float p4[4], p2[2], p1;
        { const bool up = (lane & 4) != 0;
#pragma unroll
          for (int q = 0; q < 4; ++q) { const float keep = up ? p[q + 4] : p[q], send = up ? p[q] : p[q + 4]; p4[q] = keep + shx<4>(send, lane); } }
        { const bool up = (lane & 2) != 0;
#pragma unroll
          for (int q = 0; q < 2; ++q) { const float keep = up ? p4[q + 2] : p4[q], send = up ? p4[q] : p4[q + 2]; p2[q] = keep + shx<2>(send, lane); } }
        { const bool up = (lane & 1) != 0; const float keep = up ? p2[1] : p2[0], send = up ? p2[0] : p2[1]; p1 = keep + shx<1>(send, lane); }
        p1 += shx<8>(p1, lane); p1 += shx<16>(p1, lane); p1 += shx<32>(p1, lane);
        const float act = gelu_exact(p1 * (1.0f / U8_SCALE)) * gate * (1.0f / V8_SCALE);
#pragma unroll
        for (int e = 0; e < 8; ++e) { const float a = __int_as_float(__builtin_amdgcn_readlane(__float_as_int(act), e)); float vf[16]; fp8x16_to_f32(vv[e], vf);
#pragma unroll
            for (int k = 0; k < 16; ++k) o[k] += a * vf[k]; }
    }
    const int bidx = (m >= (size_t)SEQ) ? 1 : 0;
    float* xr = P.X + m * D + 16 * lane; const float* g2 = P.gt2 + bidx * 6 * D + 16 * lane;
    float xn[16]; float ss = 0.f;
#pragma unroll
    for (int q = 0; q < 4; ++q) { const f32x4 xv = *(const f32x4*)(xr + 4 * q), gv = *(const f32x4*)(g2 + 4 * q);
#pragma unroll
        for (int e = 0; e < 4; ++e) { const float v = xv[e] + gv[e] * o[q * 4 + e]; xn[q * 4 + e] = v; ss += v * v; } }
    const float rstd = 1.0f / sqrtf(wave_sum(ss, lane) * (1.0f / D) + EPS);
    if (P.last) {
#pragma unroll
        for (int q = 0; q < 4; ++q) { const f32x4 gv = *(const f32x4*)(P.ng + 16 * lane + 4 * q); f32x4 r;
#pragma unroll
            for (int e = 0; e < 4; ++e) r[e] = xn[q * 4 + e] * rstd * gv[e];
            *(f32x4*)(P.out + m * D + 16 * lane + 4 * q) = r; }
    } else {
        float y[16];
#pragma unroll
        for (int q = 0; q < 4; ++q) { const int col = 16 * lane + 4 * q;
            const f32x4 gv = *(const f32x4*)(P.ng + col), sc = *(const f32x4*)(P.nsc + bidx * 6 * D + col), sh = *(const f32x4*)(P.nsh + bidx * 6 * D + col);
            *(f32x4*)(xr + 4 * q) = (f32x4){xn[q * 4], xn[q * 4 + 1], xn[q * 4 + 2], xn[q * 4 + 3]};
#pragma unroll
            for (int e = 0; e < 4; ++e) y[q * 4 + e] = xn[q * 4 + e] * rstd * gv[e] * (1.0f + sc[e]) + sh[e]; }
        bf16_t* ho = P.Hout + m * D + 16 * lane;
        { u32x4 w; w.x = pk2(y[0], y[1]); w.y = pk2(y[2], y[3]); w.z = pk2(y[4], y[5]); w.w = pk2(y[6], y[7]); *(u32x4*)ho = w; }
        { u32x4 w; w.x = pk2(y[8], y[9]); w.y = pk2(y[10], y[11]); w.z = pk2(y[12], y[13]); w.w = pk2(y[14], y[15]); *(u32x4*)(ho + 8) = w; }
        float pr[8];
#pragma unroll
        for (int c = 0; c < 8; ++c) { float a = 0.f;
#pragma unroll
            for (int q = 0; q < 4; ++q) { const f32x4 wv = *(const LAS f32x4*)(P.wsm + c * D + 16 * lane + 4 * q);
                a += (y[q * 4] * wv.x + y[q * 4 + 1] * wv.y) + (y[q * 4 + 2] * wv.z + y[q * 4 + 3] * wv.w); }
            pr[c] = wave_sum(a, lane); }
        if (lane < 8) { float rr = pr[0];
#pragma unroll
            for (int c = 1; c < 8; ++c) rr = (lane == c) ? pr[c] : rr;
            P.small[m * 8 + lane] = rr; }
    }
}

DI void peer_u_pass(lptr L, int tid, int bx, const bf16_t* H, const u32x2* route, const unsigned char* U8, float* ACT) {
    const int lane = tid & 63, wave = __builtin_amdgcn_readfirstlane(tid >> 6);
    const unsigned x = (unsigned)bx & 7u; const int wx = (bx >> 3) * 8 + wave;
    LAS unsigned* list = (LAS unsigned*)(L + wave * 2048);
    u32x2 e0 = route[(size_t)wx * 128 + lane], e1 = route[(size_t)wx * 128 + 64 + lane];
    u32x4 ha = *(const u32x4*)(H + (size_t)wx * D + 16 * lane), hb = *(const u32x4*)(H + (size_t)wx * D + 16 * lane + 8);
#pragma unroll 1
    for (int t = wx; t < M; t += 256) {
        float hv[16];
        hv[0] = bf_lo(ha.x); hv[1] = bf_hi(ha.x); hv[2] = bf_lo(ha.y); hv[3] = bf_hi(ha.y); hv[4] = bf_lo(ha.z); hv[5] = bf_hi(ha.z); hv[6] = bf_lo(ha.w); hv[7] = bf_hi(ha.w);
        hv[8] = bf_lo(hb.x); hv[9] = bf_hi(hb.x); hv[10] = bf_lo(hb.y); hv[11] = bf_hi(hb.y); hv[12] = bf_lo(hb.z); hv[13] = bf_hi(hb.z); hv[14] = bf_lo(hb.w); hv[15] = bf_hi(hb.w);
        const bool own0 = (e0.x & 7u) == x, own1 = (e1.x & 7u) == x;
        const unsigned long long m0 = __ballot(own0), m1 = __ballot(own1);
        const int n0 = __popcll(m0), n = n0 + __popcll(m1);
        const int p0 = (int)__builtin_amdgcn_mbcnt_hi((unsigned)(m0 >> 32), __builtin_amdgcn_mbcnt_lo((unsigned)m0, 0u));
        const int p1 = n0 + (int)__builtin_amdgcn_mbcnt_hi((unsigned)(m1 >> 32), __builtin_amdgcn_mbcnt_lo((unsigned)m1, 0u));
        if (own0) { list[p0] = e0.x; list[136 + p0] = e0.y; list[272 + p0] = (unsigned)lane; }
        if (own1) { list[p1] = e1.x; list[136 + p1] = e1.y; list[272 + p1] = (unsigned)(lane + 64); }
        if (lane < 8) { list[n + lane] = x; list[136 + n + lane] = 0u; list[272 + n + lane] = 0xffffffffu; }
        const int tn = t + 256;
        if (tn < M) { e0 = route[(size_t)tn * 128 + lane]; e1 = route[(size_t)tn * 128 + 64 + lane];
                      ha = *(const u32x4*)(H + (size_t)tn * D + 16 * lane); hb = *(const u32x4*)(H + (size_t)tn * D + 16 * lane + 8); }
        LDS_WAIT();
#pragma unroll 1
        for (int b0 = 0; b0 < n; b0 += 8) {
            const unsigned idx = list[b0 + (lane & 7)]; const float gate = __uint_as_float(list[136 + b0 + (lane & 7)]); const unsigned kk = list[272 + b0 + (lane & 7)];
            u32x4 uu[8];
#pragma unroll
            for (int e = 0; e < 8; ++e) uu[e] = *(const u32x4*)(U8 + (size_t)__builtin_amdgcn_readlane((int)idx, e) * D + 16 * lane);
            float p[8];
#pragma unroll
            for (int e = 0; e < 8; ++e) { float uf[16]; fp8x16_to_f32(uu[e], uf); float a0 = 0.f, a1 = 0.f;
#pragma unroll
                for (int k = 0; k < 16; k += 2) { a0 += hv[k] * uf[k]; a1 += hv[k + 1] * uf[k + 1]; }
                p[e] = a0 + a1; }
            float p4[4], p2[2], p1;
            { const bool up = (lane & 4) != 0;
#pragma unroll
              for (int q = 0; q < 4; ++q) { const float keep = up ? p[q + 4] : p[q], send = up ? p[q] : p[q + 4]; p4[q] = keep + shx<4>(send, lane); } }
            { const bool up = (lane & 2) != 0;
#pragma unroll
              for (int q = 0; q < 2; ++q) { const float keep = up ? p4[q + 2] : p4[q], send = up ? p4[q] : p4[q + 2]; p2[q] = keep + shx<2>(send, lane); } }
            { const bool up = (lane & 1) != 0; const float keep = up ? p2[1] : p2[0], send = up ? p2[0] : p2[1]; p1 = keep + shx<1>(send, lane); }
            p1 += shx<8>(p1, lane); p1 += shx<16>(p1, lane); p1 += shx<32>(p1, lane);
            const float act = gelu_exact(p1 * (1.0f / U8_SCALE)) * gate * (1.0f / V8_SCALE);
            if (lane < 8 && kk != 0xffffffffu) ACT[(size_t)t * 128 + kk] = act;
        }
        LDS_WAIT();
    }
}
DI void peer_v_pass(int tid, int bx, const u32x2* route, const float* ACT, const unsigned char* V8, float* X, const float* gt2) {
    const int lane = tid & 63, wave = __builtin_amdgcn_readfirstlane(tid >> 6);
    const int x = bx & 7, wx = (bx >> 3) * 8 + wave, es = lane >> 3, ch = lane & 7, col0 = 128 * x + 16 * ch;
    unsigned re[16]; float aa[16];
#pragma unroll
    for (int i = 0; i < 16; ++i) { const unsigned o_ = (unsigned)(wx * 128 + 8 * i + es); re[i] = route[o_].x; aa[i] = ACT[o_]; }
#pragma unroll 1
    for (int t = wx; t < M; t += 256) {
        u32x4 vv[16];
#pragma unroll
        for (int i = 0; i < 16; ++i) vv[i] = *(const u32x4*)(V8 + (re[i] * 1024u + (unsigned)col0));
        float ac[16];
#pragma unroll
        for (int i = 0; i < 16; ++i) ac[i] = aa[i];
        const int tn = t + 256;
        if (tn < M) {
#pragma unroll
            for (int i = 0; i < 16; ++i) { const unsigned o_ = (unsigned)(tn * 128 + 8 * i + es); re[i] = route[o_].x; aa[i] = ACT[o_]; } }
        float o[16];
#pragma unroll
        for (int k = 0; k < 16; ++k) o[k] = 0.f;
#pragma unroll
        for (int i = 0; i < 16; ++i) { float vf[16]; fp8x16_to_f32(vv[i], vf);
#pragma unroll
            for (int k = 0; k < 16; ++k) o[k] += ac[i] * vf[k];
            if ((i & 3) == 3) __builtin_amdgcn_sched_barrier(0); }
#pragma unroll
        for (int k = 0; k < 16; ++k) { o[k] += shx<8>(o[k], lane); o[k] += shx<16>(o[k], lane); o[k] += shx<32>(o[k], lane); }
        if (es == 0) { float* xr = X + (size_t)t * D + col0; const float* g2 = gt2 + (t >= SEQ ? 6 * D : 0) + col0;
#pragma unroll
            for (int q = 0; q < 4; ++q) { const f32x4 xv = *(const f32x4*)(xr + 4 * q), gv = *(const f32x4*)(g2 + 4 * q);
                *(f32x4*)(xr + 4 * q) = (f32x4){xv[0] + gv[0] * o[4 * q], xv[1] + gv[1] * o[4 * q + 1], xv[2] + gv[2] * o[4 * q + 2], xv[3] + gv[3] * o[4 * q + 3]}; } }
    }
}
DI void row_final(const f32x4 (&v)[4], const float* g, float* orow, int lane) {
    float s = 0.f;
#pragma unroll
    for (int j = 0; j < 4; ++j) s += (v[j].x * v[j].x + v[j].y * v[j].y) + (v[j].z * v[j].z + v[j].w * v[j].w);
    const float rstd = 1.0f / sqrtf(wave_sum(s, lane) * (1.0f / D) + EPS);
#pragma unroll
    for (int j = 0; j < 4; ++j) ((f32x4*)orow)[lane + 64 * j] = v[j] * rstd * ((const f32x4*)g)[lane + 64 * j];
}

constexpr float U6_SCALE = 54.0f, V6_SCALE = 4.75f;
constexpr int ROW6 = 768;
typedef unsigned v6u_t __attribute__((ext_vector_type(6)));
typedef float v32f_t __attribute__((ext_vector_type(32)));
DI unsigned enc_e2m3(float x) {
    const float a = fminf(fabsf(x), 7.5f);
    const float inv = a < 2.0f ? 8.0f : (a < 4.0f ? 4.0f : 2.0f);
    const unsigned add = a < 2.0f ? 0u : (a < 4.0f ? 8u : 16u);
    const unsigned c = (unsigned)__builtin_rintf(a * inv) + add;
    return (c > 31u ? 31u : c) | ((__float_as_uint(x) >> 26) & 32u);
}
DI void cvt_stream_fp6(const float* src, unsigned char* dst, float scale, int gw, int ngw, int lane) {
    constexpr int NGRP = NEXP * 32;
    for (int g = gw * 64 + lane; g < NGRP; g += ngw * 64) {
        const int row = g >> 5, lp = g & 31;
        const f32x4* p = (const f32x4*)(src + (size_t)g * 32);
        f32x4 v[8];
#pragma unroll
        for (int q = 0; q < 8; ++q) v[q] = __builtin_nontemporal_load(p + q);
        unsigned cd[32];
#pragma unroll
        for (int q = 0; q < 8; ++q)
#pragma unroll
            for (int e = 0; e < 4; ++e) cd[4 * q + e] = enc_e2m3(v[q][e] * scale);
        unsigned w[6];
#pragma unroll
        for (int d = 0; d < 6; ++d) { unsigned acc = 0u;
#pragma unroll
            for (int i = 0; i < 32; ++i) { const int lo = 6 * i - 32 * d;
                if (lo > -6 && lo < 32) acc |= (lo >= 0) ? (cd[i] << lo) : (cd[i] >> (-lo)); }
            w[d] = acc; }
        unsigned char* rp = dst + (size_t)row * ROW6;
        *(u32x4*)(rp + 16 * lp) = (u32x4){w[0], w[1], w[2], w[3]};
        *(u32x2*)(rp + 512 + 8 * lp) = (u32x2){w[4], w[5]};
    }
}
#ifndef PROBE_DUP
#define PROBE_DUP 0
#endif
#ifndef GATHER_DPP
#define GATHER_DPP 1
#endif
#ifndef GATHER_DEPTH
#define GATHER_DEPTH 2
#endif
#ifndef GATHER_INPLACE
#define GATHER_INPLACE 0
#endif
#ifndef GATHER_BP
#define GATHER_BP 12
#endif
#ifndef GATHER_PIPE
#define GATHER_PIPE 2
#endif
#ifndef TAB_UI4
#define TAB_UI4 1
#endif
#ifndef TAB_U4
#define TAB_U4 1
#endif
#ifndef TAB_V4
#define TAB_V4 1
#endif
constexpr float U4_SCALE = 67.0f, V4_SCALE = 5.94f;
constexpr int ROW4 = 512;
constexpr float UI_SCALE = 96.0f;
constexpr float UT_SCALE = TAB_UI4 ? UI_SCALE : TAB_U4 ? U4_SCALE : U6_SCALE, VT_SCALE = TAB_V4 ? V4_SCALE : V6_SCALE;
constexpr int ROWU = TAB_U4 ? ROW4 : ROW6, ROWV = TAB_V4 ? ROW4 : ROW6;
typedef float v2f_t __attribute__((ext_vector_type(2)));
DI unsigned enc_e2m1(float x) {
    const float a = fminf(fabsf(x), 6.0f);
    const float inv = a < 2.0f ? 2.0f : (a < 4.0f ? 1.0f : 0.5f);
    const unsigned add = a < 2.0f ? 0u : (a < 4.0f ? 2u : 4u);
    const unsigned c = (unsigned)__builtin_rintf(a * inv) + add;
    return (c > 7u ? 7u : c) | ((__float_as_uint(x) >> 28) & 8u);
}
DI void cvt_stream_fp4(const float* src, unsigned char* dst, float scale, int gw, int ngw, int lane) {
    constexpr int NGRP = NEXP * 32;
    for (int g = gw * 64 + lane; g < NGRP; g += ngw * 64) {
        const int row = g >> 5, lp = g & 31;
        const f32x4* p = (const f32x4*)(src + (size_t)g * 32);
        f32x4 v[8];
#pragma unroll
        for (int q = 0; q < 8; ++q) v[q] = __builtin_nontemporal_load(p + q);
        unsigned w[4];
#pragma unroll
        for (int d = 0; d < 4; ++d) { unsigned acc = 0u;
#pragma unroll
            for (int i = 0; i < 8; ++i) acc |= enc_e2m1(v[2 * d + (i >> 2)][i & 3] * scale) << (4 * i);
            w[d] = acc; }
        *(u32x4*)(dst + (size_t)row * ROW4 + 16 * lp) = (u32x4){w[0], w[1], w[2], w[3]};
    }
}
DI unsigned enc_u4(float x) { const float t = __builtin_floorf(x + 8.0f); return (unsigned)fminf(fmaxf(t, 0.f), 15.f); }
DI void cvt_stream_u4(const float* src, unsigned char* dst, float scale, int gw, int ngw, int lane) {
    constexpr int NGRP = NEXP * 32;
    for (int g = gw * 64 + lane; g < NGRP; g += ngw * 64) {
        const int row = g >> 5, lp = g & 31;
        const f32x4* p = (const f32x4*)(src + (size_t)g * 32);
        f32x4 v[8];
#pragma unroll
        for (int q = 0; q < 8; ++q) v[q] = __builtin_nontemporal_load(p + q);
        unsigned w[4];
#pragma unroll
        for (int d = 0; d < 4; ++d) { unsigned acc = 0u;
#pragma unroll
            for (int e = 0; e < 8; ++e) acc |= enc_u4(v[2 * d + (e >> 2)][e & 3] * scale) << (e < 4 ? 8 * e : 8 * (e - 4) + 4);
            w[d] = acc; }
        *(u32x4*)(dst + (size_t)row * ROW4 + 16 * lp) = (u32x4){w[0], w[1], w[2], w[3]};
    }
}
DI int udot_i4(const u32x4 a, const u32x4 (&h8)[2]) {
    int a0 = 0, a1 = 0;
#pragma unroll
    for (int q = 0; q < 4; ++q) {
        const unsigned lo = a[q] & 0x0f0f0f0fu, hi = (a[q] >> 4) & 0x0f0f0f0fu;
        a0 = __builtin_amdgcn_sdot4((int)h8[q >> 1][2 * (q & 1)], (int)lo, a0, false);
        a1 = __builtin_amdgcn_sdot4((int)h8[q >> 1][2 * (q & 1) + 1], (int)hi, a1, false);
    }
    return a0 + a1;
}
DI void dec_fp4x32(const u32x4 a, float (&f)[32]) {
#pragma unroll
    for (int q = 0; q < 4; ++q) {
        const v2f_t t0 = __builtin_amdgcn_cvt_scalef32_pk_f32_fp4(a[q], 1.0f, 0), t1 = __builtin_amdgcn_cvt_scalef32_pk_f32_fp4(a[q], 1.0f, 1),
                    t2 = __builtin_amdgcn_cvt_scalef32_pk_f32_fp4(a[q], 1.0f, 2), t3 = __builtin_amdgcn_cvt_scalef32_pk_f32_fp4(a[q], 1.0f, 3);
        f[8 * q] = t0[0]; f[8 * q + 1] = t0[1]; f[8 * q + 2] = t1[0]; f[8 * q + 3] = t1[1]; f[8 * q + 4] = t2[0]; f[8 * q + 5] = t2[1]; f[8 * q + 6] = t3[0]; f[8 * q + 7] = t3[1];
    }
}
DI void cvt_stream_tab(const float* src, unsigned char* dst, int kind, float scale, int gw, int ngw, int lane) {
    if (kind == 2) cvt_stream_u4(src, dst, scale, gw, ngw, lane); else if (kind == 1) cvt_stream_fp4(src, dst, scale, gw, ngw, lane); else cvt_stream_fp6(src, dst, scale, gw, ngw, lane);
}
template <int CTRL> DI float dppf(float v) { return __int_as_float(__builtin_amdgcn_update_dpp(0, __float_as_int(v), CTRL, 0xf, 0xf, false)); }
DI unsigned pick_swz(int v, int j) {
    switch (j) { case 0: return (unsigned)__builtin_amdgcn_ds_swizzle(v, 0 << 5); case 1: return (unsigned)__builtin_amdgcn_ds_swizzle(v, 1 << 5);
                 case 2: return (unsigned)__builtin_amdgcn_ds_swizzle(v, 2 << 5); default: return (unsigned)__builtin_amdgcn_ds_swizzle(v, 3 << 5); }
}
DI unsigned pick_half(int v, int j, int half) { const int a0 = __builtin_amdgcn_readlane(v, j), a1 = __builtin_amdgcn_readlane(v, 32 + j); return (unsigned)(half ? a1 : a0); }
typedef __bf16 bf2v_t __attribute__((ext_vector_type(2)));
DI float udot_fp4(const u32x4 a, const u32x4 (&hq)[4]) {
    float a0 = 0.f, a1 = 0.f;
#pragma unroll
    for (int qq = 0; qq < 2; ++qq) {
        bf2v_t t[8];
#pragma unroll
        for (int q = 0; q < 2; ++q) {
            t[4 * q + 0] = __builtin_amdgcn_cvt_scalef32_pk_bf16_fp4(a[2 * qq + q], 1.0f, 0); t[4 * q + 1] = __builtin_amdgcn_cvt_scalef32_pk_bf16_fp4(a[2 * qq + q], 1.0f, 1);
            t[4 * q + 2] = __builtin_amdgcn_cvt_scalef32_pk_bf16_fp4(a[2 * qq + q], 1.0f, 2); t[4 * q + 3] = __builtin_amdgcn_cvt_scalef32_pk_bf16_fp4(a[2 * qq + q], 1.0f, 3); }
        asm volatile("" : "+v"(t[0]), "+v"(t[1]), "+v"(t[2]), "+v"(t[3]), "+v"(t[4]), "+v"(t[5]), "+v"(t[6]), "+v"(t[7]));
#pragma unroll
        for (int q = 0; q < 2; ++q) {
            a0 = __builtin_amdgcn_fdot2_f32_bf16(__builtin_bit_cast(bf2v_t, (unsigned)hq[2 * qq + q][0]), t[4 * q + 0], a0, false);
            a1 = __builtin_amdgcn_fdot2_f32_bf16(__builtin_bit_cast(bf2v_t, (unsigned)hq[2 * qq + q][1]), t[4 * q + 1], a1, false);
            a0 = __builtin_amdgcn_fdot2_f32_bf16(__builtin_bit_cast(bf2v_t, (unsigned)hq[2 * qq + q][2]), t[4 * q + 2], a0, false);
            a1 = __builtin_amdgcn_fdot2_f32_bf16(__builtin_bit_cast(bf2v_t, (unsigned)hq[2 * qq + q][3]), t[4 * q + 3], a1, false); }
    }
    return a0 + a1;
}
typedef __bf16 bf32v_t __attribute__((ext_vector_type(32)));
DI float udot_fp6(const u32x4 a, const u32x2 b, const u32x4 (&hq)[4]) {
    const v6u_t w = {a.x, a.y, a.z, a.w, b.x, b.y}; const bf32v_t uf = __builtin_amdgcn_cvt_scalef32_pk32_bf16_fp6(w, 1.0f);
    float a0 = 0.f, a1 = 0.f;
#pragma unroll
    for (int q = 0; q < 4; ++q) {
        a0 = __builtin_amdgcn_fdot2_f32_bf16(__builtin_bit_cast(bf2v_t, (unsigned)hq[q][0]), (bf2v_t){uf[8 * q], uf[8 * q + 1]}, a0, false);
        a1 = __builtin_amdgcn_fdot2_f32_bf16(__builtin_bit_cast(bf2v_t, (unsigned)hq[q][1]), (bf2v_t){uf[8 * q + 2], uf[8 * q + 3]}, a1, false);
        a0 = __builtin_amdgcn_fdot2_f32_bf16(__builtin_bit_cast(bf2v_t, (unsigned)hq[q][2]), (bf2v_t){uf[8 * q + 4], uf[8 * q + 5]}, a0, false);
        a1 = __builtin_amdgcn_fdot2_f32_bf16(__builtin_bit_cast(bf2v_t, (unsigned)hq[q][3]), (bf2v_t){uf[8 * q + 6], uf[8 * q + 7]}, a1, false);
    }
    return a0 + a1;
}
DI void peer_gather_token6(const GatherP& P, size_t m, int lane) {
    const int lp = lane & 31, half = lane >> 5;
    u32x4 hq[4];
    { const u32x4* hr = (const u32x4*)(P.H + m * D + 32 * lp);
#pragma unroll
      for (int q = 0; q < 4; ++q) hq[q] = hr[q]; }
    float o[32];
#pragma unroll
    for (int e = 0; e < 32; ++e) o[e] = 0.f;
    float zero_ = 0.f; asm volatile("" : "+v"(zero_));
    const unsigned lp16 = 16u * (unsigned)lp, lp8 = 8u * (unsigned)lp;
    const int bpbase = half << 7;
    const int eself = 2 * (lane & 3) + half;
    const u32x2* rt = P.route + m * 128 + eself;
#if TAB_U4
#define G_UDOT(ua1, ub1) udot_fp4(ua1, hq)
#else
#define G_UDOT(ua1, ub1) udot_fp6(ua1, ub1, hq)
#endif
#define G_PICKB(v_, j_) ((unsigned)__builtin_amdgcn_ds_bpermute(bpbase + 4 * (j_), (int)(v_)))
#define G_PICKR(v_, j_) pick_half((int)(v_), (j_), half)
#define G_PICKS(v_, j_) pick_swz((int)(v_), (j_))
#define G_PICKA(v_, j_) ((GATHER_BP & 4) ? G_PICKS(v_, j_) : (GATHER_BP & 1) ? G_PICKB(v_, j_) : G_PICKR(v_, j_))
#define G_PICKI(v_, j_) ((GATHER_BP & 8) ? G_PICKS(v_, j_) : (GATHER_BP & 2) ? G_PICKB(v_, j_) : G_PICKR(v_, j_))
#if GATHER_DPP
#define GX1(v_) dppf<0xB1>(v_)
#define GX2(v_) dppf<0x4E>(v_)
#define GR4(v_) dppf<0x124>(v_)
#define GR8(v_) dppf<0x128>(v_)
#else
#define GX1(v_) shx<1>(v_, lane)
#define GX2(v_) shx<2>(v_, lane)
#define GR4(v_) shx<4>(v_, lane)
#define GR8(v_) shx<8>(v_, lane)
#endif
#define G_LOAD(ua_, ub_, va_, vb_, re_) do { const int idx_ = (int)(re_).x; _Pragma("unroll") for (int j = 0; j < 4; ++j) { \
            const unsigned ie = G_PICKI(idx_, j);      \
            const unsigned uo = ie * (unsigned)ROWU + lp16, vo = ie * (unsigned)ROWV + lp16;     \
            ua_[j] = *(const u32x4*)(P.U + uo); if (!TAB_U4) ub_[j] = *(const u32x2*)(P.U + (ie * (unsigned)ROWU + 512u + lp8)); \
            va_[j] = *(const u32x4*)(P.V + vo); if (!TAB_V4) vb_[j] = *(const u32x2*)(P.V + (ie * (unsigned)ROWV + 512u + lp8)); } } while (0)
#define G_COMP(ua_, ub_, va_, vb_, re_) do { const float gate = __int_as_float((int)(re_).y); \
        float p[4]; \
        _Pragma("unroll") for (int j = 0; j < 4; ++j) { p[j] = G_UDOT(ua_[j], ub_[j]); if (PROBE_DUP) { u32x4 t_ = ua_[j]; asm volatile("" : "+v"(t_)); p[j] += zero_ * G_UDOT(t_, ub_[j]); } } \
          \
        float p2[2], p1; \
        { const bool up = (lane & 2) != 0; \
          _Pragma("unroll") for (int q = 0; q < 2; ++q) { const float keep = up ? p[q + 2] : p[q], send = up ? p[q] : p[q + 2]; p2[q] = keep + GX2(send); } } \
        { const bool up = (lane & 1) != 0; const float keep = up ? p2[1] : p2[0], send = up ? p2[0] : p2[1]; p1 = keep + GX1(send); } \
        p1 += GR4(p1); p1 += GR8(p1); p1 += shx<16>(p1, lane); \
        const float act = gelu_exact(p1 * (1.0f / UT_SCALE)) * gate * (1.0f / VT_SCALE); \
        _Pragma("unroll") for (int j = 0; j < 4; ++j) { \
            const float a = __int_as_float((int)G_PICKA(__float_as_int(act), j)); \
            float vf[32]; \
            if (TAB_V4) dec_fp4x32(va_[j], vf); \
            else { const v6u_t w = {va_[j].x, va_[j].y, va_[j].z, va_[j].w, vb_[j].x, vb_[j].y}; const v32f_t t = __builtin_amdgcn_cvt_scalef32_pk32_f32_fp6(w, 1.0f); \
                _Pragma("unroll") for (int k = 0; k < 32; ++k) vf[k] = t[k]; } \
            _Pragma("unroll") for (int k = 0; k < 32; ++k) o[k] += a * vf[k]; } } while (0)
#if GATHER_PIPE
    u32x4 uaA[4], vaA[4], uaB[4], vaB[4]; u32x2 ubA[4], vbA[4], ubB[4], vbB[4];
    u32x2 re0 = rt[0], re1 = rt[8];
    G_LOAD(uaA, ubA, vaA, vbA, re0);
#pragma unroll 1
    for (int bt = 0; bt < 16; bt += 2) {
        u32x2 re2 = re0, re3 = re1;
        if (bt < 14) { re2 = rt[(bt + 2) * 8]; re3 = rt[(bt + 3) * 8]; }
        G_LOAD(uaB, ubB, vaB, vbB, re1);
        __builtin_amdgcn_sched_barrier(0);
        G_COMP(uaA, ubA, vaA, vbA, re0);
        if (bt < 14) G_LOAD(uaA, ubA, vaA, vbA, re2);
        __builtin_amdgcn_sched_barrier(0);
        G_COMP(uaB, ubB, vaB, vbB, re1);
        re0 = re2; re1 = re3;
    }
#else
    u32x2 re_next = rt[0];
#pragma unroll 1
    for (int bt = 0; bt < 16; ++bt) {
        const u32x2 re = re_next;
        if (bt < 15) re_next = rt[(bt + 1) * 8];
        u32x4 ua[4], va[4]; u32x2 ub[4], vb[4];
        G_LOAD(ua, ub, va, vb, re);
        G_COMP(ua, ub, va, vb, re);
    }
#endif
#undef G_LOAD
#undef G_COMP
#undef G_UDOT
#undef G_PICKA
#undef G_PICKI
#undef G_PICKB
#undef GX1
#undef GX2
#undef GR4
#undef GR8
#undef G_PICKS
#undef G_PICKR
    float oc[16];
#pragma unroll
    for (int k = 0; k < 16; ++k) { const float lo_ = o[k] + shx<32>(o[k], lane), hi_ = o[16 + k] + shx<32>(o[16 + k], lane); oc[k] = half ? hi_ : lo_; }
    const int bidx = (m >= (size_t)SEQ) ? 1 : 0; const int cbase = 32 * lp + 16 * half;
    float* xr = P.X + m * D + cbase; const float* g2 = P.gt2 + bidx * 6 * D + cbase;
    float xn[16]; float ss = 0.f;
#pragma unroll
    for (int q = 0; q < 4; ++q) { const f32x4 xv = *(const f32x4*)(xr + 4 * q), gv = *(const f32x4*)(g2 + 4 * q);
#pragma unroll
        for (int e = 0; e < 4; ++e) { const float v = xv[e] + gv[e] * oc[q * 4 + e]; xn[q * 4 + e] = v; ss += v * v; } }
    const float rstd = 1.0f / sqrtf(wave_sum(ss, lane) * (1.0f / D) + EPS);
    if (P.last) {
#pragma unroll
        for (int q = 0; q < 4; ++q) { const f32x4 gv = *(const f32x4*)(P.ng + cbase + 4 * q); f32x4 r;
#pragma unroll
            for (int e = 0; e < 4; ++e) r[e] = xn[q * 4 + e] * rstd * gv[e];
            *(f32x4*)(P.out + m * D + cbase + 4 * q) = r; }
    } else {
        float y[16];
#pragma unroll
        for (int q = 0; q < 4; ++q) { const int col = cbase + 4 * q;
            const f32x4 gv = *(const f32x4*)(P.ng + col), sc = *(const f32x4*)(P.nsc + bidx * 6 * D + col), sh = *(const f32x4*)(P.nsh + bidx * 6 * D + col);
            *(f32x4*)(xr + 4 * q) = (f32x4){xn[q * 4], xn[q * 4 + 1], xn[q * 4 + 2], xn[q * 4 + 3]};
#pragma unroll
            for (int e = 0; e < 4; ++e) y[q * 4 + e] = xn[q * 4 + e] * rstd * gv[e] * (1.0f + sc[e]) + sh[e]; }
        bf16_t* ho = P.Hout + m * D + cbase;
        { u32x4 w; w.x = pk2(y[0], y[1]); w.y = pk2(y[2], y[3]); w.z = pk2(y[4], y[5]); w.w = pk2(y[6], y[7]); *(u32x4*)ho = w; }
        { u32x4 w; w.x = pk2(y[8], y[9]); w.y = pk2(y[10], y[11]); w.z = pk2(y[12], y[13]); w.w = pk2(y[14], y[15]); *(u32x4*)(ho + 8) = w; }
        float pr[8];
#pragma unroll
        for (int c = 0; c < 8; ++c) { float a = 0.f;
#pragma unroll
            for (int q = 0; q < 4; ++q) { const f32x4 wv = *(const LAS f32x4*)(P.wsm + c * D + cbase + 4 * q);
                a += (y[q * 4] * wv.x + y[q * 4 + 1] * wv.y) + (y[q * 4 + 2] * wv.z + y[q * 4 + 3] * wv.w); }
            pr[c] = wave_sum(a, lane);
            if (c & 1) __builtin_amdgcn_sched_barrier(0); }
        if (lane < 8) { float rr = pr[0];
#pragma unroll
            for (int c = 1; c < 8; ++c) rr = (lane == c) ? pr[c] : rr;
            P.small[m * 8 + lane] = rr; }
    }
}

constexpr int GC_OFF = 32768;
DI void stage_gather_consts(const GatherP& P, lptr L, int tid) {
    LAS float* gc = (LAS float*)(L + GC_OFF);
    for (int i = tid; i < 2 * D; i += NTHR) { const int b = i >> 10, c = i & (D - 1);
        gc[i] = P.gt2[b * 6 * D + c];
        gc[2 * D + i] = P.last ? P.ng[c] : P.ng[c] * (1.0f + P.nsc[b * 6 * D + c]);
        gc[4 * D + i] = P.last ? 0.f : P.nsh[b * 6 * D + c]; }
    __syncthreads();
}
DI void gather_finish(const GatherP& P, lptr L, size_t m, int lane, float (&o)[32], const f32x4 (&xv4)[4]) {
    const int lp = lane & 31, half = lane >> 5;
    float oc[16];
#pragma unroll
    for (int k = 0; k < 16; ++k) { const float lo_ = o[k] + shx<32>(o[k], lane), hi_ = o[16 + k] + shx<32>(o[16 + k], lane); oc[k] = half ? hi_ : lo_; }
    const int bidx = (m >= (size_t)SEQ) ? 1 : 0; const int cbase = 32 * lp + 16 * half;
    const LAS float* gc = (const LAS float*)(L + GC_OFF) + bidx * D + cbase;
    float* xr = P.X + m * D + cbase;
    float xn[16]; float ss = 0.f;
#pragma unroll
    for (int q = 0; q < 4; ++q) { const f32x4 gv = *(const LAS f32x4*)(gc + 4 * q);
#pragma unroll
        for (int e = 0; e < 4; ++e) { const float v = xv4[q][e] + gv[e] * oc[q * 4 + e]; xn[q * 4 + e] = v; ss += v * v; } }
    const float rstd = 1.0f / sqrtf(wave_sum(ss, lane) * (1.0f / D) + EPS);
    if (P.last) {
#pragma unroll
        for (int q = 0; q < 4; ++q) { const f32x4 gv = *(const LAS f32x4*)(gc + 2 * D + 4 * q); f32x4 r;
#pragma unroll
            for (int e = 0; e < 4; ++e) r[e] = xn[q * 4 + e] * rstd * gv[e];
            *(f32x4*)(P.out + m * D + cbase + 4 * q) = r; }
    } else {
        float y[16];
#pragma unroll
        for (int q = 0; q < 4; ++q) {
            const f32x4 ga = *(const LAS f32x4*)(gc + 2 * D + 4 * q), sh = *(const LAS f32x4*)(gc + 4 * D + 4 * q);
            *(f32x4*)(xr + 4 * q) = (f32x4){xn[q * 4], xn[q * 4 + 1], xn[q * 4 + 2], xn[q * 4 + 3]};
#pragma unroll
            for (int e = 0; e < 4; ++e) y[q * 4 + e] = xn[q * 4 + e] * rstd * ga[e] + sh[e]; }
        bf16_t* ho = P.Hout + m * D + cbase;
        { u32x4 w; w.x = pk2(y[0], y[1]); w.y = pk2(y[2], y[3]); w.z = pk2(y[4], y[5]); w.w = pk2(y[6], y[7]); *(u32x4*)ho = w; }
        { u32x4 w; w.x = pk2(y[8], y[9]); w.y = pk2(y[10], y[11]); w.z = pk2(y[12], y[13]); w.w = pk2(y[14], y[15]); *(u32x4*)(ho + 8) = w; }
        float pr[8];
#pragma unroll
        for (int c = 0; c < 8; ++c) { float a = 0.f;
#pragma unroll
            for (int q = 0; q < 4; ++q) { const f32x4 wv = *(const LAS f32x4*)(P.wsm + c * D + cbase + 4 * q);
                a += (y[q * 4] * wv.x + y[q * 4 + 1] * wv.y) + (y[q * 4 + 2] * wv.z + y[q * 4 + 3] * wv.w); }
            pr[c] = wave_sum(a, lane);
            if (c & 1) __builtin_amdgcn_sched_barrier(0); }
        if (lane < 8) { float rr = pr[0];
#pragma unroll
            for (int c = 1; c < 8; ++c) rr = (lane == c) ? pr[c] : rr;
            P.small[m * 8 + lane] = rr; }
    }
}
#ifdef GATHER_NT
#define GNT(p_) __builtin_nontemporal_load(p_)
#else
#define GNT(p_) (*(p_))
#endif
DI void peer_gather_wave(const GatherP& P, lptr L, int gw, int ngw, int lane) {
    const int lp = lane & 31, half = lane >> 5;
    float zero_ = 0.f; asm volatile("" : "+v"(zero_));
    const unsigned lp16 = 16u * (unsigned)lp, lp8 = 8u * (unsigned)lp;
    const int bpbase = half << 7;
    const int eself = 2 * (lane & 3) + half;
    size_t m = (size_t)gw;
#if TAB_UI4
    u32x4 hq[2]; float uinv, hcorr;
#define G_HLOAD(hq_, uinv_, hcorr_, m_) do { const u32x4* hr_ = (const u32x4*)(P.H8 + (m_) * D + 32 * lp); hq_[0] = hr_[0]; hq_[1] = hr_[1]; uinv_ = P.HS[(m_)] * (1.0f / UI_SCALE); } while (0)
#define G_HCORR(hq_, hcorr_) do { int s_ = 0; _Pragma("unroll") for (int q_ = 0; q_ < 8; ++q_) s_ = __builtin_amdgcn_sdot4((int)hq_[q_ >> 2][q_ & 3], 0x01010101, s_, false); hcorr_ = 7.5f * (float)s_; } while (0)
#define G_UDOT(ua1, ub1) ((float)udot_i4(ua1, hq) - hcorr)
    constexpr int NHQ = 2;
    G_HLOAD(hq, uinv, hcorr, m); G_HCORR(hq, hcorr);
#else
    u32x4 hq[4]; const float uinv = 1.0f / UT_SCALE;
    { const u32x4* hr = (const u32x4*)(P.H + m * D + 32 * lp);
#pragma unroll
      for (int q = 0; q < 4; ++q) hq[q] = GNT(hr + q); }
    constexpr int NHQ = 4;
#if TAB_U4
#define G_UDOT(ua1, ub1) udot_fp4(ua1, hq)
#else
#define G_UDOT(ua1, ub1) udot_fp6(ua1, ub1, hq)
#endif
#endif
    const u32x2* rt = P.route + m * 128 + eself;
#define G_PICKB(v_, j_) ((unsigned)__builtin_amdgcn_ds_bpermute(bpbase + 4 * (j_), (int)(v_)))
#define G_PICKR(v_, j_) pick_half((int)(v_), (j_), half)
#define G_PICKS(v_, j_) pick_swz((int)(v_), (j_))
#define G_PICKA(v_, j_) ((GATHER_BP & 4) ? G_PICKS(v_, j_) : (GATHER_BP & 1) ? G_PICKB(v_, j_) : G_PICKR(v_, j_))
#define G_PICKI(v_, j_) ((GATHER_BP & 8) ? G_PICKS(v_, j_) : (GATHER_BP & 2) ? G_PICKB(v_, j_) : G_PICKR(v_, j_))
#if GATHER_DPP
#define GX1(v_) dppf<0xB1>(v_)
#define GX2(v_) dppf<0x4E>(v_)
#define GR4(v_) dppf<0x124>(v_)
#define GR8(v_) dppf<0x128>(v_)
#else
#define GX1(v_) shx<1>(v_, lane)
#define GX2(v_) shx<2>(v_, lane)
#define GR4(v_) shx<4>(v_, lane)
#define GR8(v_) shx<8>(v_, lane)
#endif
#define G_LOAD(ua_, ub_, va_, vb_, re_) do { const int idx_ = (int)(re_).x; _Pragma("unroll") for (int j = 0; j < 4; ++j) { \
            const unsigned ie = G_PICKI(idx_, j);      \
            const unsigned uo = ie * (unsigned)ROWU + lp16, vo = ie * (unsigned)ROWV + lp16;     \
            ua_[j] = *(const u32x4*)(P.U + uo); if (!TAB_U4) ub_[j] = *(const u32x2*)(P.U + (ie * (unsigned)ROWU + 512u + lp8)); \
            va_[j] = *(const u32x4*)(P.V + vo); if (!TAB_V4) vb_[j] = *(const u32x2*)(P.V + (ie * (unsigned)ROWV + 512u + lp8)); } } while (0)
#define G_COMP(ua_, ub_, va_, vb_, re_) do { const float gate = __int_as_float((int)(re_).y); \
        float p[4]; \
        _Pragma("unroll") for (int j = 0; j < 4; ++j) { p[j] = G_UDOT(ua_[j], ub_[j]); if (PROBE_DUP) { u32x4 t_ = ua_[j]; asm volatile("" : "+v"(t_)); p[j] += zero_ * G_UDOT(t_, ub_[j]); } } \
          \
        float p2[2], p1; \
        { const bool up = (lane & 2) != 0; \
          _Pragma("unroll") for (int q = 0; q < 2; ++q) { const float keep = up ? p[q + 2] : p[q], send = up ? p[q] : p[q + 2]; p2[q] = keep + GX2(send); } } \
        { const bool up = (lane & 1) != 0; const float keep = up ? p2[1] : p2[0], send = up ? p2[0] : p2[1]; p1 = keep + GX1(send); } \
        p1 += GR4(p1); p1 += GR8(p1); p1 += shx<16>(p1, lane); \
        const float act = gelu_exact(p1 * uinv) * gate * (1.0f / VT_SCALE); \
        _Pragma("unroll") for (int j = 0; j < 4; ++j) { \
            const float a = __int_as_float((int)G_PICKA(__float_as_int(act), j)); \
            if (TAB_V4 && !GATHER_INPLACE) { float vf[32]; dec_fp4x32(va_[j], vf); \
                _Pragma("unroll") for (int k = 0; k < 16; ++k) { o2[k][0] += a * vf[2 * k]; o2[k][1] += a * vf[2 * k + 1]; } } \
            else if (TAB_V4) { const v2f_t aa = {a, a}; \
                  \
                _Pragma("unroll") for (int q = 0; q < 4; ++q) { \
                    const v2f_t t0 = __builtin_amdgcn_cvt_scalef32_pk_f32_fp4(va_[j][q], 1.0f, 0), t1 = __builtin_amdgcn_cvt_scalef32_pk_f32_fp4(va_[j][q], 1.0f, 1), \
                                t2 = __builtin_amdgcn_cvt_scalef32_pk_f32_fp4(va_[j][q], 1.0f, 2), t3 = __builtin_amdgcn_cvt_scalef32_pk_f32_fp4(va_[j][q], 1.0f, 3); \
                    asm("v_pk_fma_f32 %0, %1, %2, %0" : "+v"(o2[4 * q + 0]) : "v"(t0), "v"(aa)); asm("v_pk_fma_f32 %0, %1, %2, %0" : "+v"(o2[4 * q + 1]) : "v"(t1), "v"(aa)); \
                    asm("v_pk_fma_f32 %0, %1, %2, %0" : "+v"(o2[4 * q + 2]) : "v"(t2), "v"(aa)); asm("v_pk_fma_f32 %0, %1, %2, %0" : "+v"(o2[4 * q + 3]) : "v"(t3), "v"(aa)); } } \
            else { float vf[32]; const v6u_t w = {va_[j].x, va_[j].y, va_[j].z, va_[j].w, vb_[j].x, vb_[j].y}; const v32f_t t = __builtin_amdgcn_cvt_scalef32_pk32_f32_fp6(w, 1.0f); \
                _Pragma("unroll") for (int k = 0; k < 32; ++k) vf[k] = t[k]; \
                _Pragma("unroll") for (int k = 0; k < 16; ++k) { o2[k][0] += a * vf[2 * k]; o2[k][1] += a * vf[2 * k + 1]; } } } } while (0)
#if GATHER_DEPTH == 3
    u32x4 uaA[4], vaA[4], uaB[4], vaB[4], uaC[4], vaC[4]; u32x2 ubA[4], vbA[4], ubB[4], vbB[4], ubC[4], vbC[4];
    u32x2 reA = GNT(rt), reB = GNT(rt + 8), reC = GNT(rt + 16), rp;
    G_LOAD(uaA, ubA, vaA, vbA, reA); G_LOAD(uaB, ubB, vaB, vbB, reB);
#pragma unroll 1
    for (;;) {
        const size_t mn = m + (size_t)ngw; const bool more = mn < (size_t)M;
        const u32x2* rtn = P.route + (more ? mn : m) * 128 + eself;
        v2f_t o2[16];
#pragma unroll
        for (int e = 0; e < 16; ++e) o2[e] = (v2f_t){0.f, 0.f};
        f32x4 xv4[4]; u32x4 hqn[NHQ]; float uinvn = 0.f;
#define G_STEP(XL, XC, REL, REC, rpsrc) do { G_LOAD(ua##XL, ub##XL, va##XL, vb##XL, REL); rp = GNT(rpsrc); __builtin_amdgcn_sched_barrier(0); \
            G_COMP(ua##XC, ub##XC, va##XC, vb##XC, REC); REC = rp; __builtin_amdgcn_sched_barrier(0); } while (0)
#pragma unroll 1
        for (int k = 0; k < 12; k += 3) {
            G_STEP(C, A, reC, reA, rt + (k + 3) * 8);
            G_STEP(A, B, reA, reB, rt + (k + 4) * 8);
            G_STEP(B, C, reB, reC, rt + (k + 5) * 8);
        }
        G_STEP(C, A, reC, reA, rt + 15 * 8);
        G_STEP(A, B, reA, reB, rtn);
        if (more) { G_STEP(B, C, reB, reC, rtn + 8); } else { rp = reC; G_COMP(uaC, ubC, vaC, vbC, reC); }
        if (more) { G_STEP(C, A, reC, reA, rtn + 16); } else { G_COMP(uaA, ubA, vaA, vbA, reA); }
#undef G_STEP
        { const float* xr = P.X + m * D + 32 * lp + 16 * half;
#pragma unroll
          for (int q = 0; q < 4; ++q) xv4[q] = GNT((const f32x4*)(xr + 4 * q)); }
#if TAB_UI4
        if (more) { float hc_; G_HLOAD(hqn, uinvn, hc_, mn); }
#else
        if (more) { const u32x4* hr = (const u32x4*)(P.H + mn * D + 32 * lp);
#pragma unroll
            for (int q = 0; q < 4; ++q) hqn[q] = GNT(hr + q); }
#endif
        __builtin_amdgcn_sched_barrier(0);
        float o[32];
#pragma unroll
        for (int e = 0; e < 16; ++e) { o[2 * e] = o2[e][0]; o[2 * e + 1] = o2[e][1]; }
        gather_finish(P, L, m, lane, o, xv4);
        if (!more) break;
        m = mn; rt = rtn;
        { const u32x2 t0 = reB, t1 = reC, t2 = reA; reA = t0; reB = t1; reC = t2; }
#pragma unroll
        for (int j = 0; j < 4; ++j) { uaA[j] = uaB[j]; vaA[j] = vaB[j]; uaB[j] = uaC[j]; vaB[j] = vaC[j]; if (!TAB_U4 && !TAB_UI4) { ubA[j] = ubB[j]; ubB[j] = ubC[j]; } if (!TAB_V4) { vbA[j] = vbB[j]; vbB[j] = vbC[j]; } }
#pragma unroll
        for (int q = 0; q < NHQ; ++q) hq[q] = hqn[q];
#if TAB_UI4
        uinv = uinvn; G_HCORR(hq, hcorr);
#endif
    }
#else
    u32x4 uaA[4], vaA[4], uaB[4], vaB[4]; u32x2 ubA[4], vbA[4], ubB[4], vbB[4];
    u32x2 re0 = GNT(rt), re1 = GNT(rt + 8);
    G_LOAD(uaA, ubA, vaA, vbA, re0);
#pragma unroll 1
    for (;;) {
        const size_t mn = m + (size_t)ngw; const bool more = mn < (size_t)M;
        const u32x2* rtn = P.route + (more ? mn : m) * 128 + eself;
        const u32x2 re0n = GNT(rtn), re1n = GNT(rtn + 8);
        v2f_t o2[16];
#pragma unroll
        for (int e = 0; e < 16; ++e) o2[e] = (v2f_t){0.f, 0.f};
        f32x4 xv4[4]; u32x4 hqn[NHQ]; float uinvn = 0.f;
#pragma unroll 1
        for (int bt = 0; bt < 16; bt += 2) {
            u32x2 re2 = re0, re3 = re1;
            if (bt < 14) { re2 = GNT(rt + (bt + 2) * 8); re3 = GNT(rt + (bt + 3) * 8); }
            G_LOAD(uaB, ubB, vaB, vbB, re1);
            __builtin_amdgcn_sched_barrier(0);
            G_COMP(uaA, ubA, vaA, vbA, re0);
            if (bt < 14) G_LOAD(uaA, ubA, vaA, vbA, re2);
            else if (more) G_LOAD(uaA, ubA, vaA, vbA, re0n);
            __builtin_amdgcn_sched_barrier(0);
            G_COMP(uaB, ubB, vaB, vbB, re1);
            re0 = re2; re1 = re3;
        }
        { const float* xr = P.X + m * D + 32 * lp + 16 * half;
#pragma unroll
          for (int q = 0; q < 4; ++q) xv4[q] = GNT((const f32x4*)(xr + 4 * q)); }
#if TAB_UI4
        if (more) { float hc_; G_HLOAD(hqn, uinvn, hc_, mn); }
#else
        if (more) { const u32x4* hr = (const u32x4*)(P.H + mn * D + 32 * lp);
#pragma unroll
            for (int q = 0; q < 4; ++q) hqn[q] = GNT(hr + q); }
#endif
        __builtin_amdgcn_sched_barrier(0);
        float o[32];
#pragma unroll
        for (int e = 0; e < 16; ++e) { o[2 * e] = o2[e][0]; o[2 * e + 1] = o2[e][1]; }
        gather_finish(P, L, m, lane, o, xv4);
        if (!more) break;
        m = mn; rt = rtn; re0 = re0n; re1 = re1n;
#pragma unroll
        for (int q = 0; q < NHQ; ++q) hq[q] = hqn[q];
#if TAB_UI4
        uinv = uinvn; G_HCORR(hq, hcorr);
#endif
    }
#endif
#undef G_LOAD
#undef G_COMP
#undef G_UDOT
#undef G_HLOAD
#undef G_HCORR
#undef G_PICKA
#undef G_PICKI
#undef G_PICKB
#undef GX1
#undef GX2
#undef GR4
#undef GR8
#undef G_PICKS
#undef G_PICKR
}

constexpr int GA_OFF = GC_OFF + 24576;
DI void peer_gather_split(const GatherP& P, lptr L, int gw, int ngw, int lane, int wave) {
    const int lp = lane & 31, half = lane >> 5;
    const unsigned lp16 = 16u * (unsigned)lp;
    const int eself = 2 * (lane & 3) + half;
    LAS float* actw = (LAS float*)(L + GA_OFF) + wave * 1024;
#define RT_AT(g_) (P.route + ((size_t)gw + (size_t)((g_) >> 4) * (size_t)ngw) * 128 + eself + ((g_) & 15) * 8)
#define ROW_LOAD(x_, tab_, row_, re_) do { const int idx_ = (int)(re_).x; _Pragma("unroll") for (int j = 0; j < 4; ++j) { \
        const unsigned ie = pick_swz(idx_, j); x_[j] = *(const u32x4*)((tab_) + (ie * (unsigned)(row_) + lp16)); } } while (0)
    {
        u32x4 hq[2], hqn[2]; float uinv, uinvn = 0.f, hcorr; float gA = 0.f, gB = 0.f;
#define S_HLOAD(hq_, uinv_, m_) do { const u32x4* hr_ = (const u32x4*)(P.H8 + (m_) * D + 32 * lp); hq_[0] = hr_[0]; hq_[1] = hr_[1]; uinv_ = P.HS[(m_)] * (1.0f / UI_SCALE); } while (0)
#define S_HCORR(hq_, hcorr_) do { int s_ = 0; _Pragma("unroll") for (int q_ = 0; q_ < 8; ++q_) s_ = __builtin_amdgcn_sdot4((int)hq_[q_ >> 2][q_ & 3], 0x01010101, s_, false); hcorr_ = 7.5f * (float)s_; } while (0)
        S_HLOAD(hq, uinv, (size_t)gw); S_HCORR(hq, hcorr);
        u32x4 u0[4], u1[4], u2[4], u3[4], u4[4], u5[4], u6[4], u7[4];
        u32x2 r0 = *RT_AT(0), r1 = *RT_AT(1), r2 = *RT_AT(2), r3 = *RT_AT(3), r4 = *RT_AT(4), r5 = *RT_AT(5), r6 = *RT_AT(6), r7 = *RT_AT(7), rp;
        ROW_LOAD(u0, P.U, ROW4, r0); ROW_LOAD(u1, P.U, ROW4, r1); ROW_LOAD(u2, P.U, ROW4, r2); ROW_LOAD(u3, P.U, ROW4, r3);
        ROW_LOAD(u4, P.U, ROW4, r4); ROW_LOAD(u5, P.U, ROW4, r5); ROW_LOAD(u6, P.U, ROW4, r6);
#define U_STEP(XL, RL, XC, RC, gc) do { \
            if ((gc) + 7 < 128) ROW_LOAD(XL, P.U, ROW4, RL); \
            rp = ((gc) + 8 < 128) ? *RT_AT((gc) + 8) : RC; \
            __builtin_amdgcn_sched_barrier(0); \
            float p[4]; \
            _Pragma("unroll") for (int j = 0; j < 4; ++j) p[j] = (float)udot_i4(XC[j], hq) - hcorr; \
            float p2[2], p1; \
            { const bool up = (lane & 2) != 0; \
              _Pragma("unroll") for (int q = 0; q < 2; ++q) { const float keep = up ? p[q + 2] : p[q], send = up ? p[q] : p[q + 2]; p2[q] = keep + dppf<0x4E>(send); } } \
            { const bool up = (lane & 1) != 0; const float keep = up ? p2[1] : p2[0], send = up ? p2[0] : p2[1]; p1 = keep + dppf<0xB1>(send); } \
            p1 += dppf<0x124>(p1); p1 += dppf<0x128>(p1); p1 += shx<16>(p1, lane); \
            if (lp < 4) actw[((gc) >> 4) * 128 + ((gc) & 15) * 8 + eself] = p1 * uinv; \
            RC = rp; } while (0)
#pragma unroll 1
        for (int g = 0; g < 128; g += 8) {
            const int bt0 = g & 15; const int k = g >> 4; const size_t mk = (size_t)gw + (size_t)k * (size_t)ngw;
            if (bt0 == 0 && g > 0) { hq[0] = hqn[0]; hq[1] = hqn[1]; uinv = uinvn; S_HCORR(hq, hcorr); }
            if (bt0 == 0) {
                gA = __int_as_float((int)P.route[mk * 128 + lane].y); gB = __int_as_float((int)P.route[mk * 128 + 64 + lane].y);
                if (g + 16 < 128) S_HLOAD(hqn, uinvn, mk + (size_t)ngw); }
            U_STEP(u7, r7, u0, r0, g + 0); U_STEP(u0, r0, u1, r1, g + 1); U_STEP(u1, r1, u2, r2, g + 2); U_STEP(u2, r2, u3, r3, g + 3);
            U_STEP(u3, r3, u4, r4, g + 4); U_STEP(u4, r4, u5, r5, g + 5); U_STEP(u5, r5, u6, r6, g + 6); U_STEP(u6, r6, u7, r7, g + 7);
            if (bt0 == 8) {
                LDS_WAIT();
                LAS float* at = actw + k * 128;
                const float v0 = at[lane], v1 = at[64 + lane];
                at[lane] = gelu_exact(v0) * gA * (1.0f / VT_SCALE); at[64 + lane] = gelu_exact(v1) * gB * (1.0f / VT_SCALE);
            }
        }
#undef U_STEP
#undef S_HLOAD
#undef S_HCORR
    }
    LDS_WAIT();
    {
        u32x4 v0[4], v1[4], v2[4], v3[4];
        u32x2 r0 = *RT_AT(0), r1 = *RT_AT(1), r2 = *RT_AT(2), r3 = *RT_AT(3), rp;
        ROW_LOAD(v0, P.V, ROW4, r0); ROW_LOAD(v1, P.V, ROW4, r1); ROW_LOAD(v2, P.V, ROW4, r2);
        v2f_t o2[16];
#pragma unroll
        for (int e = 0; e < 16; ++e) o2[e] = (v2f_t){0.f, 0.f};
        f32x4 xv4[4];
#define V_STEP(XL, RL, XC, RC, gc) do { \
            if ((gc) + 3 < 128) ROW_LOAD(XL, P.V, ROW4, RL); \
            rp = ((gc) + 4 < 128) ? *RT_AT((gc) + 4) : RC; \
            __builtin_amdgcn_sched_barrier(0); \
            { const LAS float* ab = actw + ((gc) >> 4) * 128 + ((gc) & 15) * 8 + half; \
              _Pragma("unroll") for (int j = 0; j < 4; ++j) { const float a = ab[2 * j]; \
                _Pragma("unroll") for (int q = 0; q < 4; ++q) { \
                    const v2f_t t0 = __builtin_amdgcn_cvt_scalef32_pk_f32_fp4(XC[j][q], 1.0f, 0), t1 = __builtin_amdgcn_cvt_scalef32_pk_f32_fp4(XC[j][q], 1.0f, 1), \
                                t2 = __builtin_amdgcn_cvt_scalef32_pk_f32_fp4(XC[j][q], 1.0f, 2), t3 = __builtin_amdgcn_cvt_scalef32_pk_f32_fp4(XC[j][q], 1.0f, 3); \
                    o2[4 * q + 0] += t0 * a; o2[4 * q + 1] += t1 * a; o2[4 * q + 2] += t2 * a; o2[4 * q + 3] += t3 * a; } } } \
            RC = rp; } while (0)
#pragma unroll 1
        for (int g = 0; g < 128; g += 4) {
            const int bt0 = g & 15; const int k = g >> 4; const size_t mk = (size_t)gw + (size_t)k * (size_t)ngw;
            V_STEP(v3, r3, v0, r0, g + 0);
            if (bt0 == 12) { const float* xr = P.X + mk * D + 32 * lp + 16 * half;
#pragma unroll
                for (int q = 0; q < 4; ++q) xv4[q] = *(const f32x4*)(xr + 4 * q); }
            V_STEP(v0, r0, v1, r1, g + 1);
            V_STEP(v1, r1, v2, r2, g + 2);
            V_STEP(v2, r2, v3, r3, g + 3);
            if (bt0 == 12) {
                float o[32];
#pragma unroll
                for (int e = 0; e < 16; ++e) { o[2 * e] = o2[e][0]; o[2 * e + 1] = o2[e][1]; o2[e] = (v2f_t){0.f, 0.f}; }
                gather_finish(P, L, mk, lane, o, xv4);
            }
        }
#undef V_STEP
    }
#undef ROW_LOAD
#undef RT_AT
}

#ifndef MK_SINGLE
#define MK_SINGLE 0
#endif
#ifndef TABLE_FP6
#define TABLE_FP6 1
#endif
#ifndef GATHER_MODE
#define GATHER_MODE 0
#endif
#ifndef LATE_PROLOGUE
#define LATE_PROLOGUE 0
#endif
#ifndef Q_I8
#define Q_I8 1
#endif
#ifndef MIX_SPLIT
#define MIX_SPLIT 0
#endif
#ifndef CHAIN_SPLIT
#define CHAIN_SPLIT 0
#endif
constexpr int SH = (MIX_SPLIT || CHAIN_SPLIT) ? 1 : 0;
constexpr int NSLOT = (GATHER_MODE ? 12 : 10) + SH;
constexpr int NPHASE = 2 + NSLOT * DEPTH;
constexpr int PH_ALL = (1 << (2 + NSLOT)) - 1;
enum { I_X = 0, I_C, I_ADAW, I_ADAB, I_N1G, I_N2G, I_FING, I_WIN, I_LBL, I_HGNG, I_CONVW, I_ALOG, I_DTB, I_GDNNG, I_WBH, I_WBG, I_WOUT, I_WQ, I_SK, I_U, I_V };

DI int lane_id_() { unsigned m_ = ~0u; asm volatile("" : "+s"(m_)); return (int)__builtin_amdgcn_mbcnt_hi(m_, __builtin_amdgcn_mbcnt_lo(m_, 0u)); }
template <int PHM> __global__ void __launch_bounds__(NTHR, 2) trunk_fwd(Args args) {
    extern __shared__ __attribute__((aligned(16))) unsigned char lds_raw[];
    lptr L = (lptr)lds_raw;
    const int tid0 = threadIdx.x, wave = __builtin_amdgcn_readfirstlane(tid0 >> 6);
#if MK_SINGLE
    constexpr int G = 256;
#else
    const int G = gridDim.x;
#endif
    const int bx = blockIdx.x; const int vcu = (G % 8 == 0) ? (bx % 8) * (G / 8) + bx / 8 : bx;
    const int gw = vcu * NWAVES + wave, NGW = G * NWAVES;
    unsigned char* ws0 = args.ws;
#if MK_SINGLE
    constexpr int lo = 0, hi = NPHASE;
#else
    const int lo = args.ph_lo, hi = args.ph_hi;
#endif
    volatile LAS unsigned* MISC = (volatile LAS unsigned*)(L + LDS_CTL_OFF);
    for (int u = tid0; u < (LDS_BYTES - LDS_CTL_OFF) / 4; u += NTHR) ((LAS unsigned*)(L + LDS_CTL_OFF))[u] = 0u;
    __syncthreads();
#if MK_SINGLE
    xcd_barrier_post((unsigned*)(ws0 + WS_CTL) + 4096, wave);
#define GRID_BAR() do { unsigned* bp_ = (unsigned*)(args.ws + WS_CTL) + 4096; asm volatile("" : "+s"(bp_)); XcdBarrier b_; b_.bar = bp_; b_.x = xb_xcc_id(); b_.st = (volatile LAS unsigned*)(L + LDS_CTL_OFF) + 8; xcd_barrier(b_, wave); } while (0)
#else
#define GRID_BAR() do {} while (0)
#endif
#define PH_MASK PHM
#ifndef REP_MASK
#define REP_MASK 0
#endif
#ifndef NREPA
#define NREPA 1
#endif
#define NREP(j) (1 + (((REP_MASK) >> (j)) & 1))
#define IN(k) (lo <= (k) && (k) < hi)
#define INL(j) ((((PH_MASK) >> (2 + (j))) & 1) && IN(pb + (j)))
#define IN0(k) ((((PH_MASK) >> (k)) & 1) && IN(k))
#define PHASE_BEGIN() size_t kz = 0; int tid = wave * 64 + lane_id_(); asm volatile("" : "+s"(kz), "+v"(tid)); unsigned char* ws = args.ws + kz; const int lane = tid & 63
#define INP(i) (args.in[i] + kz)
#define SEAM(k) do { if (IN(k) && IN((k) + 1)) GRID_BAR(); } while (0)

#define P_MOD   ((float*)(ws + WS_MOD))
#define P_SMALL ((float*)(ws + WS_SMALL))
#define P_SMALLL(l) ((float*)(ws + ((l) ? WS_SMALL1 : WS_SMALL)))
#define P_WIN   ((bf16_t*)(ws + WS_WIN))
#define P_WBR   ((bf16_t*)(ws + WS_WBR))
#define P_WOUT  ((bf16_t*)(ws + WS_WOUT))
#define P_WQ    ((bf16_t*)(ws + WS_WQ))
#define P_SK    ((bf16_t*)(ws + WS_SK))
#define P_PROJ  ((bf16_t*)(ws + WS_PROJ))
#define P_Y     ((bf16_t*)(ws + WS_Y))
#define P_U     ((unsigned char*)(ws + (TABLE_FP6 ? WS_U6 : WS_UV)))
#define P_V     (TABLE_FP6 ? (unsigned char*)(ws + WS_WIN + (size_t)l * 12 * MiB) : (unsigned char*)(ws + WS_UV) + (size_t)NEXP * D)
#define P_H     ((bf16_t*)(ws + WS_H))
#define P_MERGED ((bf16_t*)(ws + WS_MERGED))
#define P_WQ8   ((unsigned char*)(ws + 500 * MiB))
#define P_WQS   ((float*)(ws + 504 * MiB))
#define P_H8    ((unsigned char*)(ws + WS_Y))
#define P_HS    ((float*)(ws + WS_Y + 16 * MiB))
#define P_ROUTE ((u32x2*)(ws + WS_ROUTE))
#define MIXP_INIT(MP, l) MixP MP; MP.PROJ = P_PROJ; MP.SMALL = P_SMALLL(l); MP.convw = INP(I_CONVW) + (size_t)(l) * 4 * 1536; MP.alog = INP(I_ALOG) + (l) * 4; MP.dtb = INP(I_DTB) + (l) * 4; MP.lbl = INP(I_LBL); MP.l = (l); \
        MP.MT = ws + WS_MT; MP.NN = ws + WS_NN; MP.QT = ws + WS_QT; MP.OP = ws + WS_OP; MP.SS = ws + WS_SS; MP.DL = (float*)(ws + WS_DL)

    for (int rep_ = 0; rep_ < NREP(10); ++rep_) if (IN0(0)) { if (rep_) GRID_BAR();
        PHASE_BEGIN();
        if (vcu < (LATE_PROLOGUE ? 96 : 192)) mod_item(INP(I_C), INP(I_ADAW), INP(I_ADAB), P_MOD, vcu, L, tid);
        LAS float* scr = (LAS float*)(L + wave * 16384);
        constexpr int IT_WIN = 16 * 192, IT_WBR = 8 * 32, IT_WOUT = 16 * 32, IT_WQ = 16 * 64, IT_L = IT_WIN + 2 * IT_WBR + IT_WOUT + IT_WQ;
#define WEIGHT_ITEM_BODY \
            if (r < IT_WIN) { const int kb = r / 192, nb = r % 192, n0 = 32 * nb; transpose_item(INP(I_WIN) + (size_t)l * D * IN_COLS, IN_COLS, n0 + (n0 >= 4096 ? 8 : 0), P_WIN + (size_t)l * NPROJ * D, D, n0, 64 * kb, scr, lane); continue; } r -= IT_WIN; \
            if (r < IT_WBR) { const int kb = r / 32, nb = r % 32; transpose_item(INP(I_WBH) + (size_t)l * 512 * D, D, 32 * nb, P_WBR + ((size_t)l * 2 + 0) * D * 512, 512, 32 * nb, 64 * kb, scr, lane); continue; } r -= IT_WBR; \
            if (r < IT_WBR) { const int kb = r / 32, nb = r % 32; transpose_item(INP(I_WBG) + (size_t)l * 512 * D, D, 32 * nb, P_WBR + ((size_t)l * 2 + 1) * D * 512, 512, 32 * nb, 64 * kb, scr, lane); continue; } r -= IT_WBR; \
            if (r < IT_WOUT) { const int kb = r / 32, nb = r % 32; transpose_item(INP(I_WOUT) + (size_t)l * D * D, D, 32 * nb, P_WOUT + (size_t)l * D * D, D, 32 * nb, 64 * kb, scr, lane); continue; } r -= IT_WOUT; \
            { const int kb = r / 64, nb = r % 64; transpose_item(INP(I_WQ) + (size_t)l * D * NQ, NQ, 32 * nb, P_WQ + (size_t)l * NQ * D, D, 32 * nb, 64 * kb, scr, lane); } \

        for (int it = gw; it < (LATE_PROLOGUE ? 1 : DEPTH) * IT_L; it += NGW) {
            const int l = it / IT_L; int r = it - l * IT_L;
            WEIGHT_ITEM_BODY
        }
        cvt_stream(INP(I_SK), P_SK, (size_t)DEPTH * 8 * 2 * 128 * 128, gw, NGW, lane);
    }
    SEAM(0);
    for (int rep_ = 0; rep_ < NREP(11); ++rep_) if (IN0(1)) { if (rep_) GRID_BAR();
        PHASE_BEGIN();
        LAS float* wsm = (LAS float*)L;
        stage_wsmall(INP(I_WIN), wsm, tid);
        const float* x = INP(I_X); float* mod = P_MOD;
        for (int bb = 0; bb < BATCH; ++bb) {
            RowMod R; load_rowmod(R, INP(I_N1G), mod + (size_t)bb * 6 * D + D, mod + (size_t)bb * 6 * D, lane);
            for (int m = bb * SEQ + gw; m < (bb + 1) * SEQ; m += NGW) {
                f32x4 v[4];
#pragma unroll
                for (int j = 0; j < 4; ++j) v[j] = ((const f32x4*)(x + (size_t)m * D))[lane + 64 * j];
                row_finish<true>(v, R, P_H + (size_t)m * D, P_SMALL + (size_t)m * 8, wsm, lane);
            }
        }
#if Q_I8
        for (int rw = gw; rw < DEPTH * NQ; rw += NGW) {
            const u32x4 a = ((const u32x4*)(P_WQ + (size_t)rw * D))[2 * lane], b = ((const u32x4*)(P_WQ + (size_t)rw * D))[2 * lane + 1];
            float f[16];
            f[0] = bf_lo(a.x); f[1] = bf_hi(a.x); f[2] = bf_lo(a.y); f[3] = bf_hi(a.y); f[4] = bf_lo(a.z); f[5] = bf_hi(a.z); f[6] = bf_lo(a.w); f[7] = bf_hi(a.w);
            f[8] = bf_lo(b.x); f[9] = bf_hi(b.x); f[10] = bf_lo(b.y); f[11] = bf_hi(b.y); f[12] = bf_lo(b.z); f[13] = bf_hi(b.z); f[14] = bf_lo(b.w); f[15] = bf_hi(b.w);
            float am = 0.f;
#pragma unroll
            for (int i = 0; i < 16; ++i) am = fmaxf(am, fabsf(f[i]));
            am = fmaxf(am, shx<1>(am, lane)); am = fmaxf(am, shx<2>(am, lane)); am = fmaxf(am, shx<4>(am, lane)); am = fmaxf(am, shx<8>(am, lane)); am = fmaxf(am, shx<16>(am, lane)); am = fmaxf(am, shx<32>(am, lane));
            am = fmaxf(am, 1e-30f);
            const float sc = 127.0f / am;
            unsigned w[4];
#pragma unroll
            for (int d = 0; d < 4; ++d) { const int q0 = (int)__builtin_rintf(f[4 * d] * sc), q1 = (int)__builtin_rintf(f[4 * d + 1] * sc), q2 = (int)__builtin_rintf(f[4 * d + 2] * sc), q3 = (int)__builtin_rintf(f[4 * d + 3] * sc);
                w[d] = (unsigned)(q0 & 0xff) | ((unsigned)(q1 & 0xff) << 8) | ((unsigned)(q2 & 0xff) << 16) | ((unsigned)q3 << 24); }
            ((u32x4*)(P_WQ8 + (size_t)rw * D))[lane] = (u32x4){w[0], w[1], w[2], w[3]};
            if (lane == 0) P_WQS[rw] = am * (1.0f / 127.0f);
        }
#endif
    }
    SEAM(1);
#ifdef EXTRA_BARS
#ifndef EB_RT
#define EB_RT 0
#endif
    for (int eb_ = 0; eb_ < EXTRA_BARS + EB_RT; ++eb_) GRID_BAR();
#endif
#pragma unroll 1
    for (int l = 0; l < DEPTH; ++l) {
        const int pb = 2 + NSLOT * l;
        for (int rep_ = 0; rep_ < NREP(0); ++rep_) if (INL(0)) { if (rep_) GRID_BAR();
            PHASE_BEGIN();
            pg8::Gemm g{P_H, P_WIN + (size_t)l * NPROJ * D, M, NPROJ, D, D, D, 0, 0}; pg8::StaticOrder S; S.init(M, NPROJ, G, bx);
            pg8::EpiBf16 E{P_PROJ, NPROJ};
            pg8::gemm_phase(L, g, S, E, tid);
        }
        SEAM(pb + 0);
#if CHAIN_SPLIT
        if (INL(1)) {
            PHASE_BEGIN(); MIXP_INIT(MP, l);
            for (int i = vcu; i < 2048; i += G) { const int br = i >> 10, bhc = i & 1023;
                if (br) passA_gdn(L, tid, MP, bhc >> 7, bhc & 127); else passA_hgrn(L, tid, MP, bhc >> 7, bhc & 127); }
        }
        SEAM(pb + 1);
#pragma unroll 1
        for (int hf = 0; hf < 2; ++hf) {
            if (INL(2 + hf)) {
                PHASE_BEGIN(); MIXP_INIT(MP, l);
                const int vx = vcu & 31, xq = vcu >> 5; const int c0 = 64 * hf, c1 = c0 + 64;
                if (vx < 4) passB_gdn(L, tid, MP, xq * 4 + vx, c0, c1);
                else if (vx < 20 && wave < 2) passB_hgrn(lane, MP, ((vx - 4) * 8 + xq) * 2 + wave, c0, c1);
                else {
                    const int cw = (vx >= 20) ? (xq * 12 + vx - 20) * 8 + wave : 768 + ((vx - 4) * 8 + xq) * 6 + (wave - 2);
                    if (hf == 0) cvt_stream_tab(INP(I_U) + (size_t)l * NEXP * D, P_U, TAB_UI4 ? 2 : TAB_U4, UT_SCALE, cw, 1536, lane);
                    else {
                        const float* ngh = INP(I_HGNG) + l * 128; const float* ngg = INP(I_GDNNG) + l * 128;
                        int tl = tid; asm volatile("" : "+v"(tl)); const int ln = tl & 63;
                        if (vx >= 20) {
#pragma unroll 1
                            for (int t = cw; t < 2048; t += 768) { const int q = t >> 1, cc = q & 63, rest = q >> 6;
                                passC_wave(ln, MP, (rest >> 3) * 1024 + (rest & 7) * 128 + cc, t & 1, ngh, ngg, P_Y); }
                        } else cvt_stream_tab(INP(I_V) + (size_t)l * NEXP * D, P_V, TAB_V4, VT_SCALE, cw - 768, 768, ln);
                    }
                }
            }
            SEAM(pb + 2 + hf);
        }
        if (INL(4)) {
            PHASE_BEGIN(); MIXP_INIT(MP, l);
            const float* ngh = INP(I_HGNG) + l * 128; const float* ngg = INP(I_GDNNG) + l * 128;
            int tl = tid; asm volatile("" : "+v"(tl)); const int ln = tl & 63;
            { const int t = gw, q = t >> 1, cc = 64 + (q & 63), rest = q >> 6;
              passC_wave(ln, MP, (rest >> 3) * 1024 + (rest & 7) * 128 + cc, t & 1, ngh, ngg, P_Y); }
        }
        SEAM(pb + 4);
#elif MIX_SPLIT
        if (INL(1)) {
            PHASE_BEGIN(); MIXP_INIT(MP, l);
            for (int i = vcu; i < 1024; i += G) passA_gdn(L, tid, MP, i >> 7, i & 127);
        }
        SEAM(pb + 1);
        if (INL(2)) {
            PHASE_BEGIN(); MIXP_INIT(MP, l);
            const int vx = vcu & 31, xq = vcu >> 5;
            if (vx < 4) passB_gdn(L, tid, MP, xq * 4 + vx);
            else {
                const int widx = (vx - 4) * 8 + xq;
                for (int i = widx; i < 1024; i += 224) passA_hgrn(L, tid, MP, i >> 7, i & 127);
                cvt_stream_tab(INP(I_U) + (size_t)l * NEXP * D, P_U, TAB_UI4 ? 2 : TAB_U4, UT_SCALE, widx * 8 + wave, 224 * 8, lane);
            }
        }
        SEAM(pb + 2);
        if (INL(3)) {
            PHASE_BEGIN(); MIXP_INIT(MP, l);
            const float* ngh = INP(I_HGNG) + l * 128; const float* ngg = INP(I_GDNNG) + l * 128;
            int tl = tid; asm volatile("" : "+v"(tl)); const int ln = tl & 63;
            if (wave == 0) passB_hgrn(ln, MP, vcu);
            else {
                const int w7 = vcu * 7 + (wave - 1);
#pragma unroll 1
                for (int t = w7; t < 2048; t += 1792) passC_wave(ln, MP, 1024 + (t >> 1), t & 1, ngh, ngg, P_Y);
                cvt_stream_tab(INP(I_V) + (size_t)l * NEXP * D, P_V, TAB_V4, VT_SCALE, w7, 1792, ln);
            }
        }
        SEAM(pb + 3);
        if (INL(4)) {
            PHASE_BEGIN(); MIXP_INIT(MP, l);
            const float* ngh = INP(I_HGNG) + l * 128; const float* ngg = INP(I_GDNNG) + l * 128;
            int tl = tid; asm volatile("" : "+v"(tl)); const int ln = tl & 63;
            passC_wave(ln, MP, gw >> 1, gw & 1, ngh, ngg, P_Y);
        }
        SEAM(pb + 4);
#else
        for (int rep_ = 0; rep_ < NREP(1); ++rep_) if (INL(1)) { if (rep_) GRID_BAR();
            PHASE_BEGIN(); MIXP_INIT(MP, l);
            for (int i2 = vcu; i2 < (NREPA == 2 ? 4096 : NREPA == 3 ? 3072 : NREPA == 4 ? 3072 : 2048); i2 += G) { const int i = (NREPA == 3 && i2 >= 2048) ? i2 - 1024 : (i2 & 2047);
                const int br = i >> 10, bhc = i & 1023;
                if (br) passA_gdn(L, tid, MP, bhc >> 7, bhc & 127); else passA_hgrn(L, tid, MP, bhc >> 7, bhc & 127);
            }
        }
        SEAM(pb + 1);
        for (int rep_ = 0; rep_ < NREP(2); ++rep_) if (INL(2)) { if (rep_) GRID_BAR();
            PHASE_BEGIN(); MIXP_INIT(MP, l);
            const int vx = vcu & 31, xq = vcu >> 5;
            if (vx < 4) passB_gdn(L, tid, MP, xq * 4 + vx);
            else if (vx < 20 && wave < 2) { passB_hgrn(lane, MP, ((vx - 4) * 8 + xq) * 2 + wave);
#ifdef PROBE_H2X
                passB_hgrn(lane, MP, ((vx - 4) * 8 + xq) * 2 + wave);
#endif
            }
#if TABLE_FP6
            else {
                if (rep_ == 0) { const int cw = (vx >= 20) ? (xq * 12 + vx - 20) * 8 + wave : 768 + ((vx - 4) * 8 + xq) * 6 + (wave - 2);
#if LATE_PROLOGUE
                if (l == 0) {
                    if (vx >= 20) mod_item(INP(I_C), INP(I_ADAW), INP(I_ADAB), P_MOD, 96 + xq * 12 + vx - 20, L, tid);
                    LAS float* scr = (LAS float*)(L + wave * 16384);
                    constexpr int IT_WIN = 16 * 192, IT_WBR = 8 * 32, IT_WOUT = 16 * 32, IT_WQ = 16 * 64, IT_L = IT_WIN + 2 * IT_WBR + IT_WOUT + IT_WQ;
                    for (int it = cw; it < IT_L; it += 1536) { constexpr int l = 1; int r = it;
                        WEIGHT_ITEM_BODY
                    }
                }
#endif
                cvt_stream_tab(INP(I_U) + (size_t)l * NEXP * D, P_U, TAB_UI4 ? 2 : TAB_U4, UT_SCALE, cw, 1536, lane);
                cvt_stream_tab(INP(I_V) + (size_t)l * NEXP * D, P_V, TAB_V4, VT_SCALE, cw, 1536, lane); }
            }
#endif
        }
        SEAM(pb + 2);
        for (int rep_ = 0; rep_ < NREP(3); ++rep_) if (INL(3)) { if (rep_) GRID_BAR();
            PHASE_BEGIN(); MIXP_INIT(MP, l);
            const float* ngh = INP(I_HGNG) + l * 128; const float* ngg = INP(I_GDNNG) + l * 128;
            int tl = tid; asm volatile("" : "+v"(tl)); const int ln = tl & 63, wv = __builtin_amdgcn_readfirstlane(tl >> 6);
#pragma unroll 1
            for (int j = 0; j < 2; ++j) passC_wave(ln, MP, (gw >> 1) + 1024 * j, gw & 1, ngh, ngg, P_Y);
        }
        SEAM(pb + 3);
#endif
        for (int rep_ = 0; rep_ < NREP(4); ++rep_) if (INL(4 + SH)) { if (rep_) GRID_BAR();
            PHASE_BEGIN();
            pg8::TwoPassOrder S; S.S.init(M, D, G, bx);
            pg8::Gemm g{P_Y, P_WBR + (size_t)l * 2 * D * 512, M, D, 512, D, 512, (size_t)512, (size_t)D * 512};
            pg8::EpiGate E{P_MERGED, D, P_PROJ, NPROJ, PC_GATE};
            pg8::gemm_phase(L, g, S, E, tid);
        }
        SEAM(pb + 4 + SH);
        for (int rep_ = 0; rep_ < NREP(5); ++rep_) if (INL(5 + SH)) { if (rep_) GRID_BAR();
            PHASE_BEGIN();
            float* X = args.out;
            pg8::Gemm g{P_MERGED, P_WOUT + (size_t)l * D * D, M, D, D, D, D, 0, 0}; pg8::StaticOrder S; S.init(M, D, G, bx);
            pg8::EpiResid E{l == 0 ? INP(I_X) : (const float*)X, X, P_MOD + (size_t)l * BATCH * 6 * D + 2 * D};
            pg8::gemm_phase(L, g, S, E, tid);
#if !TABLE_FP6
            cvt_stream_fp8(INP(I_U) + (size_t)l * NEXP * D, P_U, (size_t)NEXP * D, U8_SCALE, gw, NGW, lane);
            cvt_stream_fp8(INP(I_V) + (size_t)l * NEXP * D, P_V, (size_t)NEXP * D, V8_SCALE, gw, NGW, lane);
#endif
        }
        SEAM(pb + 5 + SH);
        for (int rep_ = 0; rep_ < NREP(6); ++rep_) if (INL(6 + SH)) { if (rep_) GRID_BAR();
            PHASE_BEGIN();
            const float* X = args.out; const float* modl = P_MOD + (size_t)l * BATCH * 6 * D;
            for (int bb = 0; bb < BATCH; ++bb) {
                RowMod R; load_rowmod(R, INP(I_N2G) + l * D, modl + (size_t)bb * 6 * D + 4 * D, modl + (size_t)bb * 6 * D + 3 * D, lane);
                for (int m = bb * SEQ + gw; m < (bb + 1) * SEQ; m += NGW) {
                    f32x4 v[4];
#pragma unroll
                    for (int j = 0; j < 4; ++j) v[j] = ((const f32x4*)(X + (size_t)m * D))[lane + 64 * j];
                    row_finish<false, TAB_UI4 != 0>(v, R, P_H + (size_t)m * D, nullptr, nullptr, lane, (unsigned*)(P_H8 + (size_t)m * D), P_HS + m);
                }
            }
        }
        SEAM(pb + 6 + SH);
        for (int rep_ = 0; rep_ < NREP(7); ++rep_) if (INL(7 + SH)) { if (rep_) GRID_BAR();
            PHASE_BEGIN();
#if Q_I8
            pg8::Gemm g{(const bf16_t*)P_H8, (const bf16_t*)(P_WQ8 + (size_t)l * NQ * D), M, NQ, D / 2, D / 2, D / 2, 0, 0}; pg8::StaticOrder S; S.init(M, NQ, G, bx);
            pg8::EpiQ8 E{P_PROJ, NQ, P_HS, P_WQS + (size_t)l * NQ};
            pg8::gemm_phase<pg8::EpiQ8, pg8::StaticOrder, true>(L, g, S, E, tid);
#else
            pg8::Gemm g{P_H, P_WQ + (size_t)l * NQ * D, M, NQ, D, D, D, 0, 0}; pg8::StaticOrder S; S.init(M, NQ, G, bx);
            pg8::EpiBf16 E{P_PROJ, NQ};
            pg8::gemm_phase(L, g, S, E, tid);
#endif
        }
        SEAM(pb + 7 + SH);
        for (int rep_ = 0; rep_ < NREP(8); ++rep_) if (INL(8 + SH)) { if (rep_) GRID_BAR(); PHASE_BEGIN(); peer_route_phase(L, tid, vcu, P_PROJ, P_SK + (size_t)l * 8 * 2 * 128 * 128, P_ROUTE); }
        SEAM(pb + 8 + SH);
#if GATHER_MODE == 0
        for (int rep_ = 0; rep_ < NREP(9); ++rep_) if (INL(9 + SH)) { if (rep_) GRID_BAR();
            PHASE_BEGIN();
            float* mod = P_MOD;
            GatherP GP; GP.H = P_H; GP.route = P_ROUTE; GP.U = P_U; GP.V = P_V; GP.X = args.out; GP.gt2 = mod + (size_t)l * BATCH * 6 * D + 5 * D; GP.last = (l == DEPTH - 1);
            LAS float* wsm = (LAS float*)L;
            if (GP.last) { GP.ng = INP(I_FING); GP.nsc = nullptr; GP.nsh = nullptr; }
            else { GP.ng = INP(I_N1G) + (l + 1) * D; GP.nsc = mod + (size_t)(l + 1) * BATCH * 6 * D + D; GP.nsh = mod + (size_t)(l + 1) * BATCH * 6 * D;
                   stage_wsmall(INP(I_WIN) + (size_t)(l + 1) * D * IN_COLS, wsm, tid); }
            GP.Hout = P_H; GP.small = P_SMALLL(l + 1); GP.wsm = wsm; GP.out = args.out; GP.H8 = P_H8; GP.HS = P_HS;
#if TABLE_FP6
#if GATHER_PIPE == 3
            stage_gather_consts(GP, L, tid);
            peer_gather_split(GP, L, gw, NGW, lane, wave);
#elif GATHER_PIPE == 2
            stage_gather_consts(GP, L, tid);
            peer_gather_wave(GP, L, gw, NGW, lane);
#else
            for (int m = gw; m < M; m += NGW) peer_gather_token6(GP, (size_t)m, lane);
#endif
#else
            for (int m = gw; m < M; m += NGW) peer_gather_token(GP, (size_t)m, lane);
#endif
        }
        if (l + 1 < DEPTH) SEAM(pb + 9 + SH);
#else
        if (INL(9 + SH)) { PHASE_BEGIN(); int bxl = bx; asm volatile("" : "+s"(bxl)); peer_u_pass(L, tid, bxl, P_H, P_ROUTE, P_U, (float*)(ws + WS_ACT)); }
        SEAM(pb + 9 + SH);
        if (INL(10 + SH)) { PHASE_BEGIN(); int bxl = bx; asm volatile("" : "+s"(bxl)); peer_v_pass(tid, bxl, P_ROUTE, (const float*)(ws + WS_ACT), P_V, args.out, P_MOD + (size_t)l * BATCH * 6 * D + 5 * D); }
        SEAM(pb + 10 + SH);
        if (INL(11 + SH)) {
            PHASE_BEGIN();
            float* X = args.out; float* mod = P_MOD;
            if (l == DEPTH - 1) {
                const float* fg = INP(I_FING);
#pragma unroll 1
                for (int m = gw; m < M; m += NGW) { f32x4 v[4];
#pragma unroll
                    for (int j = 0; j < 4; ++j) v[j] = ((const f32x4*)(X + (size_t)m * D))[lane + 64 * j];
                    row_final(v, fg, X + (size_t)m * D, lane); }
            } else {
                LAS float* wsm = (LAS float*)L;
                stage_wsmall(INP(I_WIN) + (size_t)(l + 1) * D * IN_COLS, wsm, tid);
                const float* modn = mod + (size_t)(l + 1) * BATCH * 6 * D;
#pragma unroll 1
                for (int bb = 0; bb < BATCH; ++bb) {
                    RowMod R; load_rowmod(R, INP(I_N1G) + (l + 1) * D, modn + (size_t)bb * 6 * D + D, modn + (size_t)bb * 6 * D, lane);
#pragma unroll 1
                    for (int m = bb * SEQ + gw; m < (bb + 1) * SEQ; m += NGW) { f32x4 v[4];
#pragma unroll
                        for (int j = 0; j < 4; ++j) v[j] = ((const f32x4*)(X + (size_t)m * D))[lane + 64 * j];
                        row_finish<true>(v, R, P_H + (size_t)m * D, P_SMALLL(l + 1) + (size_t)m * 8, wsm, lane); }
                }
            }
        }
        if (l + 1 < DEPTH) SEAM(pb + 11 + SH);
#endif
    }
#undef IN
#undef SEAM
}

#ifndef DBG_STOP
#define DBG_STOP 0
#endif
#ifndef DBG_SEL
#define DBG_SEL 0
#endif
#if DBG_STOP || defined(DUMP_OFF)
__global__ void dbg_dump(float* out, const unsigned short* a, size_t na, const unsigned short* b, size_t nb, const float* xf) {
    const size_t i = (size_t)blockIdx.x * blockDim.x + threadIdx.x; if (i >= (size_t)M * D) return;
    float v = 0.f;
#ifdef DUMP_VAL
    if (a) { for (size_t j = i; j < na; j += (size_t)M * D) { float t = __uint_as_float((unsigned)a[j] << 16); if (!(fabsf(t) < 1e30f)) t = 1e30f; v += t; } }
#else
    if (a) { for (size_t j = i; j < na; j += (size_t)M * D) v += (float)a[j] * (1.0f / 65536.0f); }
#endif
    if (b) { for (size_t j = i; j < nb; j += (size_t)M * D) v += (float)b[j] * (1.0f / 65536.0f); }
    if (xf) { float t = xf[i]; unsigned u = __float_as_uint(t); v += (float)(u >> 16) * (1.0f / 65536.0f) + (float)(u & 0xffffu) * (1.0f / 65536.0f); }
    out[i] = v;
}
#endif
#if DBG_STOP
__global__ void dbg_route_check(const bf16_t* Q, const bf16_t* SK, const u32x2* route, unsigned* counter) {
    extern __shared__ float sh[];
    const int tid = threadIdx.x; float* my = sh + tid * 400;
    const int gid = blockIdx.x * 64 + tid, t = gid >> 3, h = gid & 7;
    for (int z = 0; z < 2; ++z) for (int n = 0; n < 128; ++n) { float a = 0.f;
        for (int d = 0; d < 128; ++d) a += bf1(Q[(size_t)t * NQ + h * 256 + z * 128 + d]) * bf1(SK[((size_t)(h * 2 + z) * 128 + n) * 128 + d]);
        my[z * 128 + n] = a; }
    float* av = my + 256; int* ai = (int*)(my + 288);
    for (int z = 0; z < 2; ++z) for (int r = 0; r < 16; ++r) { int bi = 0; float bv = -INFINITY;
        for (int n = 0; n < 128; ++n) if (my[z * 128 + n] > bv) { bv = my[z * 128 + n]; bi = n; }
        av[z * 16 + r] = bv; ai[z * 16 + r] = bi; my[z * 128 + bi] = -INFINITY; }
    unsigned char* used = (unsigned char*)(my + 320);
    for (int k = 0; k < 256; ++k) used[k] = 0;
    int mism = 0;
    int ex[16];
    for (int r = 0; r < 16; ++r) { int bi = 0; float bv = -INFINITY;
        for (int k = 0; k < 256; ++k) if (!used[k]) { const float v = av[k >> 4] + av[16 + (k & 15)]; if (v > bv) { bv = v; bi = k; } }
        used[bi] = 1; my[r] = __int_as_float(ai[bi >> 4] * 128 + ai[16 + (bi & 15)]); }
    for (int k = 0; k < 16; ++k) { const int e = (int)route[((size_t)t * 8 + h) * 16 + k].x; bool f = false;
        for (int r = 0; r < 16; ++r) f = f || (__float_as_int(my[r]) == e);
        mism += f ? 0 : 1; }
    atomicAdd(counter, (unsigned)mism);
}
__global__ void dbg_gather_check(const bf16_t* H, const u32x2* route, const bf16_t* U, const bf16_t* V, const float* O, float* acc2  ) {
    __shared__ float red[256]; __shared__ float actv;
    const int t = blockIdx.x, tid = threadIdx.x;
    float o[4] = {0.f, 0.f, 0.f, 0.f};
    for (int k = 0; k < 128; ++k) {
        const u32x2 re = route[(size_t)t * 128 + k]; const size_t ro = (size_t)re.x * D;
        float p = 0.f; for (int j = 0; j < 4; ++j) p += bf1(H[(size_t)t * D + tid * 4 + j]) * bf1(U[ro + tid * 4 + j]);
        red[tid] = p; __syncthreads();
        for (int s_ = 128; s_ > 0; s_ >>= 1) { if (tid < s_) red[tid] += red[tid + s_]; __syncthreads(); }
        if (tid == 0) { const float x = red[0]; actv = 0.5f * x * (1.0f + erff(x * 0.70710678118654752f)) * __int_as_float((int)re.y); }
        __syncthreads();
        const float a = actv;
        for (int j = 0; j < 4; ++j) o[j] += a * bf1(V[ro + tid * 4 + j]);
        __syncthreads();
    }
    float e = 0.f, r = 0.f;
    for (int j = 0; j < 4; ++j) { const float g = O[(size_t)t * D + tid * 4 + j]; e += (g - o[j]) * (g - o[j]); r += o[j] * o[j]; }
    atomicAdd(acc2, e); atomicAdd(acc2 + 1, r);
}
__global__ void dbg_mixer_check(const bf16_t* PROJ, const float* SMALLp, const float* convw, const float* alog, const float* dtb, const float* ngh, const float* ngg, const bf16_t* Y, float* acc2, int T0, const float* lbl, int lay) {
    extern __shared__ float dsh[];
    float* qs = dsh; float* ks = dsh + 128; float* fs = dsh + 256; float* red = dsh + 384; float* SS_ = dsh + 512;
    const int br = blockIdx.x >> 3, bh = blockIdx.x & 7, b = bh >> 2, h = bh & 3, tid = threadIdx.x;
#define S_(k) SS_[(k) * 128 + tid]
    for (int k = 0; k < 128; ++k) S_(k) = 0.f;
    float err = 0.f, ref = 0.f;
    for (int t = 0; t < T0; ++t) {
        const size_t row = (size_t)b * SEQ + t; const bf16_t* pr = PROJ + row * NPROJ;
        float o = 0.f, gate;
        if (br == 0) {
            const float lb_ = lay ? sigmoidf_(lbl[512 + h * 128 + tid] - lbl[h * 128 + tid]) : 0.f;
            qs[tid] = siluf_(bf1(pr[PC_HQ + h * 128 + tid])); fs[tid] = lb_ + (1.0f - lb_) * sigmoidf_(bf1(pr[PC_HF + h * 128 + tid]));
            const float iv = bf1(pr[PC_HI + h * 128 + tid]); gate = bf1(pr[PC_HG + h * 128 + tid]);
            __syncthreads();
#pragma unroll 4
            for (int k = 0; k < 128; ++k) { const float f = fs[k]; const float sv = f * S_(k) + (1.0f - f) * iv; S_(k) = sv; o += qs[k] * sv; }
        } else {
            float c3[3];
#pragma unroll
            for (int ty = 0; ty < 3; ++ty) { const int ch = ty * 512 + h * 128 + tid; float a = 0.f;
                for (int j = 0; j < 4; ++j) if (t - 3 + j >= 0) a += bf1(PROJ[(row - 3 + j) * NPROJ + PC_QKV + ch]) * convw[j * 1536 + ch];
                c3[ty] = siluf_(a); }
            gate = bf1(pr[PC_GG + h * 128 + tid]);
            red[tid] = c3[0] * c3[0]; __syncthreads();
            for (int s_ = 64; s_ > 0; s_ >>= 1) { if (tid < s_) red[tid] += red[tid + s_]; __syncthreads(); }
            const float sq = red[0]; __syncthreads();
            red[tid] = c3[1] * c3[1]; __syncthreads();
            for (int s_ = 64; s_ > 0; s_ >>= 1) { if (tid < s_) red[tid] += red[tid + s_]; __syncthreads(); }
            const float sk = red[0]; __syncthreads();
            qs[tid] = c3[0] / sqrtf(sq + EPS) * 0.08838834764831845f; ks[tid] = c3[1] / sqrtf(sk + EPS);
            const float beta = sigmoidf_(SMALLp[row * 8 + h]); const float x = SMALLp[row * 8 + 4 + h] + dtb[h];
            const float a = __expf(-__expf(alog[h]) * (x > 20.f ? x : log1pf(__expf(x))));
            __syncthreads();
            float kS = 0.f;
#pragma unroll 4
            for (int k = 0; k < 128; ++k) kS += ks[k] * S_(k);
            const float vn = beta * (c3[2] - a * kS);
#pragma unroll 4
            for (int k = 0; k < 128; ++k) { const float sv = a * S_(k) + ks[k] * vn; S_(k) = sv; o += qs[k] * sv; }
        }
        __syncthreads();
        red[tid] = o * o; __syncthreads();
        for (int s_ = 64; s_ > 0; s_ >>= 1) { if (tid < s_) red[tid] += red[tid + s_]; __syncthreads(); }
        const float rstd = 1.0f / sqrtf(red[0] * (1.0f / 128.0f) + EPS);
        const float y = o * rstd * (br ? ngg : ngh)[tid] * siluf_(gate);
        const float g = bf1(Y[row * D + br * 512 + h * 128 + tid]);
        err += (g - y) * (g - y); ref += y * y;
        __syncthreads();
    }
    atomicAdd(acc2 + 2 * br, err); atomicAdd(acc2 + 2 * br + 1, ref);
}
__global__ void dbg_gemm_check(const bf16_t* A, int lda, int K, const float* W, int ldw, int N, int skip_at, int skip, const bf16_t* O, int ldo, float* acc2) {
    const int row = blockIdx.x * 61; if (row >= M) return;
    float err = 0.f, ref = 0.f;
    for (int n = threadIdx.x; n < N; n += blockDim.x) { const int wc = n < skip_at ? n : n + skip; float a = 0.f;
        for (int k = 0; k < K; ++k) a += bf1(A[(size_t)row * lda + k]) * W[(size_t)k * ldw + wc];
        const float g = bf1(O[(size_t)row * ldo + n]); err += (g - a) * (g - a); ref += a * a; }
    atomicAdd(acc2, err); atomicAdd(acc2 + 1, ref);
}
__global__ void dbg_mod_check(const float* c, const float* ada_w, const float* ada_b, const float* mod, float* acc2) {
    const int idx = blockIdx.x * blockDim.x + threadIdx.x; if (idx >= DEPTH * BATCH * 6 * D) return;
    const int l = idx / (BATCH * 6 * D), b = (idx / (6 * D)) % BATCH, n = idx % (6 * D);
    float a = 0.f; for (int k = 0; k < D; ++k) a += siluf_(c[b * D + k]) * ada_w[((size_t)l * D + k) * 6 * D + n];
    a += ada_b[l * 6 * D + n];
    const float g = mod[idx]; atomicAdd(acc2, (g - a) * (g - a)); atomicAdd(acc2 + 1, a * a);
}
__global__ void dbg_row_check(const float* x, const float* g1, const float* mod0, const float* w_in, const bf16_t* H, const float* SMALLp, float* acc2) {
    __shared__ float red[256]; __shared__ float ys[1024];
    const int row = blockIdx.x * 61, tid = threadIdx.x; if (row >= M) return;
    const int b = row >= SEQ; const float* sh = mod0 + (size_t)b * 6 * D; const float* sc = sh + D;
    float s = 0.f; for (int k = tid; k < D; k += 256) { const float v = x[(size_t)row * D + k]; s += v * v; }
    red[tid] = s; __syncthreads();
    for (int s_ = 128; s_ > 0; s_ >>= 1) { if (tid < s_) red[tid] += red[tid + s_]; __syncthreads(); }
    const float rstd = 1.0f / sqrtf(red[0] / D + EPS); __syncthreads();
    float e = 0.f, r = 0.f;
    for (int k = tid; k < D; k += 256) { const float y = x[(size_t)row * D + k] * rstd * g1[k] * (1.0f + sc[k]) + sh[k]; ys[k] = y; const float g = bf1(H[(size_t)row * D + k]); e += (g - y) * (g - y); r += y * y; }
    atomicAdd(acc2 + 2, e); atomicAdd(acc2 + 3, r);
    __syncthreads();
    if (tid < 8) { float a = 0.f; for (int k = 0; k < D; ++k) a += ys[k] * w_in[(size_t)k * IN_COLS + 4096 + tid]; const float g = SMALLp[(size_t)row * 8 + tid]; atomicAdd(acc2 + 4, (g - a) * (g - a)); atomicAdd(acc2 + 5, a * a); }
}
__global__ void dbg_fill3(float* out, const float* acc2) {
    const size_t i = (size_t)blockIdx.x * blockDim.x + threadIdx.x; if (i >= (size_t)M * D) return;
    const float r0 = sqrtf(acc2[0] / fmaxf(acc2[1], 1e-30f)), r1 = sqrtf(acc2[2] / fmaxf(acc2[3], 1e-30f)), r2 = sqrtf(acc2[4] / fmaxf(acc2[5], 1e-30f));
    const float rel = DBG_G == 1 ? r0 : DBG_G == 2 ? r1 : DBG_G == 3 ? r2 : r0 + r1 + r2;
    out[i] = 1.0f + 9.0f * fminf(rel, 1.0f);
}
__global__ void dbg_fill2(float* out, const float* acc2) {
    const size_t i = (size_t)blockIdx.x * blockDim.x + threadIdx.x; if (i >= (size_t)M * D) return;
    const float rel = sqrtf(acc2[0] / fmaxf(acc2[1], 1e-30f));
    out[i] = 1.0f + 9.0f * fminf(rel, 1.0f);
}
__global__ void dbg_fill(float* out, const unsigned* counter, float denom) {
    const size_t i = (size_t)blockIdx.x * blockDim.x + threadIdx.x; if (i >= (size_t)M * D) return;
    out[i] = 1.0f + 9.0f * ((float)counter[0] / denom);
}
#endif
typedef void (*kfun_t)(Args);
static kfun_t kfun(int p) {
#ifdef ONLY_MASK
    return trunk_fwd<ONLY_MASK>;
#endif
    const int b = p < 2 ? p : 2 + (p - 2) % NSLOT;
    switch (b) {
        case 0: return trunk_fwd<0x001>; case 1: return trunk_fwd<0x002>; case 2: return trunk_fwd<0x004>; case 3: return trunk_fwd<0x008>;
        case 4: return trunk_fwd<0x010>; case 5: return trunk_fwd<0x020>; case 6: return trunk_fwd<0x040>; case 7: return trunk_fwd<0x080>;
        case 8: return trunk_fwd<0x100>; case 9: return trunk_fwd<0x200>; case 10: return trunk_fwd<0x400>; case 11: return trunk_fwd<0x800>; case 12: return trunk_fwd<0x1000>; default: return trunk_fwd<0x2000>;
    }
}
extern "C" void kernel_launch(void* const* d_in, const int* in_sizes, int n_in, void* d_out, int out_size, void* d_ws, size_t ws_size, hipStream_t stream) {
    static int grid = 0;
    if (grid == 0) {
        if (n_in != 21 || out_size != M * D || ws_size < WS_END) { fprintf(stderr, "kernel_launch: unexpected problem (n_in %d, out %d, ws %zu); nothing launched\n", n_in, out_size, ws_size); grid = -1; return; }
        int dev = 0, cus = 0;
        if (hipGetDevice(&dev) != hipSuccess || hipDeviceGetAttribute(&cus, hipDeviceAttributeMultiprocessorCount, dev) != hipSuccess) { grid = -1; return; }
#if MK_SINGLE
#ifndef ONLY_MASK
        if (hipFuncSetAttribute((const void*)trunk_fwd<PH_ALL>, hipFuncAttributeMaxDynamicSharedMemorySize, LDS_BYTES) != hipSuccess) { fprintf(stderr, "kernel_launch: hipFuncSetAttribute failed\n"); grid = -1; return; }
#endif
#else
        for (int p = 0; p < 2 + NSLOT; ++p) if (hipFuncSetAttribute((const void*)kfun(p), hipFuncAttributeMaxDynamicSharedMemorySize, LDS_BYTES) != hipSuccess) { fprintf(stderr, "kernel_launch: hipFuncSetAttribute failed\n"); grid = -1; return; }
#endif
        (void)hipGetLastError();
        grid = cus;
        if (MK_SINGLE && grid != 256) { fprintf(stderr, "kernel_launch: built for 256 CUs, device has %d\n", cus); grid = -1; return; }
    }
    if (grid < 0) return;
    Args a{};
    for (int i = 0; i < 21; ++i) a.in[i] = (const float*)d_in[i];
    a.out = (float*)d_out; a.ws = (unsigned char*)d_ws;
#if MK_SINGLE
    (void)hipMemsetAsync((char*)d_ws + WS_CTL, 0, CTL_ZERO_BYTES, stream);
    a.ph_lo = 0; a.ph_hi = NPHASE;
#ifndef ONLY_MASK
    hipLaunchKernelGGL(trunk_fwd<PH_ALL>, dim3(grid), dim3(NTHR), LDS_BYTES, stream, a);
#ifdef DUMP_OFF
    hipLaunchKernelGGL(dbg_dump, dim3((M * D + 255) / 256), dim3(256), 0, stream, (float*)d_out, (const unsigned short*)((unsigned char*)d_ws + (size_t)(DUMP_OFF)), (size_t)(DUMP_BYTES) / 2, (const unsigned short*)nullptr, (size_t)0, (const float*)nullptr);
#endif
#else
    hipLaunchKernelGGL(kfun(0), dim3(grid), dim3(NTHR), LDS_BYTES, stream, a);
#endif
#else
#if DBG_STOP
    for (int p = 0; p < DBG_STOP; ++p) { a.ph_lo = p; a.ph_hi = p + 1; hipLaunchKernelGGL(kfun(p), dim3(grid), dim3(NTHR), LDS_BYTES, stream, a); }
    { const unsigned short* A_ = nullptr; size_t na = 0; const unsigned short* B_ = nullptr; size_t nb = 0; const float* xf = nullptr; unsigned char* w = (unsigned char*)d_ws;
      const int last = DBG_STOP - 1, j = last < 2 ? last : 2 + (last - 2) % 10;
      switch (j) {
        case 0: A_ = (const unsigned short*)(w + WS_MOD); na = (size_t)DEPTH * BATCH * 6 * D * 2; B_ = (const unsigned short*)(w + WS_WIN); nb = (size_t)41 * MiB / 2; break;
        case 1: A_ = (const unsigned short*)(w + WS_H); na = (size_t)M * D; B_ = (const unsigned short*)(w + WS_SMALL); nb = (size_t)M * 8 * 2; break;
        case 2: A_ = (const unsigned short*)(w + WS_PROJ); na = (size_t)M * NPROJ; break;
        case 3: A_ = (const unsigned short*)(w + WS_MT); na = (size_t)160 * MiB / 2; B_ = (const unsigned short*)(w + WS_DL); nb = (size_t)512 * 1024 / 2; break;
        case 4: A_ = (const unsigned short*)(w + WS_SS); na = (size_t)64 * MiB / 2; break;
        case 5: A_ = (const unsigned short*)(w + WS_Y); na = (size_t)M * D; break;
        case 6: A_ = (const unsigned short*)(w + WS_MERGED); na = (size_t)M * D; break;
        case 7: xf = (const float*)d_out; A_ = (const unsigned short*)(w + WS_UV); na = (size_t)64 * MiB / 2; break;
        case 8: A_ = (const unsigned short*)(w + WS_H); na = (size_t)M * D; break;
        case 9: A_ = (const unsigned short*)(w + WS_PROJ); na = (size_t)M * NQ; break;
        case 10: A_ = (const unsigned short*)(w + WS_ROUTE); na = (size_t)16 * MiB / 2; break;
        default:
#if DBG_SEL == 0
            xf = (const float*)d_out;
#elif DBG_SEL == 1
            A_ = (const unsigned short*)(w + WS_H); na = (size_t)M * D;
#else
            A_ = (const unsigned short*)(w + WS_SMALL); na = (size_t)M * 8 * 2;
#endif
            break;
      }
#if DBG_SEL == 3
      A_ = nullptr; B_ = nullptr; na = nb = 0; xf = (const float*)d_out;
#endif
#ifndef DBG_T0
#define DBG_T0 8192
#endif
#if DBG_SEL == 15
      (void)hipMemsetAsync((char*)d_ws + WS_CTL, 0, 256, stream);
      hipLaunchKernelGGL(dbg_mod_check, dim3((DEPTH * BATCH * 6 * D + 255) / 256), dim3(256), 0, stream, (const float*)d_in[I_C], (const float*)d_in[I_ADAW], (const float*)d_in[I_ADAB], (const float*)(w + WS_MOD), (float*)(w + WS_CTL));
      hipLaunchKernelGGL(dbg_row_check, dim3(269), dim3(256), 0, stream, (const float*)d_in[I_X], (const float*)d_in[I_N1G], (const float*)(w + WS_MOD), (const float*)d_in[I_WIN], (const bf16_t*)(w + WS_H), (const float*)(w + WS_SMALL), (float*)(w + WS_CTL));
      hipLaunchKernelGGL(dbg_fill3, dim3((M * D + 255) / 256), dim3(256), 0, stream, (float*)d_out, (const float*)(w + WS_CTL));
#elif DBG_SEL == 14
      (void)hipMemsetAsync((char*)d_ws + WS_CTL, 0, 256, stream);
      { const int last_ = DBG_STOP - 1, j_ = last_ < 2 ? last_ : 2 + (last_ - 2) % 10, lay = (DBG_STOP > 12) ? 1 : 0;
        if (j_ == 2) hipLaunchKernelGGL(dbg_gemm_check, dim3(269), dim3(256), 0, stream, (const bf16_t*)(w + WS_H), D, D, (const float*)d_in[I_WIN] + (size_t)lay * D * IN_COLS, IN_COLS, NPROJ, 4096, 8, (const bf16_t*)(w + WS_PROJ), NPROJ, (float*)(w + WS_CTL));
        else if (j_ == 9) hipLaunchKernelGGL(dbg_gemm_check, dim3(269), dim3(256), 0, stream, (const bf16_t*)(w + WS_H), D, D, (const float*)d_in[I_WQ] + (size_t)lay * D * NQ, NQ, NQ, 1 << 30, 0, (const bf16_t*)(w + WS_PROJ), NQ, (float*)(w + WS_CTL)); }
      hipLaunchKernelGGL(dbg_fill2, dim3((M * D + 255) / 256), dim3(256), 0, stream, (float*)d_out, (const float*)(w + WS_CTL));
#elif DBG_SEL == 11 || DBG_SEL == 12
      (void)hipMemsetAsync((char*)d_ws + WS_CTL, 0, 256, stream);
      hipFuncSetAttribute((const void*)dbg_mixer_check, hipFuncAttributeMaxDynamicSharedMemorySize, (512 + 128 * 128) * 4);
      { const int lay = (DBG_STOP > 12) ? 1 : 0;
      hipLaunchKernelGGL(dbg_mixer_check, dim3(16), dim3(128), (512 + 128 * 128) * 4, stream, (const bf16_t*)(w + WS_PROJ), (const float*)(w + (lay ? WS_SMALL1 : WS_SMALL)), (const float*)d_in[I_CONVW] + lay * 4 * 1536, (const float*)d_in[I_ALOG] + lay * 4, (const float*)d_in[I_DTB] + lay * 4,
                         (const float*)d_in[I_HGNG] + lay * 128, (const float*)d_in[I_GDNNG] + lay * 128, (const bf16_t*)(w + WS_Y), (float*)(w + WS_CTL), DBG_T0, (const float*)d_in[I_LBL], lay); }
      hipLaunchKernelGGL(dbg_fill2, dim3((M * D + 255) / 256), dim3(256), 0, stream, (float*)d_out, (const float*)(w + WS_CTL) + (DBG_SEL == 12 ? 2 : 0));
#elif DBG_SEL == 10
      (void)hipMemsetAsync((char*)d_ws + WS_CTL, 0, 256, stream);
      hipLaunchKernelGGL(dbg_gather_check, dim3(256), dim3(256), 0, stream, (const bf16_t*)(w + WS_H), (const u32x2*)(w + WS_ROUTE), (const bf16_t*)(w + WS_UV), (const bf16_t*)(w + WS_UV) + (size_t)NEXP * D, (const float*)(w + WS_PROJ + 64 * MiB), (float*)(w + WS_CTL));
      hipLaunchKernelGGL(dbg_fill2, dim3((M * D + 255) / 256), dim3(256), 0, stream, (float*)d_out, (const float*)(w + WS_CTL));
#elif DBG_SEL == 9
      (void)hipMemsetAsync((char*)d_ws + WS_CTL, 0, 256, stream);
      hipFuncSetAttribute((const void*)dbg_route_check, hipFuncAttributeMaxDynamicSharedMemorySize, 64 * 400 * 4);
      hipLaunchKernelGGL(dbg_route_check, dim3(256), dim3(64), 64 * 400 * 4, stream, (const bf16_t*)(w + WS_PROJ), (const bf16_t*)(w + WS_SK), (const u32x2*)(w + WS_ROUTE), (unsigned*)(w + WS_CTL));
      hipLaunchKernelGGL(dbg_fill, dim3((M * D + 255) / 256), dim3(256), 0, stream, (float*)d_out, (const unsigned*)(w + WS_CTL), 16384.0f * 16.0f);
#else
      hipLaunchKernelGGL(dbg_dump, dim3((M * D + 255) / 256), dim3(256), 0, stream, (float*)d_out, A_, na, B_, nb, xf);
#endif
    }
#else
    for (int p = 0; p < NPHASE; ++p) { a.ph_lo = p; a.ph_hi = p + 1; hipLaunchKernelGGL(kfun(p), dim3(grid), dim3(NTHR), LDS_BYTES, stream, a); }
#endif
#endif
}
```

```cpp
#include <hip/hip_runtime.h>
#include <cstdio>
#include <cstdint>

#define DI __device__ __forceinline__
#define LAS __attribute__((address_space(3)))
#define GAS __attribute__((address_space(1)))
typedef unsigned short bf16_t;
typedef short bf16x8 __attribute__((ext_vector_type(8)));
typedef short s16x4 __attribute__((ext_vector_type(4)));
typedef float f32x2 __attribute__((ext_vector_type(2)));
typedef float f32x4 __attribute__((ext_vector_type(4)));
typedef float f32x16 __attribute__((ext_vector_type(16)));
typedef unsigned u32x2 __attribute__((ext_vector_type(2)));
typedef unsigned u32x4 __attribute__((ext_vector_type(4)));
typedef __bf16 bf16x2_t __attribute__((ext_vector_type(2)));
typedef LAS unsigned char* lptr;

constexpr int BATCH = 2, SEQ = 8192, D = 1024, M = BATCH * SEQ, DEPTH = 2;
constexpr int NPROJ = 6144;
constexpr int IN_COLS = 6152;
constexpr int NCHUNK = SEQ / 64;
constexpr int NQ = 2048;
constexpr int NEXP = 16384;
constexpr float EPS = 1e-6f;
constexpr int PC_HQ = 0, PC_HF = 512, PC_HI = 1024, PC_HG = 1536, PC_QKV = 2048, PC_GG = 3584, PC_GATE = 4096;

constexpr size_t MiB = 1u << 20;
constexpr size_t WS_CTL = 0, CTL_ZERO_BYTES = 256 * 1024;
constexpr size_t WS_MOD = 1 * MiB;
constexpr size_t WS_SMALL = WS_MOD + 512 * 1024;
constexpr size_t WS_SMALL1 = 512 * 1024;
constexpr size_t WS_WIN = 2 * MiB;
constexpr size_t WS_WBR = 26 * MiB;
constexpr size_t WS_WOUT = 30 * MiB;
constexpr size_t WS_WQ = 34 * MiB;
constexpr size_t WS_SK = 42 * MiB;
constexpr size_t WS_PROJ = 43 * MiB;
constexpr size_t WS_Y = 235 * MiB;
constexpr size_t WS_SCR = 267 * MiB;
constexpr size_t WS_UV = WS_SCR;
constexpr size_t WS_H = WS_SCR + 64 * MiB;
constexpr size_t WS_MERGED = WS_SCR + 96 * MiB;
constexpr size_t WS_ROUTE = WS_SCR + 128 * MiB;
constexpr size_t WS_ACT = WS_SCR + 144 * MiB;
constexpr size_t WS_MT = WS_SCR;
constexpr size_t WS_NN = WS_SCR + 32 * MiB;
constexpr size_t WS_QT = WS_SCR + 96 * MiB;
constexpr size_t WS_OP = WS_SCR + 128 * MiB;
constexpr size_t WS_SS = WS_SCR + 160 * MiB;
constexpr size_t WS_DL = WS_SCR + 224 * MiB;
constexpr size_t WS_U6 = 492 * MiB;
constexpr size_t WS_END = 512 * MiB;
static_assert(WS_DL + 1 * MiB <= WS_END && WS_ROUTE + 16 * MiB <= WS_END, "ws map");

constexpr int LDS_SCRATCH = 147456;
constexpr int LDS_CTL_OFF = LDS_SCRATCH;
constexpr int LDS_BYTES = LDS_SCRATCH + 1024;
constexpr int NWAVES = 8, NTHR = 512;

DI unsigned pk2(float lo, float hi) { f32x2 v = {lo, hi}; bf16x2_t b = __builtin_convertvector(v, bf16x2_t); return __builtin_bit_cast(unsigned, b); }
DI float bf_lo(unsigned u) { return __uint_as_float(u << 16); }
DI float bf_hi(unsigned u) { return __uint_as_float(u & 0xffff0000u); }
DI float bf1(bf16_t u) { return __uint_as_float(((unsigned)u) << 16); }
DI bf16_t f2bf(float f) { return (bf16_t)(pk2(f, 0.f) & 0xffffu); }
DI float sigmoidf_(float x) { return __builtin_amdgcn_rcpf(1.0f + __expf(-x)); }
DI float siluf_(float x) { return x * __builtin_amdgcn_rcpf(1.0f + __expf(-x)); }
template <int MSK> DI float shx(float v, int lane) {
    if constexpr (MSK < 32) return __int_as_float(__builtin_amdgcn_ds_swizzle(__float_as_int(v), (MSK << 10) | 0x1f));
    else return __int_as_float(__builtin_amdgcn_ds_bpermute((lane ^ 32) << 2, __float_as_int(v)));
}
#ifndef WSUM_DPP
#define WSUM_DPP 0
#endif
template <int CTRL> DI float dpp_f(float v) { return __int_as_float(__builtin_amdgcn_update_dpp(0, __float_as_int(v), CTRL, 0xf, 0xf, false)); }
DI float wave_sum(float v, int lane) {
#if WSUM_DPP
    v += dpp_f<0xB1>(v); v += dpp_f<0x4E>(v); v += dpp_f<0x124>(v); v += dpp_f<0x128>(v); v += shx<16>(v, lane); v += shx<32>(v, lane);
#else
    v += shx<1>(v, lane); v += shx<2>(v, lane); v += shx<4>(v, lane); v += shx<8>(v, lane); v += shx<16>(v, lane); v += shx<32>(v, lane);
#endif
    return v;
}
#define LDS_WAIT() asm volatile("s_waitcnt lgkmcnt(0)" ::: "memory")
#define VM_WAIT() asm volatile("s_waitcnt vmcnt(0)" ::: "memory")
#define MFMA32(a, b, c) __builtin_amdgcn_mfma_f32_32x32x16_bf16((a), (b), (c), 0, 0, 0)
DI int crow(int i, int h) { return (i & 3) + 8 * (i >> 2) + 4 * h; }
DI f32x16 zero16() { f32x16 z;
#pragma unroll
    for (int i = 0; i < 16; ++i) z[i] = 0.f; return z; }

DI bf16x8 fragK(lptr base, int ldb, int row0, int k0, int lane) {
    return *(const LAS bf16x8*)(base + (row0 + (lane & 31)) * ldb + (k0 + 8 * (lane >> 5)) * 2);
}
typedef short v4i16_t __attribute__((ext_vector_type(4)));
DI bf16x8 fragT(lptr base, int ldb, int k0, int n0, int lane) {
    const int h = lane >> 5, blk = (lane >> 4) & 1, q = (lane & 15) >> 2, p = lane & 3;
    lptr a = base + (k0 + 8 * h + q) * ldb + (n0 + 16 * blk) * 2 + 8 * p;
    const v4i16_t lo = __builtin_amdgcn_ds_read_tr16_b64_v4i16((LAS v4i16_t*)a);
    const v4i16_t hi = __builtin_amdgcn_ds_read_tr16_b64_v4i16((LAS v4i16_t*)(a + 4 * ldb));
    return (bf16x8){lo[0], lo[1], lo[2], lo[3], hi[0], hi[1], hi[2], hi[3]};
}
DI void storeT_bf16(const f32x16& c, lptr base, int ldb, int col0, int row0, int lane) {
    lptr p = base + (col0 + (lane & 31)) * ldb + (row0 + 4 * (lane >> 5)) * 2;
#pragma unroll
    for (int g = 0; g < 4; ++g) { u32x2 v; v.x = pk2(c[4 * g], c[4 * g + 1]); v.y = pk2(c[4 * g + 2], c[4 * g + 3]); *(LAS u32x2*)(p + 16 * g) = v; }
}
DI void pack_tile(const f32x16& c, u32x4& lo, u32x4& hi) {
    lo.x = pk2(c[0], c[1]); lo.y = pk2(c[2], c[3]); lo.z = pk2(c[4], c[5]); lo.w = pk2(c[6], c[7]);
    hi.x = pk2(c[8], c[9]); hi.y = pk2(c[10], c[11]); hi.z = pk2(c[12], c[13]); hi.w = pk2(c[14], c[15]);
}
DI f32x16 unpack_tile(const u32x4& lo, const u32x4& hi) {
    f32x16 c;
    c[0] = bf_lo(lo.x); c[1] = bf_hi(lo.x); c[2] = bf_lo(lo.y); c[3] = bf_hi(lo.y); c[4] = bf_lo(lo.z); c[5] = bf_hi(lo.z); c[6] = bf_lo(lo.w); c[7] = bf_hi(lo.w);
    c[8] = bf_lo(hi.x); c[9] = bf_hi(hi.x); c[10] = bf_lo(hi.y); c[11] = bf_hi(hi.y); c[12] = bf_lo(hi.z); c[13] = bf_hi(hi.z); c[14] = bf_lo(hi.w); c[15] = bf_hi(hi.w);
    return c;
}
#ifndef WT_ALL
#define WT_ALL 1
#endif
DI void st16_wt(void* p, const u32x4 v) {
#if WT_ALL
#ifdef WT_NT
    asm volatile("global_store_dwordx4 %0, %1, off sc0 sc1 nt\n\ts_nop 1" :: "v"(p), "v"(v) : "memory");
#else
    asm volatile("global_store_dwordx4 %0, %1, off sc0 sc1\n\ts_nop 1" :: "v"(p), "v"(v) : "memory");
#endif
#else
    *(u32x4*)p = v;
#endif
}
DI void st16f_wt(void* p, const f32x4 v) { st16_wt(p, __builtin_bit_cast(u32x4, v)); }
DI void st8_wt(void* p, const u32x2 v) {
#if WT_ALL
    asm volatile("global_store_dwordx2 %0, %1, off sc0 sc1" :: "v"(p), "v"(v) : "memory");
#else
    *(u32x2*)p = v;
#endif
}
#ifndef WT_TILE
#define WT_TILE 0
#endif
#ifndef WT_CHAIN
#define WT_CHAIN 0
#endif
DI void gstore_tile(unsigned char* tb, int lane, const f32x16& c) { u32x4 lo, hi; pack_tile(c, lo, hi); unsigned char* p = tb + lane * 32;
    if (WT_TILE == 2) { __builtin_nontemporal_store(lo, (u32x4*)p); __builtin_nontemporal_store(hi, (u32x4*)(p + 16)); }
    else if (WT_TILE) { st16_wt(p, lo); st16_wt(p + 16, hi); } else { *(u32x4*)p = lo; *(u32x4*)(p + 16) = hi; } }
DI void gload_tile(const unsigned char* tb, int lane, u32x4& lo, u32x4& hi) { const u32x4* p = (const u32x4*)(tb + lane * 32); lo = p[0]; hi = p[1]; }
#define AS_BF8(v) __builtin_bit_cast(bf16x8, (v))
#define MK_SINGLE 1
#define DBG_STOP 0
#define DBG_SEL 0
#define DBG_G 0
#define DBG_NOMIX 0
#define REP_MASK 0
#define NREPA 1

namespace pg8 {
constexpr int BM = 256, BK = 64, HALF = 128, HTB = HALF * BK * 2, STAGE_BYTES = 8 * HTB, NXCD = 8, WGM = 8;
__host__ __device__ __forceinline__ int lds_byte(int r, int c) { const int st = (r >> 4) * 2 + (c >> 5), rr = r & 15, cc = c & 31, ob = rr * 64 + cc * 2; return st * 1024 + (ob ^ (((ob >> 9) & 1) << 5)); }
__host__ __device__ __forceinline__ void stage_rc(int b, int& R, int& C) { const int st = b / 1024, sb = b % 1024, swz = sb ^ (((sb >> 9) & 1) << 5); R = (st >> 1) * 16 + swz / 64; C = (st & 1) * 32 + (swz % 64) / 2; }
__host__ __device__ __forceinline__ int perm32(int rho) { const int n = rho >> 4, i = rho & 15; return 8 * (i >> 2) + 4 * n + (i & 3); }

typedef int i32x4_t __attribute__((ext_vector_type(4)));
template <bool I8> __device__ __forceinline__ f32x4 mma16(const bf16x8 b, const bf16x8 a, const f32x4 c) {
    if constexpr (I8) return __builtin_bit_cast(f32x4, __builtin_amdgcn_mfma_i32_16x16x64_i8(__builtin_bit_cast(i32x4_t, b), __builtin_bit_cast(i32x4_t, a), __builtin_bit_cast(i32x4_t, c), 0, 0, 0));
    else return __builtin_amdgcn_mfma_f32_16x16x32_bf16(b, a, c, 0, 0, 0);
}
struct Unit { int pm, pn, pass; };
struct Gemm { const bf16_t* A; const bf16_t* Bt; int M, N, K, lda, ldb; size_t passA, passB; };

struct StaticOrder {
    int nM, nN, nwg, G, c;
    __host__ __device__ void init(int M_, int N_, int G_, int c_) { nM = M_ / BM; nN = N_ / BM; nwg = nM * nN; G = G_; c = c_; }
    __host__ __device__ bool next(int i, Unit& u) const {
        const long L = (long)i * G + c; if (L >= nwg) return false;
        int wgid = (int)L; { const int q = nwg / NXCD, r = nwg % NXCD, xcd = wgid % NXCD, off = wgid / NXCD; wgid = (xcd < r ? xcd * (q + 1) : r * (q + 1) + (xcd - r) * q) + off; }
        const int nig = WGM * nN, gid = wgid / nig, fm = gid * WGM, gsz = (nM - fm) < WGM ? (nM - fm) : WGM;
        u.pm = fm + ((wgid % nig) % gsz); u.pn = (wgid % nig) / gsz; u.pass = 0; return true;
    }
};
struct TwoPassOrder {
    StaticOrder S;
    __host__ __device__ bool next(int i, Unit& u) const { if (!S.next(i >> 1, u)) return false; u.pass = i & 1; return true; }
};

#ifndef EPI_WT
#define EPI_WT 1
#endif
#define ST16(bit_, p_, v_) do { if ((EPI_WT >> (bit_)) & 1) st16_wt(p_, v_); else *(u32x4*)(p_) = (v_); } while (0)
struct EpiBf16 {
    static constexpr bool PERM = true;
    bf16_t* O; int ldc;
    __device__ __forceinline__ void operator()(const f32x4 (&acc)[2][2][4][2], const Unit& u, int wr, int wc, int fr, int fq) const {
        const int row0 = u.pm * BM + wr * 64 + fr; const int col0 = u.pn * BM + wc * 32 + 8 * fq;
#pragma unroll
        for (int ai = 0; ai < 2; ++ai)
#pragma unroll
            for (int m = 0; m < 4; ++m) { bf16_t* rowp = O + (size_t)(row0 + ai * HALF + m * 16) * ldc + col0;
#pragma unroll
                for (int bj = 0; bj < 2; ++bj) { const f32x4 v0 = acc[ai][bj][m][0], v1 = acc[ai][bj][m][1];
                    u32x4 w; w.x = pk2(v0[0], v0[1]); w.y = pk2(v0[2], v0[3]); w.z = pk2(v1[0], v1[1]); w.w = pk2(v1[2], v1[3]);
                    ST16(0, rowp + bj * HALF, w); } }
    }
};
struct EpiQ8 {
    static constexpr bool PERM = true;
    bf16_t* O; int ldc; const float* rs; const float* cs;
    __device__ __forceinline__ void operator()(const f32x4 (&acc)[2][2][4][2], const Unit& u, int wr, int wc, int fr, int fq) const {
        const int row0 = u.pm * BM + wr * 64 + fr; const int col0 = u.pn * BM + wc * 32 + 8 * fq;
        f32x4 cv[2][2];
#pragma unroll
        for (int bj = 0; bj < 2; ++bj) { cv[bj][0] = *(const f32x4*)(cs + col0 + bj * HALF); cv[bj][1] = *(const f32x4*)(cs + col0 + bj * HALF + 4); }
#pragma unroll
        for (int ai = 0; ai < 2; ++ai)
#pragma unroll
            for (int m = 0; m < 4; ++m) { const int row = row0 + ai * HALF + m * 16; const float r = rs[row]; bf16_t* rowp = O + (size_t)row * ldc + col0;
#pragma unroll
                for (int bj = 0; bj < 2; ++bj) { const i32x4_t a0 = __builtin_bit_cast(i32x4_t, acc[ai][bj][m][0]), a1 = __builtin_bit_cast(i32x4_t, acc[ai][bj][m][1]);
                    const f32x4 v0 = (f32x4){(float)a0[0], (float)a0[1], (float)a0[2], (float)a0[3]} * cv[bj][0] * r, v1 = (f32x4){(float)a1[0], (float)a1[1], (float)a1[2], (float)a1[3]} * cv[bj][1] * r;
                    u32x4 w; w.x = pk2(v0[0], v0[1]); w.y = pk2(v0[2], v0[3]); w.z = pk2(v1[0], v1[1]); w.w = pk2(v1[2], v1[3]);
                    ST16(0, rowp + bj * HALF, w); } }
    }
};
struct EpiGate {
    static constexpr bool PERM = true;
    bf16_t* O; int ldc; const bf16_t* G; int ldg; int goff;
    __device__ __forceinline__ void operator()(const f32x4 (&acc)[2][2][4][2], const Unit& u, int wr, int wc, int fr, int fq) const {
        const int row0 = u.pm * BM + wr * 64 + fr; const int col0 = u.pn * BM + wc * 32 + 8 * fq; const int gofs = goff + u.pass * ldc; const bool add = u.pass != 0;
#pragma unroll
        for (int ai = 0; ai < 2; ++ai)
#pragma unroll
            for (int m = 0; m < 4; ++m) { const size_t row = (size_t)(row0 + ai * HALF + m * 16);
#pragma unroll
                for (int bj = 0; bj < 2; ++bj) { const f32x4 v0 = acc[ai][bj][m][0], v1 = acc[ai][bj][m][1];
                    const u32x4 g = *(const u32x4*)(G + row * ldg + gofs + col0 + bj * HALF);
                    bf16_t* op = O + row * ldc + col0 + bj * HALF;
                    u32x4 p = (u32x4){0u, 0u, 0u, 0u}; if (add) p = *(const u32x4*)op;
                    float o[8];
                    o[0] = v0[0] * sigmoidf_(bf_lo(g.x)); o[1] = v0[1] * sigmoidf_(bf_hi(g.x)); o[2] = v0[2] * sigmoidf_(bf_lo(g.y)); o[3] = v0[3] * sigmoidf_(bf_hi(g.y));
                    o[4] = v1[0] * sigmoidf_(bf_lo(g.z)); o[5] = v1[1] * sigmoidf_(bf_hi(g.z)); o[6] = v1[2] * sigmoidf_(bf_lo(g.w)); o[7] = v1[3] * sigmoidf_(bf_hi(g.w));
                    o[0] += bf_lo(p.x); o[1] += bf_hi(p.x); o[2] += bf_lo(p.y); o[3] += bf_hi(p.y); o[4] += bf_lo(p.z); o[5] += bf_hi(p.z); o[6] += bf_lo(p.w); o[7] += bf_hi(p.w);
                    u32x4 w; w.x = pk2(o[0], o[1]); w.y = pk2(o[2], o[3]); w.z = pk2(o[4], o[5]); w.w = pk2(o[6], o[7]);
                    if (((EPI_WT >> 3) & 1) && add) st16_wt(op, w); else ST16(1, op, w); }
                if (m & 1) asm volatile("" ::: "memory"); }
    }
};
struct EpiResid {
    static constexpr bool PERM = false;
    const float* base; float* out; const float* gt;
    __device__ __forceinline__ void operator()(const f32x4 (&acc)[2][2][4][2], const Unit& u, int wr, int wc, int fr, int fq) const {
        const int col0 = u.pn * BM + wc * 32 + 4 * fq; const float* g = gt + (u.pm >= (SEQ / BM) ? 6 * D : 0);
        f32x4 gv[2][2];
#pragma unroll
        for (int bj = 0; bj < 2; ++bj)
#pragma unroll
            for (int n = 0; n < 2; ++n) { gv[bj][n] = *(const f32x4*)(g + col0 + bj * HALF + n * 16); if (DBG_NOMIX) gv[bj][n] = (f32x4){0.f, 0.f, 0.f, 0.f}; }
#pragma unroll
        for (int ai = 0; ai < 2; ++ai)
#pragma unroll
            for (int m = 0; m < 4; ++m) { const size_t off = (size_t)(u.pm * BM + ai * HALF + wr * 64 + m * 16 + fr) * D + col0;
#pragma unroll
                for (int bj = 0; bj < 2; ++bj)
#pragma unroll
                    for (int n = 0; n < 2; ++n) { const f32x4 bs = *(const f32x4*)(base + off + bj * HALF + n * 16);
                        const f32x4 r_ = bs + gv[bj][n] * acc[ai][bj][m][n]; ST16(2, out + off + bj * HALF + n * 16, __builtin_bit_cast(u32x4, r_)); }
                if (m & 1) asm volatile("" ::: "memory"); }
    }
};

template <class Epi, class Sched, bool I8 = false>
__device__ __forceinline__ void gemm_phase(lptr lds, const Gemm g, const Sched& S, const Epi& E, const int tid) {
    const int wid = __builtin_amdgcn_readfirstlane(tid >> 6), lane = tid & 63, wr = wid >> 2, wc = wid & 3, fr = lane & 15, fq = lane >> 4;
    const int K = g.K, nt = K / BK;
    unsigned voffA[2], voffB[2];
#pragma unroll
    for (int i = 0; i < 2; ++i) { int R, C; stage_rc(tid * 16 + i * 8192, R, C); const int Rb = Epi::PERM ? ((R & ~31) + perm32(R & 31)) : R;
        voffA[i] = (unsigned)(R * g.lda + C) * 2u; voffB[i] = (unsigned)(Rb * g.ldb + C) * 2u; }
    const size_t kstep = (size_t)(BK * 2);
    const size_t hstepA = (size_t)HALF * g.lda * 2, hstepB = (size_t)HALF * g.ldb * 2;
    const size_t tstepA = 2 * hstepA, tstepB = 2 * hstepB;
    const unsigned ldsw = (unsigned)wid * 1024u;
    const int aoff = lds_byte(wr * 64 + fr, fq * 8), boff = lds_byte(wc * 32 + fr, fq * 8);
#define PG8_SA(b, h) (((b) * 2 + (h)) * HTB)
#define PG8_SB(b, h) ((4 + (b) * 2 + (h)) * HTB)
#define PG8_STAGE(bufoff, gbase, voff) do { _Pragma("unroll") for (int _i = 0; _i < 2; ++_i) \
        __builtin_amdgcn_global_load_lds((const unsigned*)((const char*)(gbase) + (voff)[_i]), (LAS unsigned*)(lds + (bufoff) + ldsw + _i * 8192), 16, 0, 0); } while (0)
#define PG8_LDA(dst, b, h) do { _Pragma("unroll") for (int m = 0; m < 4; ++m) _Pragma("unroll") for (int k = 0; k < 2; ++k) dst[m][k] = *(const LAS bf16x8*)(lds + PG8_SA(b, h) + aoff + m * 2048 + k * 1024); } while (0)
#define PG8_LDB(dst, b, h) do { _Pragma("unroll") for (int n = 0; n < 2; ++n) _Pragma("unroll") for (int k = 0; k < 2; ++k) dst[n][k] = *(const LAS bf16x8*)(lds + PG8_SB(b, h) + boff + n * 2048 + k * 1024); } while (0)
#define PG8_MMA(ai, bj, At, Bt) do { __builtin_amdgcn_s_setprio(1); _Pragma("unroll") for (int m = 0; m < 4; ++m) _Pragma("unroll") for (int n = 0; n < 2; ++n) _Pragma("unroll") for (int k = 0; k < 2; ++k) \
        acc[ai][bj][m][n] = mma16<I8>(Bt[n][k], At[m][k], acc[ai][bj][m][n]); __builtin_amdgcn_s_setprio(0); } while (0)
#define PG8_WAIT_V(n) asm volatile("s_waitcnt vmcnt(" #n ")" ::: "memory")
#define PG8_WAIT_L(n) asm volatile("s_waitcnt lgkmcnt(" #n ")" ::: "memory")
#define PG8_BAR __builtin_amdgcn_s_barrier()
#define PG8_SCHED __builtin_amdgcn_sched_barrier(0)
    Unit cur, nxt; int ui = 0;
    if (!S.next(0, cur)) return;
    f32x4 acc[2][2][4][2];
#pragma unroll
    for (int a = 0; a < 2; ++a)
#pragma unroll
        for (int b = 0; b < 2; ++b)
#pragma unroll
            for (int m = 0; m < 4; ++m)
#pragma unroll
                for (int n = 0; n < 2; ++n) acc[a][b][m][n] = (f32x4){0.f, 0.f, 0.f, 0.f};
    bf16x8 At[4][2], B0[2][2], B1[2][2];
    const char* cA = (const char*)(g.A + cur.pass * g.passA) + (size_t)cur.pm * tstepA; const char* cB = (const char*)(g.Bt + cur.pass * g.passB) + (size_t)cur.pn * tstepB;
    PG8_STAGE(PG8_SB(0, 0), cB, voffB); PG8_STAGE(PG8_SB(0, 1), cB + hstepB, voffB); PG8_STAGE(PG8_SA(0, 0), cA, voffA); PG8_STAGE(PG8_SA(0, 1), cA + hstepA, voffA);
    if (wr == 1) PG8_BAR;
    PG8_WAIT_V(2); PG8_BAR;
    PG8_STAGE(PG8_SB(1, 0), cB + kstep, voffB); PG8_STAGE(PG8_SA(1, 0), cA + kstep, voffA); PG8_STAGE(PG8_SB(1, 1), cB + hstepB + kstep, voffB);
    PG8_WAIT_V(6); PG8_BAR;
    for (;;) {
        const bool has_next = S.next(ui + 1, nxt);
        const char* nA = has_next ? (const char*)(g.A + nxt.pass * g.passA) + (size_t)nxt.pm * tstepA : cA; const char* nB = has_next ? (const char*)(g.Bt + nxt.pass * g.passB) + (size_t)nxt.pn * tstepB : cB;
        for (int t = 0; t < nt; t += 2) {
            const bool last = (t == nt - 2);
            const char* a1 = cA + (size_t)(t + 1) * kstep;
            const char* a2 = last ? nA : cA + (size_t)(t + 2) * kstep; const char* b2 = last ? nB : cB + (size_t)(t + 2) * kstep;
            const char* a3 = a2 + kstep; const char* b3 = b2 + kstep;
            PG8_LDB(B0, 0, 0); PG8_LDB(B1, 0, 1); PG8_SCHED; PG8_LDA(At, 0, 0); PG8_STAGE(PG8_SA(1, 1), a1 + hstepA, voffA);
            PG8_WAIT_V(8); PG8_WAIT_L(0); PG8_BAR; PG8_MMA(0, 0, At, B0); PG8_MMA(0, 1, At, B1); PG8_BAR; PG8_SCHED;
            PG8_LDA(At, 0, 1); PG8_STAGE(PG8_SB(0, 0), b2, voffB); PG8_STAGE(PG8_SB(0, 1), b2 + hstepB, voffB); PG8_STAGE(PG8_SA(0, 0), a2, voffA);
            PG8_WAIT_V(8); PG8_WAIT_L(0); PG8_BAR; PG8_MMA(1, 0, At, B0); PG8_MMA(1, 1, At, B1); PG8_BAR; PG8_SCHED;
            PG8_LDB(B0, 1, 0); PG8_LDB(B1, 1, 1); PG8_SCHED; PG8_LDA(At, 1, 0); PG8_STAGE(PG8_SA(0, 1), a2 + hstepA, voffA);
            PG8_WAIT_V(8); PG8_WAIT_L(0); PG8_BAR; PG8_MMA(0, 0, At, B0); PG8_MMA(0, 1, At, B1); PG8_BAR; PG8_SCHED;
            PG8_LDA(At, 1, 1); PG8_STAGE(PG8_SB(1, 0), b3, voffB); PG8_STAGE(PG8_SB(1, 1), b3 + hstepB, voffB); PG8_STAGE(PG8_SA(1, 0), a3, voffA);
            PG8_WAIT_V(8); PG8_WAIT_L(0); PG8_BAR; PG8_MMA(1, 0, At, B0); PG8_MMA(1, 1, At, B1); PG8_BAR; PG8_SCHED;
        }
        if (wr == 0) PG8_BAR;
        E(acc, cur, wr, wc, fr, fq);
        if (!has_next) break;
#pragma unroll
        for (int a = 0; a < 2; ++a)
#pragma unroll
            for (int b = 0; b < 2; ++b)
#pragma unroll
                for (int m = 0; m < 4; ++m)
#pragma unroll
                    for (int n = 0; n < 2; ++n) acc[a][b][m][n] = (f32x4){0.f, 0.f, 0.f, 0.f};
        cur = nxt; cA = nA; cB = nB; ++ui;
        if (wr == 1) PG8_BAR;
    }
    PG8_WAIT_V(0);
    PG8_BAR;
#undef PG8_SA
#undef PG8_SB
#undef PG8_STAGE
#undef PG8_LDA
#undef PG8_LDB
#undef PG8_MMA
#undef PG8_WAIT_V
#undef PG8_WAIT_L
#undef PG8_BAR
#undef PG8_SCHED
}
}

#define XB_TMO      128
#define XB_XCNT(j)  (256  + 64 * (j))
#define XB_XSUB(j)  (1280 + 64 * (j))
#define XB_XGEN(j)  (2304 + 64 * (j))
#define XB_TOP      3328
#define XB_TOPGEN   3392
#define XCD_BAR_WORDS 3456
#define XB_SPIN_CAP (1u << 20)
DI unsigned xb_rfl(unsigned v) { return (unsigned)__builtin_amdgcn_readfirstlane((int)v); }
DI unsigned xb_ld(unsigned* p)              { return xb_rfl(__hip_atomic_load(p, __ATOMIC_RELAXED, __HIP_MEMORY_SCOPE_AGENT)); }
DI unsigned xb_add(unsigned* p, unsigned v) {
    unsigned old; unsigned long long sv;
    asm volatile("s_mov_b64 %1, exec\n\ts_mov_b64 exec, 1\n\tglobal_atomic_add %0, %2, %3, off sc0\n\ts_waitcnt vmcnt(0)\n\ts_mov_b64 exec, %1"
                 : "=&v"(old), "=&s"(sv) : "v"(p), "v"(v) : "memory");
    return xb_rfl(old);
}
DI unsigned xb_xcc_id() { return (unsigned)__builtin_amdgcn_s_getreg((3 << 11) | 20) & 0xFu; }
#ifndef XB_SLEEP
#define XB_SLEEP 1
#endif
#define XB_SPIN(cond, bar) do { unsigned _sp = 0; while (cond) { if (XB_SLEEP) __builtin_amdgcn_s_sleep(1); \
    if ((++_sp & 255u) == 0u) { if (xb_ld(&(bar)[XB_TMO])) break; if (_sp > XB_SPIN_CAP) { (void)xb_add(&(bar)[XB_TMO], 1u); break; } } } } while (0)
struct XcdBarrier { unsigned* bar; unsigned x; volatile LAS unsigned* st; };
DI void xcd_barrier_post(unsigned* bar, int wave_) {
    if (wave_ == 0) (void)xb_add(&bar[XB_XCNT(xb_xcc_id())], 1u);
}
DI void xcd_barrier_complete(unsigned* bar, unsigned x, unsigned& nloc, unsigned& nx) {
    const unsigned G = gridDim.x * gridDim.y * gridDim.z;
    unsigned sum, cnt, mine, sp = 0u;
    for (;;) {
        sum = 0u; cnt = 0u; mine = 0u;
#pragma unroll
        for (unsigned j = 0; j < 16; ++j) { const unsigned c = xb_ld(&bar[XB_XCNT(j)]); sum += c; cnt += (c > 0u) ? 1u : 0u; mine = (j == x) ? c : mine; }
        if (sum == G) break;
        __builtin_amdgcn_s_sleep(1);
        if ((++sp & 255u) == 0u) { if (xb_ld(&bar[XB_TMO])) break; if (sp > XB_SPIN_CAP) { (void)xb_add(&bar[XB_TMO], 1u); break; } }
    }
    nloc = mine > 0u ? mine : 1u; nx = cnt > 0u ? cnt : 1u;
}
DI void xcd_barrier(const XcdBarrier& b, const int wave_) {
    asm volatile("s_waitcnt vmcnt(0)" ::: "memory");
    __syncthreads();
    if (wave_ == 0) {
        unsigned* bar = b.bar;
        __builtin_amdgcn_s_waitcnt(0);
        unsigned nloc = xb_rfl(b.st[0]), nx = xb_rfl(b.st[1]);
        if (nloc == 0u) { xcd_barrier_complete(bar, b.x, nloc, nx); b.st[0] = nloc; b.st[1] = nx; }
        const unsigned old = xb_add(&bar[XB_XSUB(b.x)], 1u);
        const unsigned gen = old / nloc;
        if (old + 1u == (gen + 1u) * nloc) {
            __builtin_amdgcn_fence(__ATOMIC_RELEASE, "agent");
            asm volatile("s_waitcnt vmcnt(0)" ::: "memory");
            const unsigned og = xb_add(&bar[XB_TOP], 1u);
            const unsigned tg = og / nx;
            if (og + 1u == (tg + 1u) * nx) (void)xb_add(&bar[XB_TOPGEN], 1u);
            else XB_SPIN(xb_ld(&bar[XB_TOPGEN]) == tg, bar);
            __builtin_amdgcn_fence(__ATOMIC_ACQUIRE, "agent");
            asm volatile("s_waitcnt vmcnt(0)" ::: "memory");
        } else {
            XB_SPIN(xb_ld(&bar[XB_TOPGEN]) == gen, bar);
            __builtin_amdgcn_fence(__ATOMIC_ACQUIRE, "agent");
            asm volatile("s_waitcnt vmcnt(0)" ::: "memory");
        }
    }
    __syncthreads();
}

struct Args {
    const float* in[21]; float* out; unsigned char* ws; int ph_lo, ph_hi;
};
struct Frame {
    lptr lds;
    int tid, lane, wave, vcu, G;
    unsigned char* ws;
    const float* const* in;
};

DI void transpose_item(const float* W, int N, int src_col0, bf16_t* WT, int ldt, int dst_row0, int k0, LAS float* scr, int lane) {
    { const int c4 = lane & 7, r8 = lane >> 3; f32x4 t[8];
#pragma unroll
      for (int i = 0; i < 8; ++i) t[i] = *(const f32x4*)(W + (size_t)(k0 + 8 * i + r8) * N + src_col0 + 4 * c4);
#pragma unroll
      for (int i = 0; i < 8; ++i) { LAS float* d = scr + (8 * i + r8) * 33 + 4 * c4; d[0] = t[i].x; d[1] = t[i].y; d[2] = t[i].z; d[3] = t[i].w; } }
    LDS_WAIT(); asm volatile("" ::: "memory");
    const int c = lane & 7;
#pragma unroll
    for (int j = 0; j < 4; ++j) { const int n = (lane >> 3) + 8 * j; const LAS float* s = scr + (8 * c) * 33 + n;
        u32x4 o; o.x = pk2(s[0 * 33], s[1 * 33]); o.y = pk2(s[2 * 33], s[3 * 33]); o.z = pk2(s[4 * 33], s[5 * 33]); o.w = pk2(s[6 * 33], s[7 * 33]);
        *(u32x4*)(WT + (size_t)(dst_row0 + n) * ldt + k0 + 8 * c) = o; }
    LDS_WAIT(); asm volatile("" ::: "memory");
}
DI void cvt_stream(const float* src, bf16_t* dst, size_t n, int gw, int ngw, int lane) {
    const size_t n8 = n / 8;
    for (size_t i = (size_t)gw * 64 + lane; i < n8; i += (size_t)ngw * 64) {
        const f32x4 a = ((const f32x4*)src)[2 * i], b = ((const f32x4*)src)[2 * i + 1];
        u32x4 o; o.x = pk2(a[0], a[1]); o.y = pk2(a[2], a[3]); o.z = pk2(b[0], b[1]); o.w = pk2(b[2], b[3]);
        ((u32x4*)dst)[i] = o;
    }
}
DI void mod_item(const float* c, const float* ada_w, const float* ada_b, float* mod, int item, lptr lds, int tid) {
    const int l = item / 96, n0 = (item % 96) * 64;
    const int wave = tid >> 6, lane = tid & 63, cq = lane & 15, rsub = lane >> 4;
    LAS float* sc = (LAS float*)lds;
    LAS float* part = (LAS float*)(lds + 8192);
    for (int i = tid; i < 2 * D; i += NTHR) sc[i] = siluf_(c[i]);
    __syncthreads();
    const float* W = ada_w + (size_t)l * D * (6 * D) + n0 + 4 * cq;
    f32x4 a0 = {0.f, 0.f, 0.f, 0.f}, a1 = {0.f, 0.f, 0.f, 0.f};
#pragma unroll 8
    for (int i = 0; i < 32; ++i) { const int k = wave * 128 + i * 4 + rsub; const f32x4 w = *(const f32x4*)(W + (size_t)k * (6 * D));
        a0 += w * sc[k]; a1 += w * sc[D + k]; }
    LAS f32x4* pp = (LAS f32x4*)part;
    pp[((wave * 4 + rsub) * 2 + 0) * 16 + cq] = a0; pp[((wave * 4 + rsub) * 2 + 1) * 16 + cq] = a1;
    __syncthreads();
    if (tid < 128) { const int b = tid >> 6, col = tid & 63; float s = 0.f;
#pragma unroll
        for (int w = 0; w < 32; ++w) s += part[(w * 2 + b) * 64 + col];
        mod[((size_t)l * BATCH + b) * (6 * D) + n0 + col] = s + ada_b[(size_t)l * 6 * D + n0 + col]; }
    __syncthreads();
}

struct RowMod { f32x4 a[4], b[4]; };
DI void load_rowmod(RowMod& R, const float* g, const float* sc, const float* sh, int lane) {
#pragma unroll
    for (int j = 0; j < 4; ++j) { const f32x4 gv = ((const f32x4*)g)[lane + 64 * j], sv = ((const f32x4*)sc)[lane + 64 * j]; R.a[j] = gv * (sv + 1.0f); R.b[j] = ((const f32x4*)sh)[lane + 64 * j]; }
}
template <bool SIDE, bool H8 = false> DI void row_finish(const f32x4 (&v)[4], const RowMod& R, bf16_t* hrow, float* small_row, const LAS float* wsm, int lane, unsigned* h8row = nullptr, float* hsp = nullptr) {
    float s = 0.f;
#pragma unroll
    for (int j = 0; j < 4; ++j) s += (v[j].x * v[j].x + v[j].y * v[j].y) + (v[j].z * v[j].z + v[j].w * v[j].w);
    const float rstd = 1.0f / sqrtf(wave_sum(s, lane) * (1.0f / D) + EPS);
    f32x4 y[4];
#pragma unroll
    for (int j = 0; j < 4; ++j) { y[j] = v[j] * rstd * R.a[j] + R.b[j];
        u32x2 o; o.x = pk2(y[j].x, y[j].y); o.y = pk2(y[j].z, y[j].w); ((u32x2*)hrow)[lane + 64 * j] = o; }
    if (H8) {
        float am = 0.f;
#pragma unroll
        for (int j = 0; j < 4; ++j) am = fmaxf(fmaxf(am, fmaxf(fabsf(y[j].x), fabsf(y[j].y))), fmaxf(fabsf(y[j].z), fabsf(y[j].w)));
        am = fmaxf(am, shx<1>(am, lane)); am = fmaxf(am, shx<2>(am, lane)); am = fmaxf(am, shx<4>(am, lane)); am = fmaxf(am, shx<8>(am, lane)); am = fmaxf(am, shx<16>(am, lane)); am = fmaxf(am, shx<32>(am, lane));
        am = fmaxf(am, 1e-20f);
        const float sc = 127.0f / am;
#pragma unroll
        for (int j = 0; j < 4; ++j) {
            const int q0 = (int)__builtin_rintf(y[j].x * sc), q1 = (int)__builtin_rintf(y[j].y * sc), q2 = (int)__builtin_rintf(y[j].z * sc), q3 = (int)__builtin_rintf(y[j].w * sc);
            h8row[lane + 64 * j] = (unsigned)(q0 & 0xff) | ((unsigned)(q1 & 0xff) << 8) | ((unsigned)(q2 & 0xff) << 16) | ((unsigned)q3 << 24); }
        if (lane == 0) *hsp = am * (1.0f / 127.0f);
    }
    if (SIDE) {
        float p[8];
#pragma unroll
        for (int c = 0; c < 8; ++c) { float a = 0.f;
#pragma unroll
            for (int j = 0; j < 4; ++j) { const f32x4 w = ((const LAS f32x4*)(wsm + c * D))[lane + 64 * j]; a += (y[j].x * w.x + y[j].y * w.y) + (y[j].z * w.z + y[j].w * w.w); }
            p[c] = wave_sum(a, lane);
            if (c & 1) __builtin_amdgcn_sched_barrier(0); }
        if (lane < 8) { float r = p[0];
#pragma unroll
            for (int c = 1; c < 8; ++c) r = (lane == c) ? p[c] : r;
            small_row[lane] = r; }
    }
}
DI void stage_wsmall(const float* w_in_l, LAS float* wsm, int tid) {
    for (int i = tid; i < 8 * D; i += NTHR) { const int k = i >> 3, c = i & 7; wsm[c * D + k] = w_in_l[(size_t)k * IN_COLS + 4096 + c]; }
    __syncthreads();
}

#ifndef CHAIN_OWN
#define CHAIN_OWN 1
#endif
#define WG_BAR() do { asm volatile("s_waitcnt lgkmcnt(0)" ::: "memory"); __builtin_amdgcn_s_barrier(); asm volatile("" ::: "memory"); } while (0)
constexpr int TILE_B = 2048;
constexpr int LDA_ = 272, LDT_ = 144;

struct MixP {
    const bf16_t* PROJ; const float* SMALL; const float* convw; const float* alog; const float* dtb; const float* lbl; int l;
    unsigned char* MT; unsigned char* NN; unsigned char* QT; unsigned char* OP; unsigned char* SS; float* DL;
};

DI void passA_gdn(lptr L, int tid_in, const MixP& P, int bh, int c) {
    int tid = tid_in; asm volatile("" : "+v"(tid));
    constexpr int R_KN = 0, R_QN = 18432, R_QE = 36864, R_VB = 54272, R_KBE = 71680, R_KD = 89088, R_AM = 106496, R_T = 123904, R_AQK = 133120, R_MISC = 142336, R_A10 = 144448;
    constexpr int R_UT = R_KN, R_WT = R_QN, R_D0 = R_KN, R_D1 = R_KN + 2560, R_XT = R_KN + 5120;
    const int lane = tid & 63, w = __builtin_amdgcn_readfirstlane(tid >> 6), r = lane & 31, hh = lane >> 5;
    const int b = bh >> 2, h = bh & 3; const size_t row0 = (size_t)b * SEQ + 64 * c;
    LAS float* sb = (LAS float*)(L + R_MISC); LAS float* sbeta = sb + 64; LAS float* seb = sb + 128; LAS float* sekd = sb + 192; LAS float* ssq = sb + 256; LAS float* sbl = sb + 384;
    WG_BAR();
    constexpr int RAWQ = R_AM, RAWK = R_T, RAWV = R_KD;
    const int cgx = tid & 15, sg = tid >> 4;
    {
        u32x4 raw[7];
#pragma unroll
        for (int j = 0; j < 7; ++j) { const int idx = tid + 512 * j, rr = idx / 48, rem = idx - 48 * rr, ty = rem >> 4, cc = rem & 15;
            raw[j] = (u32x4){0u, 0u, 0u, 0u};
            if (idx < 67 * 48 && 64 * c + rr - 3 >= 0) raw[j] = *(const u32x4*)(P.PROJ + (row0 + rr - 3) * NPROJ + PC_QKV + ty * 512 + h * 128 + cc * 8); }
        if (tid < 64) {
            const float* sm = P.SMALL + (row0 + tid) * 8;
            const float beta = sigmoidf_(sm[h]); const float x = sm[4 + h] + P.dtb[h];
            const float sp = x > 20.f ? x : __logf(1.0f + __expf(x));
            float bb = -__expf(P.alog[h]) * sp;
#pragma unroll
            for (int o = 1; o < 64; o <<= 1) { const float n = __int_as_float(__builtin_amdgcn_ds_bpermute((lane - o) << 2, __float_as_int(bb))); if (lane >= o) bb += n; }
            const float blast = __int_as_float(__builtin_amdgcn_readlane(__float_as_int(bb), 63));
            sb[tid] = bb; sbeta[tid] = beta; seb[tid] = __expf(bb); sekd[tid] = __expf(blast - bb); if (tid == 0) sbl[0] = __expf(blast);
        } else if (tid < 192) ssq[tid - 64] = 0.f;
#pragma unroll
        for (int j = 0; j < 7; ++j) { const int idx = tid + 512 * j, rr = idx / 48, rem = idx - 48 * rr, ty = rem >> 4, cc = rem & 15;
            if (idx < 67 * 48) *(LAS u32x4*)(L + (ty == 0 ? RAWQ : ty == 1 ? RAWK : RAWV) + rr * 256 + cc * 16) = raw[j]; }
    }
    WG_BAR();
    float val[3][2][8];
#pragma unroll
    for (int ty = 0; ty < 3; ++ty) {
        const int ch = ty * 512 + h * 128 + cgx * 8;
        f32x4 w[4][2];
#pragma unroll
        for (int j = 0; j < 4; ++j) { w[j][0] = *(const f32x4*)(P.convw + j * 1536 + ch); w[j][1] = *(const f32x4*)(P.convw + j * 1536 + ch + 4); }
        lptr rb = L + (ty == 0 ? RAWQ : ty == 1 ? RAWK : RAWV) + (2 * sg) * 256 + cgx * 16;
        u32x4 xr[5];
#pragma unroll
        for (int j = 0; j < 5; ++j) xr[j] = *(const LAS u32x4*)(rb + j * 256);
#pragma unroll
        for (int q = 0; q < 2; ++q) {
            float a[8];
#pragma unroll
            for (int e = 0; e < 8; ++e) a[e] = 0.f;
#pragma unroll
            for (int j = 0; j < 4; ++j) { const u32x4 x = xr[q + j];
                a[0] += bf_lo(x.x) * w[j][0].x; a[1] += bf_hi(x.x) * w[j][0].y; a[2] += bf_lo(x.y) * w[j][0].z; a[3] += bf_hi(x.y) * w[j][0].w;
                a[4] += bf_lo(x.z) * w[j][1].x; a[5] += bf_hi(x.z) * w[j][1].y; a[6] += bf_lo(x.w) * w[j][1].z; a[7] += bf_hi(x.w) * w[j][1].w; }
            float ss = 0.f;
#pragma unroll
            for (int e = 0; e < 8; ++e) { const float v = siluf_(a[e]); val[ty][q][e] = v; ss += v * v; }
            if (ty < 2) __hip_atomic_fetch_add(&ssq[ty * 64 + 2 * sg + q], ss, __ATOMIC_RELAXED, __HIP_MEMORY_SCOPE_WORKGROUP);
        }
    }
    WG_BAR();
#pragma unroll
    for (int ty = 0; ty < 3; ++ty)
#pragma unroll
        for (int q = 0; q < 2; ++q) {
            const int s = 2 * sg + q; const int off = s * LDA_ + cgx * 16;
            float f1, f2 = 0.f, f3 = 0.f;
            if (ty == 0) { f1 = 1.0f / sqrtf(ssq[s] + EPS) * 0.08838834764831845f; f2 = f1 * seb[s]; }
            else if (ty == 1) { f1 = 1.0f / sqrtf(ssq[64 + s] + EPS); f2 = f1 * sbeta[s] * seb[s]; f3 = f1 * sekd[s]; }
            else f1 = sbeta[s];
#define VA(e) val[ty][q][e]
            { u32x4 o; o.x = pk2(VA(0) * f1, VA(1) * f1); o.y = pk2(VA(2) * f1, VA(3) * f1); o.z = pk2(VA(4) * f1, VA(5) * f1); o.w = pk2(VA(6) * f1, VA(7) * f1); *(LAS u32x4*)(L + (ty == 0 ? R_QN : ty == 1 ? R_KN : R_VB) + off) = o; }
            if (ty < 2) { u32x4 o; o.x = pk2(VA(0) * f2, VA(1) * f2); o.y = pk2(VA(2) * f2, VA(3) * f2); o.z = pk2(VA(4) * f2, VA(5) * f2); o.w = pk2(VA(6) * f2, VA(7) * f2); *(LAS u32x4*)(L + (ty == 0 ? R_QE : R_KBE) + off) = o; }
            if (ty == 1) { u32x4 o; o.x = pk2(VA(0) * f3, VA(1) * f3); o.y = pk2(VA(2) * f3, VA(3) * f3); o.z = pk2(VA(4) * f3, VA(5) * f3); o.w = pk2(VA(6) * f3, VA(7) * f3); *(LAS u32x4*)(L + R_KD + off) = o; }
#undef VA
        }
    WG_BAR();
    {
        const int tl = w & 3, ta = tl >> 1, tb = tl & 1;
        f32x16 acc = zero16();
        lptr Bsrc = L + (w < 4 ? R_KN : R_QN);
#pragma unroll
        for (int s8 = 0; s8 < 8; ++s8) acc = MFMA32(fragK(L + R_KN, LDA_, 32 * ta, 16 * s8, lane), fragK(Bsrc, LDA_, 32 * tb, 16 * s8, lane), acc);
        const int ci = 32 * tb + r; const float bcol = sb[ci];
        if (w < 4) {
            const float bet = sbeta[ci];
#pragma unroll
            for (int g = 0; g < 4; ++g) { f32x4 o;
#pragma unroll
                for (int e = 0; e < 4; ++e) { const int jj = 32 * ta + 8 * g + 4 * hh + e; o[e] = (jj < ci) ? bet * acc[4 * g + e] * __expf(bcol - sb[jj]) : 0.f; }
                *(LAS f32x4*)(L + R_AM + ci * 272 + (32 * ta + 8 * g + 4 * hh) * 4) = o;
                if (ta == 0 && tb == 1) { u32x2 v; v.x = pk2(o[0], o[1]); v.y = pk2(o[2], o[3]); *(LAS u32x2*)(L + R_A10 + r * 80 + (8 * g + 4 * hh) * 2) = v; } }
        } else {
            f32x16 o;
#pragma unroll
            for (int i = 0; i < 16; ++i) { const int ss_ = 32 * ta + crow(i, hh); o[i] = (ss_ <= ci) ? acc[i] * __expf(bcol - sb[ss_]) : 0.f; }
            storeT_bf16(o, L + R_AQK, LDT_, 32 * tb, 32 * ta, lane);
        }
    }
    WG_BAR();
    if (w == 0) {
        const int blk = hh, cc = r;
        float x[32];
#pragma unroll
        for (int i = 0; i < 32; ++i) x[i] = 0.f;
        f32x4 rowc[8], rown[8];
#pragma unroll
        for (int i = 0; i < 32; ++i) {
            if (i + 1 < 32) { const LAS f32x4* an = (const LAS f32x4*)(L + R_AM + (32 * blk + i + 1) * 272 + (32 * blk) * 4);
#pragma unroll
                for (int jq = 0; jq < (i + 4) / 4; ++jq) rown[jq] = an[jq]; }
            float a = (i == cc) ? 1.f : 0.f;
#pragma unroll
            for (int jq = 0; jq < (i + 3) / 4; ++jq) { const f32x4 a4 = rowc[jq]; a -= (a4.x * x[4 * jq] + a4.y * x[4 * jq + 1]) + (a4.z * x[4 * jq + 2] + a4.w * x[4 * jq + 3]); }
            x[i] = a;
#pragma unroll
            for (int jq = 0; jq < 8; ++jq) rowc[jq] = rown[jq];
            __builtin_amdgcn_sched_barrier(0);
        }
#pragma unroll
        for (int i = 0; i < 32; ++i) { const bf16_t v = f2bf(x[i]);
            *(LAS bf16_t*)(L + (blk ? R_D1 : R_D0) + i * 80 + cc * 2) = v;
            *(LAS bf16_t*)(L + R_T + (32 * blk + i) * LDT_ + (32 * blk + cc) * 2) = v; }
#pragma unroll
        for (int i = 0; i < 16; ++i) *(LAS bf16_t*)(L + R_T + (16 * blk + i) * LDT_ + (32 + cc) * 2) = 0;
        LDS_WAIT();
        f32x16 xa = zero16();
#pragma unroll
        for (int s2 = 0; s2 < 2; ++s2) xa = MFMA32(fragK(L + R_A10, 80, 0, 16 * s2, lane), fragT(L + R_D0, 80, 16 * s2, 0, lane), xa);
        storeT_bf16(xa, L + R_XT, 80, 0, 0, lane);
        LDS_WAIT();
        f32x16 t10 = zero16();
#pragma unroll
        for (int s2 = 0; s2 < 2; ++s2) t10 = MFMA32(fragK(L + R_XT, 80, 0, 16 * s2, lane), fragK(L + R_D1, 80, 0, 16 * s2, lane), t10);
#pragma unroll
        for (int i = 0; i < 16; ++i) t10[i] = -t10[i];
        storeT_bf16(t10, L + R_T, LDT_, 32, 0, lane);
    }
    WG_BAR();
#pragma unroll
    for (int q = 0; q < 2; ++q) {
        const int id = 2 * w + q, which = id >> 3, ti = (id >> 2) & 1, di = id & 3;
        f32x16 acc = zero16();
        lptr Bsrc = L + (which ? R_KBE : R_VB);
#pragma unroll
        for (int s4 = 0; s4 < 4; ++s4) acc = MFMA32(fragK(L + R_T, LDT_, 32 * ti, 16 * s4, lane), fragT(Bsrc, LDA_, 16 * s4, 32 * di, lane), acc);
        storeT_bf16(acc, L + (which ? R_WT : R_UT), LDT_, 32 * di, 32 * ti, lane);
    }
    WG_BAR();
    const size_t itg = (size_t)1024 + bh * 128 + c, itm = (size_t)bh * 128 + c;
    const float bl = sbl[0];
#pragma unroll 1
    for (int q = 0; q < 6; ++q) {
        const int t = w + 8 * q;
        f32x16 acc = zero16();
        if (q < 2) {
            const int rt = t >> 2, dt = t & 3;
#pragma unroll
            for (int s4 = 0; s4 < 4; ++s4) acc = MFMA32(fragT(L + R_KD, LDA_, 16 * s4, 32 * rt, lane), fragK(L + R_UT, LDT_, 32 * dt, 16 * s4, lane), acc);
            gstore_tile(P.NN + (itg * 16 + rt * 4 + dt) * TILE_B, lane, acc);
        } else if (q < 4) {
            const int t2 = t - 16, kt = t2 >> 2, rt = t2 & 3;
#pragma unroll
            for (int s4 = 0; s4 < 4; ++s4) acc = MFMA32(fragK(L + R_WT, LDT_, 32 * kt, 16 * s4, lane), fragT(L + R_KD, LDA_, 16 * s4, 32 * rt, lane), acc);
#pragma unroll
            for (int i = 0; i < 16; ++i) acc[i] = ((kt == rt) && (crow(i, hh) == r) ? bl : 0.f) - acc[i];
            gstore_tile(P.MT + (itm * 16 + kt * 4 + rt) * TILE_B, lane, acc);
        } else if (q == 4) {
            const int t2 = t - 32, tt = t2 >> 2, dt = t2 & 3;
#pragma unroll
            for (int s4 = 0; s4 < 4; ++s4) acc = MFMA32(fragK(L + R_AQK, LDT_, 32 * tt, 16 * s4, lane), fragK(L + R_UT, LDT_, 32 * dt, 16 * s4, lane), acc);
            gstore_tile(P.OP + (itg * 8 + tt * 4 + dt) * TILE_B, lane, acc);
        } else {
            const int t2 = t - 40, kt = t2 >> 1, tt = t2 & 1;
#pragma unroll
            for (int s4 = 0; s4 < 4; ++s4) acc = MFMA32(fragK(L + R_WT, LDT_, 32 * kt, 16 * s4, lane), fragK(L + R_AQK, LDT_, 32 * tt, 16 * s4, lane), acc);
#pragma unroll
            for (int g = 0; g < 4; ++g) { const u32x2 qv = *(const LAS u32x2*)(L + R_QE + (32 * tt + r) * LDA_ + (32 * kt + 8 * g + 4 * hh) * 2);
                acc[4 * g] = bf_lo(qv.x) - acc[4 * g]; acc[4 * g + 1] = bf_hi(qv.x) - acc[4 * g + 1]; acc[4 * g + 2] = bf_lo(qv.y) - acc[4 * g + 2]; acc[4 * g + 3] = bf_hi(qv.y) - acc[4 * g + 3]; }
            gstore_tile(P.QT + (itg * 8 + kt * 2 + tt) * TILE_B, lane, acc);
        }
    }
}

DI void passA_hgrn(lptr L, int tid_in, const MixP& P, int bh, int c) {
    int tid = tid_in; asm volatile("" : "+v"(tid));
    constexpr int R_QT = 0, R_KTA = 17408, R_KTB = 34816, R_QE = 43520, R_KD = 60928, R_VV = 78336, R_ATT = 95744, R_TOT = 104960, R_REF = 107008;
    const int lane = tid & 63, w = __builtin_amdgcn_readfirstlane(tid >> 6), r = lane & 31, hh = lane >> 5;
    const int b = bh >> 2, h = bh & 3; const size_t row0 = (size_t)b * SEQ + 64 * c;
    const int k = tid & 127, qr = tid >> 7;
    LAS float* tot = (LAS float*)(L + R_TOT); LAS float* ref = (LAS float*)(L + R_REF);
    float lb = 0.f;
    if (P.l > 0) lb = sigmoidf_(P.lbl[512 + h * 128 + k] - P.lbl[h * 128 + k]);
    WG_BAR();
    float bloc[16], kk_[16]; float run = 0.f;
    bf16_t hfr[16], hqr[16];
    {
        const bf16_t* pf = P.PROJ + (row0 + 16 * qr) * NPROJ + PC_HF + h * 128 + k;
        const bf16_t* pq = P.PROJ + (row0 + 16 * qr) * NPROJ + PC_HQ + h * 128 + k;
#pragma unroll
        for (int i = 0; i < 16; ++i) hfr[i] = pf[(size_t)i * NPROJ];
#pragma unroll
        for (int i = 0; i < 16; ++i) hqr[i] = pq[(size_t)i * NPROJ];
        u32x4 vraw[2];
#pragma unroll
        for (int q = 0; q < 2; ++q) { const int ch = tid + 512 * q, row = ch >> 4, cc = ch & 15; vraw[q] = *(const u32x4*)(P.PROJ + (row0 + row) * NPROJ + PC_HI + h * 128 + cc * 8); }
        asm volatile("" ::: "memory");
#pragma unroll
        for (int i = 0; i < 16; ++i) { const float hf = bf1(hfr[i]); const float fg = lb + (1.0f - lb) * sigmoidf_(hf); run += __logf(fg); bloc[i] = run; kk_[i] = 1.0f - fg; }
        tot[qr * 128 + k] = run;
#pragma unroll
        for (int q = 0; q < 2; ++q) { const int ch = tid + 512 * q, row = ch >> 4, cc = ch & 15; *(LAS u32x4*)(L + R_VV + row * LDA_ + cc * 16) = vraw[q]; }
    }
    WG_BAR();
    float off = 0.f, blast = 0.f;
#pragma unroll
    for (int q = 0; q < 4; ++q) { const float t_ = tot[q * 128 + k]; blast += t_; if (q < qr) off += t_; }
#pragma unroll
    for (int i = 0; i < 16; ++i) bloc[i] += off;
    if (qr == 0) ref[k] = bloc[0];
    if (qr == 2) ref[128 + k] = bloc[0];
    WG_BAR();
    {
        const float ref0 = ref[k], ref1 = ref[128 + k]; const float rf = (qr < 2) ? ref0 : ref1;
#pragma unroll
        for (int i = 0; i < 16; ++i) { const int t = 16 * qr + i; const float q_ = siluf_(bf1(hqr[i])); const float bt = bloc[i];
            *(LAS bf16_t*)(L + R_QE + t * LDA_ + k * 2) = f2bf(q_ * __expf(bt));
            *(LAS bf16_t*)(L + R_KD + t * LDA_ + k * 2) = f2bf(kk_[i] * __expf(blast - bt));
            *(LAS bf16_t*)(L + R_QT + t * LDA_ + k * 2) = f2bf(q_ * __expf(fminf(bt - rf, 80.f)));
            *(LAS bf16_t*)(L + R_KTA + t * LDA_ + k * 2) = f2bf(kk_[i] * __expf(fminf(rf - bt, 80.f)));
            if (qr < 2) *(LAS bf16_t*)(L + R_KTB + t * LDA_ + k * 2) = f2bf(kk_[i] * __expf(ref1 - bt)); }
        if (qr == 0) { const int kt = k >> 5, kr = k & 31, h2 = (kr >> 2) & 1, i2 = (kr & 3) + 4 * (kr >> 3);
            P.DL[(((size_t)bh * 128 + c) * 4 + kt) * 32 + h2 * 16 + i2] = __expf(blast); }
    }
    WG_BAR();
    const size_t it = (size_t)bh * 128 + c;
    if (w < 3) {
        const int sa = (w == 2) ? 32 : 0, tb = (w == 0) ? 0 : 32;
        lptr Asrc = L + (w == 1 ? R_KTB : R_KTA);
        f32x16 acc = zero16();
#pragma unroll
        for (int s8 = 0; s8 < 8; ++s8) acc = MFMA32(fragK(Asrc, LDA_, sa, 16 * s8, lane), fragK(L + R_QT, LDA_, tb, 16 * s8, lane), acc);
        if (w != 1) {
#pragma unroll
            for (int i = 0; i < 16; ++i) acc[i] = (crow(i, hh) <= r) ? acc[i] : 0.f; }
        storeT_bf16(acc, L + R_ATT, LDT_, tb, sa, lane);
    } else if (w == 3) {
        storeT_bf16(zero16(), L + R_ATT, LDT_, 0, 32, lane);
    } else {
#pragma unroll
        for (int q = 0; q < 4; ++q) { const int t = (w - 4) * 4 + q, rt = t >> 2, dt = t & 3;
            f32x16 acc = zero16();
#pragma unroll
            for (int s4 = 0; s4 < 4; ++s4) acc = MFMA32(fragT(L + R_KD, LDA_, 16 * s4, 32 * rt, lane), fragT(L + R_VV, LDA_, 16 * s4, 32 * dt, lane), acc);
            gstore_tile(P.NN + (it * 16 + rt * 4 + dt) * TILE_B, lane, acc); }
    }
    {
        const int kt = w >> 1, tt = w & 1; u32x2 g[4];
#pragma unroll
        for (int q = 0; q < 4; ++q) g[q] = *(const LAS u32x2*)(L + R_QE + (32 * tt + r) * LDA_ + (32 * kt + 8 * q + 4 * hh) * 2);
        u32x4* p = (u32x4*)(P.QT + (it * 8 + kt * 2 + tt) * TILE_B + lane * 32);
        if (WT_TILE == 2) { __builtin_nontemporal_store((u32x4){g[0].x, g[0].y, g[1].x, g[1].y}, p); __builtin_nontemporal_store((u32x4){g[2].x, g[2].y, g[3].x, g[3].y}, p + 1); }
        else if (WT_TILE) { st16_wt(p, (u32x4){g[0].x, g[0].y, g[1].x, g[1].y}); st16_wt(p + 1, (u32x4){g[2].x, g[2].y, g[3].x, g[3].y}); }
        else { p[0] = (u32x4){g[0].x, g[0].y, g[1].x, g[1].y}; p[1] = (u32x4){g[2].x, g[2].y, g[3].x, g[3].y}; }
    }
    WG_BAR();
    {
        const int tt = w >> 2, dt = w & 3;
        f32x16 acc = zero16();
#pragma unroll
        for (int s4 = 0; s4 < 4; ++s4) acc = MFMA32(fragK(L + R_ATT, LDT_, 32 * tt, 16 * s4, lane), fragT(L + R_VV, LDA_, 16 * s4, 32 * dt, lane), acc);
        gstore_tile(P.OP + (it * 8 + tt * 4 + dt) * TILE_B, lane, acc);
    }
}

DI void passB_gdn(lptr L, int tid, const MixP& P, int j, int c0 = 0, int c1 = 128) {
    const int lane = tid & 63, w = __builtin_amdgcn_readfirstlane(tid >> 6);
    const int bh = j >> 2, dt = j & 3;
    if (w > 4) {
#pragma unroll 1
        for (int c = c0; c < c1; ++c) WG_BAR();
        return;
    }
    if (w == 4) {
        unsigned char* SSb = P.SS + ((size_t)1024 + bh * 128) * 16 * TILE_B + dt * TILE_B + lane * 32;
#pragma unroll
        for (int kt = 0; kt < 4; ++kt) { if (c0 == 0) { u32x4* ps = (u32x4*)(SSb + kt * 8192); ps[0] = (u32x4){0u, 0u, 0u, 0u}; ps[1] = (u32x4){0u, 0u, 0u, 0u}; } }
#pragma unroll 1
        for (int c = c0; c < c1; ++c) {
            WG_BAR();
            if (c < 127) {
                if (CHAIN_OWN) __builtin_amdgcn_s_sleep(3);
                lptr xb = L + (c & 1) * 8192;
#pragma unroll
                for (int kt = 0; kt < 4; ++kt) { const LAS u32x4* px = (const LAS u32x4*)(xb + kt * 2048 + lane * 32); const u32x4 a = px[0], b = px[1];
                    unsigned char* ps = SSb + (size_t)(c + 1) * 32768 + kt * 8192; if (WT_CHAIN) { st16_wt(ps, a); st16_wt(ps + 16, b); } else { *(u32x4*)ps = a; *(u32x4*)(ps + 16) = b; } }
            }
        }
        return;
    }
    const int rt = w;
    const unsigned char* MTb = P.MT + ((size_t)bh * 128) * 16 * TILE_B + rt * TILE_B + lane * 32;
    const unsigned char* NNb = P.NN + ((size_t)1024 + bh * 128) * 16 * TILE_B + (rt * 4 + dt) * TILE_B + lane * 32;
    u32x4 A[4][4][2], Nn[4][2];
    u32x4 Sb[4][2], mylo, myhi;
#pragma unroll
    for (int kt = 0; kt < 4; ++kt) { Sb[kt][0] = (u32x4){0u, 0u, 0u, 0u}; Sb[kt][1] = (u32x4){0u, 0u, 0u, 0u}; }
    if (c0 > 0) {
        const unsigned char* sr = P.SS + ((size_t)1024 + bh * 128) * 16 * TILE_B + dt * TILE_B + lane * 32 + (size_t)c0 * 32768;
#pragma unroll
        for (int kt = 0; kt < 4; ++kt) { Sb[kt][0] = *(const u32x4*)(sr + kt * 8192); Sb[kt][1] = *(const u32x4*)(sr + kt * 8192 + 16); }
    }
#define PB_LOAD(buf, cc) do { const unsigned char* pa = MTb + (size_t)(cc) * 32768; _Pragma("unroll") for (int kt = 0; kt < 4; ++kt) { A[buf][kt][0] = *(const u32x4*)(pa + kt * 8192); A[buf][kt][1] = *(const u32x4*)(pa + kt * 8192 + 16); } \
        const unsigned char* pn = NNb + (size_t)(cc) * 32768; Nn[buf][0] = *(const u32x4*)pn; Nn[buf][1] = *(const u32x4*)(pn + 16); } while (0)
#define PB_STEP(buf, cc) do { \
        f32x16 acc = unpack_tile(Nn[buf][0], Nn[buf][1]); \
        _Pragma("unroll") for (int kt = 0; kt < 4; ++kt) { acc = MFMA32(AS_BF8(A[buf][kt][0]), AS_BF8(Sb[kt][0]), acc); acc = MFMA32(AS_BF8(A[buf][kt][1]), AS_BF8(Sb[kt][1]), acc); } \
        pack_tile(acc, mylo, myhi); \
        lptr xb = L + ((cc) & 1) * 8192; \
        { LAS u32x4* px = (LAS u32x4*)(xb + rt * 2048 + lane * 32); px[0] = mylo; px[1] = myhi; } \
        WG_BAR(); \
        _Pragma("unroll") for (int kt = 0; kt < 4; ++kt) { if (CHAIN_OWN && kt == rt) { Sb[kt][0] = mylo; Sb[kt][1] = myhi; }   \
            else { const LAS u32x4* px = (const LAS u32x4*)(xb + kt * 2048 + lane * 32); Sb[kt][0] = px[0]; Sb[kt][1] = px[1]; } } \
        __builtin_amdgcn_sched_barrier(0);   } while (0)
#ifdef PROBE_DEPTH2
    PB_LOAD(0, c0); PB_LOAD(1, c0 + 1);
#pragma unroll 1
    for (int c = c0; c < c1 - 4; c += 4) {
        PB_LOAD(2, c + 2); PB_STEP(0, c);
        PB_LOAD(3, c + 3); PB_STEP(1, c + 1);
        PB_LOAD(0, c + 4); PB_STEP(2, c + 2);
        PB_LOAD(1, c + 5); PB_STEP(3, c + 3);
    }
    PB_LOAD(2, c1 - 2); PB_STEP(0, c1 - 4); PB_LOAD(3, c1 - 1); PB_STEP(1, c1 - 3); PB_STEP(2, c1 - 2); PB_STEP(3, c1 - 1);
#else
    PB_LOAD(0, c0); PB_LOAD(1, c0 + 1); PB_LOAD(2, c0 + 2);
#pragma unroll 1
    for (int c = c0; c < c1 - 4; c += 4) {
        PB_LOAD(3, c + 3); PB_STEP(0, c);
        PB_LOAD(0, c + 4); PB_STEP(1, c + 1);
        PB_LOAD(1, c + 5); PB_STEP(2, c + 2);
        PB_LOAD(2, c + 6); PB_STEP(3, c + 3);
    }
    PB_LOAD(3, c1 - 1); PB_STEP(0, c1 - 4); PB_STEP(1, c1 - 3); PB_STEP(2, c1 - 2); PB_STEP(3, c1 - 1);
#endif
#undef PB_LOAD
#undef PB_STEP
}
DI void passB_hgrn(int lane, const MixP& P, int item, int c0 = 0, int c1 = 128) {
    const int half = item & 1, tile = (item >> 1) & 15, bh = item >> 5, kt = tile >> 2, hh = lane >> 5;
    const unsigned char* NNb = P.NN + ((size_t)bh * 128) * 16 * TILE_B + tile * TILE_B + lane * 32 + half * 16;
    unsigned char* SSb = P.SS + ((size_t)bh * 128) * 16 * TILE_B + tile * TILE_B + lane * 32 + half * 16;
    const float* DLb = P.DL + (((size_t)bh * 128) * 4 + kt) * 32 + hh * 16 + half * 8;
    float S[8];
#pragma unroll
    for (int e = 0; e < 8; ++e) S[e] = 0.f;
    if (c0 > 0) { const u32x4 sv = *(const u32x4*)(SSb + (size_t)c0 * 32768);
        S[0] = bf_lo(sv.x); S[1] = bf_hi(sv.x); S[2] = bf_lo(sv.y); S[3] = bf_hi(sv.y); S[4] = bf_lo(sv.z); S[5] = bf_hi(sv.z); S[6] = bf_lo(sv.w); S[7] = bf_hi(sv.w); }
    u32x4 nA[8]; f32x4 dA[8][2]; u32x4 so[8];
#define HB_LOAD(nb, db, c0) do { _Pragma("unroll") for (int i = 0; i < 8; ++i) { nb[i] = *(const u32x4*)(NNb + (size_t)((c0) + i) * 32768); \
        const f32x4* pd = (const f32x4*)(DLb + (size_t)((c0) + i) * 128); db[i][0] = pd[0]; db[i][1] = pd[1]; } } while (0)
#define HB_RUN(nb, db) do { _Pragma("unroll") for (int i = 0; i < 8; ++i) { \
        so[i].x = pk2(S[0], S[1]); so[i].y = pk2(S[2], S[3]); so[i].z = pk2(S[4], S[5]); so[i].w = pk2(S[6], S[7]); \
        const u32x4 n = nb[i]; \
        S[0] = S[0] * db[i][0][0] + bf_lo(n.x); S[1] = S[1] * db[i][0][1] + bf_hi(n.x); S[2] = S[2] * db[i][0][2] + bf_lo(n.y); S[3] = S[3] * db[i][0][3] + bf_hi(n.y); \
        S[4] = S[4] * db[i][1][0] + bf_lo(n.z); S[5] = S[5] * db[i][1][1] + bf_hi(n.z); S[6] = S[6] * db[i][1][2] + bf_lo(n.w); S[7] = S[7] * db[i][1][3] + bf_hi(n.w); } } while (0)
#define HB_STORE(c0) do { _Pragma("unroll") for (int i = 0; i < 8; ++i) { if (WT_CHAIN) st16_wt(SSb + (size_t)((c0) + i) * 32768, so[i]); else *(u32x4*)(SSb + (size_t)((c0) + i) * 32768) = so[i]; } } while (0)
    HB_LOAD(nA, dA, c0);
#pragma unroll 1
    for (int c = c0; c < c1; c += 8) {
        HB_RUN(nA, dA); if (c + 8 < c1) HB_LOAD(nA, dA, c + 8); HB_STORE(c);
    }
    if (c1 < 128) { u32x4 sv; sv.x = pk2(S[0], S[1]); sv.y = pk2(S[2], S[3]); sv.z = pk2(S[4], S[5]); sv.w = pk2(S[6], S[7]);
        *(u32x4*)(SSb + (size_t)c1 * 32768) = sv; }
#undef HB_LOAD
#undef HB_RUN
#undef HB_STORE
}

struct PCLoad { u32x4 ol, oh, ql[4], qh[4], sl[4], sh_[4]; bf16_t g[16]; };
DI void passC_load(PCLoad& T, int lane, int w, const MixP& P, int it) {
    const int r = lane & 31, hh = lane >> 5, tt = w >> 2, dt = w & 3;
    const int br = it >> 10, bhc = it & 1023, bh = bhc >> 7, c = bhc & 127, b = bh >> 2, h = bh & 3;
    const size_t row0 = (size_t)b * SEQ + 64 * c;
    gload_tile(P.OP + ((size_t)it * 8 + tt * 4 + dt) * TILE_B, lane, T.ol, T.oh);
#pragma unroll
    for (int kt = 0; kt < 4; ++kt) { gload_tile(P.QT + ((size_t)it * 8 + kt * 2 + tt) * TILE_B, lane, T.ql[kt], T.qh[kt]); gload_tile(P.SS + ((size_t)it * 16 + kt * 4 + dt) * TILE_B, lane, T.sl[kt], T.sh_[kt]); }
    const int gcol = (br ? PC_GG : PC_HG) + h * 128 + 32 * dt + r;
#pragma unroll
    for (int i = 0; i < 16; ++i) T.g[i] = P.PROJ[(row0 + 32 * tt + crow(i, hh)) * NPROJ + gcol];
    __builtin_amdgcn_sched_barrier(0);
}
DI void passC_finish(const PCLoad& T, lptr L, int lane, int w, int it, int par, const float* ng_h, const float* ng_g, bf16_t* Y) {
    const int r = lane & 31, hh = lane >> 5, tt = w >> 2, dt = w & 3;
    const int br = it >> 10, bhc = it & 1023, bh = bhc >> 7, c = bhc & 127, b = bh >> 2, h = bh & 3;
    const size_t row0 = (size_t)b * SEQ + 64 * c;
    f32x16 acc = unpack_tile(T.ol, T.oh);
#pragma unroll
    for (int kt = 0; kt < 4; ++kt) { acc = MFMA32(AS_BF8(T.ql[kt]), AS_BF8(T.sl[kt]), acc); acc = MFMA32(AS_BF8(T.qh[kt]), AS_BF8(T.sh_[kt]), acc); }
    LAS float* ps = (LAS float*)(L + par * 1024);
#pragma unroll
    for (int i = 0; i < 16; ++i) { float s = acc[i] * acc[i];
        s += shx<1>(s, lane); s += shx<2>(s, lane); s += shx<4>(s, lane); s += shx<8>(s, lane); s += shx<16>(s, lane);
        if (r == 0) ps[dt * 64 + 32 * tt + crow(i, hh)] = s; }
    WG_BAR();
    const int d = 32 * dt + r; const float ng = (br ? ng_g : ng_h)[d];
#pragma unroll
    for (int i = 0; i < 16; ++i) { const int t = 32 * tt + crow(i, hh);
        const float tot = (ps[t] + ps[64 + t]) + (ps[128 + t] + ps[192 + t]);
        const float rstd = 1.0f / sqrtf(tot * (1.0f / 128.0f) + EPS);
        Y[(row0 + t) * D + br * 512 + h * 128 + d] = f2bf(acc[i] * rstd * ng * siluf_(bf1(T.g[i]))); }
}

DI void passC_wave(int lane, const MixP& P, int it, int tt, const float* ng_h, const float* ng_g, bf16_t* Y) {
    const int r = lane & 31, hh = lane >> 5;
    const int br = it >> 10, bhc = it & 1023, bh = bhc >> 7, c = bhc & 127, b = bh >> 2, h = bh & 3;
    const size_t rowb = (size_t)b * SEQ + 64 * c + 32 * tt;
    u32x4 ql[4], qh[4];
#pragma unroll
    for (int kt = 0; kt < 4; ++kt) gload_tile(P.QT + ((size_t)it * 8 + kt * 2 + tt) * TILE_B, lane, ql[kt], qh[kt]);
    u32x4 ol[2], oh[2], sl[2][4], sh_[2][4];
#define PC_LD(buf, dt) do { gload_tile(P.OP + ((size_t)it * 8 + tt * 4 + (dt)) * TILE_B, lane, ol[buf], oh[buf]); \
        _Pragma("unroll") for (int kt = 0; kt < 4; ++kt) gload_tile(P.SS + ((size_t)it * 16 + kt * 4 + (dt)) * TILE_B, lane, sl[buf][kt], sh_[buf][kt]); } while (0)
    f32x16 acc[4];
    PC_LD(0, 0);
#pragma unroll
    for (int dt = 0; dt < 4; ++dt) {
        if (dt < 3) PC_LD((dt + 1) & 1, dt + 1);
        __builtin_amdgcn_sched_barrier(0);
        f32x16 a = unpack_tile(ol[dt & 1], oh[dt & 1]);
#pragma unroll
        for (int kt = 0; kt < 4; ++kt) { a = MFMA32(AS_BF8(ql[kt]), AS_BF8(sl[dt & 1][kt]), a); a = MFMA32(AS_BF8(qh[kt]), AS_BF8(sh_[dt & 1][kt]), a); }
        acc[dt] = a;
    }
#undef PC_LD
    const bf16_t* gp = P.PROJ + rowb * NPROJ + (br ? PC_GG : PC_HG) + h * 128 + r;
    bf16_t g0[16], g1[16];
#pragma unroll
    for (int i = 0; i < 16; ++i) g0[i] = gp[(size_t)crow(i, hh) * NPROJ];
    float rstd[16];
#pragma unroll
    for (int i = 0; i < 16; ++i) { float s = (acc[0][i] * acc[0][i] + acc[1][i] * acc[1][i]) + (acc[2][i] * acc[2][i] + acc[3][i] * acc[3][i]);
        s += shx<1>(s, lane); s += shx<2>(s, lane); s += shx<4>(s, lane); s += shx<8>(s, lane); s += shx<16>(s, lane);
        rstd[i] = 1.0f / sqrtf(s * (1.0f / 128.0f) + EPS); }
    const float* ngp = (br ? ng_g : ng_h) + r;
    bf16_t* yp = Y + rowb * D + br * 512 + h * 128 + r;
#pragma unroll
    for (int dt = 0; dt < 4; ++dt) {
        if (dt < 3) {
#pragma unroll
            for (int i = 0; i < 16; ++i) { const bf16_t v = gp[(size_t)crow(i, hh) * NPROJ + 32 * (dt + 1)]; if (dt & 1) g0[i] = v; else g1[i] = v; } }
        const float ng = ngp[32 * dt];
#pragma unroll
        for (int i = 0; i < 16; ++i) { const bf16_t gv = (dt & 1) ? g1[i] : g0[i];
            yp[(size_t)crow(i, hh) * D + 32 * dt] = f2bf(acc[dt][i] * rstd[i] * ng * siluf_(bf1(gv))); }
    }
}

DI float selh(int hm, float a0, float a1) { return __int_as_float((__float_as_int(a0) & ~hm) | (__float_as_int(a1) & hm)); }
DI float max3f_(float a, float b, float c) { return fmaxf(fmaxf(a, b), c); }
#define CE_(a, b) { const float t_ = fmaxf(a, b); b = fminf(a, b); a = t_; }
#define SORT16_(P, B) do {   \
    CE_(P[(B) + 0], P[(B) + 13]); CE_(P[(B) + 1], P[(B) + 12]); CE_(P[(B) + 2], P[(B) + 15]); CE_(P[(B) + 3], P[(B) + 14]); CE_(P[(B) + 4], P[(B) + 8]); CE_(P[(B) + 5], P[(B) + 6]); CE_(P[(B) + 7], P[(B) + 11]); CE_(P[(B) + 9], P[(B) + 10]); \
    CE_(P[(B) + 0], P[(B) + 5]); CE_(P[(B) + 1], P[(B) + 7]); CE_(P[(B) + 2], P[(B) + 9]); CE_(P[(B) + 3], P[(B) + 4]); CE_(P[(B) + 6], P[(B) + 13]); CE_(P[(B) + 8], P[(B) + 14]); CE_(P[(B) + 10], P[(B) + 15]); CE_(P[(B) + 11], P[(B) + 12]); \
    CE_(P[(B) + 0], P[(B) + 1]); CE_(P[(B) + 2], P[(B) + 3]); CE_(P[(B) + 4], P[(B) + 5]); CE_(P[(B) + 6], P[(B) + 8]); CE_(P[(B) + 7], P[(B) + 9]); CE_(P[(B) + 10], P[(B) + 11]); CE_(P[(B) + 12], P[(B) + 13]); CE_(P[(B) + 14], P[(B) + 15]); \
    CE_(P[(B) + 0], P[(B) + 2]); CE_(P[(B) + 1], P[(B) + 3]); CE_(P[(B) + 4], P[(B) + 10]); CE_(P[(B) + 5], P[(B) + 11]); CE_(P[(B) + 6], P[(B) + 7]); CE_(P[(B) + 8], P[(B) + 9]); CE_(P[(B) + 12], P[(B) + 14]); CE_(P[(B) + 13], P[(B) + 15]); \
    CE_(P[(B) + 1], P[(B) + 2]); CE_(P[(B) + 3], P[(B) + 12]); CE_(P[(B) + 4], P[(B) + 6]); CE_(P[(B) + 5], P[(B) + 7]); CE_(P[(B) + 8], P[(B) + 10]); CE_(P[(B) + 9], P[(B) + 11]); CE_(P[(B) + 13], P[(B) + 14]); \
    CE_(P[(B) + 1], P[(B) + 4]); CE_(P[(B) + 2], P[(B) + 6]); CE_(P[(B) + 5], P[(B) + 8]); CE_(P[(B) + 7], P[(B) + 10]); CE_(P[(B) + 9], P[(B) + 13]); CE_(P[(B) + 11], P[(B) + 14]); \
    CE_(P[(B) + 2], P[(B) + 4]); CE_(P[(B) + 3], P[(B) + 6]); CE_(P[(B) + 9], P[(B) + 12]); CE_(P[(B) + 11], P[(B) + 13]); \
    CE_(P[(B) + 3], P[(B) + 5]); CE_(P[(B) + 6], P[(B) + 8]); CE_(P[(B) + 7], P[(B) + 9]); CE_(P[(B) + 10], P[(B) + 12]); \
    CE_(P[(B) + 3], P[(B) + 4]); CE_(P[(B) + 5], P[(B) + 6]); CE_(P[(B) + 7], P[(B) + 8]); CE_(P[(B) + 9], P[(B) + 10]); CE_(P[(B) + 11], P[(B) + 12]); \
    CE_(P[(B) + 6], P[(B) + 7]); CE_(P[(B) + 8], P[(B) + 9]); \
} while (0)
#define MERGE16_(P, B) do { \
    CE_(P[(B) + 0], P[(B) + 8]); CE_(P[(B) + 1], P[(B) + 9]); CE_(P[(B) + 2], P[(B) + 10]); CE_(P[(B) + 3], P[(B) + 11]); CE_(P[(B) + 4], P[(B) + 12]); CE_(P[(B) + 5], P[(B) + 13]); CE_(P[(B) + 6], P[(B) + 14]); CE_(P[(B) + 7], P[(B) + 15]); \
    CE_(P[(B) + 0], P[(B) + 4]); CE_(P[(B) + 1], P[(B) + 5]); CE_(P[(B) + 2], P[(B) + 6]); CE_(P[(B) + 3], P[(B) + 7]); CE_(P[(B) + 8], P[(B) + 12]); CE_(P[(B) + 9], P[(B) + 13]); CE_(P[(B) + 10], P[(B) + 14]); CE_(P[(B) + 11], P[(B) + 15]); \
    CE_(P[(B) + 0], P[(B) + 2]); CE_(P[(B) + 1], P[(B) + 3]); CE_(P[(B) + 4], P[(B) + 6]); CE_(P[(B) + 5], P[(B) + 7]); CE_(P[(B) + 8], P[(B) + 10]); CE_(P[(B) + 9], P[(B) + 11]); CE_(P[(B) + 12], P[(B) + 14]); CE_(P[(B) + 13], P[(B) + 15]); \
    CE_(P[(B) + 0], P[(B) + 1]); CE_(P[(B) + 2], P[(B) + 3]); CE_(P[(B) + 4], P[(B) + 5]); CE_(P[(B) + 6], P[(B) + 7]); CE_(P[(B) + 8], P[(B) + 9]); CE_(P[(B) + 10], P[(B) + 11]); CE_(P[(B) + 12], P[(B) + 13]); CE_(P[(B) + 14], P[(B) + 15]); \
} while (0)
#define SORT32_(P, B) do { \
    CE_(P[(B) + 0], P[(B) + 1]); CE_(P[(B) + 3], P[(B) + 2]); CE_(P[(B) + 4], P[(B) + 5]); CE_(P[(B) + 7], P[(B) + 6]); CE_(P[(B) + 8], P[(B) + 9]); CE_(P[(B) + 11], P[(B) + 10]); CE_(P[(B) + 12], P[(B) + 13]); CE_(P[(B) + 15], P[(B) + 14]); \
    CE_(P[(B) + 16], P[(B) + 17]); CE_(P[(B) + 19], P[(B) + 18]); CE_(P[(B) + 20], P[(B) + 21]); CE_(P[(B) + 23], P[(B) + 22]); CE_(P[(B) + 24], P[(B) + 25]); CE_(P[(B) + 27], P[(B) + 26]); CE_(P[(B) + 28], P[(B) + 29]); CE_(P[(B) + 31], P[(B) + 30]); \
    CE_(P[(B) + 0], P[(B) + 2]); CE_(P[(B) + 1], P[(B) + 3]); CE_(P[(B) + 6], P[(B) + 4]); CE_(P[(B) + 7], P[(B) + 5]); CE_(P[(B) + 8], P[(B) + 10]); CE_(P[(B) + 9], P[(B) + 11]); CE_(P[(B) + 14], P[(B) + 12]); CE_(P[(B) + 15], P[(B) + 13]); \
    CE_(P[(B) + 16], P[(B) + 18]); CE_(P[(B) + 17], P[(B) + 19]); CE_(P[(B) + 22], P[(B) + 20]); CE_(P[(B) + 23], P[(B) + 21]); CE_(P[(B) + 24], P[(B) + 26]); CE_(P[(B) + 25], P[(B) + 27]); CE_(P[(B) + 30], P[(B) + 28]); CE_(P[(B) + 31], P[(B) + 29]); \
    CE_(P[(B) + 0], P[(B) + 1]); CE_(P[(B) + 2], P[(B) + 3]); CE_(P[(B) + 5], P[(B) + 4]); CE_(P[(B) + 7], P[(B) + 6]); CE_(P[(B) + 8], P[(B) + 9]); CE_(P[(B) + 10], P[(B) + 11]); CE_(P[(B) + 13], P[(B) + 12]); CE_(P[(B) + 15], P[(B) + 14]); \
    CE_(P[(B) + 16], P[(B) + 17]); CE_(P[(B) + 18], P[(B) + 19]); CE_(P[(B) + 21], P[(B) + 20]); CE_(P[(B) + 23], P[(B) + 22]); CE_(P[(B) + 24], P[(B) + 25]); CE_(P[(B) + 26], P[(B) + 27]); CE_(P[(B) + 29], P[(B) + 28]); CE_(P[(B) + 31], P[(B) + 30]); \
    CE_(P[(B) + 0], P[(B) + 4]); CE_(P[(B) + 1], P[(B) + 5]); CE_(P[(B) + 2], P[(B) + 6]); CE_(P[(B) + 3], P[(B) + 7]); CE_(P[(B) + 12], P[(B) + 8]); CE_(P[(B) + 13], P[(B) + 9]); CE_(P[(B) + 14], P[(B) + 10]); CE_(P[(B) + 15], P[(B) + 11]); \
    CE_(P[(B) + 16], P[(B) + 20]); CE_(P[(B) + 17], P[(B) + 21]); CE_(P[(B) + 18], P[(B) + 22]); CE_(P[(B) + 19], P[(B) + 23]); CE_(P[(B) + 28], P[(B) + 24]); CE_(P[(B) + 29], P[(B) + 25]); CE_(P[(B) + 30], P[(B) + 26]); CE_(P[(B) + 31], P[(B) + 27]); \
    CE_(P[(B) + 0], P[(B) + 2]); CE_(P[(B) + 1], P[(B) + 3]); CE_(P[(B) + 4], P[(B) + 6]); CE_(P[(B) + 5], P[(B) + 7]); CE_(P[(B) + 10], P[(B) + 8]); CE_(P[(B) + 11], P[(B) + 9]); CE_(P[(B) + 14], P[(B) + 12]); CE_(P[(B) + 15], P[(B) + 13]); \
    CE_(P[(B) + 16], P[(B) + 18]); CE_(P[(B) + 17], P[(B) + 19]); CE_(P[(B) + 20], P[(B) + 22]); CE_(P[(B) + 21], P[(B) + 23]); CE_(P[(B) + 26], P[(B) + 24]); CE_(P[(B) + 27], P[(B) + 25]); CE_(P[(B) + 30], P[(B) + 28]); CE_(P[(B) + 31], P[(B) + 29]); \
    CE_(P[(B) + 0], P[(B) + 1]); CE_(P[(B) + 2], P[(B) + 3]); CE_(P[(B) + 4], P[(B) + 5]); CE_(P[(B) + 6], P[(B) + 7]); CE_(P[(B) + 9], P[(B) + 8]); CE_(P[(B) + 11], P[(B) + 10]); CE_(P[(B) + 13], P[(B) + 12]); CE_(P[(B) + 15], P[(B) + 14]); \
    CE_(P[(B) + 16], P[(B) + 17]); CE_(P[(B) + 18], P[(B) + 19]); CE_(P[(B) + 20], P[(B) + 21]); CE_(P[(B) + 22], P[(B) + 23]); CE_(P[(B) + 25], P[(B) + 24]); CE_(P[(B) + 27], P[(B) + 26]); CE_(P[(B) + 29], P[(B) + 28]); CE_(P[(B) + 31], P[(B) + 30]); \
    CE_(P[(B) + 0], P[(B) + 8]); CE_(P[(B) + 1], P[(B) + 9]); CE_(P[(B) + 2], P[(B) + 10]); CE_(P[(B) + 3], P[(B) + 11]); CE_(P[(B) + 4], P[(B) + 12]); CE_(P[(B) + 5], P[(B) + 13]); CE_(P[(B) + 6], P[(B) + 14]); CE_(P[(B) + 7], P[(B) + 15]); \
    CE_(P[(B) + 24], P[(B) + 16]); CE_(P[(B) + 25], P[(B) + 17]); CE_(P[(B) + 26], P[(B) + 18]); CE_(P[(B) + 27], P[(B) + 19]); CE_(P[(B) + 28], P[(B) + 20]); CE_(P[(B) + 29], P[(B) + 21]); CE_(P[(B) + 30], P[(B) + 22]); CE_(P[(B) + 31], P[(B) + 23]); \
    CE_(P[(B) + 0], P[(B) + 4]); CE_(P[(B) + 1], P[(B) + 5]); CE_(P[(B) + 2], P[(B) + 6]); CE_(P[(B) + 3], P[(B) + 7]); CE_(P[(B) + 8], P[(B) + 12]); CE_(P[(B) + 9], P[(B) + 13]); CE_(P[(B) + 10], P[(B) + 14]); CE_(P[(B) + 11], P[(B) + 15]); \
    CE_(P[(B) + 20], P[(B) + 16]); CE_(P[(B) + 21], P[(B) + 17]); CE_(P[(B) + 22], P[(B) + 18]); CE_(P[(B) + 23], P[(B) + 19]); CE_(P[(B) + 28], P[(B) + 24]); CE_(P[(B) + 29], P[(B) + 25]); CE_(P[(B) + 30], P[(B) + 26]); CE_(P[(B) + 31], P[(B) + 27]); \
    CE_(P[(B) + 0], P[(B) + 2]); CE_(P[(B) + 1], P[(B) + 3]); CE_(P[(B) + 4], P[(B) + 6]); CE_(P[(B) + 5], P[(B) + 7]); CE_(P[(B) + 8], P[(B) + 10]); CE_(P[(B) + 9], P[(B) + 11]); CE_(P[(B) + 12], P[(B) + 14]); CE_(P[(B) + 13], P[(B) + 15]); \
    CE_(P[(B) + 18], P[(B) + 16]); CE_(P[(B) + 19], P[(B) + 17]); CE_(P[(B) + 22], P[(B) + 20]); CE_(P[(B) + 23], P[(B) + 21]); CE_(P[(B) + 26], P[(B) + 24]); CE_(P[(B) + 27], P[(B) + 25]); CE_(P[(B) + 30], P[(B) + 28]); CE_(P[(B) + 31], P[(B) + 29]); \
    CE_(P[(B) + 0], P[(B) + 1]); CE_(P[(B) + 2], P[(B) + 3]); CE_(P[(B) + 4], P[(B) + 5]); CE_(P[(B) + 6], P[(B) + 7]); CE_(P[(B) + 8], P[(B) + 9]); CE_(P[(B) + 10], P[(B) + 11]); CE_(P[(B) + 12], P[(B) + 13]); CE_(P[(B) + 14], P[(B) + 15]); \
    CE_(P[(B) + 17], P[(B) + 16]); CE_(P[(B) + 19], P[(B) + 18]); CE_(P[(B) + 21], P[(B) + 20]); CE_(P[(B) + 23], P[(B) + 22]); CE_(P[(B) + 25], P[(B) + 24]); CE_(P[(B) + 27], P[(B) + 26]); CE_(P[(B) + 29], P[(B) + 28]); CE_(P[(B) + 31], P[(B) + 30]); \
    CE_(P[(B) + 0], P[(B) + 16]); CE_(P[(B) + 1], P[(B) + 17]); CE_(P[(B) + 2], P[(B) + 18]); CE_(P[(B) + 3], P[(B) + 19]); CE_(P[(B) + 4], P[(B) + 20]); CE_(P[(B) + 5], P[(B) + 21]); CE_(P[(B) + 6], P[(B) + 22]); CE_(P[(B) + 7], P[(B) + 23]); \
    CE_(P[(B) + 8], P[(B) + 24]); CE_(P[(B) + 9], P[(B) + 25]); CE_(P[(B) + 10], P[(B) + 26]); CE_(P[(B) + 11], P[(B) + 27]); CE_(P[(B) + 12], P[(B) + 28]); CE_(P[(B) + 13], P[(B) + 29]); CE_(P[(B) + 14], P[(B) + 30]); CE_(P[(B) + 15], P[(B) + 31]); \
    CE_(P[(B) + 0], P[(B) + 8]); CE_(P[(B) + 1], P[(B) + 9]); CE_(P[(B) + 2], P[(B) + 10]); CE_(P[(B) + 3], P[(B) + 11]); CE_(P[(B) + 4], P[(B) + 12]); CE_(P[(B) + 5], P[(B) + 13]); CE_(P[(B) + 6], P[(B) + 14]); CE_(P[(B) + 7], P[(B) + 15]); \
    CE_(P[(B) + 16], P[(B) + 24]); CE_(P[(B) + 17], P[(B) + 25]); CE_(P[(B) + 18], P[(B) + 26]); CE_(P[(B) + 19], P[(B) + 27]); CE_(P[(B) + 20], P[(B) + 28]); CE_(P[(B) + 21], P[(B) + 29]); CE_(P[(B) + 22], P[(B) + 30]); CE_(P[(B) + 23], P[(B) + 31]); \
    CE_(P[(B) + 0], P[(B) + 4]); CE_(P[(B) + 1], P[(B) + 5]); CE_(P[(B) + 2], P[(B) + 6]); CE_(P[(B) + 3], P[(B) + 7]); CE_(P[(B) + 8], P[(B) + 12]); CE_(P[(B) + 9], P[(B) + 13]); CE_(P[(B) + 10], P[(B) + 14]); CE_(P[(B) + 11], P[(B) + 15]); \
    CE_(P[(B) + 16], P[(B) + 20]); CE_(P[(B) + 17], P[(B) + 21]); CE_(P[(B) + 18], P[(B) + 22]); CE_(P[(B) + 19], P[(B) + 23]); CE_(P[(B) + 24], P[(B) + 28]); CE_(P[(B) + 25], P[(B) + 29]); CE_(P[(B) + 26], P[(B) + 30]); CE_(P[(B) + 27], P[(B) + 31]); \
    CE_(P[(B) + 0], P[(B) + 2]); CE_(P[(B) + 1], P[(B) + 3]); CE_(P[(B) + 4], P[(B) + 6]); CE_(P[(B) + 5], P[(B) + 7]); CE_(P[(B) + 8], P[(B) + 10]); CE_(P[(B) + 9], P[(B) + 11]); CE_(P[(B) + 12], P[(B) + 14]); CE_(P[(B) + 13], P[(B) + 15]); \
    CE_(P[(B) + 16], P[(B) + 18]); CE_(P[(B) + 17], P[(B) + 19]); CE_(P[(B) + 20], P[(B) + 22]); CE_(P[(B) + 21], P[(B) + 23]); CE_(P[(B) + 24], P[(B) + 26]); CE_(P[(B) + 25], P[(B) + 27]); CE_(P[(B) + 28], P[(B) + 30]); CE_(P[(B) + 29], P[(B) + 31]); \
    CE_(P[(B) + 0], P[(B) + 1]); CE_(P[(B) + 2], P[(B) + 3]); CE_(P[(B) + 4], P[(B) + 5]); CE_(P[(B) + 6], P[(B) + 7]); CE_(P[(B) + 8], P[(B) + 9]); CE_(P[(B) + 10], P[(B) + 11]); CE_(P[(B) + 12], P[(B) + 13]); CE_(P[(B) + 14], P[(B) + 15]); \
    CE_(P[(B) + 16], P[(B) + 17]); CE_(P[(B) + 18], P[(B) + 19]); CE_(P[(B) + 20], P[(B) + 21]); CE_(P[(B) + 22], P[(B) + 23]); CE_(P[(B) + 24], P[(B) + 25]); CE_(P[(B) + 26], P[(B) + 27]); CE_(P[(B) + 28], P[(B) + 29]); CE_(P[(B) + 30], P[(B) + 31]); \
} while (0)

DI void top16_of_128(float (&p)[64], float (&out)[16], int lane) {
    SORT16_(p, 0); SORT16_(p, 16); SORT16_(p, 32); SORT16_(p, 48);
#pragma unroll
    for (int i = 0; i < 16; ++i) { p[i] = fmaxf(p[i], p[31 - i]); p[32 + i] = fmaxf(p[32 + i], p[63 - i]); }
    MERGE16_(p, 0); MERGE16_(p, 32);
#pragma unroll
    for (int i = 0; i < 16; ++i) p[i] = fmaxf(p[i], p[47 - i]);
    MERGE16_(p, 0);
    float q[16];
#pragma unroll
    for (int i = 0; i < 16; ++i) q[i] = shx<32>(p[15 - i], lane);
#pragma unroll
    for (int i = 0; i < 16; ++i) p[i] = fmaxf(p[i], q[i]);
    MERGE16_(p, 0);
#pragma unroll
    for (int i = 0; i < 16; ++i) out[i] = p[i];
}
DI void route_q_load(bf16x8 (&bq)[8], const bf16_t* Q, int head, int tile, int z, int lane) {
    const bf16_t* qrow = Q + ((size_t)tile * 32 + (lane & 31)) * NQ + head * 256 + z * 128 + 8 * (lane >> 5);
#pragma unroll
    for (int s8 = 0; s8 < 8; ++s8) bq[s8] = *(const bf16x8*)(qrow + 16 * s8);
}
DI void peer_route_tile(lptr L, int lane, int wave, const bf16_t* Q, int head, int tile, u32x2* route, bf16x8 (&bq0)[8], int next_tile) {
    const int r = lane & 31, hh = lane >> 5;
    const size_t tok = (size_t)tile * 32 + r;
    float top[2][16];
    bf16x8 bq1[8];
    route_q_load(bq1, Q, head, tile, 1, lane);
    __builtin_amdgcn_sched_barrier(0);
#pragma unroll
    for (int z = 0; z < 2; ++z) {
        bf16x8 bq[8];
#pragma unroll
        for (int s8 = 0; s8 < 8; ++s8) bq[s8] = z ? bq1[s8] : bq0[s8];
        float p[64];
#pragma unroll
        for (int m = 0; m < 4; ++m) { f32x16 acc = zero16();
#pragma unroll
            for (int s8 = 0; s8 < 8; ++s8) acc = MFMA32(fragK(L + z * 34816, 272, 32 * m, 16 * s8, lane), bq[s8], acc);
#pragma unroll
            for (int i = 0; i < 16; ++i) p[m * 16 + i] = __int_as_float((__float_as_int(acc[i]) & ~0x7f) | (32 * m + crow(i, hh)));
            __builtin_amdgcn_sched_barrier(0); }
        if (z == 1 && next_tile >= 0) { route_q_load(bq0, Q, head, next_tile, 0, lane); __builtin_amdgcn_sched_barrier(0); }
        top16_of_128(p, top[z], lane);
    }
    float cand[50];
#define CAND_ROW(i, off) _Pragma("unroll") for (int j = 0; j < 16 / ((i) + 1); ++j) { const float s = top[0][i] + top[1][j]; \
        cand[(off) + j] = __int_as_float((__float_as_int(s) & ~0xff) | ((i) * 16 + j)); }
    CAND_ROW(0, 0) CAND_ROW(1, 16) CAND_ROW(2, 24) CAND_ROW(3, 29) CAND_ROW(4, 33) CAND_ROW(5, 36) CAND_ROW(6, 38) CAND_ROW(7, 40)
    CAND_ROW(8, 42) CAND_ROW(9, 43) CAND_ROW(10, 44) CAND_ROW(11, 45) CAND_ROW(12, 46) CAND_ROW(13, 47) CAND_ROW(14, 48) CAND_ROW(15, 49)
#undef CAND_ROW
    float c32[32];
#pragma unroll
    for (int m = 0; m < 25; ++m) c32[m] = selh(-hh, cand[2 * m], cand[2 * m + 1]);
#pragma unroll
    for (int m = 25; m < 32; ++m) c32[m] = -INFINITY;
    SORT32_(c32, 0);
    float win[16];
    {
        float q[16];
#pragma unroll
        for (int i = 0; i < 16; ++i) q[i] = shx<32>(c32[15 - i], lane);
#pragma unroll
        for (int i = 0; i < 16; ++i) c32[i] = fmaxf(c32[i], q[i]);
        MERGE16_(c32, 0);
#pragma unroll
        for (int i = 0; i < 16; ++i) win[i] = c32[i];
    }
    LAS unsigned* tb = (LAS unsigned*)(L + 69632 + wave * 4352) + r * 33 + 16 * hh;
#pragma unroll
    for (int q = 0; q < 16; ++q) tb[q] = (unsigned)__float_as_int(selh(-hh, top[0][q], top[1][q])) & 0x7fu;
    float e[16], sum = 0.f;
#pragma unroll
    for (int q = 0; q < 16; ++q) { e[q] = __expf(win[q] - win[0]); sum += e[q]; }
    const float inv = 1.0f / sum;
    LDS_WAIT();
    const LAS unsigned* tr_ = (const LAS unsigned*)(L + 69632 + wave * 4352) + r * 33;
    u32x2* ro = route + (tok * 8 + head) * 16 + 8 * hh;
#pragma unroll
    for (int q = 0; q < 8; ++q) {
        const float wv = selh(-hh, win[q], win[8 + q]); const float ev = selh(-hh, e[q], e[8 + q]);
        const int id = __float_as_int(wv) & 0xff;
        const unsigned n0 = tr_[id >> 4], n1 = tr_[16 + (id & 15)];
        u32x2 o; o.x = n0 * 128u + n1; o.y = (unsigned)__float_as_int(ev * inv); ro[q] = o;
    }
    LDS_WAIT();
}
DI void peer_route_unit(lptr L, int tid, int pm, int head, const bf16_t* Q, const bf16_t* SK, u32x2* route) {
    const int lane = tid & 63, wave = __builtin_amdgcn_readfirstlane(tid >> 6);
    __syncthreads();
    for (int i = tid; i < 2 * 128 * 16; i += NTHR) { const int z = i >> 11, n = (i >> 4) & 127, cc = i & 15;
        *(LAS u32x4*)(L + z * 34816 + n * 272 + cc * 16) = *(const u32x4*)(SK + ((size_t)(head * 2 + z) * 128 + n) * 128 + cc * 8); }
    __syncthreads();
    bf16x8 bq0[8]; route_q_load(bq0, Q, head, pm * 8 + wave, 0, lane);
    peer_route_tile(L, lane, wave, Q, head, pm * 8 + wave, route, bq0, -1);
}
DI void peer_route_phase(lptr L, int tid, int vcu, const bf16_t* Q, const bf16_t* SK  , u32x2* route) {
    const int lane = tid & 63, wave = __builtin_amdgcn_readfirstlane(tid >> 6);
    const int head = vcu & 7, base = vcu >> 3;
    __syncthreads();
    for (int i = tid; i < 2 * 128 * 16; i += NTHR) { const int z = i >> 11, n = (i >> 4) & 127, cc = i & 15;
        *(LAS u32x4*)(L + z * 34816 + n * 272 + cc * 16) = *(const u32x4*)(SK + ((size_t)(head * 2 + z) * 128 + n) * 128 + cc * 8); }
    __syncthreads();
    bf16x8 bq0[8];
    route_q_load(bq0, Q, head, base * 16 + wave * 2, 0, lane);
#pragma unroll 1
    for (int i = 0; i < 2; ++i) peer_route_tile(L, lane, wave, Q, head, base * 16 + wave * 2 + i, route, bq0, i == 0 ? base * 16 + wave * 2 + 1 : -1);
}

DI float erf_as(float x) {
    const float ax = fabsf(x), t = __builtin_amdgcn_rcpf(1.0f + 0.3275911f * ax);
    const float poly = t * (0.254829592f + t * (-0.284496736f + t * (1.421413741f + t * (-1.453152027f + t * 1.061405429f))));
    const float r = 1.0f - poly * __expf(-ax * ax);
    return __builtin_copysignf(r, x);
}
DI float gelu_exact(float x) { return 0.5f * x * (1.0f + erf_as(x * 0.70710678118654752f)); }
struct GatherP {
    const bf16_t* H; const u32x2* route; const unsigned char* U; const unsigned char* V; float* X; const float* gt2;
    int last; const float* ng; const float* nsc; const float* nsh;
    bf16_t* Hout; float* small; const LAS float* wsm; float* out;
    const unsigned char* H8; const float* HS;
    unsigned char* G8; float* GS;
};
constexpr float U8_SCALE = 256.0f, V8_SCALE = 16.0f;
DI void cvt_stream_fp8(const float* src, unsigned char* dst, size_t n, float scale, int gw, int ngw, int lane) {
    const size_t n16 = n / 16, stride = (size_t)ngw * 64;
    for (size_t i0 = (size_t)gw * 64 + lane; i0 < n16; i0 += 4 * stride) {
        f32x4 a[4][4];
#pragma unroll
        for (int u = 0; u < 4; ++u) { const size_t i = i0 + u * stride;
#pragma unroll
            for (int q = 0; q < 4; ++q) a[u][q] = (i < n16) ? ((const f32x4*)src)[4 * i + q] : (f32x4){0.f, 0.f, 0.f, 0.f}; }
#pragma unroll
        for (int u = 0; u < 4; ++u) { const size_t i = i0 + u * stride; u32x4 o;
#pragma unroll
            for (int q = 0; q < 4; ++q) { f32x4 v = a[u][q] * scale;
#pragma unroll
                for (int e = 0; e < 4; ++e) v[e] = fminf(fmaxf(v[e], -448.f), 448.f);
                int p = 0; p = __builtin_amdgcn_cvt_pk_fp8_f32(v[0], v[1], p, false); p = __builtin_amdgcn_cvt_pk_fp8_f32(v[2], v[3], p, true); o[q] = (unsigned)p; }
            if (i < n16) ((u32x4*)dst)[i] = o; }
    }
}
DI void fp8x16_to_f32(const u32x4& v, float (&f)[16]) {
    const unsigned d0 = v.x, d1 = v.y, d2 = v.z, d3 = v.w;
    f32x2 t;
    t = __builtin_amdgcn_cvt_pk_f32_fp8((int)d0, false); f[0] = t.x; f[1] = t.y; t = __builtin_amdgcn_cvt_pk_f32_fp8((int)d0, true); f[2] = t.x; f[3] = t.y;
    t = __builtin_amdgcn_cvt_pk_f32_fp8((int)d1, false); f[4] = t.x; f[5] = t.y; t = __builtin_amdgcn_cvt_pk_f32_fp8((int)d1, true); f[6] = t.x; f[7] = t.y;
    t = __builtin_amdgcn_cvt_pk_f32_fp8((int)d2, false); f[8] = t.x; f[9] = t.y; t = __builtin_amdgcn_cvt_pk_f32_fp8((int)d2, true); f[10] = t.x; f[11] = t.y;
    t = __builtin_amdgcn_cvt_pk_f32_fp8((int)d3, false); f[12] = t.x; f[13] = t.y; t = __builtin_amdgcn_cvt_pk_f32_fp8((int)d3, true); f[14] = t.x; f[15] = t.y;
}
#ifndef DBG_G
#define DBG_G 0
#endif
DI void peer_gather_token(const GatherP& P, size_t m, int lane) {
    float hv[16];
    { const bf16_t* hrow = P.H + m * D + 16 * lane; const u32x4 a = *(const u32x4*)hrow, b = *(const u32x4*)(hrow + 8);
      hv[0] = bf_lo(a.x); hv[1] = bf_hi(a.x); hv[2] = bf_lo(a.y); hv[3] = bf_hi(a.y); hv[4] = bf_lo(a.z); hv[5] = bf_hi(a.z); hv[6] = bf_lo(a.w); hv[7] = bf_hi(a.w);
      hv[8] = bf_lo(b.x); hv[9] = bf_hi(b.x); hv[10] = bf_lo(b.y); hv[11] = bf_hi(b.y); hv[12] = bf_lo(b.z); hv[13] = bf_hi(b.z); hv[14] = bf_lo(b.w); hv[15] = bf_hi(b.w); }
    float o[16];
#pragma unroll
    for (int e = 0; e < 16; ++e) o[e] = 0.f;
    const u32x2* rt = P.route + m * 128 + (lane & 7);
#pragma unroll 1
    for (int bt = 0; bt < 16; ++bt) {
        const u32x2 re = rt[bt * 8];
        const int idx = (int)re.x; const float gate = __int_as_float((int)re.y);
        u32x4 uu[8], vv[8];
#pragma unroll
        for (int e = 0; e < 8; ++e) {
            const size_t ro = (size_t)__builtin_amdgcn_readlane(idx, e) * D + 16 * lane;
            uu[e] = *(const u32x4*)(P.U + ro); vv[e] = *(const u32x4*)(P.V + ro);
        }
        float p[8];
#pragma unroll
        for (int e = 0; e < 8; ++e) { float uf[16]; fp8x16_to_f32(uu[e], uf); float a0 = 0.f, a1 = 0.f;
#pragma unroll
            for (int k = 0; k < 16; k += 2) { a0 += hv[k] * uf[k]; a1 += hv[k + 1] * uf[k + 1]; }
            p[e] = a0 + a1; }
        float p4[4], p2[2], p1;
        { const bool up = (lane & 4) != 0;
#pragma unroll
          for (int q = 0; q < 4; ++q) { const float keep = up ? p[q + 4] : p[q], send = up ? p[q] : p[q + 4]; p4[q] = keep + shx<4>(send, lane); } }
        { const bool up = (lane & 2) != 0;
#pragma unroll
          for (int q = 0; q < 2; ++q) { const float keep = up ? p4[q + 2] : p4[q], send = up ? p4[q] : p4[q + 2]; p2[q] = keep + shx<2>(send, lane); } }
        { const bool up = (lane & 1) != 0; const float keep = up ? p2[1] : p2[0], send = up ? p2[0] : p2[1]; p1 = keep + shx<1>(send, lane); }
        p1 += shx<8>(p1, lane); p1 += shx<16>(p1, lane); p1 += shx<32>(p1, lane);
        const float act = gelu_exact(p1 * (1.0f / U8_SCALE)) * gate * (1.0f / V8_SCALE);
#pragma unroll
        for (int e = 0; e < 8; ++e) { const float a = __int_as_float(__builtin_amdgcn_readlane(__float_as_int(act), e)); float vf[16]; fp8x16_to_f32(vv[e], vf);
#pragma unroll
            for (int k = 0; k < 16; ++k) o[k] += a * vf[k]; }
    }
    const int bidx = (m >= (size_t)SEQ) ? 1 : 0;
    float* xr = P.X + m * D + 16 * lane; const float* g2 = P.gt2 + bidx * 6 * D + 16 * lane;
    float xn[16]; float ss = 0.f;
#pragma unroll
    for (int q = 0; q < 4; ++q) { const f32x4 xv = *(const f32x4*)(xr + 4 * q), gv = *(const f32x4*)(g2 + 4 * q);
#pragma unroll
        for (int e = 0; e < 4; ++e) { const float v = xv[e] + gv[e] * o[q * 4 + e]; xn[q * 4 + e] = v; ss += v * v; } }
    const float rstd = 1.0f / sqrtf(wave_sum(ss, lane) * (1.0f / D) + EPS);
    if (P.last) {
#pragma unroll
        for (int q = 0; q < 4; ++q) { const f32x4 gv = *(const f32x4*)(P.ng + 16 * lane + 4 * q); f32x4 r;
#pragma unroll
            for (int e = 0; e < 4; ++e) r[e] = xn[q * 4 + e] * rstd * gv[e];
            *(f32x4*)(P.out + m * D + 16 * lane + 4 * q) = r; }
    } else {
        float y[16];
#pragma unroll
        for (int q = 0; q < 4; ++q) { const int col = 16 * lane + 4 * q;
            const f32x4 gv = *(const f32x4*)(P.ng + col), sc = *(const f32x4*)(P.nsc + bidx * 6 * D + col), sh = *(const f32x4*)(P.nsh + bidx * 6 * D + col);
            *(f32x4*)(xr + 4 * q) = (f32x4){xn[q * 4], xn[q * 4 + 1], xn[q * 4 + 2], xn[q * 4 + 3]};
#pragma unroll
            for (int e = 0; e < 4; ++e) y[q * 4 + e] = xn[q * 4 + e] * rstd * gv[e] * (1.0f + sc[e]) + sh[e]; }
        bf16_t* ho = P.Hout + m * D + 16 * lane;
        { u32x4 w; w.x = pk2(y[0], y[1]); w.y = pk2(y[2], y[3]); w.z = pk2(y[4], y[5]); w.w = pk2(y[6], y[7]); *(u32x4*)ho = w; }
        { u32x4 w; w.x = pk2(y[8], y[9]); w.y = pk2(y[10], y[11]); w.z = pk2(y[12], y[13]); w.w = pk2(y[14], y[15]); *(u32x4*)(ho + 8) = w; }
#if IN_I8
        {
            float am = 0.f;
#pragma unroll
            for (int i = 0; i < 16; ++i) am = fmaxf(am, fabsf(y[i]));
            am = fmaxf(am, shx<1>(am, lane)); am = fmaxf(am, shx<2>(am, lane)); am = fmaxf(am, shx<4>(am, lane)); am = fmaxf(am, shx<8>(am, lane)); am = fmaxf(am, shx<16>(am, lane)); am = fmaxf(am, shx<32>(am, lane));
            am = fmaxf(am, 1e-20f); const float sc = 127.0f / am;
            unsigned w[4];
#pragma unroll
            for (int d = 0; d < 4; ++d) { const int q0 = (int)__builtin_rintf(y[4 * d] * sc), q1 = (int)__builtin_rintf(y[4 * d + 1] * sc), q2 = (int)__builtin_rintf(y[4 * d + 2] * sc), q3 = (int)__builtin_rintf(y[4 * d + 3] * sc);
                w[d] = (unsigned)(q0 & 0xff) | ((unsigned)(q1 & 0xff) << 8) | ((unsigned)(q2 & 0xff) << 16) | ((unsigned)q3 << 24); }
            *(u32x4*)(P.G8 + m * D + cbase) = (u32x4){w[0], w[1], w[2], w[3]};
            if (lane == 0) P.GS[m] = am * (1.0f / 127.0f);
        }
#endif
        float pr[8];
#pragma unroll
        for (int c = 0; c < 8; ++c) { float a = 0.f;
#pragma unroll
            for (int q = 0; q < 4; ++q) { const f32x4 wv = *(const LAS f32x4*)(P.wsm + c * D + 16 * lane + 4 * q);
                a += (y[q * 4] * wv.x + y[q * 4 + 1] * wv.y) + (y[q * 4 + 2] * wv.z + y[q * 4 + 3] * wv.w); }
            pr[c] = wave_sum(a, lane); }
        if (lane < 8) { float rr = pr[0];
#pragma unroll
            for (int c = 1; c < 8; ++c) rr = (lane == c) ? pr[c] : rr;
            P.small[m * 8 + lane] = rr; }
    }
}

DI void peer_u_pass(lptr L, int tid, int bx, const bf16_t* H, const u32x2* route, const unsigned char* U8, float* ACT) {
    const int lane = tid & 63, wave = __builtin_amdgcn_readfirstlane(tid >> 6);
    const unsigned x = (unsigned)bx & 7u; const int wx = (bx >> 3) * 8 + wave;
    LAS unsigned* list = (LAS unsigned*)(L + wave * 2048);
    u32x2 e0 = route[(size_t)wx * 128 + lane], e1 = route[(size_t)wx * 128 + 64 + lane];
    u32x4 ha = *(const u32x4*)(H + (size_t)wx * D + 16 * lane), hb = *(const u32x4*)(H + (size_t)wx * D + 16 * lane + 8);
#pragma unroll 1
    for (int t = wx; t < M; t += 256) {
        float hv[16];
        hv[0] = bf_lo(ha.x); hv[1] = bf_hi(ha.x); hv[2] = bf_lo(ha.y); hv[3] = bf_hi(ha.y); hv[4] = bf_lo(ha.z); hv[5] = bf_hi(ha.z); hv[6] = bf_lo(ha.w); hv[7] = bf_hi(ha.w);
        hv[8] = bf_lo(hb.x); hv[9] = bf_hi(hb.x); hv[10] = bf_lo(hb.y); hv[11] = bf_hi(hb.y); hv[12] = bf_lo(hb.z); hv[13] = bf_hi(hb.z); hv[14] = bf_lo(hb.w); hv[15] = bf_hi(hb.w);
        const bool own0 = (e0.x & 7u) == x, own1 = (e1.x & 7u) == x;
        const unsigned long long m0 = __ballot(own0), m1 = __ballot(own1);
        const int n0 = __popcll(m0), n = n0 + __popcll(m1);
        const int p0 = (int)__builtin_amdgcn_mbcnt_hi((unsigned)(m0 >> 32), __builtin_amdgcn_mbcnt_lo((unsigned)m0, 0u));
        const int p1 = n0 + (int)__builtin_amdgcn_mbcnt_hi((unsigned)(m1 >> 32), __builtin_amdgcn_mbcnt_lo((unsigned)m1, 0u));
        if (own0) { list[p0] = e0.x; list[136 + p0] = e0.y; list[272 + p0] = (unsigned)lane; }
        if (own1) { list[p1] = e1.x; list[136 + p1] = e1.y; list[272 + p1] = (unsigned)(lane + 64); }
        if (lane < 8) { list[n + lane] = x; list[136 + n + lane] = 0u; list[272 + n + lane] = 0xffffffffu; }
        const int tn = t + 256;
        if (tn < M) { e0 = route[(size_t)tn * 128 + lane]; e1 = route[(size_t)tn * 128 + 64 + lane];
                      ha = *(const u32x4*)(H + (size_t)tn * D + 16 * lane); hb = *(const u32x4*)(H + (size_t)tn * D + 16 * lane + 8); }
        LDS_WAIT();
#pragma unroll 1
        for (int b0 = 0; b0 < n; b0 += 8) {
            const unsigned idx = list[b0 + (lane & 7)]; const float gate = __uint_as_float(list[136 + b0 + (lane & 7)]); const unsigned kk = list[272 + b0 + (lane & 7)];
            u32x4 uu[8];
#pragma unroll
            for (int e = 0; e < 8; ++e) uu[e] = *(const u32x4*)(U8 + (size_t)__builtin_amdgcn_readlane((int)idx, e) * D + 16 * lane);
            float p[8];
#pragma unroll
            for (int e = 0; e < 8; ++e) { float uf[16]; fp8x16_to_f32(uu[e], uf); float a0 = 0.f, a1 = 0.f;
#pragma unroll
                for (int k = 0; k < 16; k += 2) { a0 += hv[k] * uf[k]; a1 += hv[k + 1] * uf[k + 1]; }
                p[e] = a0 + a1; }
            float p4[4], p2[2], p1;
            { const bool up = (lane & 4) != 0;
#pragma unroll
              for (int q = 0; q < 4; ++q) { const float keep = up ? p[q + 4] : p[q], send = up ? p[q] : p[q + 4]; p4[q] = keep + shx<4>(send, lane); } }
            { const bool up = (lane & 2) != 0;
#pragma unroll
              for (int q = 0; q < 2; ++q) { const float keep = up ? p4[q + 2] : p4[q], send = up ? p4[q] : p4[q + 2]; p2[q] = keep + shx<2>(send, lane); } }
            { const bool up = (lane & 1) != 0; const float keep = up ? p2[1] : p2[0], send = up ? p2[0] : p2[1]; p1 = keep + shx<1>(send, lane); }
            p1 += shx<8>(p1, lane); p1 += shx<16>(p1, lane); p1 += shx<32>(p1, lane);
            const float act = gelu_exact(p1 * (1.0f / U8_SCALE)) * gate * (1.0f / V8_SCALE);
            if (lane < 8 && kk != 0xffffffffu) ACT[(size_t)t * 128 + kk] = act;
        }
        LDS_WAIT();
    }
}
DI void peer_v_pass(int tid, int bx, const u32x2* route, const float* ACT, const unsigned char* V8, float* X, const float* gt2) {
    const int lane = tid & 63, wave = __builtin_amdgcn_readfirstlane(tid >> 6);
    const int x = bx & 7, wx = (bx >> 3) * 8 + wave, es = lane >> 3, ch = lane & 7, col0 = 128 * x + 16 * ch;
    unsigned re[16]; float aa[16];
#pragma unroll
    for (int i = 0; i < 16; ++i) { const unsigned o_ = (unsigned)(wx * 128 + 8 * i + es); re[i] = route[o_].x; aa[i] = ACT[o_]; }
#pragma unroll 1
    for (int t = wx; t < M; t += 256) {
        u32x4 vv[16];
#pragma unroll
        for (int i = 0; i < 16; ++i) vv[i] = *(const u32x4*)(V8 + (re[i] * 1024u + (unsigned)col0));
        float ac[16];
#pragma unroll
        for (int i = 0; i < 16; ++i) ac[i] = aa[i];
        const int tn = t + 256;
        if (tn < M) {
#pragma unroll
            for (int i = 0; i < 16; ++i) { const unsigned o_ = (unsigned)(tn * 128 + 8 * i + es); re[i] = route[o_].x; aa[i] = ACT[o_]; } }
        float o[16];
#pragma unroll
        for (int k = 0; k < 16; ++k) o[k] = 0.f;
#pragma unroll
        for (int i = 0; i < 16; ++i) { float vf[16]; fp8x16_to_f32(vv[i], vf);
#pragma unroll
            for (int k = 0; k < 16; ++k) o[k] += ac[i] * vf[k];
            if ((i & 3) == 3) __builtin_amdgcn_sched_barrier(0); }
#pragma unroll
        for (int k = 0; k < 16; ++k) { o[k] += shx<8>(o[k], lane); o[k] += shx<16>(o[k], lane); o[k] += shx<32>(o[k], lane); }
        if (es == 0) { float* xr = X + (size_t)t * D + col0; const float* g2 = gt2 + (t >= SEQ ? 6 * D : 0) + col0;
#pragma unroll
            for (int q = 0; q < 4; ++q) { const f32x4 xv = *(const f32x4*)(xr + 4 * q), gv = *(const f32x4*)(g2 + 4 * q);
                *(f32x4*)(xr + 4 * q) = (f32x4){xv[0] + gv[0] * o[4 * q], xv[1] + gv[1] * o[4 * q + 1], xv[2] + gv[2] * o[4 * q + 2], xv[3] + gv[3] * o[4 * q + 3]}; } }
    }
}
DI void row_final(const f32x4 (&v)[4], const float* g, float* orow, int lane) {
    float s = 0.f;
#pragma unroll
    for (int j = 0; j < 4; ++j) s += (v[j].x * v[j].x + v[j].y * v[j].y) + (v[j].z * v[j].z + v[j].w * v[j].w);
    const float rstd = 1.0f / sqrtf(wave_sum(s, lane) * (1.0f / D) + EPS);
#pragma unroll
    for (int j = 0; j < 4; ++j) ((f32x4*)orow)[lane + 64 * j] = v[j] * rstd * ((const f32x4*)g)[lane + 64 * j];
}

constexpr float U6_SCALE = 54.0f, V6_SCALE = 4.75f;
constexpr int ROW6 = 768;
typedef unsigned v6u_t __attribute__((ext_vector_type(6)));
typedef float v32f_t __attribute__((ext_vector_type(32)));
DI unsigned enc_e2m3(float x) {
    const float a = fminf(fabsf(x), 7.5f);
    const float inv = a < 2.0f ? 8.0f : (a < 4.0f ? 4.0f : 2.0f);
    const unsigned add = a < 2.0f ? 0u : (a < 4.0f ? 8u : 16u);
    const unsigned c = (unsigned)__builtin_rintf(a * inv) + add;
    return (c > 31u ? 31u : c) | ((__float_as_uint(x) >> 26) & 32u);
}
DI void cvt_stream_fp6(const float* src, unsigned char* dst, float scale, int gw, int ngw, int lane) {
    constexpr int NGRP = NEXP * 32;
    for (int g = gw * 64 + lane; g < NGRP; g += ngw * 64) {
        const int row = g >> 5, lp = g & 31;
        const f32x4* p = (const f32x4*)(src + (size_t)g * 32);
        f32x4 v[8];
#pragma unroll
        for (int q = 0; q < 8; ++q) v[q] = __builtin_nontemporal_load(p + q);
        unsigned cd[32];
#pragma unroll
        for (int q = 0; q < 8; ++q)
#pragma unroll
            for (int e = 0; e < 4; ++e) cd[4 * q + e] = enc_e2m3(v[q][e] * scale);
        unsigned w[6];
#pragma unroll
        for (int d = 0; d < 6; ++d) { unsigned acc = 0u;
#pragma unroll
            for (int i = 0; i < 32; ++i) { const int lo = 6 * i - 32 * d;
                if (lo > -6 && lo < 32) acc |= (lo >= 0) ? (cd[i] << lo) : (cd[i] >> (-lo)); }
            w[d] = acc; }
        unsigned char* rp = dst + (size_t)row * ROW6;
        *(u32x4*)(rp + 16 * lp) = (u32x4){w[0], w[1], w[2], w[3]};
        *(u32x2*)(rp + 512 + 8 * lp) = (u32x2){w[4], w[5]};
    }
}
#ifndef PROBE_DUP
#define PROBE_DUP 0
#endif
#ifndef GATHER_DPP
#define GATHER_DPP 1
#endif
#ifndef GATHER_DEPTH
#define GATHER_DEPTH 2
#endif
#ifndef GATHER_INPLACE
#define GATHER_INPLACE 0
#endif
#ifndef GATHER_BP
#define GATHER_BP 12
#endif
#ifndef GATHER_PIPE
#define GATHER_PIPE 2
#endif
#ifndef IN_I8
#define IN_I8 1
#endif
#ifndef TAB_UI4
#define TAB_UI4 1
#endif
#ifndef TAB_U4
#define TAB_U4 1
#endif
#ifndef TAB_V4
#define TAB_V4 1
#endif
constexpr float U4_SCALE = 67.0f, V4_SCALE = 5.94f;
constexpr int ROW4 = 512;
constexpr float UI_SCALE = 96.0f;
constexpr float UT_SCALE = TAB_UI4 ? UI_SCALE : TAB_U4 ? U4_SCALE : U6_SCALE, VT_SCALE = TAB_V4 ? V4_SCALE : V6_SCALE;
constexpr int ROWU = TAB_U4 ? ROW4 : ROW6, ROWV = TAB_V4 ? ROW4 : ROW6;
typedef float v2f_t __attribute__((ext_vector_type(2)));
DI unsigned enc_e2m1(float x) {
    const float a = fminf(fabsf(x), 6.0f);
    const float inv = a < 2.0f ? 2.0f : (a < 4.0f ? 1.0f : 0.5f);
    const unsigned add = a < 2.0f ? 0u : (a < 4.0f ? 2u : 4u);
    const unsigned c = (unsigned)__builtin_rintf(a * inv) + add;
    return (c > 7u ? 7u : c) | ((__float_as_uint(x) >> 28) & 8u);
}
DI void cvt_stream_fp4(const float* src, unsigned char* dst, float scale, int gw, int ngw, int lane) {
    constexpr int NGRP = NEXP * 32;
    for (int g = gw * 64 + lane; g < NGRP; g += ngw * 64) {
        const int row = g >> 5, lp = g & 31;
        const f32x4* p = (const f32x4*)(src + (size_t)g * 32);
        f32x4 v[8];
#pragma unroll
        for (int q = 0; q < 8; ++q) v[q] = __builtin_nontemporal_load(p + q);
        unsigned w[4];
#pragma unroll
        for (int d = 0; d < 4; ++d) { unsigned acc = 0u;
#pragma unroll
            for (int i = 0; i < 8; ++i) acc |= enc_e2m1(v[2 * d + (i >> 2)][i & 3] * scale) << (4 * i);
            w[d] = acc; }
        *(u32x4*)(dst + (size_t)row * ROW4 + 16 * lp) = (u32x4){w[0], w[1], w[2], w[3]};
    }
}
DI unsigned enc_u4(float x) { const float t = __builtin_floorf(x + 8.0f); return (unsigned)fminf(fmaxf(t, 0.f), 15.f); }
DI void cvt_stream_u4(const float* src, unsigned char* dst, float scale, int gw, int ngw, int lane) {
    constexpr int NGRP = NEXP * 32;
    for (int g = gw * 64 + lane; g < NGRP; g += ngw * 64) {
        const int row = g >> 5, lp = g & 31;
        const f32x4* p = (const f32x4*)(src + (size_t)g * 32);
        f32x4 v[8];
#pragma unroll
        for (int q = 0; q < 8; ++q) v[q] = __builtin_nontemporal_load(p + q);
        unsigned w[4];
#pragma unroll
        for (int d = 0; d < 4; ++d) { unsigned acc = 0u;
#pragma unroll
            for (int e = 0; e < 8; ++e) acc |= enc_u4(v[2 * d + (e >> 2)][e & 3] * scale) << (e < 4 ? 8 * e : 8 * (e - 4) + 4);
            w[d] = acc; }
        *(u32x4*)(dst + (size_t)row * ROW4 + 16 * lp) = (u32x4){w[0], w[1], w[2], w[3]};
    }
}
DI int udot_i4(const u32x4 a, const u32x4 (&h8)[2]) {
    int a0 = 0, a1 = 0;
#pragma unroll
    for (int q = 0; q < 4; ++q) {
        const unsigned lo = a[q] & 0x0f0f0f0fu, hi = (a[q] >> 4) & 0x0f0f0f0fu;
        a0 = __builtin_amdgcn_sdot4((int)h8[q >> 1][2 * (q & 1)], (int)lo, a0, false);
        a1 = __builtin_amdgcn_sdot4((int)h8[q >> 1][2 * (q & 1) + 1], (int)hi, a1, false);
    }
    return a0 + a1;
}
DI void dec_fp4x32(const u32x4 a, float (&f)[32]) {
#pragma unroll
    for (int q = 0; q < 4; ++q) {
        const v2f_t t0 = __builtin_amdgcn_cvt_scalef32_pk_f32_fp4(a[q], 1.0f, 0), t1 = __builtin_amdgcn_cvt_scalef32_pk_f32_fp4(a[q], 1.0f, 1),
                    t2 = __builtin_amdgcn_cvt_scalef32_pk_f32_fp4(a[q], 1.0f, 2), t3 = __builtin_amdgcn_cvt_scalef32_pk_f32_fp4(a[q], 1.0f, 3);
        f[8 * q] = t0[0]; f[8 * q + 1] = t0[1]; f[8 * q + 2] = t1[0]; f[8 * q + 3] = t1[1]; f[8 * q + 4] = t2[0]; f[8 * q + 5] = t2[1]; f[8 * q + 6] = t3[0]; f[8 * q + 7] = t3[1];
    }
}
DI void cvt_stream_tab(const float* src, unsigned char* dst, int kind, float scale, int gw, int ngw, int lane) {
    if (kind == 2) cvt_stream_u4(src, dst, scale, gw, ngw, lane); else if (kind == 1) cvt_stream_fp4(src, dst, scale, gw, ngw, lane); else cvt_stream_fp6(src, dst, scale, gw, ngw, lane);
}
template <int CTRL> DI float dppf(float v) { return __int_as_float(__builtin_amdgcn_update_dpp(0, __float_as_int(v), CTRL, 0xf, 0xf, false)); }
DI unsigned pick_swz(int v, int j) {
    switch (j) { case 0: return (unsigned)__builtin_amdgcn_ds_swizzle(v, 0 << 5); case 1: return (unsigned)__builtin_amdgcn_ds_swizzle(v, 1 << 5);
                 case 2: return (unsigned)__builtin_amdgcn_ds_swizzle(v, 2 << 5); default: return (unsigned)__builtin_amdgcn_ds_swizzle(v, 3 << 5); }
}
DI unsigned pick_half(int v, int j, int half) { const int a0 = __builtin_amdgcn_readlane(v, j), a1 = __builtin_amdgcn_readlane(v, 32 + j); return (unsigned)(half ? a1 : a0); }
typedef __bf16 bf2v_t __attribute__((ext_vector_type(2)));
DI float udot_fp4(const u32x4 a, const u32x4 (&hq)[4]) {
    float a0 = 0.f, a1 = 0.f;
#pragma unroll
    for (int qq = 0; qq < 2; ++qq) {
        bf2v_t t[8];
#pragma unroll
        for (int q = 0; q < 2; ++q) {
            t[4 * q + 0] = __builtin_amdgcn_cvt_scalef32_pk_bf16_fp4(a[2 * qq + q], 1.0f, 0); t[4 * q + 1] = __builtin_amdgcn_cvt_scalef32_pk_bf16_fp4(a[2 * qq + q], 1.0f, 1);
            t[4 * q + 2] = __builtin_amdgcn_cvt_scalef32_pk_bf16_fp4(a[2 * qq + q], 1.0f, 2); t[4 * q + 3] = __builtin_amdgcn_cvt_scalef32_pk_bf16_fp4(a[2 * qq + q], 1.0f, 3); }
        asm volatile("" : "+v"(t[0]), "+v"(t[1]), "+v"(t[2]), "+v"(t[3]), "+v"(t[4]), "+v"(t[5]), "+v"(t[6]), "+v"(t[7]));
#pragma unroll
        for (int q = 0; q < 2; ++q) {
            a0 = __builtin_amdgcn_fdot2_f32_bf16(__builtin_bit_cast(bf2v_t, (unsigned)hq[2 * qq + q][0]), t[4 * q + 0], a0, false);
            a1 = __builtin_amdgcn_fdot2_f32_bf16(__builtin_bit_cast(bf2v_t, (unsigned)hq[2 * qq + q][1]), t[4 * q + 1], a1, false);
            a0 = __builtin_amdgcn_fdot2_f32_bf16(__builtin_bit_cast(bf2v_t, (unsigned)hq[2 * qq + q][2]), t[4 * q + 2], a0, false);
            a1 = __builtin_amdgcn_fdot2_f32_bf16(__builtin_bit_cast(bf2v_t, (unsigned)hq[2 * qq + q][3]), t[4 * q + 3], a1, false); }
    }
    return a0 + a1;
}
typedef __bf16 bf32v_t __attribute__((ext_vector_type(32)));
DI float udot_fp6(const u32x4 a, const u32x2 b, const u32x4 (&hq)[4]) {
    const v6u_t w = {a.x, a.y, a.z, a.w, b.x, b.y}; const bf32v_t uf = __builtin_amdgcn_cvt_scalef32_pk32_bf16_fp6(w, 1.0f);
    float a0 = 0.f, a1 = 0.f;
#pragma unroll
    for (int q = 0; q < 4; ++q) {
        a0 = __builtin_amdgcn_fdot2_f32_bf16(__builtin_bit_cast(bf2v_t, (unsigned)hq[q][0]), (bf2v_t){uf[8 * q], uf[8 * q + 1]}, a0, false);
        a1 = __builtin_amdgcn_fdot2_f32_bf16(__builtin_bit_cast(bf2v_t, (unsigned)hq[q][1]), (bf2v_t){uf[8 * q + 2], uf[8 * q + 3]}, a1, false);
        a0 = __builtin_amdgcn_fdot2_f32_bf16(__builtin_bit_cast(bf2v_t, (unsigned)hq[q][2]), (bf2v_t){uf[8 * q + 4], uf[8 * q + 5]}, a0, false);
        a1 = __builtin_amdgcn_fdot2_f32_bf16(__builtin_bit_cast(bf2v_t, (unsigned)hq[q][3]), (bf2v_t){uf[8 * q + 6], uf[8 * q + 7]}, a1, false);
    }
    return a0 + a1;
}
DI void peer_gather_token6(const GatherP& P, size_t m, int lane) {
    const int lp = lane & 31, half = lane >> 5;
    u32x4 hq[4];
    { const u32x4* hr = (const u32x4*)(P.H + m * D + 32 * lp);
#pragma unroll
      for (int q = 0; q < 4; ++q) hq[q] = hr[q]; }
    float o[32];
#pragma unroll
    for (int e = 0; e < 32; ++e) o[e] = 0.f;
    float zero_ = 0.f; asm volatile("" : "+v"(zero_));
    const unsigned lp16 = 16u * (unsigned)lp, lp8 = 8u * (unsigned)lp;
    const int bpbase = half << 7;
    const int eself = 2 * (lane & 3) + half;
    const u32x2* rt = P.route + m * 128 + eself;
#if TAB_U4
#define G_UDOT(ua1, ub1) udot_fp4(ua1, hq)
#else
#define G_UDOT(ua1, ub1) udot_fp6(ua1, ub1, hq)
#endif
#define G_PICKB(v_, j_) ((unsigned)__builtin_amdgcn_ds_bpermute(bpbase + 4 * (j_), (int)(v_)))
#define G_PICKR(v_, j_) pick_half((int)(v_), (j_), half)
#define G_PICKS(v_, j_) pick_swz((int)(v_), (j_))
#define G_PICKA(v_, j_) ((GATHER_BP & 4) ? G_PICKS(v_, j_) : (GATHER_BP & 1) ? G_PICKB(v_, j_) : G_PICKR(v_, j_))
#define G_PICKI(v_, j_) ((GATHER_BP & 8) ? G_PICKS(v_, j_) : (GATHER_BP & 2) ? G_PICKB(v_, j_) : G_PICKR(v_, j_))
#if GATHER_DPP
#define GX1(v_) dppf<0xB1>(v_)
#define GX2(v_) dppf<0x4E>(v_)
#define GR4(v_) dppf<0x124>(v_)
#define GR8(v_) dppf<0x128>(v_)
#else
#define GX1(v_) shx<1>(v_, lane)
#define GX2(v_) shx<2>(v_, lane)
#define GR4(v_) shx<4>(v_, lane)
#define GR8(v_) shx<8>(v_, lane)
#endif
#define G_LOAD(ua_, ub_, va_, vb_, re_) do { const int idx_ = (int)(re_).x; _Pragma("unroll") for (int j = 0; j < 4; ++j) { \
            const unsigned ie = G_PICKI(idx_, j);      \
            const unsigned uo = ie * (unsigned)ROWU + lp16, vo = ie * (unsigned)ROWV + lp16;     \
            ua_[j] = *(const u32x4*)(P.U + uo); if (!TAB_U4) ub_[j] = *(const u32x2*)(P.U + (ie * (unsigned)ROWU + 512u + lp8)); \
            va_[j] = *(const u32x4*)(P.V + vo); if (!TAB_V4) vb_[j] = *(const u32x2*)(P.V + (ie * (unsigned)ROWV + 512u + lp8)); } } while (0)
#define G_COMP(ua_, ub_, va_, vb_, re_) do { const float gate = __int_as_float((int)(re_).y); \
        float p[4]; \
        _Pragma("unroll") for (int j = 0; j < 4; ++j) { p[j] = G_UDOT(ua_[j], ub_[j]); if (PROBE_DUP) { u32x4 t_ = ua_[j]; asm volatile("" : "+v"(t_)); p[j] += zero_ * G_UDOT(t_, ub_[j]); } } \
          \
        float p2[2], p1; \
        { const bool up = (lane & 2) != 0; \
          _Pragma("unroll") for (int q = 0; q < 2; ++q) { const float keep = up ? p[q + 2] : p[q], send = up ? p[q] : p[q + 2]; p2[q] = keep + GX2(send); } } \
        { const bool up = (lane & 1) != 0; const float keep = up ? p2[1] : p2[0], send = up ? p2[0] : p2[1]; p1 = keep + GX1(send); } \
        p1 += GR4(p1); p1 += GR8(p1); p1 += shx<16>(p1, lane); \
        const float act = gelu_exact(p1 * (1.0f / UT_SCALE)) * gate * (1.0f / VT_SCALE); \
        _Pragma("unroll") for (int j = 0; j < 4; ++j) { \
            const float a = __int_as_float((int)G_PICKA(__float_as_int(act), j)); \
            float vf[32]; \
            if (TAB_V4) dec_fp4x32(va_[j], vf); \
            else { const v6u_t w = {va_[j].x, va_[j].y, va_[j].z, va_[j].w, vb_[j].x, vb_[j].y}; const v32f_t t = __builtin_amdgcn_cvt_scalef32_pk32_f32_fp6(w, 1.0f); \
                _Pragma("unroll") for (int k = 0; k < 32; ++k) vf[k] = t[k]; } \
            _Pragma("unroll") for (int k = 0; k < 32; ++k) o[k] += a * vf[k]; } } while (0)
#if GATHER_PIPE
    u32x4 uaA[4], vaA[4], uaB[4], vaB[4]; u32x2 ubA[4], vbA[4], ubB[4], vbB[4];
    u32x2 re0 = rt[0], re1 = rt[8];
    G_LOAD(uaA, ubA, vaA, vbA, re0);
#pragma unroll 1
    for (int bt = 0; bt < 16; bt += 2) {
        u32x2 re2 = re0, re3 = re1;
        if (bt < 14) { re2 = rt[(bt + 2) * 8]; re3 = rt[(bt + 3) * 8]; }
        G_LOAD(uaB, ubB, vaB, vbB, re1);
        __builtin_amdgcn_sched_barrier(0);
        G_COMP(uaA, ubA, vaA, vbA, re0);
        if (bt < 14) G_LOAD(uaA, ubA, vaA, vbA, re2);
        __builtin_amdgcn_sched_barrier(0);
        G_COMP(uaB, ubB, vaB, vbB, re1);
        re0 = re2; re1 = re3;
    }
#else
    u32x2 re_next = rt[0];
#pragma unroll 1
    for (int bt = 0; bt < 16; ++bt) {
        const u32x2 re = re_next;
        if (bt < 15) re_next = rt[(bt + 1) * 8];
        u32x4 ua[4], va[4]; u32x2 ub[4], vb[4];
        G_LOAD(ua, ub, va, vb, re);
        G_COMP(ua, ub, va, vb, re);
    }
#endif
#undef G_LOAD
#undef G_COMP
#undef G_UDOT
#undef G_PICKA
#undef G_PICKI
#undef G_PICKB
#undef GX1
#undef GX2
#undef GR4
#undef GR8
#undef G_PICKS
#undef G_PICKR
    float oc[16];
#pragma unroll
    for (int k = 0; k < 16; ++k) { const float lo_ = o[k] + shx<32>(o[k], lane), hi_ = o[16 + k] + shx<32>(o[16 + k], lane); oc[k] = half ? hi_ : lo_; }
    const int bidx = (m >= (size_t)SEQ) ? 1 : 0; const int cbase = 32 * lp + 16 * half;
    float* xr = P.X + m * D + cbase; const float* g2 = P.gt2 + bidx * 6 * D + cbase;
    float xn[16]; float ss = 0.f;
#pragma unroll
    for (int q = 0; q < 4; ++q) { const f32x4 xv = *(const f32x4*)(xr + 4 * q), gv = *(const f32x4*)(g2 + 4 * q);
#pragma unroll
        for (int e = 0; e < 4; ++e) { const float v = xv[e] + gv[e] * oc[q * 4 + e]; xn[q * 4 + e] = v; ss += v * v; } }
    const float rstd = 1.0f / sqrtf(wave_sum(ss, lane) * (1.0f / D) + EPS);
    if (P.last) {
#pragma unroll
        for (int q = 0; q < 4; ++q) { const f32x4 gv = *(const f32x4*)(P.ng + cbase + 4 * q); f32x4 r;
#pragma unroll
            for (int e = 0; e < 4; ++e) r[e] = xn[q * 4 + e] * rstd * gv[e];
            *(f32x4*)(P.out + m * D + cbase + 4 * q) = r; }
    } else {
        float y[16];
#pragma unroll
        for (int q = 0; q < 4; ++q) { const int col = cbase + 4 * q;
            const f32x4 gv = *(const f32x4*)(P.ng + col), sc = *(const f32x4*)(P.nsc + bidx * 6 * D + col), sh = *(const f32x4*)(P.nsh + bidx * 6 * D + col);
            *(f32x4*)(xr + 4 * q) = (f32x4){xn[q * 4], xn[q * 4 + 1], xn[q * 4 + 2], xn[q * 4 + 3]};
#pragma unroll
            for (int e = 0; e < 4; ++e) y[q * 4 + e] = xn[q * 4 + e] * rstd * gv[e] * (1.0f + sc[e]) + sh[e]; }
        bf16_t* ho = P.Hout + m * D + cbase;
        { u32x4 w; w.x = pk2(y[0], y[1]); w.y = pk2(y[2], y[3]); w.z = pk2(y[4], y[5]); w.w = pk2(y[6], y[7]); *(u32x4*)ho = w; }
        { u32x4 w; w.x = pk2(y[8], y[9]); w.y = pk2(y[10], y[11]); w.z = pk2(y[12], y[13]); w.w = pk2(y[14], y[15]); *(u32x4*)(ho + 8) = w; }
#if IN_I8
        {
            float am = 0.f;
#pragma unroll
            for (int i = 0; i < 16; ++i) am = fmaxf(am, fabsf(y[i]));
            am = fmaxf(am, shx<1>(am, lane)); am = fmaxf(am, shx<2>(am, lane)); am = fmaxf(am, shx<4>(am, lane)); am = fmaxf(am, shx<8>(am, lane)); am = fmaxf(am, shx<16>(am, lane)); am = fmaxf(am, shx<32>(am, lane));
            am = fmaxf(am, 1e-20f); const float sc = 127.0f / am;
            unsigned w[4];
#pragma unroll
            for (int d = 0; d < 4; ++d) { const int q0 = (int)__builtin_rintf(y[4 * d] * sc), q1 = (int)__builtin_rintf(y[4 * d + 1] * sc), q2 = (int)__builtin_rintf(y[4 * d + 2] * sc), q3 = (int)__builtin_rintf(y[4 * d + 3] * sc);
                w[d] = (unsigned)(q0 & 0xff) | ((unsigned)(q1 & 0xff) << 8) | ((unsigned)(q2 & 0xff) << 16) | ((unsigned)q3 << 24); }
            *(u32x4*)(P.G8 + m * D + cbase) = (u32x4){w[0], w[1], w[2], w[3]};
            if (lane == 0) P.GS[m] = am * (1.0f / 127.0f);
        }
#endif
        float pr[8];
#pragma unroll
        for (int c = 0; c < 8; ++c) { float a = 0.f;
#pragma unroll
            for (int q = 0; q < 4; ++q) { const f32x4 wv = *(const LAS f32x4*)(P.wsm + c * D + cbase + 4 * q);
                a += (y[q * 4] * wv.x + y[q * 4 + 1] * wv.y) + (y[q * 4 + 2] * wv.z + y[q * 4 + 3] * wv.w); }
            pr[c] = wave_sum(a, lane);
            if (c & 1) __builtin_amdgcn_sched_barrier(0); }
        if (lane < 8) { float rr = pr[0];
#pragma unroll
            for (int c = 1; c < 8; ++c) rr = (lane == c) ? pr[c] : rr;
            P.small[m * 8 + lane] = rr; }
    }
}

constexpr int GC_OFF = 32768;
DI void stage_gather_consts(const GatherP& P, lptr L, int tid) {
    LAS float* gc = (LAS float*)(L + GC_OFF);
    for (int i = tid; i < 2 * D; i += NTHR) { const int b = i >> 10, c = i & (D - 1);
        gc[i] = P.gt2[b * 6 * D + c];
        gc[2 * D + i] = P.last ? P.ng[c] : P.ng[c] * (1.0f + P.nsc[b * 6 * D + c]);
        gc[4 * D + i] = P.last ? 0.f : P.nsh[b * 6 * D + c]; }
    __syncthreads();
}
DI void gather_finish(const GatherP& P, lptr L, size_t m, int lane, float (&o)[32], const f32x4 (&xv4)[4]) {
    const int lp = lane & 31, half = lane >> 5;
    float oc[16];
#pragma unroll
    for (int k = 0; k < 16; ++k) { const float lo_ = o[k] + shx<32>(o[k], lane), hi_ = o[16 + k] + shx<32>(o[16 + k], lane); oc[k] = half ? hi_ : lo_; }
    const int bidx = (m >= (size_t)SEQ) ? 1 : 0; const int cbase = 32 * lp + 16 * half;
    const LAS float* gc = (const LAS float*)(L + GC_OFF) + bidx * D + cbase;
    float* xr = P.X + m * D + cbase;
    float xn[16]; float ss = 0.f;
#pragma unroll
    for (int q = 0; q < 4; ++q) { const f32x4 gv = *(const LAS f32x4*)(gc + 4 * q);
#pragma unroll
        for (int e = 0; e < 4; ++e) { const float v = xv4[q][e] + gv[e] * oc[q * 4 + e]; xn[q * 4 + e] = v; ss += v * v; } }
    const float rstd = 1.0f / sqrtf(wave_sum(ss, lane) * (1.0f / D) + EPS);
    if (P.last) {
#pragma unroll
        for (int q = 0; q < 4; ++q) { const f32x4 gv = *(const LAS f32x4*)(gc + 2 * D + 4 * q); f32x4 r;
#pragma unroll
            for (int e = 0; e < 4; ++e) r[e] = xn[q * 4 + e] * rstd * gv[e];
            *(f32x4*)(P.out + m * D + cbase + 4 * q) = r; }
    } else {
        float y[16];
#pragma unroll
        for (int q = 0; q < 4; ++q) {
            const f32x4 ga = *(const LAS f32x4*)(gc + 2 * D + 4 * q), sh = *(const LAS f32x4*)(gc + 4 * D + 4 * q);
            *(f32x4*)(xr + 4 * q) = (f32x4){xn[q * 4], xn[q * 4 + 1], xn[q * 4 + 2], xn[q * 4 + 3]};
#pragma unroll
            for (int e = 0; e < 4; ++e) y[q * 4 + e] = xn[q * 4 + e] * rstd * ga[e] + sh[e]; }
        bf16_t* ho = P.Hout + m * D + cbase;
        { u32x4 w; w.x = pk2(y[0], y[1]); w.y = pk2(y[2], y[3]); w.z = pk2(y[4], y[5]); w.w = pk2(y[6], y[7]); *(u32x4*)ho = w; }
        { u32x4 w; w.x = pk2(y[8], y[9]); w.y = pk2(y[10], y[11]); w.z = pk2(y[12], y[13]); w.w = pk2(y[14], y[15]); *(u32x4*)(ho + 8) = w; }
#if IN_I8
        {
            float am = 0.f;
#pragma unroll
            for (int i = 0; i < 16; ++i) am = fmaxf(am, fabsf(y[i]));
            am = fmaxf(am, shx<1>(am, lane)); am = fmaxf(am, shx<2>(am, lane)); am = fmaxf(am, shx<4>(am, lane)); am = fmaxf(am, shx<8>(am, lane)); am = fmaxf(am, shx<16>(am, lane)); am = fmaxf(am, shx<32>(am, lane));
            am = fmaxf(am, 1e-20f); const float sc = 127.0f / am;
            unsigned w[4];
#pragma unroll
            for (int d = 0; d < 4; ++d) { const int q0 = (int)__builtin_rintf(y[4 * d] * sc), q1 = (int)__builtin_rintf(y[4 * d + 1] * sc), q2 = (int)__builtin_rintf(y[4 * d + 2] * sc), q3 = (int)__builtin_rintf(y[4 * d + 3] * sc);
                w[d] = (unsigned)(q0 & 0xff) | ((unsigned)(q1 & 0xff) << 8) | ((unsigned)(q2 & 0xff) << 16) | ((unsigned)q3 << 24); }
            *(u32x4*)(P.G8 + m * D + cbase) = (u32x4){w[0], w[1], w[2], w[3]};
            if (lane == 0) P.GS[m] = am * (1.0f / 127.0f);
        }
#endif
        float pr[8];
#pragma unroll
        for (int c = 0; c < 8; ++c) { float a = 0.f;
#pragma unroll
            for (int q = 0; q < 4; ++q) { const f32x4 wv = *(const LAS f32x4*)(P.wsm + c * D + cbase + 4 * q);
                a += (y[q * 4] * wv.x + y[q * 4 + 1] * wv.y) + (y[q * 4 + 2] * wv.z + y[q * 4 + 3] * wv.w); }
            pr[c] = wave_sum(a, lane);
            if (c & 1) __builtin_amdgcn_sched_barrier(0); }
        if (lane < 8) { float rr = pr[0];
#pragma unroll
            for (int c = 1; c < 8; ++c) rr = (lane == c) ? pr[c] : rr;
            P.small[m * 8 + lane] = rr; }
    }
}
#ifdef GATHER_NT
#define GNT(p_) __builtin_nontemporal_load(p_)
#else
#define GNT(p_) (*(p_))
#endif
DI void peer_gather_wave(const GatherP& P, lptr L, int gw, int ngw, int lane) {
    const int lp = lane & 31, half = lane >> 5;
    float zero_ = 0.f; asm volatile("" : "+v"(zero_));
    const unsigned lp16 = 16u * (unsigned)lp, lp8 = 8u * (unsigned)lp;
    const int bpbase = half << 7;
    const int eself = 2 * (lane & 3) + half;
    size_t m = (size_t)gw;
#if TAB_UI4
    u32x4 hq[2]; float uinv, hcorr;
#define G_HLOAD(hq_, uinv_, hcorr_, m_) do { const u32x4* hr_ = (const u32x4*)(P.H8 + (m_) * D + 32 * lp); hq_[0] = hr_[0]; hq_[1] = hr_[1]; uinv_ = P.HS[(m_)] * (1.0f / UI_SCALE); } while (0)
#define G_HCORR(hq_, hcorr_) do { int s_ = 0; _Pragma("unroll") for (int q_ = 0; q_ < 8; ++q_) s_ = __builtin_amdgcn_sdot4((int)hq_[q_ >> 2][q_ & 3], 0x01010101, s_, false); hcorr_ = 7.5f * (float)s_; } while (0)
#define G_UDOT(ua1, ub1) ((float)udot_i4(ua1, hq) - hcorr)
    constexpr int NHQ = 2;
    G_HLOAD(hq, uinv, hcorr, m); G_HCORR(hq, hcorr);
#else
    u32x4 hq[4]; const float uinv = 1.0f / UT_SCALE;
    { const u32x4* hr = (const u32x4*)(P.H + m * D + 32 * lp);
#pragma unroll
      for (int q = 0; q < 4; ++q) hq[q] = GNT(hr + q); }
    constexpr int NHQ = 4;
#if TAB_U4
#define G_UDOT(ua1, ub1) udot_fp4(ua1, hq)
#else
#define G_UDOT(ua1, ub1) udot_fp6(ua1, ub1, hq)
#endif
#endif
    const u32x2* rt = P.route + m * 128 + eself;
#define G_PICKB(v_, j_) ((unsigned)__builtin_amdgcn_ds_bpermute(bpbase + 4 * (j_), (int)(v_)))
#define G_PICKR(v_, j_) pick_half((int)(v_), (j_), half)
#define G_PICKS(v_, j_) pick_swz((int)(v_), (j_))
#define G_PICKA(v_, j_) ((GATHER_BP & 4) ? G_PICKS(v_, j_) : (GATHER_BP & 1) ? G_PICKB(v_, j_) : G_PICKR(v_, j_))
#define G_PICKI(v_, j_) ((GATHER_BP & 8) ? G_PICKS(v_, j_) : (GATHER_BP & 2) ? G_PICKB(v_, j_) : G_PICKR(v_, j_))
#if GATHER_DPP
#define GX1(v_) dppf<0xB1>(v_)
#define GX2(v_) dppf<0x4E>(v_)
#define GR4(v_) dppf<0x124>(v_)
#define GR8(v_) dppf<0x128>(v_)
#else
#define GX1(v_) shx<1>(v_, lane)
#define GX2(v_) shx<2>(v_, lane)
#define GR4(v_) shx<4>(v_, lane)
#define GR8(v_) shx<8>(v_, lane)
#endif
#define G_LOAD(ua_, ub_, va_, vb_, re_) do { const int idx_ = (int)(re_).x; _Pragma("unroll") for (int j = 0; j < 4; ++j) { \
            const unsigned ie = G_PICKI(idx_, j);      \
            const unsigned uo = ie * (unsigned)ROWU + lp16, vo = ie * (unsigned)ROWV + lp16;     \
            ua_[j] = *(const u32x4*)(P.U + uo); if (!TAB_U4) ub_[j] = *(const u32x2*)(P.U + (ie * (unsigned)ROWU + 512u + lp8)); \
            va_[j] = *(const u32x4*)(P.V + vo); if (!TAB_V4) vb_[j] = *(const u32x2*)(P.V + (ie * (unsigned)ROWV + 512u + lp8)); } } while (0)
#define G_COMP(ua_, ub_, va_, vb_, re_) do { const float gate = __int_as_float((int)(re_).y); \
        float p[4]; \
        _Pragma("unroll") for (int j = 0; j < 4; ++j) { p[j] = G_UDOT(ua_[j], ub_[j]); if (PROBE_DUP) { u32x4 t_ = ua_[j]; asm volatile("" : "+v"(t_)); p[j] += zero_ * G_UDOT(t_, ub_[j]); } } \
          \
        float p2[2], p1; \
        { const bool up = (lane & 2) != 0; \
          _Pragma("unroll") for (int q = 0; q < 2; ++q) { const float keep = up ? p[q + 2] : p[q], send = up ? p[q] : p[q + 2]; p2[q] = keep + GX2(send); } } \
        { const bool up = (lane & 1) != 0; const float keep = up ? p2[1] : p2[0], send = up ? p2[0] : p2[1]; p1 = keep + GX1(send); } \
        p1 += GR4(p1); p1 += GR8(p1); p1 += shx<16>(p1, lane); \
        const float act = gelu_exact(p1 * uinv) * gate * (1.0f / VT_SCALE); \
        _Pragma("unroll") for (int j = 0; j < 4; ++j) { \
            const float a = __int_as_float((int)G_PICKA(__float_as_int(act), j)); \
            if (TAB_V4 && !GATHER_INPLACE) { float vf[32]; dec_fp4x32(va_[j], vf); \
                _Pragma("unroll") for (int k = 0; k < 16; ++k) { o2[k][0] += a * vf[2 * k]; o2[k][1] += a * vf[2 * k + 1]; } } \
            else if (TAB_V4) { const v2f_t aa = {a, a}; \
                  \
                _Pragma("unroll") for (int q = 0; q < 4; ++q) { \
                    const v2f_t t0 = __builtin_amdgcn_cvt_scalef32_pk_f32_fp4(va_[j][q], 1.0f, 0), t1 = __builtin_amdgcn_cvt_scalef32_pk_f32_fp4(va_[j][q], 1.0f, 1), \
                                t2 = __builtin_amdgcn_cvt_scalef32_pk_f32_fp4(va_[j][q], 1.0f, 2), t3 = __builtin_amdgcn_cvt_scalef32_pk_f32_fp4(va_[j][q], 1.0f, 3); \
                    asm("v_pk_fma_f32 %0, %1, %2, %0" : "+v"(o2[4 * q + 0]) : "v"(t0), "v"(aa)); asm("v_pk_fma_f32 %0, %1, %2, %0" : "+v"(o2[4 * q + 1]) : "v"(t1), "v"(aa)); \
                    asm("v_pk_fma_f32 %0, %1, %2, %0" : "+v"(o2[4 * q + 2]) : "v"(t2), "v"(aa)); asm("v_pk_fma_f32 %0, %1, %2, %0" : "+v"(o2[4 * q + 3]) : "v"(t3), "v"(aa)); } } \
            else { float vf[32]; const v6u_t w = {va_[j].x, va_[j].y, va_[j].z, va_[j].w, vb_[j].x, vb_[j].y}; const v32f_t t = __builtin_amdgcn_cvt_scalef32_pk32_f32_fp6(w, 1.0f); \
                _Pragma("unroll") for (int k = 0; k < 32; ++k) vf[k] = t[k]; \
                _Pragma("unroll") for (int k = 0; k < 16; ++k) { o2[k][0] += a * vf[2 * k]; o2[k][1] += a * vf[2 * k + 1]; } } } } while (0)
#if GATHER_DEPTH == 3
    u32x4 uaA[4], vaA[4], uaB[4], vaB[4], uaC[4], vaC[4]; u32x2 ubA[4], vbA[4], ubB[4], vbB[4], ubC[4], vbC[4];
    u32x2 reA = GNT(rt), reB = GNT(rt + 8), reC = GNT(rt + 16), rp;
    G_LOAD(uaA, ubA, vaA, vbA, reA); G_LOAD(uaB, ubB, vaB, vbB, reB);
#pragma unroll 1
    for (;;) {
        const size_t mn = m + (size_t)ngw; const bool more = mn < (size_t)M;
        const u32x2* rtn = P.route + (more ? mn : m) * 128 + eself;
        v2f_t o2[16];
#pragma unroll
        for (int e = 0; e < 16; ++e) o2[e] = (v2f_t){0.f, 0.f};
        f32x4 xv4[4]; u32x4 hqn[NHQ]; float uinvn = 0.f;
#define G_STEP(XL, XC, REL, REC, rpsrc) do { G_LOAD(ua##XL, ub##XL, va##XL, vb##XL, REL); rp = GNT(rpsrc); __builtin_amdgcn_sched_barrier(0); \
            G_COMP(ua##XC, ub##XC, va##XC, vb##XC, REC); REC = rp; __builtin_amdgcn_sched_barrier(0); } while (0)
#pragma unroll 1
        for (int k = 0; k < 12; k += 3) {
            G_STEP(C, A, reC, reA, rt + (k + 3) * 8);
            G_STEP(A, B, reA, reB, rt + (k + 4) * 8);
            G_STEP(B, C, reB, reC, rt + (k + 5) * 8);
        }
        G_STEP(C, A, reC, reA, rt + 15 * 8);
        G_STEP(A, B, reA, reB, rtn);
        if (more) { G_STEP(B, C, reB, reC, rtn + 8); } else { rp = reC; G_COMP(uaC, ubC, vaC, vbC, reC); }
        if (more) { G_STEP(C, A, reC, reA, rtn + 16); } else { G_COMP(uaA, ubA, vaA, vbA, reA); }
#undef G_STEP
        { const float* xr = P.X + m * D + 32 * lp + 16 * half;
#pragma unroll
          for (int q = 0; q < 4; ++q) xv4[q] = GNT((const f32x4*)(xr + 4 * q)); }
#if TAB_UI4
        if (more) { float hc_; G_HLOAD(hqn, uinvn, hc_, mn); }
#else
        if (more) { const u32x4* hr = (const u32x4*)(P.H + mn * D + 32 * lp);
#pragma unroll
            for (int q = 0; q < 4; ++q) hqn[q] = GNT(hr + q); }
#endif
        __builtin_amdgcn_sched_barrier(0);
        float o[32];
#pragma unroll
        for (int e = 0; e < 16; ++e) { o[2 * e] = o2[e][0]; o[2 * e + 1] = o2[e][1]; }
        gather_finish(P, L, m, lane, o, xv4);
        if (!more) break;
        m = mn; rt = rtn;
        { const u32x2 t0 = reB, t1 = reC, t2 = reA; reA = t0; reB = t1; reC = t2; }
#pragma unroll
        for (int j = 0; j < 4; ++j) { uaA[j] = uaB[j]; vaA[j] = vaB[j]; uaB[j] = uaC[j]; vaB[j] = vaC[j]; if (!TAB_U4 && !TAB_UI4) { ubA[j] = ubB[j]; ubB[j] = ubC[j]; } if (!TAB_V4) { vbA[j] = vbB[j]; vbB[j] = vbC[j]; } }
#pragma unroll
        for (int q = 0; q < NHQ; ++q) hq[q] = hqn[q];
#if TAB_UI4
        uinv = uinvn; G_HCORR(hq, hcorr);
#endif
    }
#else
    u32x4 uaA[4], vaA[4], uaB[4], vaB[4]; u32x2 ubA[4], vbA[4], ubB[4], vbB[4];
    u32x2 re0 = GNT(rt), re1 = GNT(rt + 8);
    G_LOAD(uaA, ubA, vaA, vbA, re0);
#pragma unroll 1
    for (;;) {
        const size_t mn = m + (size_t)ngw; const bool more = mn < (size_t)M;
        const u32x2* rtn = P.route + (more ? mn : m) * 128 + eself;
        const u32x2 re0n = GNT(rtn), re1n = GNT(rtn + 8);
        v2f_t o2[16];
#pragma unroll
        for (int e = 0; e < 16; ++e) o2[e] = (v2f_t){0.f, 0.f};
        f32x4 xv4[4]; u32x4 hqn[NHQ]; float uinvn = 0.f;
#pragma unroll 1
        for (int bt = 0; bt < 16; bt += 2) {
            u32x2 re2 = re0, re3 = re1;
            if (bt < 14) { re2 = GNT(rt + (bt + 2) * 8); re3 = GNT(rt + (bt + 3) * 8); }
            G_LOAD(uaB, ubB, vaB, vbB, re1);
            __builtin_amdgcn_sched_barrier(0);
            G_COMP(uaA, ubA, vaA, vbA, re0);
            if (bt < 14) G_LOAD(uaA, ubA, vaA, vbA, re2);
            else if (more) G_LOAD(uaA, ubA, vaA, vbA, re0n);
            __builtin_amdgcn_sched_barrier(0);
            G_COMP(uaB, ubB, vaB, vbB, re1);
            re0 = re2; re1 = re3;
        }
        { const float* xr = P.X + m * D + 32 * lp + 16 * half;
#pragma unroll
          for (int q = 0; q < 4; ++q) xv4[q] = GNT((const f32x4*)(xr + 4 * q)); }
#if TAB_UI4
        if (more) { float hc_; G_HLOAD(hqn, uinvn, hc_, mn); }
#else
        if (more) { const u32x4* hr = (const u32x4*)(P.H + mn * D + 32 * lp);
#pragma unroll
            for (int q = 0; q < 4; ++q) hqn[q] = GNT(hr + q); }
#endif
        __builtin_amdgcn_sched_barrier(0);
        float o[32];
#pragma unroll
        for (int e = 0; e < 16; ++e) { o[2 * e] = o2[e][0]; o[2 * e + 1] = o2[e][1]; }
        gather_finish(P, L, m, lane, o, xv4);
        if (!more) break;
        m = mn; rt = rtn; re0 = re0n; re1 = re1n;
#pragma unroll
        for (int q = 0; q < NHQ; ++q) hq[q] = hqn[q];
#if TAB_UI4
        uinv = uinvn; G_HCORR(hq, hcorr);
#endif
    }
#endif
#undef G_LOAD
#undef G_COMP
#undef G_UDOT
#undef G_HLOAD
#undef G_HCORR
#undef G_PICKA
#undef G_PICKI
#undef G_PICKB
#undef GX1
#undef GX2
#undef GR4
#undef GR8
#undef G_PICKS
#undef G_PICKR
}

constexpr int GA_OFF = GC_OFF + 24576;
DI void peer_gather_split(const GatherP& P, lptr L, int gw, int ngw, int lane, int wave) {
    const int lp = lane & 31, half = lane >> 5;
    const unsigned lp16 = 16u * (unsigned)lp;
    const int eself = 2 * (lane & 3) + half;
    LAS float* actw = (LAS float*)(L + GA_OFF) + wave * 1024;
#define RT_AT(g_) (P.route + ((size_t)gw + (size_t)((g_) >> 4) * (size_t)ngw) * 128 + eself + ((g_) & 15) * 8)
#define ROW_LOAD(x_, tab_, row_, re_) do { const int idx_ = (int)(re_).x; _Pragma("unroll") for (int j = 0; j < 4; ++j) { \
        const unsigned ie = pick_swz(idx_, j); x_[j] = *(const u32x4*)((tab_) + (ie * (unsigned)(row_) + lp16)); } } while (0)
    {
        u32x4 hq[2], hqn[2]; float uinv, uinvn = 0.f, hcorr; float gA = 0.f, gB = 0.f;
#define S_HLOAD(hq_, uinv_, m_) do { const u32x4* hr_ = (const u32x4*)(P.H8 + (m_) * D + 32 * lp); hq_[0] = hr_[0]; hq_[1] = hr_[1]; uinv_ = P.HS[(m_)] * (1.0f / UI_SCALE); } while (0)
#define S_HCORR(hq_, hcorr_) do { int s_ = 0; _Pragma("unroll") for (int q_ = 0; q_ < 8; ++q_) s_ = __builtin_amdgcn_sdot4((int)hq_[q_ >> 2][q_ & 3], 0x01010101, s_, false); hcorr_ = 7.5f * (float)s_; } while (0)
        S_HLOAD(hq, uinv, (size_t)gw); S_HCORR(hq, hcorr);
        u32x4 u0[4], u1[4], u2[4], u3[4], u4[4], u5[4], u6[4], u7[4];
        u32x2 r0 = *RT_AT(0), r1 = *RT_AT(1), r2 = *RT_AT(2), r3 = *RT_AT(3), r4 = *RT_AT(4), r5 = *RT_AT(5), r6 = *RT_AT(6), r7 = *RT_AT(7), rp;
        ROW_LOAD(u0, P.U, ROW4, r0); ROW_LOAD(u1, P.U, ROW4, r1); ROW_LOAD(u2, P.U, ROW4, r2); ROW_LOAD(u3, P.U, ROW4, r3);
        ROW_LOAD(u4, P.U, ROW4, r4); ROW_LOAD(u5, P.U, ROW4, r5); ROW_LOAD(u6, P.U, ROW4, r6);
#define U_STEP(XL, RL, XC, RC, gc) do { \
            if ((gc) + 7 < 128) ROW_LOAD(XL, P.U, ROW4, RL); \
            rp = ((gc) + 8 < 128) ? *RT_AT((gc) + 8) : RC; \
            __builtin_amdgcn_sched_barrier(0); \
            float p[4]; \
            _Pragma("unroll") for (int j = 0; j < 4; ++j) p[j] = (float)udot_i4(XC[j], hq) - hcorr; \
            float p2[2], p1; \
            { const bool up = (lane & 2) != 0; \
              _Pragma("unroll") for (int q = 0; q < 2; ++q) { const float keep = up ? p[q + 2] : p[q], send = up ? p[q] : p[q + 2]; p2[q] = keep + dppf<0x4E>(send); } } \
            { const bool up = (lane & 1) != 0; const float keep = up ? p2[1] : p2[0], send = up ? p2[0] : p2[1]; p1 = keep + dppf<0xB1>(send); } \
            p1 += dppf<0x124>(p1); p1 += dppf<0x128>(p1); p1 += shx<16>(p1, lane); \
            if (lp < 4) actw[((gc) >> 4) * 128 + ((gc) & 15) * 8 + eself] = p1 * uinv; \
            RC = rp; } while (0)
#pragma unroll 1
        for (int g = 0; g < 128; g += 8) {
            const int bt0 = g & 15; const int k = g >> 4; const size_t mk = (size_t)gw + (size_t)k * (size_t)ngw;
            if (bt0 == 0 && g > 0) { hq[0] = hqn[0]; hq[1] = hqn[1]; uinv = uinvn; S_HCORR(hq, hcorr); }
            if (bt0 == 0) {
                gA = __int_as_float((int)P.route[mk * 128 + lane].y); gB = __int_as_float((int)P.route[mk * 128 + 64 + lane].y);
                if (g + 16 < 128) S_HLOAD(hqn, uinvn, mk + (size_t)ngw); }
            U_STEP(u7, r7, u0, r0, g + 0); U_STEP(u0, r0, u1, r1, g + 1); U_STEP(u1, r1, u2, r2, g + 2); U_STEP(u2, r2, u3, r3, g + 3);
            U_STEP(u3, r3, u4, r4, g + 4); U_STEP(u4, r4, u5, r5, g + 5); U_STEP(u5, r5, u6, r6, g + 6); U_STEP(u6, r6, u7, r7, g + 7);
            if (bt0 == 8) {
                LDS_WAIT();
                LAS float* at = actw + k * 128;
                const float v0 = at[lane], v1 = at[64 + lane];
                at[lane] = gelu_exact(v0) * gA * (1.0f / VT_SCALE); at[64 + lane] = gelu_exact(v1) * gB * (1.0f / VT_SCALE);
            }
        }
#undef U_STEP
#undef S_HLOAD
#undef S_HCORR
    }
    LDS_WAIT();
    {
        u32x4 v0[4], v1[4], v2[4], v3[4];
        u32x2 r0 = *RT_AT(0), r1 = *RT_AT(1), r2 = *RT_AT(2), r3 = *RT_AT(3), rp;
        ROW_LOAD(v0, P.V, ROW4, r0); ROW_LOAD(v1, P.V, ROW4, r1); ROW_LOAD(v2, P.V, ROW4, r2);
        v2f_t o2[16];
#pragma unroll
        for (int e = 0; e < 16; ++e) o2[e] = (v2f_t){0.f, 0.f};
        f32x4 xv4[4];
#define V_STEP(XL, RL, XC, RC, gc) do { \
            if ((gc) + 3 < 128) ROW_LOAD(XL, P.V, ROW4, RL); \
            rp = ((gc) + 4 < 128) ? *RT_AT((gc) + 4) : RC; \
            __builtin_amdgcn_sched_barrier(0); \
            { const LAS float* ab = actw + ((gc) >> 4) * 128 + ((gc) & 15) * 8 + half; \
              _Pragma("unroll") for (int j = 0; j < 4; ++j) { const float a = ab[2 * j]; \
                _Pragma("unroll") for (int q = 0; q < 4; ++q) { \
                    const v2f_t t0 = __builtin_amdgcn_cvt_scalef32_pk_f32_fp4(XC[j][q], 1.0f, 0), t1 = __builtin_amdgcn_cvt_scalef32_pk_f32_fp4(XC[j][q], 1.0f, 1), \
                                t2 = __builtin_amdgcn_cvt_scalef32_pk_f32_fp4(XC[j][q], 1.0f, 2), t3 = __builtin_amdgcn_cvt_scalef32_pk_f32_fp4(XC[j][q], 1.0f, 3); \
                    o2[4 * q + 0] += t0 * a; o2[4 * q + 1] += t1 * a; o2[4 * q + 2] += t2 * a; o2[4 * q + 3] += t3 * a; } } } \
            RC = rp; } while (0)
#pragma unroll 1
        for (int g = 0; g < 128; g += 4) {
            const int bt0 = g & 15; const int k = g >> 4; const size_t mk = (size_t)gw + (size_t)k * (size_t)ngw;
            V_STEP(v3, r3, v0, r0, g + 0);
            if (bt0 == 12) { const float* xr = P.X + mk * D + 32 * lp + 16 * half;
#pragma unroll
                for (int q = 0; q < 4; ++q) xv4[q] = *(const f32x4*)(xr + 4 * q); }
            V_STEP(v0, r0, v1, r1, g + 1);
            V_STEP(v1, r1, v2, r2, g + 2);
            V_STEP(v2, r2, v3, r3, g + 3);
            if (bt0 == 12) {
                float o[32];
#pragma unroll
                for (int e = 0; e < 16; ++e) { o[2 * e] = o2[e][0]; o[2 * e + 1] = o2[e][1]; o2[e] = (v2f_t){0.f, 0.f}; }
                gather_finish(P, L, mk, lane, o, xv4);
            }
        }
#undef V_STEP
    }
#undef ROW_LOAD
#undef RT_AT
}

#ifndef MK_SINGLE
#define MK_SINGLE 0
#endif
#ifndef TABLE_FP6
#define TABLE_FP6 1
#endif
#ifndef GATHER_MODE
#define GATHER_MODE 0
#endif
#ifndef LATE_PROLOGUE
#define LATE_PROLOGUE 0
#endif
#ifndef IN_I8
#define IN_I8 1
#endif
#ifndef Q_I8
#define Q_I8 1
#endif
#ifndef MIX_SPLIT
#define MIX_SPLIT 0
#endif
#ifndef CHAIN_SPLIT
#define CHAIN_SPLIT 0
#endif
constexpr int SH = (MIX_SPLIT || CHAIN_SPLIT) ? 1 : 0;
constexpr int NSLOT = (GATHER_MODE ? 12 : 10) + SH;
constexpr int NPHASE = 2 + NSLOT * DEPTH;
constexpr int PH_ALL = (1 << (2 + NSLOT)) - 1;
enum { I_X = 0, I_C, I_ADAW, I_ADAB, I_N1G, I_N2G, I_FING, I_WIN, I_LBL, I_HGNG, I_CONVW, I_ALOG, I_DTB, I_GDNNG, I_WBH, I_WBG, I_WOUT, I_WQ, I_SK, I_U, I_V };

DI void quant_row8(const bf16_t* src, unsigned char* dst, float* scale, int lane) {
    const u32x4 a = ((const u32x4*)src)[2 * lane], b = ((const u32x4*)src)[2 * lane + 1];
    float f[16];
    f[0] = bf_lo(a.x); f[1] = bf_hi(a.x); f[2] = bf_lo(a.y); f[3] = bf_hi(a.y); f[4] = bf_lo(a.z); f[5] = bf_hi(a.z); f[6] = bf_lo(a.w); f[7] = bf_hi(a.w);
    f[8] = bf_lo(b.x); f[9] = bf_hi(b.x); f[10] = bf_lo(b.y); f[11] = bf_hi(b.y); f[12] = bf_lo(b.z); f[13] = bf_hi(b.z); f[14] = bf_lo(b.w); f[15] = bf_hi(b.w);
    float am = 0.f;
#pragma unroll
    for (int i = 0; i < 16; ++i) am = fmaxf(am, fabsf(f[i]));
    am = fmaxf(am, shx<1>(am, lane)); am = fmaxf(am, shx<2>(am, lane)); am = fmaxf(am, shx<4>(am, lane)); am = fmaxf(am, shx<8>(am, lane)); am = fmaxf(am, shx<16>(am, lane)); am = fmaxf(am, shx<32>(am, lane));
    am = fmaxf(am, 1e-30f);
    const float sc = 127.0f / am;
    unsigned w[4];
#pragma unroll
    for (int d = 0; d < 4; ++d) { const int q0 = (int)__builtin_rintf(f[4 * d] * sc), q1 = (int)__builtin_rintf(f[4 * d + 1] * sc), q2 = (int)__builtin_rintf(f[4 * d + 2] * sc), q3 = (int)__builtin_rintf(f[4 * d + 3] * sc);
        w[d] = (unsigned)(q0 & 0xff) | ((unsigned)(q1 & 0xff) << 8) | ((unsigned)(q2 & 0xff) << 16) | ((unsigned)q3 << 24); }
    ((u32x4*)dst)[lane] = (u32x4){w[0], w[1], w[2], w[3]};
    if (lane == 0) *scale = am * (1.0f / 127.0f);
}
DI int lane_id_() { unsigned m_ = ~0u; asm volatile("" : "+s"(m_)); return (int)__builtin_amdgcn_mbcnt_hi(m_, __builtin_amdgcn_mbcnt_lo(m_, 0u)); }
template <int PHM> __global__ void __launch_bounds__(NTHR, 2) trunk_fwd(Args args) {
    extern __shared__ __attribute__((aligned(16))) unsigned char lds_raw[];
    lptr L = (lptr)lds_raw;
    const int tid0 = threadIdx.x, wave = __builtin_amdgcn_readfirstlane(tid0 >> 6);
#if MK_SINGLE
    constexpr int G = 256;
#else
    const int G = gridDim.x;
#endif
    const int bx = blockIdx.x; const int vcu = (G % 8 == 0) ? (bx % 8) * (G / 8) + bx / 8 : bx;
    const int gw = vcu * NWAVES + wave, NGW = G * NWAVES;
    unsigned char* ws0 = args.ws;
#if MK_SINGLE
    constexpr int lo = 0, hi = NPHASE;
#else
    const int lo = args.ph_lo, hi = args.ph_hi;
#endif
    volatile LAS unsigned* MISC = (volatile LAS unsigned*)(L + LDS_CTL_OFF);
    for (int u = tid0; u < (LDS_BYTES - LDS_CTL_OFF) / 4; u += NTHR) ((LAS unsigned*)(L + LDS_CTL_OFF))[u] = 0u;
    __syncthreads();
#if MK_SINGLE
    xcd_barrier_post((unsigned*)(ws0 + WS_CTL) + 4096, wave);
#define GRID_BAR() do { unsigned* bp_ = (unsigned*)(args.ws + WS_CTL) + 4096; asm volatile("" : "+s"(bp_)); XcdBarrier b_; b_.bar = bp_; b_.x = xb_xcc_id(); b_.st = (volatile LAS unsigned*)(L + LDS_CTL_OFF) + 8; xcd_barrier(b_, wave); } while (0)
#else
#define GRID_BAR() do {} while (0)
#endif
#define PH_MASK PHM
#ifndef REP_MASK
#define REP_MASK 0
#endif
#ifndef NREPA
#define NREPA 1
#endif
#define NREP(j) (1 + (((REP_MASK) >> (j)) & 1))
#define IN(k) (lo <= (k) && (k) < hi)
#define INL(j) ((((PH_MASK) >> (2 + (j))) & 1) && IN(pb + (j)))
#define IN0(k) ((((PH_MASK) >> (k)) & 1) && IN(k))
#define PHASE_BEGIN() size_t kz = 0; int tid = wave * 64 + lane_id_(); asm volatile("" : "+s"(kz), "+v"(tid)); unsigned char* ws = args.ws + kz; const int lane = tid & 63
#define INP(i) (args.in[i] + kz)
#define SEAM(k) do { if (IN(k) && IN((k) + 1)) GRID_BAR(); } while (0)

#define P_MOD   ((float*)(ws + WS_MOD))
#define P_SMALL ((float*)(ws + WS_SMALL))
#define P_SMALLL(l) ((float*)(ws + ((l) ? WS_SMALL1 : WS_SMALL)))
#define P_WIN   ((bf16_t*)(ws + WS_WIN))
#define P_WBR   ((bf16_t*)(ws + WS_WBR))
#define P_WOUT  ((bf16_t*)(ws + WS_WOUT))
#define P_WQ    ((bf16_t*)(ws + WS_WQ))
#define P_SK    ((bf16_t*)(ws + WS_SK))
#define P_PROJ  ((bf16_t*)(ws + WS_PROJ))
#define P_Y     ((bf16_t*)(ws + WS_Y))
#define P_U     ((unsigned char*)(ws + (TABLE_FP6 ? WS_U6 : WS_UV)))
#define P_V     (TABLE_FP6 ? (unsigned char*)(ws + WS_WIN + (size_t)l * 12 * MiB) : (unsigned char*)(ws + WS_UV) + (size_t)NEXP * D)
#define P_H     ((bf16_t*)(ws + WS_H))
#define P_MERGED ((bf16_t*)(ws + WS_MERGED))
#define P_WQ8   ((unsigned char*)(ws + 500 * MiB))
#define P_WQS   ((float*)(ws + 504 * MiB))
#define P_WINS  ((float*)(ws + 504 * MiB + 16384))
#define P_WIN8(l_) ((unsigned char*)(ws + ((l_) ? 34 * MiB : 505 * MiB)))
#define P_G8    ((unsigned char*)(ws + WS_SCR))
#define P_GS    ((float*)(ws + WS_SCR + 16 * MiB))
#define P_H8    ((unsigned char*)(ws + WS_Y))
#define P_HS    ((float*)(ws + WS_Y + 16 * MiB))
#define P_ROUTE ((u32x2*)(ws + WS_ROUTE))
#define MIXP_INIT(MP, l) MixP MP; MP.PROJ = P_PROJ; MP.SMALL = P_SMALLL(l); MP.convw = INP(I_CONVW) + (size_t)(l) * 4 * 1536; MP.alog = INP(I_ALOG) + (l) * 4; MP.dtb = INP(I_DTB) + (l) * 4; MP.lbl = INP(I_LBL); MP.l = (l); \
        MP.MT = ws + WS_MT; MP.NN = ws + WS_NN; MP.QT = ws + WS_QT; MP.OP = ws + WS_OP; MP.SS = ws + WS_SS; MP.DL = (float*)(ws + WS_DL)

    for (int rep_ = 0; rep_ < NREP(10); ++rep_) if (IN0(0)) { if (rep_) GRID_BAR();
        PHASE_BEGIN();
        if (vcu < (LATE_PROLOGUE ? 96 : 192)) mod_item(INP(I_C), INP(I_ADAW), INP(I_ADAB), P_MOD, vcu, L, tid);
        LAS float* scr = (LAS float*)(L + wave * 16384);
        constexpr int IT_WIN = 16 * 192, IT_WBR = 8 * 32, IT_WOUT = 16 * 32, IT_WQ = 16 * 64, IT_L = IT_WIN + 2 * IT_WBR + IT_WOUT + IT_WQ;
#define WEIGHT_ITEM_BODY \
            if (r < IT_WIN) { const int kb = r / 192, nb = r % 192, n0 = 32 * nb; transpose_item(INP(I_WIN) + (size_t)l * D * IN_COLS, IN_COLS, n0 + (n0 >= 4096 ? 8 : 0), P_WIN + (size_t)l * NPROJ * D, D, n0, 64 * kb, scr, lane); continue; } r -= IT_WIN; \
            if (r < IT_WBR) { const int kb = r / 32, nb = r % 32; transpose_item(INP(I_WBH) + (size_t)l * 512 * D, D, 32 * nb, P_WBR + ((size_t)l * 2 + 0) * D * 512, 512, 32 * nb, 64 * kb, scr, lane); continue; } r -= IT_WBR; \
            if (r < IT_WBR) { const int kb = r / 32, nb = r % 32; transpose_item(INP(I_WBG) + (size_t)l * 512 * D, D, 32 * nb, P_WBR + ((size_t)l * 2 + 1) * D * 512, 512, 32 * nb, 64 * kb, scr, lane); continue; } r -= IT_WBR; \
            if (r < IT_WOUT) { const int kb = r / 32, nb = r % 32; transpose_item(INP(I_WOUT) + (size_t)l * D * D, D, 32 * nb, P_WOUT + (size_t)l * D * D, D, 32 * nb, 64 * kb, scr, lane); continue; } r -= IT_WOUT; \
            { const int kb = r / 64, nb = r % 64; transpose_item(INP(I_WQ) + (size_t)l * D * NQ, NQ, 32 * nb, P_WQ + (size_t)l * NQ * D, D, 32 * nb, 64 * kb, scr, lane); } \

        for (int it = gw; it < (LATE_PROLOGUE ? 1 : DEPTH) * IT_L; it += NGW) {
            const int l = it / IT_L; int r = it - l * IT_L;
            WEIGHT_ITEM_BODY
        }
        cvt_stream(INP(I_SK), P_SK, (size_t)DEPTH * 8 * 2 * 128 * 128, gw, NGW, lane);
    }
    SEAM(0);
    for (int rep_ = 0; rep_ < NREP(11); ++rep_) if (IN0(1)) { if (rep_) GRID_BAR();
        PHASE_BEGIN();
        LAS float* wsm = (LAS float*)L;
        stage_wsmall(INP(I_WIN), wsm, tid);
        const float* x = INP(I_X); float* mod = P_MOD;
        for (int bb = 0; bb < BATCH; ++bb) {
            RowMod R; load_rowmod(R, INP(I_N1G), mod + (size_t)bb * 6 * D + D, mod + (size_t)bb * 6 * D, lane);
            for (int m = bb * SEQ + gw; m < (bb + 1) * SEQ; m += NGW) {
                f32x4 v[4];
#pragma unroll
                for (int j = 0; j < 4; ++j) v[j] = ((const f32x4*)(x + (size_t)m * D))[lane + 64 * j];
                row_finish<true, IN_I8 != 0>(v, R, P_H + (size_t)m * D, P_SMALL + (size_t)m * 8, wsm, lane, (unsigned*)(P_G8 + (size_t)m * D), P_GS + m);
            }
        }
#if IN_I8
        for (int rw = gw; rw < NPROJ; rw += NGW) quant_row8(P_WIN + (size_t)rw * D, P_WIN8(0) + (size_t)rw * D, P_WINS + rw, lane);
#endif
#if Q_I8
        for (int rw = gw; rw < DEPTH * NQ; rw += NGW) {
            const u32x4 a = ((const u32x4*)(P_WQ + (size_t)rw * D))[2 * lane], b = ((const u32x4*)(P_WQ + (size_t)rw * D))[2 * lane + 1];
            float f[16];
            f[0] = bf_lo(a.x); f[1] = bf_hi(a.x); f[2] = bf_lo(a.y); f[3] = bf_hi(a.y); f[4] = bf_lo(a.z); f[5] = bf_hi(a.z); f[6] = bf_lo(a.w); f[7] = bf_hi(a.w);
            f[8] = bf_lo(b.x); f[9] = bf_hi(b.x); f[10] = bf_lo(b.y); f[11] = bf_hi(b.y); f[12] = bf_lo(b.z); f[13] = bf_hi(b.z); f[14] = bf_lo(b.w); f[15] = bf_hi(b.w);
            float am = 0.f;
#pragma unroll
            for (int i = 0; i < 16; ++i) am = fmaxf(am, fabsf(f[i]));
            am = fmaxf(am, shx<1>(am, lane)); am = fmaxf(am, shx<2>(am, lane)); am = fmaxf(am, shx<4>(am, lane)); am = fmaxf(am, shx<8>(am, lane)); am = fmaxf(am, shx<16>(am, lane)); am = fmaxf(am, shx<32>(am, lane));
            am = fmaxf(am, 1e-30f);
            const float sc = 127.0f / am;
            unsigned w[4];
#pragma unroll
            for (int d = 0; d < 4; ++d) { const int q0 = (int)__builtin_rintf(f[4 * d] * sc), q1 = (int)__builtin_rintf(f[4 * d + 1] * sc), q2 = (int)__builtin_rintf(f[4 * d + 2] * sc), q3 = (int)__builtin_rintf(f[4 * d + 3] * sc);
                w[d] = (unsigned)(q0 & 0xff) | ((unsigned)(q1 & 0xff) << 8) | ((unsigned)(q2 & 0xff) << 16) | ((unsigned)q3 << 24); }
            ((u32x4*)(P_WQ8 + (size_t)rw * D))[lane] = (u32x4){w[0], w[1], w[2], w[3]};
            if (lane == 0) P_WQS[rw] = am * (1.0f / 127.0f);
        }
#endif
    }
    SEAM(1);
#ifdef EXTRA_BARS
#ifndef EB_RT
#define EB_RT 0
#endif
    for (int eb_ = 0; eb_ < EXTRA_BARS + EB_RT; ++eb_) GRID_BAR();
#endif
#pragma unroll 1
    for (int l = 0; l < DEPTH; ++l) {
        const int pb = 2 + NSLOT * l;
        for (int rep_ = 0; rep_ < NREP(0); ++rep_) if (INL(0)) { if (rep_) GRID_BAR();
            PHASE_BEGIN();
#if IN_I8
            pg8::Gemm g{(const bf16_t*)P_G8, (const bf16_t*)P_WIN8(l), M, NPROJ, D / 2, D / 2, D / 2, 0, 0}; pg8::StaticOrder S; S.init(M, NPROJ, G, bx);
            pg8::EpiQ8 E{P_PROJ, NPROJ, P_GS, P_WINS + (size_t)l * NPROJ};
            pg8::gemm_phase<pg8::EpiQ8, pg8::StaticOrder, true>(L, g, S, E, tid);
#else
            pg8::Gemm g{P_H, P_WIN + (size_t)l * NPROJ * D, M, NPROJ, D, D, D, 0, 0}; pg8::StaticOrder S; S.init(M, NPROJ, G, bx);
            pg8::EpiBf16 E{P_PROJ, NPROJ};
            pg8::gemm_phase(L, g, S, E, tid);
#endif
        }
        SEAM(pb + 0);
#if CHAIN_SPLIT
        if (INL(1)) {
            PHASE_BEGIN(); MIXP_INIT(MP, l);
            for (int i = vcu; i < 2048; i += G) { const int br = i >> 10, bhc = i & 1023;
                if (br) passA_gdn(L, tid, MP, bhc >> 7, bhc & 127); else passA_hgrn(L, tid, MP, bhc >> 7, bhc & 127); }
        }
        SEAM(pb + 1);
#pragma unroll 1
        for (int hf = 0; hf < 2; ++hf) {
            if (INL(2 + hf)) {
                PHASE_BEGIN(); MIXP_INIT(MP, l);
                const int vx = vcu & 31, xq = vcu >> 5; const int c0 = 64 * hf, c1 = c0 + 64;
                if (vx < 4) passB_gdn(L, tid, MP, xq * 4 + vx, c0, c1);
                else if (vx < 20 && wave < 2) passB_hgrn(lane, MP, ((vx - 4) * 8 + xq) * 2 + wave, c0, c1);
                else {
                    const int cw = (vx >= 20) ? (xq * 12 + vx - 20) * 8 + wave : 768 + ((vx - 4) * 8 + xq) * 6 + (wave - 2);
                    if (hf == 0) cvt_stream_tab(INP(I_U) + (size_t)l * NEXP * D, P_U, TAB_UI4 ? 2 : TAB_U4, UT_SCALE, cw, 1536, lane);
                    else {
                        const float* ngh = INP(I_HGNG) + l * 128; const float* ngg = INP(I_GDNNG) + l * 128;
                        int tl = tid; asm volatile("" : "+v"(tl)); const int ln = tl & 63;
                        if (vx >= 20) {
#pragma unroll 1
                            for (int t = cw; t < 2048; t += 768) { const int q = t >> 1, cc = q & 63, rest = q >> 6;
                                passC_wave(ln, MP, (rest >> 3) * 1024 + (rest & 7) * 128 + cc, t & 1, ngh, ngg, P_Y); }
                        } else cvt_stream_tab(INP(I_V) + (size_t)l * NEXP * D, P_V, TAB_V4, VT_SCALE, cw - 768, 768, ln);
                    }
                }
            }
            SEAM(pb + 2 + hf);
        }
        if (INL(4)) {
            PHASE_BEGIN(); MIXP_INIT(MP, l);
            const float* ngh = INP(I_HGNG) + l * 128; const float* ngg = INP(I_GDNNG) + l * 128;
            int tl = tid; asm volatile("" : "+v"(tl)); const int ln = tl & 63;
            { const int t = gw, q = t >> 1, cc = 64 + (q & 63), rest = q >> 6;
              passC_wave(ln, MP, (rest >> 3) * 1024 + (rest & 7) * 128 + cc, t & 1, ngh, ngg, P_Y); }
        }
        SEAM(pb + 4);
#elif MIX_SPLIT
        if (INL(1)) {
            PHASE_BEGIN(); MIXP_INIT(MP, l);
            for (int i = vcu; i < 1024; i += G) passA_gdn(L, tid, MP, i >> 7, i & 127);
        }
        SEAM(pb + 1);
        if (INL(2)) {
            PHASE_BEGIN(); MIXP_INIT(MP, l);
            const int vx = vcu & 31, xq = vcu >> 5;
            if (vx < 4) passB_gdn(L, tid, MP, xq * 4 + vx);
            else {
                const int widx = (vx - 4) * 8 + xq;
                for (int i = widx; i < 1024; i += 224) passA_hgrn(L, tid, MP, i >> 7, i & 127);
                cvt_stream_tab(INP(I_U) + (size_t)l * NEXP * D, P_U, TAB_UI4 ? 2 : TAB_U4, UT_SCALE, widx * 8 + wave, 224 * 8, lane);
            }
        }
        SEAM(pb + 2);
        if (INL(3)) {
            PHASE_BEGIN(); MIXP_INIT(MP, l);
            const float* ngh = INP(I_HGNG) + l * 128; const float* ngg = INP(I_GDNNG) + l * 128;
            int tl = tid; asm volatile("" : "+v"(tl)); const int ln = tl & 63;
            if (wave == 0) passB_hgrn(ln, MP, vcu);
            else {
                const int w7 = vcu * 7 + (wave - 1);
#pragma unroll 1
                for (int t = w7; t < 2048; t += 1792) passC_wave(ln, MP, 1024 + (t >> 1), t & 1, ngh, ngg, P_Y);
                cvt_stream_tab(INP(I_V) + (size_t)l * NEXP * D, P_V, TAB_V4, VT_SCALE, w7, 1792, ln);
            }
        }
        SEAM(pb + 3);
        if (INL(4)) {
            PHASE_BEGIN(); MIXP_INIT(MP, l);
            const float* ngh = INP(I_HGNG) + l * 128; const float* ngg = INP(I_GDNNG) + l * 128;
            int tl = tid; asm volatile("" : "+v"(tl)); const int ln = tl & 63;
            passC_wave(ln, MP, gw >> 1, gw & 1, ngh, ngg, P_Y);
        }
        SEAM(pb + 4);
#else
        for (int rep_ = 0; rep_ < NREP(1); ++rep_) if (INL(1)) { if (rep_) GRID_BAR();
            PHASE_BEGIN(); MIXP_INIT(MP, l);
            for (int i2 = vcu; i2 < (NREPA == 2 ? 4096 : NREPA == 3 ? 3072 : NREPA == 4 ? 3072 : 2048); i2 += G) { const int i = (NREPA == 3 && i2 >= 2048) ? i2 - 1024 : (i2 & 2047);
                const int br = i >> 10, bhc = i & 1023;
                if (br) passA_gdn(L, tid, MP, bhc >> 7, bhc & 127); else passA_hgrn(L, tid, MP, bhc >> 7, bhc & 127);
            }
        }
        SEAM(pb + 1);
        for (int rep_ = 0; rep_ < NREP(2); ++rep_) if (INL(2)) { if (rep_) GRID_BAR();
            PHASE_BEGIN(); MIXP_INIT(MP, l);
            const int vx = vcu & 31, xq = vcu >> 5;
            if (vx < 4) passB_gdn(L, tid, MP, xq * 4 + vx);
            else if (vx < 20 && wave < 2) { passB_hgrn(lane, MP, ((vx - 4) * 8 + xq) * 2 + wave);
#ifdef PROBE_H2X
                passB_hgrn(lane, MP, ((vx - 4) * 8 + xq) * 2 + wave);
#endif
            }
#if TABLE_FP6
            else {
                if (rep_ == 0) { const int cw = (vx >= 20) ? (xq * 12 + vx - 20) * 8 + wave : 768 + ((vx - 4) * 8 + xq) * 6 + (wave - 2);
#if LATE_PROLOGUE
                if (l == 0) {
                    if (vx >= 20) mod_item(INP(I_C), INP(I_ADAW), INP(I_ADAB), P_MOD, 96 + xq * 12 + vx - 20, L, tid);
                    LAS float* scr = (LAS float*)(L + wave * 16384);
                    constexpr int IT_WIN = 16 * 192, IT_WBR = 8 * 32, IT_WOUT = 16 * 32, IT_WQ = 16 * 64, IT_L = IT_WIN + 2 * IT_WBR + IT_WOUT + IT_WQ;
                    for (int it = cw; it < IT_L; it += 1536) { constexpr int l = 1; int r = it;
                        WEIGHT_ITEM_BODY
                    }
                }
#endif
                cvt_stream_tab(INP(I_U) + (size_t)l * NEXP * D, P_U, TAB_UI4 ? 2 : TAB_U4, UT_SCALE, cw, 1536, lane);
                cvt_stream_tab(INP(I_V) + (size_t)l * NEXP * D, P_V, TAB_V4, VT_SCALE, cw, 1536, lane); }
            }
#endif
        }
        SEAM(pb + 2);
        for (int rep_ = 0; rep_ < NREP(3); ++rep_) if (INL(3)) { if (rep_) GRID_BAR();
            PHASE_BEGIN(); MIXP_INIT(MP, l);
            const float* ngh = INP(I_HGNG) + l * 128; const float* ngg = INP(I_GDNNG) + l * 128;
            int tl = tid; asm volatile("" : "+v"(tl)); const int ln = tl & 63, wv = __builtin_amdgcn_readfirstlane(tl >> 6);
#pragma unroll 1
            for (int j = 0; j < 2; ++j) passC_wave(ln, MP, (gw >> 1) + 1024 * j, gw & 1, ngh, ngg, P_Y);
        }
        SEAM(pb + 3);
#endif
        for (int rep_ = 0; rep_ < NREP(4); ++rep_) if (INL(4 + SH)) { if (rep_) GRID_BAR();
            PHASE_BEGIN();
            pg8::TwoPassOrder S; S.S.init(M, D, G, bx);
            pg8::Gemm g{P_Y, P_WBR + (size_t)l * 2 * D * 512, M, D, 512, D, 512, (size_t)512, (size_t)D * 512};
            pg8::EpiGate E{P_MERGED, D, P_PROJ, NPROJ, PC_GATE};
            pg8::gemm_phase(L, g, S, E, tid);
        }
        SEAM(pb + 4 + SH);
        for (int rep_ = 0; rep_ < NREP(5); ++rep_) if (INL(5 + SH)) { if (rep_) GRID_BAR();
            PHASE_BEGIN();
            float* X = args.out;
            pg8::Gemm g{P_MERGED, P_WOUT + (size_t)l * D * D, M, D, D, D, D, 0, 0}; pg8::StaticOrder S; S.init(M, D, G, bx);
            pg8::EpiResid E{l == 0 ? INP(I_X) : (const float*)X, X, P_MOD + (size_t)l * BATCH * 6 * D + 2 * D};
            pg8::gemm_phase(L, g, S, E, tid);
#if !TABLE_FP6
            cvt_stream_fp8(INP(I_U) + (size_t)l * NEXP * D, P_U, (size_t)NEXP * D, U8_SCALE, gw, NGW, lane);
            cvt_stream_fp8(INP(I_V) + (size_t)l * NEXP * D, P_V, (size_t)NEXP * D, V8_SCALE, gw, NGW, lane);
#endif
        }
        SEAM(pb + 5 + SH);
        for (int rep_ = 0; rep_ < NREP(6); ++rep_) if (INL(6 + SH)) { if (rep_) GRID_BAR();
            PHASE_BEGIN();
            const float* X = args.out; const float* modl = P_MOD + (size_t)l * BATCH * 6 * D;
            for (int bb = 0; bb < BATCH; ++bb) {
                RowMod R; load_rowmod(R, INP(I_N2G) + l * D, modl + (size_t)bb * 6 * D + 4 * D, modl + (size_t)bb * 6 * D + 3 * D, lane);
                for (int m = bb * SEQ + gw; m < (bb + 1) * SEQ; m += NGW) {
                    f32x4 v[4];
#pragma unroll
                    for (int j = 0; j < 4; ++j) v[j] = ((const f32x4*)(X + (size_t)m * D))[lane + 64 * j];
                    row_finish<false, TAB_UI4 != 0>(v, R, P_H + (size_t)m * D, nullptr, nullptr, lane, (unsigned*)(P_H8 + (size_t)m * D), P_HS + m);
                }
            }
#if IN_I8
            if (l == 0) for (int rw = gw; rw < NPROJ; rw += NGW) quant_row8(P_WIN + (size_t)NPROJ * D + (size_t)rw * D, P_WIN8(1) + (size_t)rw * D, P_WINS + NPROJ + rw, lane);
#endif
        }
        SEAM(pb + 6 + SH);
        for (int rep_ = 0; rep_ < NREP(7); ++rep_) if (INL(7 + SH)) { if (rep_) GRID_BAR();
            PHASE_BEGIN();
#if Q_I8
            pg8::Gemm g{(const bf16_t*)P_H8, (const bf16_t*)(P_WQ8 + (size_t)l * NQ * D), M, NQ, D / 2, D / 2, D / 2, 0, 0}; pg8::StaticOrder S; S.init(M, NQ, G, bx);
            pg8::EpiQ8 E{P_PROJ, NQ, P_HS, P_WQS + (size_t)l * NQ};
            pg8::gemm_phase<pg8::EpiQ8, pg8::StaticOrder, true>(L, g, S, E, tid);
#else
            pg8::Gemm g{P_H, P_WQ + (size_t)l * NQ * D, M, NQ, D, D, D, 0, 0}; pg8::StaticOrder S; S.init(M, NQ, G, bx);
            pg8::EpiBf16 E{P_PROJ, NQ};
            pg8::gemm_phase(L, g, S, E, tid);
#endif
        }
        SEAM(pb + 7 + SH);
        for (int rep_ = 0; rep_ < NREP(8); ++rep_) if (INL(8 + SH)) { if (rep_) GRID_BAR(); PHASE_BEGIN(); peer_route_phase(L, tid, vcu, P_PROJ, P_SK + (size_t)l * 8 * 2 * 128 * 128, P_ROUTE); }
        SEAM(pb + 8 + SH);
#if GATHER_MODE == 0
        for (int rep_ = 0; rep_ < NREP(9); ++rep_) if (INL(9 + SH)) { if (rep_) GRID_BAR();
            PHASE_BEGIN();
            float* mod = P_MOD;
            GatherP GP; GP.H = P_H; GP.route = P_ROUTE; GP.U = P_U; GP.V = P_V; GP.X = args.out; GP.gt2 = mod + (size_t)l * BATCH * 6 * D + 5 * D; GP.last = (l == DEPTH - 1);
            LAS float* wsm = (LAS float*)L;
            if (GP.last) { GP.ng = INP(I_FING); GP.nsc = nullptr; GP.nsh = nullptr; }
            else { GP.ng = INP(I_N1G) + (l + 1) * D; GP.nsc = mod + (size_t)(l + 1) * BATCH * 6 * D + D; GP.nsh = mod + (size_t)(l + 1) * BATCH * 6 * D;
                   stage_wsmall(INP(I_WIN) + (size_t)(l + 1) * D * IN_COLS, wsm, tid); }
            GP.Hout = P_H; GP.small = P_SMALLL(l + 1); GP.wsm = wsm; GP.out = args.out; GP.H8 = P_H8; GP.HS = P_HS; GP.G8 = P_G8; GP.GS = P_GS;
#if TABLE_FP6
#if GATHER_PIPE == 3
            stage_gather_consts(GP, L, tid);
            peer_gather_split(GP, L, gw, NGW, lane, wave);
#elif GATHER_PIPE == 2
            stage_gather_consts(GP, L, tid);
            peer_gather_wave(GP, L, gw, NGW, lane);
#else
            for (int m = gw; m < M; m += NGW) peer_gather_token6(GP, (size_t)m, lane);
#endif
#else
            for (int m = gw; m < M; m += NGW) peer_gather_token(GP, (size_t)m, lane);
#endif
        }
        if (l + 1 < DEPTH) SEAM(pb + 9 + SH);
#else
        if (INL(9 + SH)) { PHASE_BEGIN(); int bxl = bx; asm volatile("" : "+s"(bxl)); peer_u_pass(L, tid, bxl, P_H, P_ROUTE, P_U, (float*)(ws + WS_ACT)); }
        SEAM(pb + 9 + SH);
        if (INL(10 + SH)) { PHASE_BEGIN(); int bxl = bx; asm volatile("" : "+s"(bxl)); peer_v_pass(tid, bxl, P_ROUTE, (const float*)(ws + WS_ACT), P_V, args.out, P_MOD + (size_t)l * BATCH * 6 * D + 5 * D); }
        SEAM(pb + 10 + SH);
        if (INL(11 + SH)) {
            PHASE_BEGIN();
            float* X = args.out; float* mod = P_MOD;
            if (l == DEPTH - 1) {
                const float* fg = INP(I_FING);
#pragma unroll 1
                for (int m = gw; m < M; m += NGW) { f32x4 v[4];
#pragma unroll
                    for (int j = 0; j < 4; ++j) v[j] = ((const f32x4*)(X + (size_t)m * D))[lane + 64 * j];
                    row_final(v, fg, X + (size_t)m * D, lane); }
            } else {
                LAS float* wsm = (LAS float*)L;
                stage_wsmall(INP(I_WIN) + (size_t)(l + 1) * D * IN_COLS, wsm, tid);
                const float* modn = mod + (size_t)(l + 1) * BATCH * 6 * D;
#pragma unroll 1
                for (int bb = 0; bb < BATCH; ++bb) {
                    RowMod R; load_rowmod(R, INP(I_N1G) + (l + 1) * D, modn + (size_t)bb * 6 * D + D, modn + (size_t)bb * 6 * D, lane);
#pragma unroll 1
                    for (int m = bb * SEQ + gw; m < (bb + 1) * SEQ; m += NGW) { f32x4 v[4];
#pragma unroll
                        for (int j = 0; j < 4; ++j) v[j] = ((const f32x4*)(X + (size_t)m * D))[lane + 64 * j];
                        row_finish<true>(v, R, P_H + (size_t)m * D, P_SMALLL(l + 1) + (size_t)m * 8, wsm, lane); }
                }
            }
        }
        if (l + 1 < DEPTH) SEAM(pb + 11 + SH);
#endif
    }
#undef IN
#undef SEAM
}

#ifndef DBG_STOP
#define DBG_STOP 0
#endif
#ifndef DBG_SEL
#define DBG_SEL 0
#endif
#if DBG_STOP || defined(DUMP_OFF)
__global__ void dbg_dump(float* out, const unsigned short* a, size_t na, const unsigned short* b, size_t nb, const float* xf) {
    const size_t i = (size_t)blockIdx.x * blockDim.x + threadIdx.x; if (i >= (size_t)M * D) return;
    float v = 0.f;
#ifdef DUMP_VAL
    if (a) { for (size_t j = i; j < na; j += (size_t)M * D) { float t = __uint_as_float((unsigned)a[j] << 16); if (!(fabsf(t) < 1e30f)) t = 1e30f; v += t; } }
#else
    if (a) { for (size_t j = i; j < na; j += (size_t)M * D) v += (float)a[j] * (1.0f / 65536.0f); }
#endif
    if (b) { for (size_t j = i; j < nb; j += (size_t)M * D) v += (float)b[j] * (1.0f / 65536.0f); }
    if (xf) { float t = xf[i]; unsigned u = __float_as_uint(t); v += (float)(u >> 16) * (1.0f / 65536.0f) + (float)(u & 0xffffu) * (1.0f / 65536.0f); }
    out[i] = v;
}
#endif
#if DBG_STOP
__global__ void dbg_route_check(const bf16_t* Q, const bf16_t* SK, const u32x2* route, unsigned* counter) {
    extern __shared__ float sh[];
    const int tid = threadIdx.x; float* my = sh + tid * 400;
    const int gid = blockIdx.x * 64 + tid, t = gid >> 3, h = gid & 7;
    for (int z = 0; z < 2; ++z) for (int n = 0; n < 128; ++n) { float a = 0.f;
        for (int d = 0; d < 128; ++d) a += bf1(Q[(size_t)t * NQ + h * 256 + z * 128 + d]) * bf1(SK[((size_t)(h * 2 + z) * 128 + n) * 128 + d]);
        my[z * 128 + n] = a; }
    float* av = my + 256; int* ai = (int*)(my + 288);
    for (int z = 0; z < 2; ++z) for (int r = 0; r < 16; ++r) { int bi = 0; float bv = -INFINITY;
        for (int n = 0; n < 128; ++n) if (my[z * 128 + n] > bv) { bv = my[z * 128 + n]; bi = n; }
        av[z * 16 + r] = bv; ai[z * 16 + r] = bi; my[z * 128 + bi] = -INFINITY; }
    unsigned char* used = (unsigned char*)(my + 320);
    for (int k = 0; k < 256; ++k) used[k] = 0;
    int mism = 0;
    int ex[16];
    for (int r = 0; r < 16; ++r) { int bi = 0; float bv = -INFINITY;
        for (int k = 0; k < 256; ++k) if (!used[k]) { const float v = av[k >> 4] + av[16 + (k & 15)]; if (v > bv) { bv = v; bi = k; } }
        used[bi] = 1; my[r] = __int_as_float(ai[bi >> 4] * 128 + ai[16 + (bi & 15)]); }
    for (int k = 0; k < 16; ++k) { const int e = (int)route[((size_t)t * 8 + h) * 16 + k].x; bool f = false;
        for (int r = 0; r < 16; ++r) f = f || (__float_as_int(my[r]) == e);
        mism += f ? 0 : 1; }
    atomicAdd(counter, (unsigned)mism);
}
__global__ void dbg_gather_check(const bf16_t* H, const u32x2* route, const bf16_t* U, const bf16_t* V, const float* O, float* acc2  ) {
    __shared__ float red[256]; __shared__ float actv;
    const int t = blockIdx.x, tid = threadIdx.x;
    float o[4] = {0.f, 0.f, 0.f, 0.f};
    for (int k = 0; k < 128; ++k) {
        const u32x2 re = route[(size_t)t * 128 + k]; const size_t ro = (size_t)re.x * D;
        float p = 0.f; for (int j = 0; j < 4; ++j) p += bf1(H[(size_t)t * D + tid * 4 + j]) * bf1(U[ro + tid * 4 + j]);
        red[tid] = p; __syncthreads();
        for (int s_ = 128; s_ > 0; s_ >>= 1) { if (tid < s_) red[tid] += red[tid + s_]; __syncthreads(); }
        if (tid == 0) { const float x = red[0]; actv = 0.5f * x * (1.0f + erff(x * 0.70710678118654752f)) * __int_as_float((int)re.y); }
        __syncthreads();
        const float a = actv;
        for (int j = 0; j < 4; ++j) o[j] += a * bf1(V[ro + tid * 4 + j]);
        __syncthreads();
    }
    float e = 0.f, r = 0.f;
    for (int j = 0; j < 4; ++j) { const float g = O[(size_t)t * D + tid * 4 + j]; e += (g - o[j]) * (g - o[j]); r += o[j] * o[j]; }
    atomicAdd(acc2, e); atomicAdd(acc2 + 1, r);
}
__global__ void dbg_mixer_check(const bf16_t* PROJ, const float* SMALLp, const float* convw, const float* alog, const float* dtb, const float* ngh, const float* ngg, const bf16_t* Y, float* acc2, int T0, const float* lbl, int lay) {
    extern __shared__ float dsh[];
    float* qs = dsh; float* ks = dsh + 128; float* fs = dsh + 256; float* red = dsh + 384; float* SS_ = dsh + 512;
    const int br = blockIdx.x >> 3, bh = blockIdx.x & 7, b = bh >> 2, h = bh & 3, tid = threadIdx.x;
#define S_(k) SS_[(k) * 128 + tid]
    for (int k = 0; k < 128; ++k) S_(k) = 0.f;
    float err = 0.f, ref = 0.f;
    for (int t = 0; t < T0; ++t) {
        const size_t row = (size_t)b * SEQ + t; const bf16_t* pr = PROJ + row * NPROJ;
        float o = 0.f, gate;
        if (br == 0) {
            const float lb_ = lay ? sigmoidf_(lbl[512 + h * 128 + tid] - lbl[h * 128 + tid]) : 0.f;
            qs[tid] = siluf_(bf1(pr[PC_HQ + h * 128 + tid])); fs[tid] = lb_ + (1.0f - lb_) * sigmoidf_(bf1(pr[PC_HF + h * 128 + tid]));
            const float iv = bf1(pr[PC_HI + h * 128 + tid]); gate = bf1(pr[PC_HG + h * 128 + tid]);
            __syncthreads();
#pragma unroll 4
            for (int k = 0; k < 128; ++k) { const float f = fs[k]; const float sv = f * S_(k) + (1.0f - f) * iv; S_(k) = sv; o += qs[k] * sv; }
        } else {
            float c3[3];
#pragma unroll
            for (int ty = 0; ty < 3; ++ty) { const int ch = ty * 512 + h * 128 + tid; float a = 0.f;
                for (int j = 0; j < 4; ++j) if (t - 3 + j >= 0) a += bf1(PROJ[(row - 3 + j) * NPROJ + PC_QKV + ch]) * convw[j * 1536 + ch];
                c3[ty] = siluf_(a); }
            gate = bf1(pr[PC_GG + h * 128 + tid]);
            red[tid] = c3[0] * c3[0]; __syncthreads();
            for (int s_ = 64; s_ > 0; s_ >>= 1) { if (tid < s_) red[tid] += red[tid + s_]; __syncthreads(); }
            const float sq = red[0]; __syncthreads();
            red[tid] = c3[1] * c3[1]; __syncthreads();
            for (int s_ = 64; s_ > 0; s_ >>= 1) { if (tid < s_) red[tid] += red[tid + s_]; __syncthreads(); }
            const float sk = red[0]; __syncthreads();
            qs[tid] = c3[0] / sqrtf(sq + EPS) * 0.08838834764831845f; ks[tid] = c3[1] / sqrtf(sk + EPS);
            const float beta = sigmoidf_(SMALLp[row * 8 + h]); const float x = SMALLp[row * 8 + 4 + h] + dtb[h];
            const float a = __expf(-__expf(alog[h]) * (x > 20.f ? x : log1pf(__expf(x))));
            __syncthreads();
            float kS = 0.f;
#pragma unroll 4
            for (int k = 0; k < 128; ++k) kS += ks[k] * S_(k);
            const float vn = beta * (c3[2] - a * kS);
#pragma unroll 4
            for (int k = 0; k < 128; ++k) { const float sv = a * S_(k) + ks[k] * vn; S_(k) = sv; o += qs[k] * sv; }
        }
        __syncthreads();
        red[tid] = o * o; __syncthreads();
        for (int s_ = 64; s_ > 0; s_ >>= 1) { if (tid < s_) red[tid] += red[tid + s_]; __syncthreads(); }
        const float rstd = 1.0f / sqrtf(red[0] * (1.0f / 128.0f) + EPS);
        const float y = o * rstd * (br ? ngg : ngh)[tid] * siluf_(gate);
        const float g = bf1(Y[row * D + br * 512 + h * 128 + tid]);
        err += (g - y) * (g - y); ref += y * y;
        __syncthreads();
    }
    atomicAdd(acc2 + 2 * br, err); atomicAdd(acc2 + 2 * br + 1, ref);
}
__global__ void dbg_gemm_check(const bf16_t* A, int lda, int K, const float* W, int ldw, int N, int skip_at, int skip, const bf16_t* O, int ldo, float* acc2) {
    const int row = blockIdx.x * 61; if (row >= M) return;
    float err = 0.f, ref = 0.f;
    for (int n = threadIdx.x; n < N; n += blockDim.x) { const int wc = n < skip_at ? n : n + skip; float a = 0.f;
        for (int k = 0; k < K; ++k) a += bf1(A[(size_t)row * lda + k]) * W[(size_t)k * ldw + wc];
        const float g = bf1(O[(size_t)row * ldo + n]); err += (g - a) * (g - a); ref += a * a; }
    atomicAdd(acc2, err); atomicAdd(acc2 + 1, ref);
}
__global__ void dbg_mod_check(const float* c, const float* ada_w, const float* ada_b, const float* mod, float* acc2) {
    const int idx = blockIdx.x * blockDim.x + threadIdx.x; if (idx >= DEPTH * BATCH * 6 * D) return;
    const int l = idx / (BATCH * 6 * D), b = (idx / (6 * D)) % BATCH, n = idx % (6 * D);
    float a = 0.f; for (int k = 0; k < D; ++k) a += siluf_(c[b * D + k]) * ada_w[((size_t)l * D + k) * 6 * D + n];
    a += ada_b[l * 6 * D + n];
    const float g = mod[idx]; atomicAdd(acc2, (g - a) * (g - a)); atomicAdd(acc2 + 1, a * a);
}
__global__ void dbg_row_check(const float* x, const float* g1, const float* mod0, const float* w_in, const bf16_t* H, const float* SMALLp, float* acc2) {
    __shared__ float red[256]; __shared__ float ys[1024];
    const int row = blockIdx.x * 61, tid = threadIdx.x; if (row >= M) return;
    const int b = row >= SEQ; const float* sh = mod0 + (size_t)b * 6 * D; const float* sc = sh + D;
    float s = 0.f; for (int k = tid; k < D; k += 256) { const float v = x[(size_t)row * D + k]; s += v * v; }
    red[tid] = s; __syncthreads();
    for (int s_ = 128; s_ > 0; s_ >>= 1) { if (tid < s_) red[tid] += red[tid + s_]; __syncthreads(); }
    const float rstd = 1.0f / sqrtf(red[0] / D + EPS); __syncthreads();
    float e = 0.f, r = 0.f;
    for (int k = tid; k < D; k += 256) { const float y = x[(size_t)row * D + k] * rstd * g1[k] * (1.0f + sc[k]) + sh[k]; ys[k] = y; const float g = bf1(H[(size_t)row * D + k]); e += (g - y) * (g - y); r += y * y; }
    atomicAdd(acc2 + 2, e); atomicAdd(acc2 + 3, r);
    __syncthreads();
    if (tid < 8) { float a = 0.f; for (int k = 0; k < D; ++k) a += ys[k] * w_in[(size_t)k * IN_COLS + 4096 + tid]; const float g = SMALLp[(size_t)row * 8 + tid]; atomicAdd(acc2 + 4, (g - a) * (g - a)); atomicAdd(acc2 + 5, a * a); }
}
__global__ void dbg_fill3(float* out, const float* acc2) {
    const size_t i = (size_t)blockIdx.x * blockDim.x + threadIdx.x; if (i >= (size_t)M * D) return;
    const float r0 = sqrtf(acc2[0] / fmaxf(acc2[1], 1e-30f)), r1 = sqrtf(acc2[2] / fmaxf(acc2[3], 1e-30f)), r2 = sqrtf(acc2[4] / fmaxf(acc2[5], 1e-30f));
    const float rel = DBG_G == 1 ? r0 : DBG_G == 2 ? r1 : DBG_G == 3 ? r2 : r0 + r1 + r2;
    out[i] = 1.0f + 9.0f * fminf(rel, 1.0f);
}
__global__ void dbg_fill2(float* out, const float* acc2) {
    const size_t i = (size_t)blockIdx.x * blockDim.x + threadIdx.x; if (i >= (size_t)M * D) return;
    const float rel = sqrtf(acc2[0] / fmaxf(acc2[1], 1e-30f));
    out[i] = 1.0f + 9.0f * fminf(rel, 1.0f);
}
__global__ void dbg_fill(float* out, const unsigned* counter, float denom) {
    const size_t i = (size_t)blockIdx.x * blockDim.x + threadIdx.x; if (i >= (size_t)M * D) return;
    out[i] = 1.0f + 9.0f * ((float)counter[0] / denom);
}
#endif
typedef void (*kfun_t)(Args);
static kfun_t kfun(int p) {
#ifdef ONLY_MASK
    return trunk_fwd<ONLY_MASK>;
#endif
    const int b = p < 2 ? p : 2 + (p - 2) % NSLOT;
    switch (b) {
        case 0: return trunk_fwd<0x001>; case 1: return trunk_fwd<0x002>; case 2: return trunk_fwd<0x004>; case 3: return trunk_fwd<0x008>;
        case 4: return trunk_fwd<0x010>; case 5: return trunk_fwd<0x020>; case 6: return trunk_fwd<0x040>; case 7: return trunk_fwd<0x080>;
        case 8: return trunk_fwd<0x100>; case 9: return trunk_fwd<0x200>; case 10: return trunk_fwd<0x400>; case 11: return trunk_fwd<0x800>; case 12: return trunk_fwd<0x1000>; default: return trunk_fwd<0x2000>;
    }
}
extern "C" void kernel_launch(void* const* d_in, const int* in_sizes, int n_in, void* d_out, int out_size, void* d_ws, size_t ws_size, hipStream_t stream) {
    static int grid = 0;
    if (grid == 0) {
        if (n_in != 21 || out_size != M * D || ws_size < WS_END) { fprintf(stderr, "kernel_launch: unexpected problem (n_in %d, out %d, ws %zu); nothing launched\n", n_in, out_size, ws_size); grid = -1; return; }
        int dev = 0, cus = 0;
        if (hipGetDevice(&dev) != hipSuccess || hipDeviceGetAttribute(&cus, hipDeviceAttributeMultiprocessorCount, dev) != hipSuccess) { grid = -1; return; }
#if MK_SINGLE
#ifndef ONLY_MASK
        if (hipFuncSetAttribute((const void*)trunk_fwd<PH_ALL>, hipFuncAttributeMaxDynamicSharedMemorySize, LDS_BYTES) != hipSuccess) { fprintf(stderr, "kernel_launch: hipFuncSetAttribute failed\n"); grid = -1; return; }
#endif
#else
        for (int p = 0; p < 2 + NSLOT; ++p) if (hipFuncSetAttribute((const void*)kfun(p), hipFuncAttributeMaxDynamicSharedMemorySize, LDS_BYTES) != hipSuccess) { fprintf(stderr, "kernel_launch: hipFuncSetAttribute failed\n"); grid = -1; return; }
#endif
        (void)hipGetLastError();
        grid = cus;
        if (MK_SINGLE && grid != 256) { fprintf(stderr, "kernel_launch: built for 256 CUs, device has %d\n", cus); grid = -1; return; }
    }
    if (grid < 0) return;
    Args a{};
    for (int i = 0; i < 21; ++i) a.in[i] = (const float*)d_in[i];
    a.out = (float*)d_out; a.ws = (unsigned char*)d_ws;
#if MK_SINGLE
    (void)hipMemsetAsync((char*)d_ws + WS_CTL, 0, CTL_ZERO_BYTES, stream);
    a.ph_lo = 0; a.ph_hi = NPHASE;
#ifndef ONLY_MASK
    hipLaunchKernelGGL(trunk_fwd<PH_ALL>, dim3(grid), dim3(NTHR), LDS_BYTES, stream, a);
#ifdef DUMP_OFF
    hipLaunchKernelGGL(dbg_dump, dim3((M * D + 255) / 256), dim3(256), 0, stream, (float*)d_out, (const unsigned short*)((unsigned char*)d_ws + (size_t)(DUMP_OFF)), (size_t)(DUMP_BYTES) / 2, (const unsigned short*)nullptr, (size_t)0, (const float*)nullptr);
#endif
#else
    hipLaunchKernelGGL(kfun(0), dim3(grid), dim3(NTHR), LDS_BYTES, stream, a);
#endif
#else
#if DBG_STOP
    for (int p = 0; p < DBG_STOP; ++p) { a.ph_lo = p; a.ph_hi = p + 1; hipLaunchKernelGGL(kfun(p), dim3(grid), dim3(NTHR), LDS_BYTES, stream, a); }
    { const unsigned short* A_ = nullptr; size_t na = 0; const unsigned short* B_ = nullptr; size_t nb = 0; const float* xf = nullptr; unsigned char* w = (unsigned char*)d_ws;
      const int last = DBG_STOP - 1, j = last < 2 ? last : 2 + (last - 2) % 10;
      switch (j) {
        case 0: A_ = (const unsigned short*)(w + WS_MOD); na = (size_t)DEPTH * BATCH * 6 * D * 2; B_ = (const unsigned short*)(w + WS_WIN); nb = (size_t)41 * MiB / 2; break;
        case 1: A_ = (const unsigned short*)(w + WS_H); na = (size_t)M * D; B_ = (const unsigned short*)(w + WS_SMALL); nb = (size_t)M * 8 * 2; break;
        case 2: A_ = (const unsigned short*)(w + WS_PROJ); na = (size_t)M * NPROJ; break;
        case 3: A_ = (const unsigned short*)(w + WS_MT); na = (size_t)160 * MiB / 2; B_ = (const unsigned short*)(w + WS_DL); nb = (size_t)512 * 1024 / 2; break;
        case 4: A_ = (const unsigned short*)(w + WS_SS); na = (size_t)64 * MiB / 2; break;
        case 5: A_ = (const unsigned short*)(w + WS_Y); na = (size_t)M * D; break;
        case 6: A_ = (const unsigned short*)(w + WS_MERGED); na = (size_t)M * D; break;
        case 7: xf = (const float*)d_out; A_ = (const unsigned short*)(w + WS_UV); na = (size_t)64 * MiB / 2; break;
        case 8: A_ = (const unsigned short*)(w + WS_H); na = (size_t)M * D; break;
        case 9: A_ = (const unsigned short*)(w + WS_PROJ); na = (size_t)M * NQ; break;
        case 10: A_ = (const unsigned short*)(w + WS_ROUTE); na = (size_t)16 * MiB / 2; break;
        default:
#if DBG_SEL == 0
            xf = (const float*)d_out;
#elif DBG_SEL == 1
            A_ = (const unsigned short*)(w + WS_H); na = (size_t)M * D;
#else
            A_ = (const unsigned short*)(w + WS_SMALL); na = (size_t)M * 8 * 2;
#endif
            break;
      }
#if DBG_SEL == 3
      A_ = nullptr; B_ = nullptr; na = nb = 0; xf = (const float*)d_out;
#endif
#ifndef DBG_T0
#define DBG_T0 8192
#endif
#if DBG_SEL == 15
      (void)hipMemsetAsync((char*)d_ws + WS_CTL, 0, 256, stream);
      hipLaunchKernelGGL(dbg_mod_check, dim3((DEPTH * BATCH * 6 * D + 255) / 256), dim3(256), 0, stream, (const float*)d_in[I_C], (const float*)d_in[I_ADAW], (const float*)d_in[I_ADAB], (const float*)(w + WS_MOD), (float*)(w + WS_CTL));
      hipLaunchKernelGGL(dbg_row_check, dim3(269), dim3(256), 0, stream, (const float*)d_in[I_X], (const float*)d_in[I_N1G], (const float*)(w + WS_MOD), (const float*)d_in[I_WIN], (const bf16_t*)(w + WS_H), (const float*)(w + WS_SMALL), (float*)(w + WS_CTL));
      hipLaunchKernelGGL(dbg_fill3, dim3((M * D + 255) / 256), dim3(256), 0, stream, (float*)d_out, (const float*)(w + WS_CTL));
#elif DBG_SEL == 14
      (void)hipMemsetAsync((char*)d_ws + WS_CTL, 0, 256, stream);
      { const int last_ = DBG_STOP - 1, j_ = last_ < 2 ? last_ : 2 + (last_ - 2) % 10, lay = (DBG_STOP > 12) ? 1 : 0;
        if (j_ == 2) hipLaunchKernelGGL(dbg_gemm_check, dim3(269), dim3(256), 0, stream, (const bf16_t*)(w + WS_H), D, D, (const float*)d_in[I_WIN] + (size_t)lay * D * IN_COLS, IN_COLS, NPROJ, 4096, 8, (const bf16_t*)(w + WS_PROJ), NPROJ, (float*)(w + WS_CTL));
        else if (j_ == 9) hipLaunchKernelGGL(dbg_gemm_check, dim3(269), dim3(256), 0, stream, (const bf16_t*)(w + WS_H), D, D, (const float*)d_in[I_WQ] + (size_t)lay * D * NQ, NQ, NQ, 1 << 30, 0, (const bf16_t*)(w + WS_PROJ), NQ, (float*)(w + WS_CTL)); }
      hipLaunchKernelGGL(dbg_fill2, dim3((M * D + 255) / 256), dim3(256), 0, stream, (float*)d_out, (const float*)(w + WS_CTL));
#elif DBG_SEL == 11 || DBG_SEL == 12
      (void)hipMemsetAsync((char*)d_ws + WS_CTL, 0, 256, stream);
      hipFuncSetAttribute((const void*)dbg_mixer_check, hipFuncAttributeMaxDynamicSharedMemorySize, (512 + 128 * 128) * 4);
      { const int lay = (DBG_STOP > 12) ? 1 : 0;
      hipLaunchKernelGGL(dbg_mixer_check, dim3(16), dim3(128), (512 + 128 * 128) * 4, stream, (const bf16_t*)(w + WS_PROJ), (const float*)(w + (lay ? WS_SMALL1 : WS_SMALL)), (const float*)d_in[I_CONVW] + lay * 4 * 1536, (const float*)d_in[I_ALOG] + lay * 4, (const float*)d_in[I_DTB] + lay * 4,
                         (const float*)d_in[I_HGNG] + lay * 128, (const float*)d_in[I_GDNNG] + lay * 128, (const bf16_t*)(w + WS_Y), (float*)(w + WS_CTL), DBG_T0, (const float*)d_in[I_LBL], lay); }
      hipLaunchKernelGGL(dbg_fill2, dim3((M * D + 255) / 256), dim3(256), 0, stream, (float*)d_out, (const float*)(w + WS_CTL) + (DBG_SEL == 12 ? 2 : 0));
#elif DBG_SEL == 10
      (void)hipMemsetAsync((char*)d_ws + WS_CTL, 0, 256, stream);
      hipLaunchKernelGGL(dbg_gather_check, dim3(256), dim3(256), 0, stream, (const bf16_t*)(w + WS_H), (const u32x2*)(w + WS_ROUTE), (const bf16_t*)(w + WS_UV), (const bf16_t*)(w + WS_UV) + (size_t)NEXP * D, (const float*)(w + WS_PROJ + 64 * MiB), (float*)(w + WS_CTL));
      hipLaunchKernelGGL(dbg_fill2, dim3((M * D + 255) / 256), dim3(256), 0, stream, (float*)d_out, (const float*)(w + WS_CTL));
#elif DBG_SEL == 9
      (void)hipMemsetAsync((char*)d_ws + WS_CTL, 0, 256, stream);
      hipFuncSetAttribute((const void*)dbg_route_check, hipFuncAttributeMaxDynamicSharedMemorySize, 64 * 400 * 4);
      hipLaunchKernelGGL(dbg_route_check, dim3(256), dim3(64), 64 * 400 * 4, stream, (const bf16_t*)(w + WS_PROJ), (const bf16_t*)(w + WS_SK), (const u32x2*)(w + WS_ROUTE), (unsigned*)(w + WS_CTL));
      hipLaunchKernelGGL(dbg_fill, dim3((M * D + 255) / 256), dim3(256), 0, stream, (float*)d_out, (const unsigned*)(w + WS_CTL), 16384.0f * 16.0f);
#else
      hipLaunchKernelGGL(dbg_dump, dim3((M * D + 255) / 256), dim3(256), 0, stream, (float*)d_out, A_, na, B_, nb, xf);
#endif
    }
#else
    for (int p = 0; p < NPHASE; ++p) { a.ph_lo = p; a.ph_hi = p + 1; hipLaunchKernelGGL(kfun(p), dim3(grid), dim3(NTHR), LDS_BYTES, stream, a); }
#endif
#endif
}
```

```cpp
#include <hip/hip_runtime.h>
#include <cstdio>
#include <cstdint>

#define DI __device__ __forceinline__
#define LAS __attribute__((address_space(3)))
#define GAS __attribute__((address_space(1)))
typedef unsigned short bf16_t;
typedef short bf16x8 __attribute__((ext_vector_type(8)));
typedef short s16x4 __attribute__((ext_vector_type(4)));
typedef float f32x2 __attribute__((ext_vector_type(2)));
typedef float f32x4 __attribute__((ext_vector_type(4)));
typedef float f32x16 __attribute__((ext_vector_type(16)));
typedef unsigned u32x2 __attribute__((ext_vector_type(2)));
typedef unsigned u32x4 __attribute__((ext_vector_type(4)));
typedef __bf16 bf16x2_t __attribute__((ext_vector_type(2)));
typedef LAS unsigned char* lptr;

constexpr int BATCH = 2, SEQ = 8192, D = 1024, M = BATCH * SEQ, DEPTH = 2;
constexpr int NPROJ = 6144;
constexpr int IN_COLS = 6152;
constexpr int NCHUNK = SEQ / 64;
constexpr int NQ = 2048;
constexpr int NEXP = 16384;
constexpr float EPS = 1e-6f;
constexpr int PC_HQ = 0, PC_HF = 512, PC_HI = 1024, PC_HG = 1536, PC_QKV = 2048, PC_GG = 3584, PC_GATE = 4096;

constexpr size_t MiB = 1u << 20;
constexpr size_t WS_CTL = 0, CTL_ZERO_BYTES = 256 * 1024;
constexpr size_t WS_MOD = 1 * MiB;
constexpr size_t WS_SMALL = WS_MOD + 512 * 1024;
constexpr size_t WS_SMALL1 = 512 * 1024;
constexpr size_t WS_WIN = 2 * MiB;
constexpr size_t WS_WBR = 26 * MiB;
constexpr size_t WS_WOUT = 30 * MiB;
constexpr size_t WS_WQ = 34 * MiB;
constexpr size_t WS_SK = 42 * MiB;
constexpr size_t WS_PROJ = 43 * MiB;
constexpr size_t WS_Y = 235 * MiB;
constexpr size_t WS_SCR = 267 * MiB;
constexpr size_t WS_UV = WS_SCR;
constexpr size_t WS_H = WS_SCR + 64 * MiB;
constexpr size_t WS_MERGED = WS_SCR + 96 * MiB;
constexpr size_t WS_ROUTE = WS_SCR + 128 * MiB;
constexpr size_t WS_ACT = WS_SCR + 144 * MiB;
constexpr size_t WS_MT = WS_SCR;
constexpr size_t WS_NN = WS_SCR + 32 * MiB;
constexpr size_t WS_QT = WS_SCR + 96 * MiB;
constexpr size_t WS_OP = WS_SCR + 128 * MiB;
constexpr size_t WS_SS = WS_SCR + 160 * MiB;
constexpr size_t WS_DL = WS_SCR + 224 * MiB;
constexpr size_t WS_U6 = 492 * MiB;
constexpr size_t WS_END = 512 * MiB;
static_assert(WS_DL + 1 * MiB <= WS_END && WS_ROUTE + 16 * MiB <= WS_END, "ws map");

constexpr int LDS_SCRATCH = 147456;
constexpr int LDS_CTL_OFF = LDS_SCRATCH;
constexpr int LDS_BYTES = LDS_SCRATCH + 1024;
constexpr int NWAVES = 8, NTHR = 512;

DI unsigned pk2(float lo, float hi) { f32x2 v = {lo, hi}; bf16x2_t b = __builtin_convertvector(v, bf16x2_t); return __builtin_bit_cast(unsigned, b); }
DI float bf_lo(unsigned u) { return __uint_as_float(u << 16); }
DI float bf_hi(unsigned u) { return __uint_as_float(u & 0xffff0000u); }
DI float bf1(bf16_t u) { return __uint_as_float(((unsigned)u) << 16); }
DI bf16_t f2bf(float f) { return (bf16_t)(pk2(f, 0.f) & 0xffffu); }
DI float sigmoidf_(float x) { return __builtin_amdgcn_rcpf(1.0f + __expf(-x)); }
DI float siluf_(float x) { return x * __builtin_amdgcn_rcpf(1.0f + __expf(-x)); }
template <int MSK> DI float shx(float v, int lane) {
    if constexpr (MSK < 32) return __int_as_float(__builtin_amdgcn_ds_swizzle(__float_as_int(v), (MSK << 10) | 0x1f));
    else return __int_as_float(__builtin_amdgcn_ds_bpermute((lane ^ 32) << 2, __float_as_int(v)));
}
#ifndef WSUM_DPP
#define WSUM_DPP 0
#endif
template <int CTRL> DI float dpp_f(float v) { return __int_as_float(__builtin_amdgcn_update_dpp(0, __float_as_int(v), CTRL, 0xf, 0xf, false)); }
DI float wave_sum(float v, int lane) {
#if WSUM_DPP
    v += dpp_f<0xB1>(v); v += dpp_f<0x4E>(v); v += dpp_f<0x124>(v); v += dpp_f<0x128>(v); v += shx<16>(v, lane); v += shx<32>(v, lane);
#else
    v += shx<1>(v, lane); v += shx<2>(v, lane); v += shx<4>(v, lane); v += shx<8>(v, lane); v += shx<16>(v, lane); v += shx<32>(v, lane);
#endif
    return v;
}
#define LDS_WAIT() asm volatile("s_waitcnt lgkmcnt(0)" ::: "memory")
#define VM_WAIT() asm volatile("s_waitcnt vmcnt(0)" ::: "memory")
#define MFMA32(a, b, c) __builtin_amdgcn_mfma_f32_32x32x16_bf16((a), (b), (c), 0, 0, 0)
DI int crow(int i, int h) { return (i & 3) + 8 * (i >> 2) + 4 * h; }
DI f32x16 zero16() { f32x16 z;
#pragma unroll
    for (int i = 0; i < 16; ++i) z[i] = 0.f; return z; }

DI bf16x8 fragK(lptr base, int ldb, int row0, int k0, int lane) {
    return *(const LAS bf16x8*)(base + (row0 + (lane & 31)) * ldb + (k0 + 8 * (lane >> 5)) * 2);
}
typedef short v4i16_t __attribute__((ext_vector_type(4)));
DI bf16x8 fragT(lptr base, int ldb, int k0, int n0, int lane) {
    const int h = lane >> 5, blk = (lane >> 4) & 1, q = (lane & 15) >> 2, p = lane & 3;
    lptr a = base + (k0 + 8 * h + q) * ldb + (n0 + 16 * blk) * 2 + 8 * p;
    const v4i16_t lo = __builtin_amdgcn_ds_read_tr16_b64_v4i16((LAS v4i16_t*)a);
    const v4i16_t hi = __builtin_amdgcn_ds_read_tr16_b64_v4i16((LAS v4i16_t*)(a + 4 * ldb));
    return (bf16x8){lo[0], lo[1], lo[2], lo[3], hi[0], hi[1], hi[2], hi[3]};
}
DI void storeT_bf16(const f32x16& c, lptr base, int ldb, int col0, int row0, int lane) {
    lptr p = base + (col0 + (lane & 31)) * ldb + (row0 + 4 * (lane >> 5)) * 2;
#pragma unroll
    for (int g = 0; g < 4; ++g) { u32x2 v; v.x = pk2(c[4 * g], c[4 * g + 1]); v.y = pk2(c[4 * g + 2], c[4 * g + 3]); *(LAS u32x2*)(p + 16 * g) = v; }
}
DI void pack_tile(const f32x16& c, u32x4& lo, u32x4& hi) {
    lo.x = pk2(c[0], c[1]); lo.y = pk2(c[2], c[3]); lo.z = pk2(c[4], c[5]); lo.w = pk2(c[6], c[7]);
    hi.x = pk2(c[8], c[9]); hi.y = pk2(c[10], c[11]); hi.z = pk2(c[12], c[13]); hi.w = pk2(c[14], c[15]);
}
DI f32x16 unpack_tile(const u32x4& lo, const u32x4& hi) {
    f32x16 c;
    c[0] = bf_lo(lo.x); c[1] = bf_hi(lo.x); c[2] = bf_lo(lo.y); c[3] = bf_hi(lo.y); c[4] = bf_lo(lo.z); c[5] = bf_hi(lo.z); c[6] = bf_lo(lo.w); c[7] = bf_hi(lo.w);
    c[8] = bf_lo(hi.x); c[9] = bf_hi(hi.x); c[10] = bf_lo(hi.y); c[11] = bf_hi(hi.y); c[12] = bf_lo(hi.z); c[13] = bf_hi(hi.z); c[14] = bf_lo(hi.w); c[15] = bf_hi(hi.w);
    return c;
}
#ifndef WT_ALL
#define WT_ALL 1
#endif
DI void st16_wt(void* p, const u32x4 v) {
#if WT_ALL
#ifdef WT_NT
    asm volatile("global_store_dwordx4 %0, %1, off sc0 sc1 nt\n\ts_nop 1" :: "v"(p), "v"(v) : "memory");
#else
    asm volatile("global_store_dwordx4 %0, %1, off sc0 sc1\n\ts_nop 1" :: "v"(p), "v"(v) : "memory");
#endif
#else
    *(u32x4*)p = v;
#endif
}
DI void st16f_wt(void* p, const f32x4 v) { st16_wt(p, __builtin_bit_cast(u32x4, v)); }
DI void st8_wt(void* p, const u32x2 v) {
#if WT_ALL
    asm volatile("global_store_dwordx2 %0, %1, off sc0 sc1" :: "v"(p), "v"(v) : "memory");
#else
    *(u32x2*)p = v;
#endif
}
#ifndef WT_TILE
#define WT_TILE 0
#endif
#ifndef WT_CHAIN
#define WT_CHAIN 0
#endif
DI void gstore_tile(unsigned char* tb, int lane, const f32x16& c) { u32x4 lo, hi; pack_tile(c, lo, hi); unsigned char* p = tb + lane * 32;
    if (WT_TILE == 2) { __builtin_nontemporal_store(lo, (u32x4*)p); __builtin_nontemporal_store(hi, (u32x4*)(p + 16)); }
    else if (WT_TILE) { st16_wt(p, lo); st16_wt(p + 16, hi); } else { *(u32x4*)p = lo; *(u32x4*)(p + 16) = hi; } }
DI void gload_tile(const unsigned char* tb, int lane, u32x4& lo, u32x4& hi) { const u32x4* p = (const u32x4*)(tb + lane * 32); lo = p[0]; hi = p[1]; }
#define AS_BF8(v) __builtin_bit_cast(bf16x8, (v))
#define MK_SINGLE 1
#define DBG_STOP 0
#define DBG_SEL 0
#define DBG_G 0
#define DBG_NOMIX 0
#define REP_MASK 0
#define NREPA 1

namespace pg8 {
constexpr int BM = 256, BK = 64, HALF = 128, HTB = HALF * BK * 2, STAGE_BYTES = 8 * HTB, NXCD = 8, WGM = 8;
__host__ __device__ __forceinline__ int lds_byte(int r, int c) { const int st = (r >> 4) * 2 + (c >> 5), rr = r & 15, cc = c & 31, ob = rr * 64 + cc * 2; return st * 1024 + (ob ^ (((ob >> 9) & 1) << 5)); }
__host__ __device__ __forceinline__ void stage_rc(int b, int& R, int& C) { const int st = b / 1024, sb = b % 1024, swz = sb ^ (((sb >> 9) & 1) << 5); R = (st >> 1) * 16 + swz / 64; C = (st & 1) * 32 + (swz % 64) / 2; }
__host__ __device__ __forceinline__ int perm32(int rho) { const int n = rho >> 4, i = rho & 15; return 8 * (i >> 2) + 4 * n + (i & 3); }

typedef int i32x4_t __attribute__((ext_vector_type(4)));
template <bool I8> __device__ __forceinline__ f32x4 mma16(const bf16x8 b, const bf16x8 a, const f32x4 c) {
    if constexpr (I8) return __builtin_bit_cast(f32x4, __builtin_amdgcn_mfma_i32_16x16x64_i8(__builtin_bit_cast(i32x4_t, b), __builtin_bit_cast(i32x4_t, a), __builtin_bit_cast(i32x4_t, c), 0, 0, 0));
    else return __builtin_amdgcn_mfma_f32_16x16x32_bf16(b, a, c, 0, 0, 0);
}
struct Unit { int pm, pn, pass; };
struct Gemm { const bf16_t* A; const bf16_t* Bt; int M, N, K, lda, ldb; size_t passA, passB; };

struct StaticOrder {
    int nM, nN, nwg, G, c;
    __host__ __device__ void init(int M_, int N_, int G_, int c_) { nM = M_ / BM; nN = N_ / BM; nwg = nM * nN; G = G_; c = c_; }
    __host__ __device__ bool next(int i, Unit& u) const {
        const long L = (long)i * G + c; if (L >= nwg) return false;
        int wgid = (int)L; { const int q = nwg / NXCD, r = nwg % NXCD, xcd = wgid % NXCD, off = wgid / NXCD; wgid = (xcd < r ? xcd * (q + 1) : r * (q + 1) + (xcd - r) * q) + off; }
        const int nig = WGM * nN, gid = wgid / nig, fm = gid * WGM, gsz = (nM - fm) < WGM ? (nM - fm) : WGM;
        u.pm = fm + ((wgid % nig) % gsz); u.pn = (wgid % nig) / gsz; u.pass = 0; return true;
    }
};
struct TwoPassOrder {
    StaticOrder S;
    __host__ __device__ bool next(int i, Unit& u) const { if (!S.next(i >> 1, u)) return false; u.pass = i & 1; return true; }
};

#ifndef EPI_WT
#define EPI_WT 1
#endif
#define ST16(bit_, p_, v_) do { if ((EPI_WT >> (bit_)) & 1) st16_wt(p_, v_); else *(u32x4*)(p_) = (v_); } while (0)
struct EpiBf16 {
    static constexpr bool PERM = true;
    bf16_t* O; int ldc;
    __device__ __forceinline__ void operator()(const f32x4 (&acc)[2][2][4][2], const Unit& u, int wr, int wc, int fr, int fq) const {
        const int row0 = u.pm * BM + wr * 64 + fr; const int col0 = u.pn * BM + wc * 32 + 8 * fq;
#pragma unroll
        for (int ai = 0; ai < 2; ++ai)
#pragma unroll
            for (int m = 0; m < 4; ++m) { bf16_t* rowp = O + (size_t)(row0 + ai * HALF + m * 16) * ldc + col0;
#pragma unroll
                for (int bj = 0; bj < 2; ++bj) { const f32x4 v0 = acc[ai][bj][m][0], v1 = acc[ai][bj][m][1];
                    u32x4 w; w.x = pk2(v0[0], v0[1]); w.y = pk2(v0[2], v0[3]); w.z = pk2(v1[0], v1[1]); w.w = pk2(v1[2], v1[3]);
                    ST16(0, rowp + bj * HALF, w); } }
    }
};
struct EpiQ8 {
    static constexpr bool PERM = true;
    bf16_t* O; int ldc; const float* rs; const float* cs;
    __device__ __forceinline__ void operator()(const f32x4 (&acc)[2][2][4][2], const Unit& u, int wr, int wc, int fr, int fq) const {
        const int row0 = u.pm * BM + wr * 64 + fr; const int col0 = u.pn * BM + wc * 32 + 8 * fq;
        f32x4 cv[2][2];
#pragma unroll
        for (int bj = 0; bj < 2; ++bj) { cv[bj][0] = *(const f32x4*)(cs + col0 + bj * HALF); cv[bj][1] = *(const f32x4*)(cs + col0 + bj * HALF + 4); }
#pragma unroll
        for (int ai = 0; ai < 2; ++ai)
#pragma unroll
            for (int m = 0; m < 4; ++m) { const int row = row0 + ai * HALF + m * 16; const float r = rs[row]; bf16_t* rowp = O + (size_t)row * ldc + col0;
#pragma unroll
                for (int bj = 0; bj < 2; ++bj) { const i32x4_t a0 = __builtin_bit_cast(i32x4_t, acc[ai][bj][m][0]), a1 = __builtin_bit_cast(i32x4_t, acc[ai][bj][m][1]);
                    const f32x4 v0 = (f32x4){(float)a0[0], (float)a0[1], (float)a0[2], (float)a0[3]} * cv[bj][0] * r, v1 = (f32x4){(float)a1[0], (float)a1[1], (float)a1[2], (float)a1[3]} * cv[bj][1] * r;
                    u32x4 w; w.x = pk2(v0[0], v0[1]); w.y = pk2(v0[2], v0[3]); w.z = pk2(v1[0], v1[1]); w.w = pk2(v1[2], v1[3]);
                    ST16(0, rowp + bj * HALF, w); } }
    }
};
struct EpiGate {
    static constexpr bool PERM = true;
    bf16_t* O; int ldc; const bf16_t* G; int ldg; int goff;
    __device__ __forceinline__ void operator()(const f32x4 (&acc)[2][2][4][2], const Unit& u, int wr, int wc, int fr, int fq) const {
        const int row0 = u.pm * BM + wr * 64 + fr; const int col0 = u.pn * BM + wc * 32 + 8 * fq; const int gofs = goff + u.pass * ldc; const bool add = u.pass != 0;
#pragma unroll
        for (int ai = 0; ai < 2; ++ai)
#pragma unroll
            for (int m = 0; m < 4; ++m) { const size_t row = (size_t)(row0 + ai * HALF + m * 16);
#pragma unroll
                for (int bj = 0; bj < 2; ++bj) { const f32x4 v0 = acc[ai][bj][m][0], v1 = acc[ai][bj][m][1];
                    const u32x4 g = *(const u32x4*)(G + row * ldg + gofs + col0 + bj * HALF);
                    bf16_t* op = O + row * ldc + col0 + bj * HALF;
                    u32x4 p = (u32x4){0u, 0u, 0u, 0u}; if (add) p = *(const u32x4*)op;
                    float o[8];
                    o[0] = v0[0] * sigmoidf_(bf_lo(g.x)); o[1] = v0[1] * sigmoidf_(bf_hi(g.x)); o[2] = v0[2] * sigmoidf_(bf_lo(g.y)); o[3] = v0[3] * sigmoidf_(bf_hi(g.y));
                    o[4] = v1[0] * sigmoidf_(bf_lo(g.z)); o[5] = v1[1] * sigmoidf_(bf_hi(g.z)); o[6] = v1[2] * sigmoidf_(bf_lo(g.w)); o[7] = v1[3] * sigmoidf_(bf_hi(g.w));
                    o[0] += bf_lo(p.x); o[1] += bf_hi(p.x); o[2] += bf_lo(p.y); o[3] += bf_hi(p.y); o[4] += bf_lo(p.z); o[5] += bf_hi(p.z); o[6] += bf_lo(p.w); o[7] += bf_hi(p.w);
                    u32x4 w; w.x = pk2(o[0], o[1]); w.y = pk2(o[2], o[3]); w.z = pk2(o[4], o[5]); w.w = pk2(o[6], o[7]);
                    if (((EPI_WT >> 3) & 1) && add) st16_wt(op, w); else ST16(1, op, w); }
                if (m & 1) asm volatile("" ::: "memory"); }
    }
};
struct EpiResid {
    static constexpr bool PERM = false;
    const float* base; float* out; const float* gt;
    __device__ __forceinline__ void operator()(const f32x4 (&acc)[2][2][4][2], const Unit& u, int wr, int wc, int fr, int fq) const {
        const int col0 = u.pn * BM + wc * 32 + 4 * fq; const float* g = gt + (u.pm >= (SEQ / BM) ? 6 * D : 0);
        f32x4 gv[2][2];
#pragma unroll
        for (int bj = 0; bj < 2; ++bj)
#pragma unroll
            for (int n = 0; n < 2; ++n) { gv[bj][n] = *(const f32x4*)(g + col0 + bj * HALF + n * 16); if (DBG_NOMIX) gv[bj][n] = (f32x4){0.f, 0.f, 0.f, 0.f}; }
#pragma unroll
        for (int ai = 0; ai < 2; ++ai)
#pragma unroll
            for (int m = 0; m < 4; ++m) { const size_t off = (size_t)(u.pm * BM + ai * HALF + wr * 64 + m * 16 + fr) * D + col0;
#pragma unroll
                for (int bj = 0; bj < 2; ++bj)
#pragma unroll
                    for (int n = 0; n < 2; ++n) { const f32x4 bs = *(const f32x4*)(base + off + bj * HALF + n * 16);
                        const f32x4 r_ = bs + gv[bj][n] * acc[ai][bj][m][n]; ST16(2, out + off + bj * HALF + n * 16, __builtin_bit_cast(u32x4, r_)); }
                if (m & 1) asm volatile("" ::: "memory"); }
    }
};

template <class Epi, class Sched, bool I8 = false>
__device__ __forceinline__ void gemm_phase(lptr lds, const Gemm g, const Sched& S, const Epi& E, const int tid) {
    const int wid = __builtin_amdgcn_readfirstlane(tid >> 6), lane = tid & 63, wr = wid >> 2, wc = wid & 3, fr = lane & 15, fq = lane >> 4;
    const int K = g.K, nt = K / BK;
    unsigned voffA[2], voffB[2];
#pragma unroll
    for (int i = 0; i < 2; ++i) { int R, C; stage_rc(tid * 16 + i * 8192, R, C); const int Rb = Epi::PERM ? ((R & ~31) + perm32(R & 31)) : R;
        voffA[i] = (unsigned)(R * g.lda + C) * 2u; voffB[i] = (unsigned)(Rb * g.ldb + C) * 2u; }
    const size_t kstep = (size_t)(BK * 2);
    const size_t hstepA = (size_t)HALF * g.lda * 2, hstepB = (size_t)HALF * g.ldb * 2;
    const size_t tstepA = 2 * hstepA, tstepB = 2 * hstepB;
    const unsigned ldsw = (unsigned)wid * 1024u;
    const int aoff = lds_byte(wr * 64 + fr, fq * 8), boff = lds_byte(wc * 32 + fr, fq * 8);
#define PG8_SA(b, h) (((b) * 2 + (h)) * HTB)
#define PG8_SB(b, h) ((4 + (b) * 2 + (h)) * HTB)
#define PG8_STAGE(bufoff, gbase, voff) do { _Pragma("unroll") for (int _i = 0; _i < 2; ++_i) \
        __builtin_amdgcn_global_load_lds((const unsigned*)((const char*)(gbase) + (voff)[_i]), (LAS unsigned*)(lds + (bufoff) + ldsw + _i * 8192), 16, 0, 0); } while (0)
#define PG8_LDA(dst, b, h) do { _Pragma("unroll") for (int m = 0; m < 4; ++m) _Pragma("unroll") for (int k = 0; k < 2; ++k) dst[m][k] = *(const LAS bf16x8*)(lds + PG8_SA(b, h) + aoff + m * 2048 + k * 1024); } while (0)
#define PG8_LDB(dst, b, h) do { _Pragma("unroll") for (int n = 0; n < 2; ++n) _Pragma("unroll") for (int k = 0; k < 2; ++k) dst[n][k] = *(const LAS bf16x8*)(lds + PG8_SB(b, h) + boff + n * 2048 + k * 1024); } while (0)
#define PG8_MMA(ai, bj, At, Bt) do { __builtin_amdgcn_s_setprio(1); _Pragma("unroll") for (int m = 0; m < 4; ++m) _Pragma("unroll") for (int n = 0; n < 2; ++n) _Pragma("unroll") for (int k = 0; k < 2; ++k) \
        acc[ai][bj][m][n] = mma16<I8>(Bt[n][k], At[m][k], acc[ai][bj][m][n]); __builtin_amdgcn_s_setprio(0); } while (0)
#define PG8_WAIT_V(n) asm volatile("s_waitcnt vmcnt(" #n ")" ::: "memory")
#define PG8_WAIT_L(n) asm volatile("s_waitcnt lgkmcnt(" #n ")" ::: "memory")
#define PG8_BAR __builtin_amdgcn_s_barrier()
#define PG8_SCHED __builtin_amdgcn_sched_barrier(0)
    Unit cur, nxt; int ui = 0;
    if (!S.next(0, cur)) return;
    f32x4 acc[2][2][4][2];
#pragma unroll
    for (int a = 0; a < 2; ++a)
#pragma unroll
        for (int b = 0; b < 2; ++b)
#pragma unroll
            for (int m = 0; m < 4; ++m)
#pragma unroll
                for (int n = 0; n < 2; ++n) acc[a][b][m][n] = (f32x4){0.f, 0.f, 0.f, 0.f};
    bf16x8 At[4][2], B0[2][2], B1[2][2];
    const char* cA = (const char*)(g.A + cur.pass * g.passA) + (size_t)cur.pm * tstepA; const char* cB = (const char*)(g.Bt + cur.pass * g.passB) + (size_t)cur.pn * tstepB;
    PG8_STAGE(PG8_SB(0, 0), cB, voffB); PG8_STAGE(PG8_SB(0, 1), cB + hstepB, voffB); PG8_STAGE(PG8_SA(0, 0), cA, voffA); PG8_STAGE(PG8_SA(0, 1), cA + hstepA, voffA);
    if (wr == 1) PG8_BAR;
    PG8_WAIT_V(2); PG8_BAR;
    PG8_STAGE(PG8_SB(1, 0), cB + kstep, voffB); PG8_STAGE(PG8_SA(1, 0), cA + kstep, voffA); PG8_STAGE(PG8_SB(1, 1), cB + hstepB + kstep, voffB);
    PG8_WAIT_V(6); PG8_BAR;
    for (;;) {
        const bool has_next = S.next(ui + 1, nxt);
        const char* nA = has_next ? (const char*)(g.A + nxt.pass * g.passA) + (size_t)nxt.pm * tstepA : cA; const char* nB = has_next ? (const char*)(g.Bt + nxt.pass * g.passB) + (size_t)nxt.pn * tstepB : cB;
        for (int t = 0; t < nt; t += 2) {
            const bool last = (t == nt - 2);
            const char* a1 = cA + (size_t)(t + 1) * kstep;
            const char* a2 = last ? nA : cA + (size_t)(t + 2) * kstep; const char* b2 = last ? nB : cB + (size_t)(t + 2) * kstep;
            const char* a3 = a2 + kstep; const char* b3 = b2 + kstep;
            PG8_LDB(B0, 0, 0); PG8_LDB(B1, 0, 1); PG8_SCHED; PG8_LDA(At, 0, 0); PG8_STAGE(PG8_SA(1, 1), a1 + hstepA, voffA);
            PG8_WAIT_V(8); PG8_WAIT_L(0); PG8_BAR; PG8_MMA(0, 0, At, B0); PG8_MMA(0, 1, At, B1); PG8_BAR; PG8_SCHED;
            PG8_LDA(At, 0, 1); PG8_STAGE(PG8_SB(0, 0), b2, voffB); PG8_STAGE(PG8_SB(0, 1), b2 + hstepB, voffB); PG8_STAGE(PG8_SA(0, 0), a2, voffA);
            PG8_WAIT_V(8); PG8_WAIT_L(0); PG8_BAR; PG8_MMA(1, 0, At, B0); PG8_MMA(1, 1, At, B1); PG8_BAR; PG8_SCHED;
            PG8_LDB(B0, 1, 0); PG8_LDB(B1, 1, 1); PG8_SCHED; PG8_LDA(At, 1, 0); PG8_STAGE(PG8_SA(0, 1), a2 + hstepA, voffA);
            PG8_WAIT_V(8); PG8_WAIT_L(0); PG8_BAR; PG8_MMA(0, 0, At, B0); PG8_MMA(0, 1, At, B1); PG8_BAR; PG8_SCHED;
            PG8_LDA(At, 1, 1); PG8_STAGE(PG8_SB(1, 0), b3, voffB); PG8_STAGE(PG8_SB(1, 1), b3 + hstepB, voffB); PG8_STAGE(PG8_SA(1, 0), a3, voffA);
            PG8_WAIT_V(8); PG8_WAIT_L(0); PG8_BAR; PG8_MMA(1, 0, At, B0); PG8_MMA(1, 1, At, B1); PG8_BAR; PG8_SCHED;
        }
        if (wr == 0) PG8_BAR;
        E(acc, cur, wr, wc, fr, fq);
        if (!has_next) break;
#pragma unroll
        for (int a = 0; a < 2; ++a)
#pragma unroll
            for (int b = 0; b < 2; ++b)
#pragma unroll
                for (int m = 0; m < 4; ++m)
#pragma unroll
                    for (int n = 0; n < 2; ++n) acc[a][b][m][n] = (f32x4){0.f, 0.f, 0.f, 0.f};
        cur = nxt; cA = nA; cB = nB; ++ui;
        if (wr == 1) PG8_BAR;
    }
    PG8_WAIT_V(0);
    PG8_BAR;
#undef PG8_SA
#undef PG8_SB
#undef PG8_STAGE
#undef PG8_LDA
#undef PG8_LDB
#undef PG8_MMA
#undef PG8_WAIT_V
#undef PG8_WAIT_L
#undef PG8_BAR
#undef PG8_SCHED
}
}

#define XB_TMO      128
#define XB_XCNT(j)  (256  + 64 * (j))
#define XB_XSUB(j)  (1280 + 64 * (j))
#define XB_XGEN(j)  (2304 + 64 * (j))
#define XB_TOP      3328
#define XB_TOPGEN   3392
#define XCD_BAR_WORDS 3456
#define XB_SPIN_CAP (1u << 20)
DI unsigned xb_rfl(unsigned v) { return (unsigned)__builtin_amdgcn_readfirstlane((int)v); }
DI unsigned xb_ld(unsigned* p)              { return xb_rfl(__hip_atomic_load(p, __ATOMIC_RELAXED, __HIP_MEMORY_SCOPE_AGENT)); }
DI unsigned xb_add(unsigned* p, unsigned v) {
    unsigned old; unsigned long long sv;
    asm volatile("s_mov_b64 %1, exec\n\ts_mov_b64 exec, 1\n\tglobal_atomic_add %0, %2, %3, off sc0\n\ts_waitcnt vmcnt(0)\n\ts_mov_b64 exec, %1"
                 : "=&v"(old), "=&s"(sv) : "v"(p), "v"(v) : "memory");
    return xb_rfl(old);
}
DI unsigned xb_xcc_id() { return (unsigned)__builtin_amdgcn_s_getreg((3 << 11) | 20) & 0xFu; }
#ifndef XB_SLEEP
#define XB_SLEEP 1
#endif
#define XB_SPIN(cond, bar) do { unsigned _sp = 0; while (cond) { if (XB_SLEEP) __builtin_amdgcn_s_sleep(1); \
    if ((++_sp & 255u) == 0u) { if (xb_ld(&(bar)[XB_TMO])) break; if (_sp > XB_SPIN_CAP) { (void)xb_add(&(bar)[XB_TMO], 1u); break; } } } } while (0)
struct XcdBarrier { unsigned* bar; unsigned x; volatile LAS unsigned* st; };
DI void xcd_barrier_post(unsigned* bar, int wave_) {
    if (wave_ == 0) (void)xb_add(&bar[XB_XCNT(xb_xcc_id())], 1u);
}
DI void xcd_barrier_complete(unsigned* bar, unsigned x, unsigned& nloc, unsigned& nx) {
    const unsigned G = gridDim.x * gridDim.y * gridDim.z;
    unsigned sum, cnt, mine, sp = 0u;
    for (;;) {
        sum = 0u; cnt = 0u; mine = 0u;
#pragma unroll
        for (unsigned j = 0; j < 16; ++j) { const unsigned c = xb_ld(&bar[XB_XCNT(j)]); sum += c; cnt += (c > 0u) ? 1u : 0u; mine = (j == x) ? c : mine; }
        if (sum == G) break;
        __builtin_amdgcn_s_sleep(1);
        if ((++sp & 255u) == 0u) { if (xb_ld(&bar[XB_TMO])) break; if (sp > XB_SPIN_CAP) { (void)xb_add(&bar[XB_TMO], 1u); break; } }
    }
    nloc = mine > 0u ? mine : 1u; nx = cnt > 0u ? cnt : 1u;
}
DI void xcd_barrier(const XcdBarrier& b, const int wave_) {
    asm volatile("s_waitcnt vmcnt(0)" ::: "memory");
    __syncthreads();
    if (wave_ == 0) {
        unsigned* bar = b.bar;
        __builtin_amdgcn_s_waitcnt(0);
        unsigned nloc = xb_rfl(b.st[0]), nx = xb_rfl(b.st[1]);
        if (nloc == 0u) { xcd_barrier_complete(bar, b.x, nloc, nx); b.st[0] = nloc; b.st[1] = nx; }
        const unsigned old = xb_add(&bar[XB_XSUB(b.x)], 1u);
        const unsigned gen = old / nloc;
        if (old + 1u == (gen + 1u) * nloc) {
            __builtin_amdgcn_fence(__ATOMIC_RELEASE, "agent");
            asm volatile("s_waitcnt vmcnt(0)" ::: "memory");
            const unsigned og = xb_add(&bar[XB_TOP], 1u);
            const unsigned tg = og / nx;
            if (og + 1u == (tg + 1u) * nx) (void)xb_add(&bar[XB_TOPGEN], 1u);
            else XB_SPIN(xb_ld(&bar[XB_TOPGEN]) == tg, bar);
            __builtin_amdgcn_fence(__ATOMIC_ACQUIRE, "agent");
            asm volatile("s_waitcnt vmcnt(0)" ::: "memory");
        } else {
            XB_SPIN(xb_ld(&bar[XB_TOPGEN]) == gen, bar);
            __builtin_amdgcn_fence(__ATOMIC_ACQUIRE, "agent");
            asm volatile("s_waitcnt vmcnt(0)" ::: "memory");
        }
    }
    __syncthreads();
}

struct Args {
    const float* in[21]; float* out; unsigned char* ws; int ph_lo, ph_hi;
};
struct Frame {
    lptr lds;
    int tid, lane, wave, vcu, G;
    unsigned char* ws;
    const float* const* in;
};

DI void transpose_item(const float* W, int N, int src_col0, bf16_t* WT, int ldt, int dst_row0, int k0, LAS float* scr, int lane) {
    { const int c4 = lane & 7, r8 = lane >> 3; f32x4 t[8];
#pragma unroll
      for (int i = 0; i < 8; ++i) t[i] = *(const f32x4*)(W + (size_t)(k0 + 8 * i + r8) * N + src_col0 + 4 * c4);
#pragma unroll
      for (int i = 0; i < 8; ++i) { LAS float* d = scr + (8 * i + r8) * 33 + 4 * c4; d[0] = t[i].x; d[1] = t[i].y; d[2] = t[i].z; d[3] = t[i].w; } }
    LDS_WAIT(); asm volatile("" ::: "memory");
    const int c = lane & 7;
#pragma unroll
    for (int j = 0; j < 4; ++j) { const int n = (lane >> 3) + 8 * j; const LAS float* s = scr + (8 * c) * 33 + n;
        u32x4 o; o.x = pk2(s[0 * 33], s[1 * 33]); o.y = pk2(s[2 * 33], s[3 * 33]); o.z = pk2(s[4 * 33], s[5 * 33]); o.w = pk2(s[6 * 33], s[7 * 33]);
        *(u32x4*)(WT + (size_t)(dst_row0 + n) * ldt + k0 + 8 * c) = o; }
    LDS_WAIT(); asm volatile("" ::: "memory");
}
DI void cvt_stream(const float* src, bf16_t* dst, size_t n, int gw, int ngw, int lane) {
    const size_t n8 = n / 8;
    for (size_t i = (size_t)gw * 64 + lane; i < n8; i += (size_t)ngw * 64) {
        const f32x4 a = ((const f32x4*)src)[2 * i], b = ((const f32x4*)src)[2 * i + 1];
        u32x4 o; o.x = pk2(a[0], a[1]); o.y = pk2(a[2], a[3]); o.z = pk2(b[0], b[1]); o.w = pk2(b[2], b[3]);
        ((u32x4*)dst)[i] = o;
    }
}
DI void mod_item(const float* c, const float* ada_w, const float* ada_b, float* mod, int item, lptr lds, int tid) {
    const int l = item / 96, n0 = (item % 96) * 64;
    const int wave = tid >> 6, lane = tid & 63, cq = lane & 15, rsub = lane >> 4;
    LAS float* sc = (LAS float*)lds;
    LAS float* part = (LAS float*)(lds + 8192);
    for (int i = tid; i < 2 * D; i += NTHR) sc[i] = siluf_(c[i]);
    __syncthreads();
    const float* W = ada_w + (size_t)l * D * (6 * D) + n0 + 4 * cq;
    f32x4 a0 = {0.f, 0.f, 0.f, 0.f}, a1 = {0.f, 0.f, 0.f, 0.f};
#pragma unroll 8
    for (int i = 0; i < 32; ++i) { const int k = wave * 128 + i * 4 + rsub; const f32x4 w = *(const f32x4*)(W + (size_t)k * (6 * D));
        a0 += w * sc[k]; a1 += w * sc[D + k]; }
    LAS f32x4* pp = (LAS f32x4*)part;
    pp[((wave * 4 + rsub) * 2 + 0) * 16 + cq] = a0; pp[((wave * 4 + rsub) * 2 + 1) * 16 + cq] = a1;
    __syncthreads();
    if (tid < 128) { const int b = tid >> 6, col = tid & 63; float s = 0.f;
#pragma unroll
        for (int w = 0; w < 32; ++w) s += part[(w * 2 + b) * 64 + col];
        mod[((size_t)l * BATCH + b) * (6 * D) + n0 + col] = s + ada_b[(size_t)l * 6 * D + n0 + col]; }
    __syncthreads();
}

struct RowMod { f32x4 a[4], b[4]; };
DI void load_rowmod(RowMod& R, const float* g, const float* sc, const float* sh, int lane) {
#pragma unroll
    for (int j = 0; j < 4; ++j) { const f32x4 gv = ((const f32x4*)g)[lane + 64 * j], sv = ((const f32x4*)sc)[lane + 64 * j]; R.a[j] = gv * (sv + 1.0f); R.b[j] = ((const f32x4*)sh)[lane + 64 * j]; }
}
template <bool SIDE, bool H8 = false, bool HB = true> DI void row_finish(const f32x4 (&v)[4], const RowMod& R, bf16_t* hrow, float* small_row, const LAS float* wsm, int lane, unsigned* h8row = nullptr, float* hsp = nullptr) {
    float s = 0.f;
#pragma unroll
    for (int j = 0; j < 4; ++j) s += (v[j].x * v[j].x + v[j].y * v[j].y) + (v[j].z * v[j].z + v[j].w * v[j].w);
    const float rstd = 1.0f / sqrtf(wave_sum(s, lane) * (1.0f / D) + EPS);
    f32x4 y[4];
#pragma unroll
    for (int j = 0; j < 4; ++j) { y[j] = v[j] * rstd * R.a[j] + R.b[j];
        if (HB) { u32x2 o; o.x = pk2(y[j].x, y[j].y); o.y = pk2(y[j].z, y[j].w); ((u32x2*)hrow)[lane + 64 * j] = o; } }
    if (H8) {
        float am = 0.f;
#pragma unroll
        for (int j = 0; j < 4; ++j) am = fmaxf(fmaxf(am, fmaxf(fabsf(y[j].x), fabsf(y[j].y))), fmaxf(fabsf(y[j].z), fabsf(y[j].w)));
        am = fmaxf(am, shx<1>(am, lane)); am = fmaxf(am, shx<2>(am, lane)); am = fmaxf(am, shx<4>(am, lane)); am = fmaxf(am, shx<8>(am, lane)); am = fmaxf(am, shx<16>(am, lane)); am = fmaxf(am, shx<32>(am, lane));
        am = fmaxf(am, 1e-20f);
        const float sc = 127.0f / am;
#pragma unroll
        for (int j = 0; j < 4; ++j) {
            const int q0 = (int)__builtin_rintf(y[j].x * sc), q1 = (int)__builtin_rintf(y[j].y * sc), q2 = (int)__builtin_rintf(y[j].z * sc), q3 = (int)__builtin_rintf(y[j].w * sc);
            h8row[lane + 64 * j] = (unsigned)(q0 & 0xff) | ((unsigned)(q1 & 0xff) << 8) | ((unsigned)(q2 & 0xff) << 16) | ((unsigned)q3 << 24); }
        if (lane == 0) *hsp = am * (1.0f / 127.0f);
    }
    if (SIDE) {
        float p[8];
#pragma unroll
        for (int c = 0; c < 8; ++c) { float a = 0.f;
#pragma unroll
            for (int j = 0; j < 4; ++j) { const f32x4 w = ((const LAS f32x4*)(wsm + c * D))[lane + 64 * j]; a += (y[j].x * w.x + y[j].y * w.y) + (y[j].z * w.z + y[j].w * w.w); }
            p[c] = wave_sum(a, lane);
            if (c & 1) __builtin_amdgcn_sched_barrier(0); }
        if (lane < 8) { float r = p[0];
#pragma unroll
            for (int c = 1; c < 8; ++c) r = (lane == c) ? p[c] : r;
            small_row[lane] = r; }
    }
}
DI void stage_wsmall(const float* w_in_l, LAS float* wsm, int tid) {
    for (int i = tid; i < 8 * D; i += NTHR) { const int k = i >> 3, c = i & 7; wsm[c * D + k] = w_in_l[(size_t)k * IN_COLS + 4096 + c]; }
    __syncthreads();
}

#ifndef CHAIN_OWN
#define CHAIN_OWN 1
#endif
#define WG_BAR() do { asm volatile("s_waitcnt lgkmcnt(0)" ::: "memory"); __builtin_amdgcn_s_barrier(); asm volatile("" ::: "memory"); } while (0)
constexpr int TILE_B = 2048;
constexpr int LDA_ = 272, LDT_ = 144;

struct MixP {
    const bf16_t* PROJ; const float* SMALL; const float* convw; const float* alog; const float* dtb; const float* lbl; int l;
    unsigned char* MT; unsigned char* NN; unsigned char* QT; unsigned char* OP; unsigned char* SS; float* DL;
};

DI void passA_gdn(lptr L, int tid_in, const MixP& P, int bh, int c) {
    int tid = tid_in; asm volatile("" : "+v"(tid));
    constexpr int R_KN = 0, R_QN = 18432, R_QE = 36864, R_VB = 54272, R_KBE = 71680, R_KD = 89088, R_AM = 106496, R_T = 123904, R_AQK = 133120, R_MISC = 142336, R_A10 = 144448;
    constexpr int R_UT = R_KN, R_WT = R_QN, R_D0 = R_KN, R_D1 = R_KN + 2560, R_XT = R_KN + 5120;
    const int lane = tid & 63, w = __builtin_amdgcn_readfirstlane(tid >> 6), r = lane & 31, hh = lane >> 5;
    const int b = bh >> 2, h = bh & 3; const size_t row0 = (size_t)b * SEQ + 64 * c;
    LAS float* sb = (LAS float*)(L + R_MISC); LAS float* sbeta = sb + 64; LAS float* seb = sb + 128; LAS float* sekd = sb + 192; LAS float* ssq = sb + 256; LAS float* sbl = sb + 384;
    WG_BAR();
    constexpr int RAWQ = R_AM, RAWK = R_T, RAWV = R_KD;
    const int cgx = tid & 15, sg = tid >> 4;
    {
        u32x4 raw[7];
#pragma unroll
        for (int j = 0; j < 7; ++j) { const int idx = tid + 512 * j, rr = idx / 48, rem = idx - 48 * rr, ty = rem >> 4, cc = rem & 15;
            raw[j] = (u32x4){0u, 0u, 0u, 0u};
            if (idx < 67 * 48 && 64 * c + rr - 3 >= 0) raw[j] = *(const u32x4*)(P.PROJ + (row0 + rr - 3) * NPROJ + PC_QKV + ty * 512 + h * 128 + cc * 8); }
        if (tid < 64) {
            const float* sm = P.SMALL + (row0 + tid) * 8;
            const float beta = sigmoidf_(sm[h]); const float x = sm[4 + h] + P.dtb[h];
            const float sp = x > 20.f ? x : __logf(1.0f + __expf(x));
            float bb = -__expf(P.alog[h]) * sp;
#pragma unroll
            for (int o = 1; o < 64; o <<= 1) { const float n = __int_as_float(__builtin_amdgcn_ds_bpermute((lane - o) << 2, __float_as_int(bb))); if (lane >= o) bb += n; }
            const float blast = __int_as_float(__builtin_amdgcn_readlane(__float_as_int(bb), 63));
            sb[tid] = bb; sbeta[tid] = beta; seb[tid] = __expf(bb); sekd[tid] = __expf(blast - bb); if (tid == 0) sbl[0] = __expf(blast);
        } else if (tid < 192) ssq[tid - 64] = 0.f;
#pragma unroll
        for (int j = 0; j < 7; ++j) { const int idx = tid + 512 * j, rr = idx / 48, rem = idx - 48 * rr, ty = rem >> 4, cc = rem & 15;
            if (idx < 67 * 48) *(LAS u32x4*)(L + (ty == 0 ? RAWQ : ty == 1 ? RAWK : RAWV) + rr * 256 + cc * 16) = raw[j]; }
    }
    WG_BAR();
    float val[3][2][8];
#pragma unroll
    for (int ty = 0; ty < 3; ++ty) {
        const int ch = ty * 512 + h * 128 + cgx * 8;
        f32x4 w[4][2];
#pragma unroll
        for (int j = 0; j < 4; ++j) { w[j][0] = *(const f32x4*)(P.convw + j * 1536 + ch); w[j][1] = *(const f32x4*)(P.convw + j * 1536 + ch + 4); }
        lptr rb = L + (ty == 0 ? RAWQ : ty == 1 ? RAWK : RAWV) + (2 * sg) * 256 + cgx * 16;
        u32x4 xr[5];
#pragma unroll
        for (int j = 0; j < 5; ++j) xr[j] = *(const LAS u32x4*)(rb + j * 256);
#pragma unroll
        for (int q = 0; q < 2; ++q) {
            float a[8];
#pragma unroll
            for (int e = 0; e < 8; ++e) a[e] = 0.f;
#pragma unroll
            for (int j = 0; j < 4; ++j) { const u32x4 x = xr[q + j];
                a[0] += bf_lo(x.x) * w[j][0].x; a[1] += bf_hi(x.x) * w[j][0].y; a[2] += bf_lo(x.y) * w[j][0].z; a[3] += bf_hi(x.y) * w[j][0].w;
                a[4] += bf_lo(x.z) * w[j][1].x; a[5] += bf_hi(x.z) * w[j][1].y; a[6] += bf_lo(x.w) * w[j][1].z; a[7] += bf_hi(x.w) * w[j][1].w; }
            float ss = 0.f;
#pragma unroll
            for (int e = 0; e < 8; ++e) { const float v = siluf_(a[e]); val[ty][q][e] = v; ss += v * v; }
            if (ty < 2) __hip_atomic_fetch_add(&ssq[ty * 64 + 2 * sg + q], ss, __ATOMIC_RELAXED, __HIP_MEMORY_SCOPE_WORKGROUP);
        }
    }
    WG_BAR();
#pragma unroll
    for (int ty = 0; ty < 3; ++ty)
#pragma unroll
        for (int q = 0; q < 2; ++q) {
            const int s = 2 * sg + q; const int off = s * LDA_ + cgx * 16;
            float f1, f2 = 0.f, f3 = 0.f;
            if (ty == 0) { f1 = 1.0f / sqrtf(ssq[s] + EPS) * 0.08838834764831845f; f2 = f1 * seb[s]; }
            else if (ty == 1) { f1 = 1.0f / sqrtf(ssq[64 + s] + EPS); f2 = f1 * sbeta[s] * seb[s]; f3 = f1 * sekd[s]; }
            else f1 = sbeta[s];
#define VA(e) val[ty][q][e]
            { u32x4 o; o.x = pk2(VA(0) * f1, VA(1) * f1); o.y = pk2(VA(2) * f1, VA(3) * f1); o.z = pk2(VA(4) * f1, VA(5) * f1); o.w = pk2(VA(6) * f1, VA(7) * f1); *(LAS u32x4*)(L + (ty == 0 ? R_QN : ty == 1 ? R_KN : R_VB) + off) = o; }
            if (ty < 2) { u32x4 o; o.x = pk2(VA(0) * f2, VA(1) * f2); o.y = pk2(VA(2) * f2, VA(3) * f2); o.z = pk2(VA(4) * f2, VA(5) * f2); o.w = pk2(VA(6) * f2, VA(7) * f2); *(LAS u32x4*)(L + (ty == 0 ? R_QE : R_KBE) + off) = o; }
            if (ty == 1) { u32x4 o; o.x = pk2(VA(0) * f3, VA(1) * f3); o.y = pk2(VA(2) * f3, VA(3) * f3); o.z = pk2(VA(4) * f3, VA(5) * f3); o.w = pk2(VA(6) * f3, VA(7) * f3); *(LAS u32x4*)(L + R_KD + off) = o; }
#undef VA
        }
    WG_BAR();
    {
        const int tl = w & 3, ta = tl >> 1, tb = tl & 1;
        f32x16 acc = zero16();
        lptr Bsrc = L + (w < 4 ? R_KN : R_QN);
#pragma unroll
        for (int s8 = 0; s8 < 8; ++s8) acc = MFMA32(fragK(L + R_KN, LDA_, 32 * ta, 16 * s8, lane), fragK(Bsrc, LDA_, 32 * tb, 16 * s8, lane), acc);
        const int ci = 32 * tb + r; const float bcol = sb[ci];
        if (w < 4) {
            const float bet = sbeta[ci];
#pragma unroll
            for (int g = 0; g < 4; ++g) { f32x4 o;
#pragma unroll
                for (int e = 0; e < 4; ++e) { const int jj = 32 * ta + 8 * g + 4 * hh + e; o[e] = (jj < ci) ? bet * acc[4 * g + e] * __expf(bcol - sb[jj]) : 0.f; }
                *(LAS f32x4*)(L + R_AM + ci * 272 + (32 * ta + 8 * g + 4 * hh) * 4) = o;
                if (ta == 0 && tb == 1) { u32x2 v; v.x = pk2(o[0], o[1]); v.y = pk2(o[2], o[3]); *(LAS u32x2*)(L + R_A10 + r * 80 + (8 * g + 4 * hh) * 2) = v; } }
        } else {
            f32x16 o;
#pragma unroll
            for (int i = 0; i < 16; ++i) { const int ss_ = 32 * ta + crow(i, hh); o[i] = (ss_ <= ci) ? acc[i] * __expf(bcol - sb[ss_]) : 0.f; }
            storeT_bf16(o, L + R_AQK, LDT_, 32 * tb, 32 * ta, lane);
        }
    }
    WG_BAR();
    if (w == 0) {
        const int blk = hh, cc = r;
        float x[32];
#pragma unroll
        for (int i = 0; i < 32; ++i) x[i] = 0.f;
        f32x4 rowc[8], rown[8];
#pragma unroll
        for (int i = 0; i < 32; ++i) {
            if (i + 1 < 32) { const LAS f32x4* an = (const LAS f32x4*)(L + R_AM + (32 * blk + i + 1) * 272 + (32 * blk) * 4);
#pragma unroll
                for (int jq = 0; jq < (i + 4) / 4; ++jq) rown[jq] = an[jq]; }
            float a = (i == cc) ? 1.f : 0.f;
#pragma unroll
            for (int jq = 0; jq < (i + 3) / 4; ++jq) { const f32x4 a4 = rowc[jq]; a -= (a4.x * x[4 * jq] + a4.y * x[4 * jq + 1]) + (a4.z * x[4 * jq + 2] + a4.w * x[4 * jq + 3]); }
            x[i] = a;
#pragma unroll
            for (int jq = 0; jq < 8; ++jq) rowc[jq] = rown[jq];
            __builtin_amdgcn_sched_barrier(0);
        }
#pragma unroll
        for (int i = 0; i < 32; ++i) { const bf16_t v = f2bf(x[i]);
            *(LAS bf16_t*)(L + (blk ? R_D1 : R_D0) + i * 80 + cc * 2) = v;
            *(LAS bf16_t*)(L + R_T + (32 * blk + i) * LDT_ + (32 * blk + cc) * 2) = v; }
#pragma unroll
        for (int i = 0; i < 16; ++i) *(LAS bf16_t*)(L + R_T + (16 * blk + i) * LDT_ + (32 + cc) * 2) = 0;
        LDS_WAIT();
        f32x16 xa = zero16();
#pragma unroll
        for (int s2 = 0; s2 < 2; ++s2) xa = MFMA32(fragK(L + R_A10, 80, 0, 16 * s2, lane), fragT(L + R_D0, 80, 16 * s2, 0, lane), xa);
        storeT_bf16(xa, L + R_XT, 80, 0, 0, lane);
        LDS_WAIT();
        f32x16 t10 = zero16();
#pragma unroll
        for (int s2 = 0; s2 < 2; ++s2) t10 = MFMA32(fragK(L + R_XT, 80, 0, 16 * s2, lane), fragK(L + R_D1, 80, 0, 16 * s2, lane), t10);
#pragma unroll
        for (int i = 0; i < 16; ++i) t10[i] = -t10[i];
        storeT_bf16(t10, L + R_T, LDT_, 32, 0, lane);
    }
    WG_BAR();
#pragma unroll
    for (int q = 0; q < 2; ++q) {
        const int id = 2 * w + q, which = id >> 3, ti = (id >> 2) & 1, di = id & 3;
        f32x16 acc = zero16();
        lptr Bsrc = L + (which ? R_KBE : R_VB);
#pragma unroll
        for (int s4 = 0; s4 < 4; ++s4) acc = MFMA32(fragK(L + R_T, LDT_, 32 * ti, 16 * s4, lane), fragT(Bsrc, LDA_, 16 * s4, 32 * di, lane), acc);
        storeT_bf16(acc, L + (which ? R_WT : R_UT), LDT_, 32 * di, 32 * ti, lane);
    }
    WG_BAR();
    const size_t itg = (size_t)1024 + bh * 128 + c, itm = (size_t)bh * 128 + c;
    const float bl = sbl[0];
#pragma unroll 1
    for (int q = 0; q < 6; ++q) {
        const int t = w + 8 * q;
        f32x16 acc = zero16();
        if (q < 2) {
            const int rt = t >> 2, dt = t & 3;
#pragma unroll
            for (int s4 = 0; s4 < 4; ++s4) acc = MFMA32(fragT(L + R_KD, LDA_, 16 * s4, 32 * rt, lane), fragK(L + R_UT, LDT_, 32 * dt, 16 * s4, lane), acc);
            gstore_tile(P.NN + (itg * 16 + rt * 4 + dt) * TILE_B, lane, acc);
        } else if (q < 4) {
            const int t2 = t - 16, kt = t2 >> 2, rt = t2 & 3;
#pragma unroll
            for (int s4 = 0; s4 < 4; ++s4) acc = MFMA32(fragK(L + R_WT, LDT_, 32 * kt, 16 * s4, lane), fragT(L + R_KD, LDA_, 16 * s4, 32 * rt, lane), acc);
#pragma unroll
            for (int i = 0; i < 16; ++i) acc[i] = ((kt == rt) && (crow(i, hh) == r) ? bl : 0.f) - acc[i];
            gstore_tile(P.MT + (itm * 16 + kt * 4 + rt) * TILE_B, lane, acc);
        } else if (q == 4) {
            const int t2 = t - 32, tt = t2 >> 2, dt = t2 & 3;
#pragma unroll
            for (int s4 = 0; s4 < 4; ++s4) acc = MFMA32(fragK(L + R_AQK, LDT_, 32 * tt, 16 * s4, lane), fragK(L + R_UT, LDT_, 32 * dt, 16 * s4, lane), acc);
            gstore_tile(P.OP + (itg * 8 + tt * 4 + dt) * TILE_B, lane, acc);
        } else {
            const int t2 = t - 40, kt = t2 >> 1, tt = t2 & 1;
#pragma unroll
            for (int s4 = 0; s4 < 4; ++s4) acc = MFMA32(fragK(L + R_WT, LDT_, 32 * kt, 16 * s4, lane), fragK(L + R_AQK, LDT_, 32 * tt, 16 * s4, lane), acc);
#pragma unroll
            for (int g = 0; g < 4; ++g) { const u32x2 qv = *(const LAS u32x2*)(L + R_QE + (32 * tt + r) * LDA_ + (32 * kt + 8 * g + 4 * hh) * 2);
                acc[4 * g] = bf_lo(qv.x) - acc[4 * g]; acc[4 * g + 1] = bf_hi(qv.x) - acc[4 * g + 1]; acc[4 * g + 2] = bf_lo(qv.y) - acc[4 * g + 2]; acc[4 * g + 3] = bf_hi(qv.y) - acc[4 * g + 3]; }
            gstore_tile(P.QT + (itg * 8 + kt * 2 + tt) * TILE_B, lane, acc);
        }
    }
}

DI void passA_hgrn(lptr L, int tid_in, const MixP& P, int bh, int c) {
    int tid = tid_in; asm volatile("" : "+v"(tid));
    constexpr int R_QT = 0, R_KTA = 17408, R_KTB = 34816, R_QE = 43520, R_KD = 60928, R_VV = 78336, R_ATT = 95744, R_TOT = 104960, R_REF = 107008;
    const int lane = tid & 63, w = __builtin_amdgcn_readfirstlane(tid >> 6), r = lane & 31, hh = lane >> 5;
    const int b = bh >> 2, h = bh & 3; const size_t row0 = (size_t)b * SEQ + 64 * c;
    const int k = tid & 127, qr = tid >> 7;
    LAS float* tot = (LAS float*)(L + R_TOT); LAS float* ref = (LAS float*)(L + R_REF);
    float lb = 0.f;
    if (P.l > 0) lb = sigmoidf_(P.lbl[512 + h * 128 + k] - P.lbl[h * 128 + k]);
    WG_BAR();
    float bloc[16], kk_[16]; float run = 0.f;
    bf16_t hfr[16], hqr[16];
    {
        const bf16_t* pf = P.PROJ + (row0 + 16 * qr) * NPROJ + PC_HF + h * 128 + k;
        const bf16_t* pq = P.PROJ + (row0 + 16 * qr) * NPROJ + PC_HQ + h * 128 + k;
#pragma unroll
        for (int i = 0; i < 16; ++i) hfr[i] = pf[(size_t)i * NPROJ];
#pragma unroll
        for (int i = 0; i < 16; ++i) hqr[i] = pq[(size_t)i * NPROJ];
        u32x4 vraw[2];
#pragma unroll
        for (int q = 0; q < 2; ++q) { const int ch = tid + 512 * q, row = ch >> 4, cc = ch & 15; vraw[q] = *(const u32x4*)(P.PROJ + (row0 + row) * NPROJ + PC_HI + h * 128 + cc * 8); }
        asm volatile("" ::: "memory");
#pragma unroll
        for (int i = 0; i < 16; ++i) { const float hf = bf1(hfr[i]); const float fg = lb + (1.0f - lb) * sigmoidf_(hf); run += __logf(fg); bloc[i] = run; kk_[i] = 1.0f - fg; }
        tot[qr * 128 + k] = run;
#pragma unroll
        for (int q = 0; q < 2; ++q) { const int ch = tid + 512 * q, row = ch >> 4, cc = ch & 15; *(LAS u32x4*)(L + R_VV + row * LDA_ + cc * 16) = vraw[q]; }
    }
    WG_BAR();
    float off = 0.f, blast = 0.f;
#pragma unroll
    for (int q = 0; q < 4; ++q) { const float t_ = tot[q * 128 + k]; blast += t_; if (q < qr) off += t_; }
#pragma unroll
    for (int i = 0; i < 16; ++i) bloc[i] += off;
    if (qr == 0) ref[k] = bloc[0];
    if (qr == 2) ref[128 + k] = bloc[0];
    WG_BAR();
    {
        const float ref0 = ref[k], ref1 = ref[128 + k]; const float rf = (qr < 2) ? ref0 : ref1;
#pragma unroll
        for (int i = 0; i < 16; ++i) { const int t = 16 * qr + i; const float q_ = siluf_(bf1(hqr[i])); const float bt = bloc[i];
            *(LAS bf16_t*)(L + R_QE + t * LDA_ + k * 2) = f2bf(q_ * __expf(bt));
            *(LAS bf16_t*)(L + R_KD + t * LDA_ + k * 2) = f2bf(kk_[i] * __expf(blast - bt));
            *(LAS bf16_t*)(L + R_QT + t * LDA_ + k * 2) = f2bf(q_ * __expf(fminf(bt - rf, 80.f)));
            *(LAS bf16_t*)(L + R_KTA + t * LDA_ + k * 2) = f2bf(kk_[i] * __expf(fminf(rf - bt, 80.f)));
            if (qr < 2) *(LAS bf16_t*)(L + R_KTB + t * LDA_ + k * 2) = f2bf(kk_[i] * __expf(ref1 - bt)); }
        if (qr == 0) { const int kt = k >> 5, kr = k & 31, h2 = (kr >> 2) & 1, i2 = (kr & 3) + 4 * (kr >> 3);
            P.DL[(((size_t)bh * 128 + c) * 4 + kt) * 32 + h2 * 16 + i2] = __expf(blast); }
    }
    WG_BAR();
    const size_t it = (size_t)bh * 128 + c;
    if (w < 3) {
        const int sa = (w == 2) ? 32 : 0, tb = (w == 0) ? 0 : 32;
        lptr Asrc = L + (w == 1 ? R_KTB : R_KTA);
        f32x16 acc = zero16();
#pragma unroll
        for (int s8 = 0; s8 < 8; ++s8) acc = MFMA32(fragK(Asrc, LDA_, sa, 16 * s8, lane), fragK(L + R_QT, LDA_, tb, 16 * s8, lane), acc);
        if (w != 1) {
#pragma unroll
            for (int i = 0; i < 16; ++i) acc[i] = (crow(i, hh) <= r) ? acc[i] : 0.f; }
        storeT_bf16(acc, L + R_ATT, LDT_, tb, sa, lane);
    } else if (w == 3) {
        storeT_bf16(zero16(), L + R_ATT, LDT_, 0, 32, lane);
    } else {
#pragma unroll
        for (int q = 0; q < 4; ++q) { const int t = (w - 4) * 4 + q, rt = t >> 2, dt = t & 3;
            f32x16 acc = zero16();
#pragma unroll
            for (int s4 = 0; s4 < 4; ++s4) acc = MFMA32(fragT(L + R_KD, LDA_, 16 * s4, 32 * rt, lane), fragT(L + R_VV, LDA_, 16 * s4, 32 * dt, lane), acc);
            gstore_tile(P.NN + (it * 16 + rt * 4 + dt) * TILE_B, lane, acc); }
    }
    {
        const int kt = w >> 1, tt = w & 1; u32x2 g[4];
#pragma unroll
        for (int q = 0; q < 4; ++q) g[q] = *(const LAS u32x2*)(L + R_QE + (32 * tt + r) * LDA_ + (32 * kt + 8 * q + 4 * hh) * 2);
        u32x4* p = (u32x4*)(P.QT + (it * 8 + kt * 2 + tt) * TILE_B + lane * 32);
        if (WT_TILE == 2) { __builtin_nontemporal_store((u32x4){g[0].x, g[0].y, g[1].x, g[1].y}, p); __builtin_nontemporal_store((u32x4){g[2].x, g[2].y, g[3].x, g[3].y}, p + 1); }
        else if (WT_TILE) { st16_wt(p, (u32x4){g[0].x, g[0].y, g[1].x, g[1].y}); st16_wt(p + 1, (u32x4){g[2].x, g[2].y, g[3].x, g[3].y}); }
        else { p[0] = (u32x4){g[0].x, g[0].y, g[1].x, g[1].y}; p[1] = (u32x4){g[2].x, g[2].y, g[3].x, g[3].y}; }
    }
    WG_BAR();
    {
        const int tt = w >> 2, dt = w & 3;
        f32x16 acc = zero16();
#pragma unroll
        for (int s4 = 0; s4 < 4; ++s4) acc = MFMA32(fragK(L + R_ATT, LDT_, 32 * tt, 16 * s4, lane), fragT(L + R_VV, LDA_, 16 * s4, 32 * dt, lane), acc);
        gstore_tile(P.OP + (it * 8 + tt * 4 + dt) * TILE_B, lane, acc);
    }
}

DI void passB_gdn(lptr L, int tid, const MixP& P, int j, int c0 = 0, int c1 = 128) {
    const int lane = tid & 63, w = __builtin_amdgcn_readfirstlane(tid >> 6);
    const int bh = j >> 2, dt = j & 3;
    if (w > 4) {
#pragma unroll 1
        for (int c = c0; c < c1; ++c) WG_BAR();
        return;
    }
    if (w == 4) {
        unsigned char* SSb = P.SS + ((size_t)1024 + bh * 128) * 16 * TILE_B + dt * TILE_B + lane * 32;
#pragma unroll
        for (int kt = 0; kt < 4; ++kt) { if (c0 == 0) { u32x4* ps = (u32x4*)(SSb + kt * 8192); ps[0] = (u32x4){0u, 0u, 0u, 0u}; ps[1] = (u32x4){0u, 0u, 0u, 0u}; } }
#pragma unroll 1
        for (int c = c0; c < c1; ++c) {
            WG_BAR();
            if (c < 127) {
                if (CHAIN_OWN) __builtin_amdgcn_s_sleep(3);
                lptr xb = L + (c & 1) * 8192;
#pragma unroll
                for (int kt = 0; kt < 4; ++kt) { const LAS u32x4* px = (const LAS u32x4*)(xb + kt * 2048 + lane * 32); const u32x4 a = px[0], b = px[1];
                    unsigned char* ps = SSb + (size_t)(c + 1) * 32768 + kt * 8192; if (WT_CHAIN) { st16_wt(ps, a); st16_wt(ps + 16, b); } else { *(u32x4*)ps = a; *(u32x4*)(ps + 16) = b; } }
            }
        }
        return;
    }
    const int rt = w;
    const unsigned char* MTb = P.MT + ((size_t)bh * 128) * 16 * TILE_B + rt * TILE_B + lane * 32;
    const unsigned char* NNb = P.NN + ((size_t)1024 + bh * 128) * 16 * TILE_B + (rt * 4 + dt) * TILE_B + lane * 32;
    u32x4 A[4][4][2], Nn[4][2];
    u32x4 Sb[4][2], mylo, myhi;
#pragma unroll
    for (int kt = 0; kt < 4; ++kt) { Sb[kt][0] = (u32x4){0u, 0u, 0u, 0u}; Sb[kt][1] = (u32x4){0u, 0u, 0u, 0u}; }
    if (c0 > 0) {
        const unsigned char* sr = P.SS + ((size_t)1024 + bh * 128) * 16 * TILE_B + dt * TILE_B + lane * 32 + (size_t)c0 * 32768;
#pragma unroll
        for (int kt = 0; kt < 4; ++kt) { Sb[kt][0] = *(const u32x4*)(sr + kt * 8192); Sb[kt][1] = *(const u32x4*)(sr + kt * 8192 + 16); }
    }
#define PB_LOAD(buf, cc) do { const unsigned char* pa = MTb + (size_t)(cc) * 32768; _Pragma("unroll") for (int kt = 0; kt < 4; ++kt) { A[buf][kt][0] = *(const u32x4*)(pa + kt * 8192); A[buf][kt][1] = *(const u32x4*)(pa + kt * 8192 + 16); } \
        const unsigned char* pn = NNb + (size_t)(cc) * 32768; Nn[buf][0] = *(const u32x4*)pn; Nn[buf][1] = *(const u32x4*)(pn + 16); } while (0)
#define PB_STEP(buf, cc) do { \
        f32x16 acc = unpack_tile(Nn[buf][0], Nn[buf][1]); \
        _Pragma("unroll") for (int kt = 0; kt < 4; ++kt) { acc = MFMA32(AS_BF8(A[buf][kt][0]), AS_BF8(Sb[kt][0]), acc); acc = MFMA32(AS_BF8(A[buf][kt][1]), AS_BF8(Sb[kt][1]), acc); } \
        pack_tile(acc, mylo, myhi); \
        lptr xb = L + ((cc) & 1) * 8192; \
        { LAS u32x4* px = (LAS u32x4*)(xb + rt * 2048 + lane * 32); px[0] = mylo; px[1] = myhi; } \
        WG_BAR(); \
        _Pragma("unroll") for (int kt = 0; kt < 4; ++kt) { if (CHAIN_OWN && kt == rt) { Sb[kt][0] = mylo; Sb[kt][1] = myhi; }   \
            else { const LAS u32x4* px = (const LAS u32x4*)(xb + kt * 2048 + lane * 32); Sb[kt][0] = px[0]; Sb[kt][1] = px[1]; } } \
        __builtin_amdgcn_sched_barrier(0);   } while (0)
#ifdef PROBE_DEPTH2
    PB_LOAD(0, c0); PB_LOAD(1, c0 + 1);
#pragma unroll 1
    for (int c = c0; c < c1 - 4; c += 4) {
        PB_LOAD(2, c + 2); PB_STEP(0, c);
        PB_LOAD(3, c + 3); PB_STEP(1, c + 1);
        PB_LOAD(0, c + 4); PB_STEP(2, c + 2);
        PB_LOAD(1, c + 5); PB_STEP(3, c + 3);
    }
    PB_LOAD(2, c1 - 2); PB_STEP(0, c1 - 4); PB_LOAD(3, c1 - 1); PB_STEP(1, c1 - 3); PB_STEP(2, c1 - 2); PB_STEP(3, c1 - 1);
#else
    PB_LOAD(0, c0); PB_LOAD(1, c0 + 1); PB_LOAD(2, c0 + 2);
#pragma unroll 1
    for (int c = c0; c < c1 - 4; c += 4) {
        PB_LOAD(3, c + 3); PB_STEP(0, c);
        PB_LOAD(0, c + 4); PB_STEP(1, c + 1);
        PB_LOAD(1, c + 5); PB_STEP(2, c + 2);
        PB_LOAD(2, c + 6); PB_STEP(3, c + 3);
    }
    PB_LOAD(3, c1 - 1); PB_STEP(0, c1 - 4); PB_STEP(1, c1 - 3); PB_STEP(2, c1 - 2); PB_STEP(3, c1 - 1);
#endif
#undef PB_LOAD
#undef PB_STEP
}
DI void passB_hgrn(int lane, const MixP& P, int item, int c0 = 0, int c1 = 128) {
    const int half = item & 1, tile = (item >> 1) & 15, bh = item >> 5, kt = tile >> 2, hh = lane >> 5;
    const unsigned char* NNb = P.NN + ((size_t)bh * 128) * 16 * TILE_B + tile * TILE_B + lane * 32 + half * 16;
    unsigned char* SSb = P.SS + ((size_t)bh * 128) * 16 * TILE_B + tile * TILE_B + lane * 32 + half * 16;
    const float* DLb = P.DL + (((size_t)bh * 128) * 4 + kt) * 32 + hh * 16 + half * 8;
    float S[8];
#pragma unroll
    for (int e = 0; e < 8; ++e) S[e] = 0.f;
    if (c0 > 0) { const u32x4 sv = *(const u32x4*)(SSb + (size_t)c0 * 32768);
        S[0] = bf_lo(sv.x); S[1] = bf_hi(sv.x); S[2] = bf_lo(sv.y); S[3] = bf_hi(sv.y); S[4] = bf_lo(sv.z); S[5] = bf_hi(sv.z); S[6] = bf_lo(sv.w); S[7] = bf_hi(sv.w); }
    u32x4 nA[8]; f32x4 dA[8][2]; u32x4 so[8];
#define HB_LOAD(nb, db, c0) do { _Pragma("unroll") for (int i = 0; i < 8; ++i) { nb[i] = *(const u32x4*)(NNb + (size_t)((c0) + i) * 32768); \
        const f32x4* pd = (const f32x4*)(DLb + (size_t)((c0) + i) * 128); db[i][0] = pd[0]; db[i][1] = pd[1]; } } while (0)
#define HB_RUN(nb, db) do { _Pragma("unroll") for (int i = 0; i < 8; ++i) { \
        so[i].x = pk2(S[0], S[1]); so[i].y = pk2(S[2], S[3]); so[i].z = pk2(S[4], S[5]); so[i].w = pk2(S[6], S[7]); \
        const u32x4 n = nb[i]; \
        S[0] = S[0] * db[i][0][0] + bf_lo(n.x); S[1] = S[1] * db[i][0][1] + bf_hi(n.x); S[2] = S[2] * db[i][0][2] + bf_lo(n.y); S[3] = S[3] * db[i][0][3] + bf_hi(n.y); \
        S[4] = S[4] * db[i][1][0] + bf_lo(n.z); S[5] = S[5] * db[i][1][1] + bf_hi(n.z); S[6] = S[6] * db[i][1][2] + bf_lo(n.w); S[7] = S[7] * db[i][1][3] + bf_hi(n.w); } } while (0)
#define HB_STORE(c0) do { _Pragma("unroll") for (int i = 0; i < 8; ++i) { if (WT_CHAIN) st16_wt(SSb + (size_t)((c0) + i) * 32768, so[i]); else *(u32x4*)(SSb + (size_t)((c0) + i) * 32768) = so[i]; } } while (0)
    HB_LOAD(nA, dA, c0);
#pragma unroll 1
    for (int c = c0; c < c1; c += 8) {
        HB_RUN(nA, dA); if (c + 8 < c1) HB_LOAD(nA, dA, c + 8); HB_STORE(c);
    }
    if (c1 < 128) { u32x4 sv; sv.x = pk2(S[0], S[1]); sv.y = pk2(S[2], S[3]); sv.z = pk2(S[4], S[5]); sv.w = pk2(S[6], S[7]);
        *(u32x4*)(SSb + (size_t)c1 * 32768) = sv; }
#undef HB_LOAD
#undef HB_RUN
#undef HB_STORE
}

struct PCLoad { u32x4 ol, oh, ql[4], qh[4], sl[4], sh_[4]; bf16_t g[16]; };
DI void passC_load(PCLoad& T, int lane, int w, const MixP& P, int it) {
    const int r = lane & 31, hh = lane >> 5, tt = w >> 2, dt = w & 3;
    const int br = it >> 10, bhc = it & 1023, bh = bhc >> 7, c = bhc & 127, b = bh >> 2, h = bh & 3;
    const size_t row0 = (size_t)b * SEQ + 64 * c;
    gload_tile(P.OP + ((size_t)it * 8 + tt * 4 + dt) * TILE_B, lane, T.ol, T.oh);
#pragma unroll
    for (int kt = 0; kt < 4; ++kt) { gload_tile(P.QT + ((size_t)it * 8 + kt * 2 + tt) * TILE_B, lane, T.ql[kt], T.qh[kt]); gload_tile(P.SS + ((size_t)it * 16 + kt * 4 + dt) * TILE_B, lane, T.sl[kt], T.sh_[kt]); }
    const int gcol = (br ? PC_GG : PC_HG) + h * 128 + 32 * dt + r;
#pragma unroll
    for (int i = 0; i < 16; ++i) T.g[i] = P.PROJ[(row0 + 32 * tt + crow(i, hh)) * NPROJ + gcol];
    __builtin_amdgcn_sched_barrier(0);
}
DI void passC_finish(const PCLoad& T, lptr L, int lane, int w, int it, int par, const float* ng_h, const float* ng_g, bf16_t* Y) {
    const int r = lane & 31, hh = lane >> 5, tt = w >> 2, dt = w & 3;
    const int br = it >> 10, bhc = it & 1023, bh = bhc >> 7, c = bhc & 127, b = bh >> 2, h = bh & 3;
    const size_t row0 = (size_t)b * SEQ + 64 * c;
    f32x16 acc = unpack_tile(T.ol, T.oh);
#pragma unroll
    for (int kt = 0; kt < 4; ++kt) { acc = MFMA32(AS_BF8(T.ql[kt]), AS_BF8(T.sl[kt]), acc); acc = MFMA32(AS_BF8(T.qh[kt]), AS_BF8(T.sh_[kt]), acc); }
    LAS float* ps = (LAS float*)(L + par * 1024);
#pragma unroll
    for (int i = 0; i < 16; ++i) { float s = acc[i] * acc[i];
        s += shx<1>(s, lane); s += shx<2>(s, lane); s += shx<4>(s, lane); s += shx<8>(s, lane); s += shx<16>(s, lane);
        if (r == 0) ps[dt * 64 + 32 * tt + crow(i, hh)] = s; }
    WG_BAR();
    const int d = 32 * dt + r; const float ng = (br ? ng_g : ng_h)[d];
#pragma unroll
    for (int i = 0; i < 16; ++i) { const int t = 32 * tt + crow(i, hh);
        const float tot = (ps[t] + ps[64 + t]) + (ps[128 + t] + ps[192 + t]);
        const float rstd = 1.0f / sqrtf(tot * (1.0f / 128.0f) + EPS);
        Y[(row0 + t) * D + br * 512 + h * 128 + d] = f2bf(acc[i] * rstd * ng * siluf_(bf1(T.g[i]))); }
}

DI void passC_wave(int lane, const MixP& P, int it, int tt, const float* ng_h, const float* ng_g, bf16_t* Y) {
    const int r = lane & 31, hh = lane >> 5;
    const int br = it >> 10, bhc = it & 1023, bh = bhc >> 7, c = bhc & 127, b = bh >> 2, h = bh & 3;
    const size_t rowb = (size_t)b * SEQ + 64 * c + 32 * tt;
    u32x4 ql[4], qh[4];
#pragma unroll
    for (int kt = 0; kt < 4; ++kt) gload_tile(P.QT + ((size_t)it * 8 + kt * 2 + tt) * TILE_B, lane, ql[kt], qh[kt]);
    u32x4 ol[2], oh[2], sl[2][4], sh_[2][4];
#define PC_LD(buf, dt) do { gload_tile(P.OP + ((size_t)it * 8 + tt * 4 + (dt)) * TILE_B, lane, ol[buf], oh[buf]); \
        _Pragma("unroll") for (int kt = 0; kt < 4; ++kt) gload_tile(P.SS + ((size_t)it * 16 + kt * 4 + (dt)) * TILE_B, lane, sl[buf][kt], sh_[buf][kt]); } while (0)
    f32x16 acc[4];
    PC_LD(0, 0);
#pragma unroll
    for (int dt = 0; dt < 4; ++dt) {
        if (dt < 3) PC_LD((dt + 1) & 1, dt + 1);
        __builtin_amdgcn_sched_barrier(0);
        f32x16 a = unpack_tile(ol[dt & 1], oh[dt & 1]);
#pragma unroll
        for (int kt = 0; kt < 4; ++kt) { a = MFMA32(AS_BF8(ql[kt]), AS_BF8(sl[dt & 1][kt]), a); a = MFMA32(AS_BF8(qh[kt]), AS_BF8(sh_[dt & 1][kt]), a); }
        acc[dt] = a;
    }
#undef PC_LD
    const bf16_t* gp = P.PROJ + rowb * NPROJ + (br ? PC_GG : PC_HG) + h * 128 + r;
    bf16_t g0[16], g1[16];
#pragma unroll
    for (int i = 0; i < 16; ++i) g0[i] = gp[(size_t)crow(i, hh) * NPROJ];
    float rstd[16];
#pragma unroll
    for (int i = 0; i < 16; ++i) { float s = (acc[0][i] * acc[0][i] + acc[1][i] * acc[1][i]) + (acc[2][i] * acc[2][i] + acc[3][i] * acc[3][i]);
        s += shx<1>(s, lane); s += shx<2>(s, lane); s += shx<4>(s, lane); s += shx<8>(s, lane); s += shx<16>(s, lane);
        rstd[i] = 1.0f / sqrtf(s * (1.0f / 128.0f) + EPS); }
    const float* ngp = (br ? ng_g : ng_h) + r;
    bf16_t* yp = Y + rowb * D + br * 512 + h * 128 + r;
#pragma unroll
    for (int dt = 0; dt < 4; ++dt) {
        if (dt < 3) {
#pragma unroll
            for (int i = 0; i < 16; ++i) { const bf16_t v = gp[(size_t)crow(i, hh) * NPROJ + 32 * (dt + 1)]; if (dt & 1) g0[i] = v; else g1[i] = v; } }
        const float ng = ngp[32 * dt];
#pragma unroll
        for (int i = 0; i < 16; ++i) { const bf16_t gv = (dt & 1) ? g1[i] : g0[i];
            yp[(size_t)crow(i, hh) * D + 32 * dt] = f2bf(acc[dt][i] * rstd[i] * ng * siluf_(bf1(gv))); }
    }
}

DI float selh(int hm, float a0, float a1) { return __int_as_float((__float_as_int(a0) & ~hm) | (__float_as_int(a1) & hm)); }
DI float max3f_(float a, float b, float c) { return fmaxf(fmaxf(a, b), c); }
#define CE_(a, b) { const float t_ = fmaxf(a, b); b = fminf(a, b); a = t_; }
#define SORT16_(P, B) do {   \
    CE_(P[(B) + 0], P[(B) + 13]); CE_(P[(B) + 1], P[(B) + 12]); CE_(P[(B) + 2], P[(B) + 15]); CE_(P[(B) + 3], P[(B) + 14]); CE_(P[(B) + 4], P[(B) + 8]); CE_(P[(B) + 5], P[(B) + 6]); CE_(P[(B) + 7], P[(B) + 11]); CE_(P[(B) + 9], P[(B) + 10]); \
    CE_(P[(B) + 0], P[(B) + 5]); CE_(P[(B) + 1], P[(B) + 7]); CE_(P[(B) + 2], P[(B) + 9]); CE_(P[(B) + 3], P[(B) + 4]); CE_(P[(B) + 6], P[(B) + 13]); CE_(P[(B) + 8], P[(B) + 14]); CE_(P[(B) + 10], P[(B) + 15]); CE_(P[(B) + 11], P[(B) + 12]); \
    CE_(P[(B) + 0], P[(B) + 1]); CE_(P[(B) + 2], P[(B) + 3]); CE_(P[(B) + 4], P[(B) + 5]); CE_(P[(B) + 6], P[(B) + 8]); CE_(P[(B) + 7], P[(B) + 9]); CE_(P[(B) + 10], P[(B) + 11]); CE_(P[(B) + 12], P[(B) + 13]); CE_(P[(B) + 14], P[(B) + 15]); \
    CE_(P[(B) + 0], P[(B) + 2]); CE_(P[(B) + 1], P[(B) + 3]); CE_(P[(B) + 4], P[(B) + 10]); CE_(P[(B) + 5], P[(B) + 11]); CE_(P[(B) + 6], P[(B) + 7]); CE_(P[(B) + 8], P[(B) + 9]); CE_(P[(B) + 12], P[(B) + 14]); CE_(P[(B) + 13], P[(B) + 15]); \
    CE_(P[(B) + 1], P[(B) + 2]); CE_(P[(B) + 3], P[(B) + 12]); CE_(P[(B) + 4], P[(B) + 6]); CE_(P[(B) + 5], P[(B) + 7]); CE_(P[(B) + 8], P[(B) + 10]); CE_(P[(B) + 9], P[(B) + 11]); CE_(P[(B) + 13], P[(B) + 14]); \
    CE_(P[(B) + 1], P[(B) + 4]); CE_(P[(B) + 2], P[(B) + 6]); CE_(P[(B) + 5], P[(B) + 8]); CE_(P[(B) + 7], P[(B) + 10]); CE_(P[(B) + 9], P[(B) + 13]); CE_(P[(B) + 11], P[(B) + 14]); \
    CE_(P[(B) + 2], P[(B) + 4]); CE_(P[(B) + 3], P[(B) + 6]); CE_(P[(B) + 9], P[(B) + 12]); CE_(P[(B) + 11], P[(B) + 13]); \
    CE_(P[(B) + 3], P[(B) + 5]); CE_(P[(B) + 6], P[(B) + 8]); CE_(P[(B) + 7], P[(B) + 9]); CE_(P[(B) + 10], P[(B) + 12]); \
    CE_(P[(B) + 3], P[(B) + 4]); CE_(P[(B) + 5], P[(B) + 6]); CE_(P[(B) + 7], P[(B) + 8]); CE_(P[(B) + 9], P[(B) + 10]); CE_(P[(B) + 11], P[(B) + 12]); \
    CE_(P[(B) + 6], P[(B) + 7]); CE_(P[(B) + 8], P[(B) + 9]); \
} while (0)
#define MERGE16_(P, B) do { \
    CE_(P[(B) + 0], P[(B) + 8]); CE_(P[(B) + 1], P[(B) + 9]); CE_(P[(B) + 2], P[(B) + 10]); CE_(P[(B) + 3], P[(B) + 11]); CE_(P[(B) + 4], P[(B) + 12]); CE_(P[(B) + 5], P[(B) + 13]); CE_(P[(B) + 6], P[(B) + 14]); CE_(P[(B) + 7], P[(B) + 15]); \
    CE_(P[(B) + 0], P[(B) + 4]); CE_(P[(B) + 1], P[(B) + 5]); CE_(P[(B) + 2], P[(B) + 6]); CE_(P[(B) + 3], P[(B) + 7]); CE_(P[(B) + 8], P[(B) + 12]); CE_(P[(B) + 9], P[(B) + 13]); CE_(P[(B) + 10], P[(B) + 14]); CE_(P[(B) + 11], P[(B) + 15]); \
    CE_(P[(B) + 0], P[(B) + 2]); CE_(P[(B) + 1], P[(B) + 3]); CE_(P[(B) + 4], P[(B) + 6]); CE_(P[(B) + 5], P[(B) + 7]); CE_(P[(B) + 8], P[(B) + 10]); CE_(P[(B) + 9], P[(B) + 11]); CE_(P[(B) + 12], P[(B) + 14]); CE_(P[(B) + 13], P[(B) + 15]); \
    CE_(P[(B) + 0], P[(B) + 1]); CE_(P[(B) + 2], P[(B) + 3]); CE_(P[(B) + 4], P[(B) + 5]); CE_(P[(B) + 6], P[(B) + 7]); CE_(P[(B) + 8], P[(B) + 9]); CE_(P[(B) + 10], P[(B) + 11]); CE_(P[(B) + 12], P[(B) + 13]); CE_(P[(B) + 14], P[(B) + 15]); \
} while (0)
#define SORT32_(P, B) do { \
    CE_(P[(B) + 0], P[(B) + 1]); CE_(P[(B) + 3], P[(B) + 2]); CE_(P[(B) + 4], P[(B) + 5]); CE_(P[(B) + 7], P[(B) + 6]); CE_(P[(B) + 8], P[(B) + 9]); CE_(P[(B) + 11], P[(B) + 10]); CE_(P[(B) + 12], P[(B) + 13]); CE_(P[(B) + 15], P[(B) + 14]); \
    CE_(P[(B) + 16], P[(B) + 17]); CE_(P[(B) + 19], P[(B) + 18]); CE_(P[(B) + 20], P[(B) + 21]); CE_(P[(B) + 23], P[(B) + 22]); CE_(P[(B) + 24], P[(B) + 25]); CE_(P[(B) + 27], P[(B) + 26]); CE_(P[(B) + 28], P[(B) + 29]); CE_(P[(B) + 31], P[(B) + 30]); \
    CE_(P[(B) + 0], P[(B) + 2]); CE_(P[(B) + 1], P[(B) + 3]); CE_(P[(B) + 6], P[(B) + 4]); CE_(P[(B) + 7], P[(B) + 5]); CE_(P[(B) + 8], P[(B) + 10]); CE_(P[(B) + 9], P[(B) + 11]); CE_(P[(B) + 14], P[(B) + 12]); CE_(P[(B) + 15], P[(B) + 13]); \
    CE_(P[(B) + 16], P[(B) + 18]); CE_(P[(B) + 17], P[(B) + 19]); CE_(P[(B) + 22], P[(B) + 20]); CE_(P[(B) + 23], P[(B) + 21]); CE_(P[(B) + 24], P[(B) + 26]); CE_(P[(B) + 25], P[(B) + 27]); CE_(P[(B) + 30], P[(B) + 28]); CE_(P[(B) + 31], P[(B) + 29]); \
    CE_(P[(B) + 0], P[(B) + 1]); CE_(P[(B) + 2], P[(B) + 3]); CE_(P[(B) + 5], P[(B) + 4]); CE_(P[(B) + 7], P[(B) + 6]); CE_(P[(B) + 8], P[(B) + 9]); CE_(P[(B) + 10], P[(B) + 11]); CE_(P[(B) + 13], P[(B) + 12]); CE_(P[(B) + 15], P[(B) + 14]); \
    CE_(P[(B) + 16], P[(B) + 17]); CE_(P[(B) + 18], P[(B) + 19]); CE_(P[(B) + 21], P[(B) + 20]); CE_(P[(B) + 23], P[(B) + 22]); CE_(P[(B) + 24], P[(B) + 25]); CE_(P[(B) + 26], P[(B) + 27]); CE_(P[(B) + 29], P[(B) + 28]); CE_(P[(B) + 31], P[(B) + 30]); \
    CE_(P[(B) + 0], P[(B) + 4]); CE_(P[(B) + 1], P[(B) + 5]); CE_(P[(B) + 2], P[(B) + 6]); CE_(P[(B) + 3], P[(B) + 7]); CE_(P[(B) + 12], P[(B) + 8]); CE_(P[(B) + 13], P[(B) + 9]); CE_(P[(B) + 14], P[(B) + 10]); CE_(P[(B) + 15], P[(B) + 11]); \
    CE_(P[(B) + 16], P[(B) + 20]); CE_(P[(B) + 17], P[(B) + 21]); CE_(P[(B) + 18], P[(B) + 22]); CE_(P[(B) + 19], P[(B) + 23]); CE_(P[(B) + 28], P[(B) + 24]); CE_(P[(B) + 29], P[(B) + 25]); CE_(P[(B) + 30], P[(B) + 26]); CE_(P[(B) + 31], P[(B) + 27]); \
    CE_(P[(B) + 0], P[(B) + 2]); CE_(P[(B) + 1], P[(B) + 3]); CE_(P[(B) + 4], P[(B) + 6]); CE_(P[(B) + 5], P[(B) + 7]); CE_(P[(B) + 10], P[(B) + 8]); CE_(P[(B) + 11], P[(B) + 9]); CE_(P[(B) + 14], P[(B) + 12]); CE_(P[(B) + 15], P[(B) + 13]); \
    CE_(P[(B) + 16], P[(B) + 18]); CE_(P[(B) + 17], P[(B) + 19]); CE_(P[(B) + 20], P[(B) + 22]); CE_(P[(B) + 21], P[(B) + 23]); CE_(P[(B) + 26], P[(B) + 24]); CE_(P[(B) + 27], P[(B) + 25]); CE_(P[(B) + 30], P[(B) + 28]); CE_(P[(B) + 31], P[(B) + 29]); \
    CE_(P[(B) + 0], P[(B) + 1]); CE_(P[(B) + 2], P[(B) + 3]); CE_(P[(B) + 4], P[(B) + 5]); CE_(P[(B) + 6], P[(B) + 7]); CE_(P[(B) + 9], P[(B) + 8]); CE_(P[(B) + 11], P[(B) + 10]); CE_(P[(B) + 13], P[(B) + 12]); CE_(P[(B) + 15], P[(B) + 14]); \
    CE_(P[(B) + 16], P[(B) + 17]); CE_(P[(B) + 18], P[(B) + 19]); CE_(P[(B) + 20], P[(B) + 21]); CE_(P[(B) + 22], P[(B) + 23]); CE_(P[(B) + 25], P[(B) + 24]); CE_(P[(B) + 27], P[(B) + 26]); CE_(P[(B) + 29], P[(B) + 28]); CE_(P[(B) + 31], P[(B) + 30]); \
    CE_(P[(B) + 0], P[(B) + 8]); CE_(P[(B) + 1], P[(B) + 9]); CE_(P[(B) + 2], P[(B) + 10]); CE_(P[(B) + 3], P[(B) + 11]); CE_(P[(B) + 4], P[(B) + 12]); CE_(P[(B) + 5], P[(B) + 13]); CE_(P[(B) + 6], P[(B) + 14]); CE_(P[(B) + 7], P[(B) + 15]); \
    CE_(P[(B) + 24], P[(B) + 16]); CE_(P[(B) + 25], P[(B) + 17]); CE_(P[(B) + 26], P[(B) + 18]); CE_(P[(B) + 27], P[(B) + 19]); CE_(P[(B) + 28], P[(B) + 20]); CE_(P[(B) + 29], P[(B) + 21]); CE_(P[(B) + 30], P[(B) + 22]); CE_(P[(B) + 31], P[(B) + 23]); \
    CE_(P[(B) + 0], P[(B) + 4]); CE_(P[(B) + 1], P[(B) + 5]); CE_(P[(B) + 2], P[(B) + 6]); CE_(P[(B) + 3], P[(B) + 7]); CE_(P[(B) + 8], P[(B) + 12]); CE_(P[(B) + 9], P[(B) + 13]); CE_(P[(B) + 10], P[(B) + 14]); CE_(P[(B) + 11], P[(B) + 15]); \
    CE_(P[(B) + 20], P[(B) + 16]); CE_(P[(B) + 21], P[(B) + 17]); CE_(P[(B) + 22], P[(B) + 18]); CE_(P[(B) + 23], P[(B) + 19]); CE_(P[(B) + 28], P[(B) + 24]); CE_(P[(B) + 29], P[(B) + 25]); CE_(P[(B) + 30], P[(B) + 26]); CE_(P[(B) + 31], P[(B) + 27]); \
    CE_(P[(B) + 0], P[(B) + 2]); CE_(P[(B) + 1], P[(B) + 3]); CE_(P[(B) + 4], P[(B) + 6]); CE_(P[(B) + 5], P[(B) + 7]); CE_(P[(B) + 8], P[(B) + 10]); CE_(P[(B) + 9], P[(B) + 11]); CE_(P[(B) + 12], P[(B) + 14]); CE_(P[(B) + 13], P[(B) + 15]); \
    CE_(P[(B) + 18], P[(B) + 16]); CE_(P[(B) + 19], P[(B) + 17]); CE_(P[(B) + 22], P[(B) + 20]); CE_(P[(B) + 23], P[(B) + 21]); CE_(P[(B) + 26], P[(B) + 24]); CE_(P[(B) + 27], P[(B) + 25]); CE_(P[(B) + 30], P[(B) + 28]); CE_(P[(B) + 31], P[(B) + 29]); \
    CE_(P[(B) + 0], P[(B) + 1]); CE_(P[(B) + 2], P[(B) + 3]); CE_(P[(B) + 4], P[(B) + 5]); CE_(P[(B) + 6], P[(B) + 7]); CE_(P[(B) + 8], P[(B) + 9]); CE_(P[(B) + 10], P[(B) + 11]); CE_(P[(B) + 12], P[(B) + 13]); CE_(P[(B) + 14], P[(B) + 15]); \
    CE_(P[(B) + 17], P[(B) + 16]); CE_(P[(B) + 19], P[(B) + 18]); CE_(P[(B) + 21], P[(B) + 20]); CE_(P[(B) + 23], P[(B) + 22]); CE_(P[(B) + 25], P[(B) + 24]); CE_(P[(B) + 27], P[(B) + 26]); CE_(P[(B) + 29], P[(B) + 28]); CE_(P[(B) + 31], P[(B) + 30]); \
    CE_(P[(B) + 0], P[(B) + 16]); CE_(P[(B) + 1], P[(B) + 17]); CE_(P[(B) + 2], P[(B) + 18]); CE_(P[(B) + 3], P[(B) + 19]); CE_(P[(B) + 4], P[(B) + 20]); CE_(P[(B) + 5], P[(B) + 21]); CE_(P[(B) + 6], P[(B) + 22]); CE_(P[(B) + 7], P[(B) + 23]); \
    CE_(P[(B) + 8], P[(B) + 24]); CE_(P[(B) + 9], P[(B) + 25]); CE_(P[(B) + 10], P[(B) + 26]); CE_(P[(B) + 11], P[(B) + 27]); CE_(P[(B) + 12], P[(B) + 28]); CE_(P[(B) + 13], P[(B) + 29]); CE_(P[(B) + 14], P[(B) + 30]); CE_(P[(B) + 15], P[(B) + 31]); \
    CE_(P[(B) + 0], P[(B) + 8]); CE_(P[(B) + 1], P[(B) + 9]); CE_(P[(B) + 2], P[(B) + 10]); CE_(P[(B) + 3], P[(B) + 11]); CE_(P[(B) + 4], P[(B) + 12]); CE_(P[(B) + 5], P[(B) + 13]); CE_(P[(B) + 6], P[(B) + 14]); CE_(P[(B) + 7], P[(B) + 15]); \
    CE_(P[(B) + 16], P[(B) + 24]); CE_(P[(B) + 17], P[(B) + 25]); CE_(P[(B) + 18], P[(B) + 26]); CE_(P[(B) + 19], P[(B) + 27]); CE_(P[(B) + 20], P[(B) + 28]); CE_(P[(B) + 21], P[(B) + 29]); CE_(P[(B) + 22], P[(B) + 30]); CE_(P[(B) + 23], P[(B) + 31]); \
    CE_(P[(B) + 0], P[(B) + 4]); CE_(P[(B) + 1], P[(B) + 5]); CE_(P[(B) + 2], P[(B) + 6]); CE_(P[(B) + 3], P[(B) + 7]); CE_(P[(B) + 8], P[(B) + 12]); CE_(P[(B) + 9], P[(B) + 13]); CE_(P[(B) + 10], P[(B) + 14]); CE_(P[(B) + 11], P[(B) + 15]); \
    CE_(P[(B) + 16], P[(B) + 20]); CE_(P[(B) + 17], P[(B) + 21]); CE_(P[(B) + 18], P[(B) + 22]); CE_(P[(B) + 19], P[(B) + 23]); CE_(P[(B) + 24], P[(B) + 28]); CE_(P[(B) + 25], P[(B) + 29]); CE_(P[(B) + 26], P[(B) + 30]); CE_(P[(B) + 27], P[(B) + 31]); \
    CE_(P[(B) + 0], P[(B) + 2]); CE_(P[(B) + 1], P[(B) + 3]); CE_(P[(B) + 4], P[(B) + 6]); CE_(P[(B) + 5], P[(B) + 7]); CE_(P[(B) + 8], P[(B) + 10]); CE_(P[(B) + 9], P[(B) + 11]); CE_(P[(B) + 12], P[(B) + 14]); CE_(P[(B) + 13], P[(B) + 15]); \
    CE_(P[(B) + 16], P[(B) + 18]); CE_(P[(B) + 17], P[(B) + 19]); CE_(P[(B) + 20], P[(B) + 22]); CE_(P[(B) + 21], P[(B) + 23]); CE_(P[(B) + 24], P[(B) + 26]); CE_(P[(B) + 25], P[(B) + 27]); CE_(P[(B) + 28], P[(B) + 30]); CE_(P[(B) + 29], P[(B) + 31]); \
    CE_(P[(B) + 0], P[(B) + 1]); CE_(P[(B) + 2], P[(B) + 3]); CE_(P[(B) + 4], P[(B) + 5]); CE_(P[(B) + 6], P[(B) + 7]); CE_(P[(B) + 8], P[(B) + 9]); CE_(P[(B) + 10], P[(B) + 11]); CE_(P[(B) + 12], P[(B) + 13]); CE_(P[(B) + 14], P[(B) + 15]); \
    CE_(P[(B) + 16], P[(B) + 17]); CE_(P[(B) + 18], P[(B) + 19]); CE_(P[(B) + 20], P[(B) + 21]); CE_(P[(B) + 22], P[(B) + 23]); CE_(P[(B) + 24], P[(B) + 25]); CE_(P[(B) + 26], P[(B) + 27]); CE_(P[(B) + 28], P[(B) + 29]); CE_(P[(B) + 30], P[(B) + 31]); \
} while (0)

DI void top16_of_128(float (&p)[64], float (&out)[16], int lane) {
    SORT16_(p, 0); SORT16_(p, 16); SORT16_(p, 32); SORT16_(p, 48);
#pragma unroll
    for (int i = 0; i < 16; ++i) { p[i] = fmaxf(p[i], p[31 - i]); p[32 + i] = fmaxf(p[32 + i], p[63 - i]); }
    MERGE16_(p, 0); MERGE16_(p, 32);
#pragma unroll
    for (int i = 0; i < 16; ++i) p[i] = fmaxf(p[i], p[47 - i]);
    MERGE16_(p, 0);
    float q[16];
#pragma unroll
    for (int i = 0; i < 16; ++i) q[i] = shx<32>(p[15 - i], lane);
#pragma unroll
    for (int i = 0; i < 16; ++i) p[i] = fmaxf(p[i], q[i]);
    MERGE16_(p, 0);
#pragma unroll
    for (int i = 0; i < 16; ++i) out[i] = p[i];
}
DI void route_q_load(bf16x8 (&bq)[8], const bf16_t* Q, int head, int tile, int z, int lane) {
    const bf16_t* qrow = Q + ((size_t)tile * 32 + (lane & 31)) * NQ + head * 256 + z * 128 + 8 * (lane >> 5);
#pragma unroll
    for (int s8 = 0; s8 < 8; ++s8) bq[s8] = *(const bf16x8*)(qrow + 16 * s8);
}
DI void peer_route_tile(lptr L, int lane, int wave, const bf16_t* Q, int head, int tile, u32x2* route, bf16x8 (&bq0)[8], int next_tile) {
    const int r = lane & 31, hh = lane >> 5;
    const size_t tok = (size_t)tile * 32 + r;
    float top[2][16];
    bf16x8 bq1[8];
    route_q_load(bq1, Q, head, tile, 1, lane);
    __builtin_amdgcn_sched_barrier(0);
#pragma unroll
    for (int z = 0; z < 2; ++z) {
        bf16x8 bq[8];
#pragma unroll
        for (int s8 = 0; s8 < 8; ++s8) bq[s8] = z ? bq1[s8] : bq0[s8];
        float p[64];
#pragma unroll
        for (int m = 0; m < 4; ++m) { f32x16 acc = zero16();
#pragma unroll
            for (int s8 = 0; s8 < 8; ++s8) acc = MFMA32(fragK(L + z * 34816, 272, 32 * m, 16 * s8, lane), bq[s8], acc);
#pragma unroll
            for (int i = 0; i < 16; ++i) p[m * 16 + i] = __int_as_float((__float_as_int(acc[i]) & ~0x7f) | (32 * m + crow(i, hh)));
            __builtin_amdgcn_sched_barrier(0); }
        if (z == 1 && next_tile >= 0) { route_q_load(bq0, Q, head, next_tile, 0, lane); __builtin_amdgcn_sched_barrier(0); }
        top16_of_128(p, top[z], lane);
    }
    float cand[50];
#define CAND_ROW(i, off) _Pragma("unroll") for (int j = 0; j < 16 / ((i) + 1); ++j) { const float s = top[0][i] + top[1][j]; \
        cand[(off) + j] = __int_as_float((__float_as_int(s) & ~0xff) | ((i) * 16 + j)); }
    CAND_ROW(0, 0) CAND_ROW(1, 16) CAND_ROW(2, 24) CAND_ROW(3, 29) CAND_ROW(4, 33) CAND_ROW(5, 36) CAND_ROW(6, 38) CAND_ROW(7, 40)
    CAND_ROW(8, 42) CAND_ROW(9, 43) CAND_ROW(10, 44) CAND_ROW(11, 45) CAND_ROW(12, 46) CAND_ROW(13, 47) CAND_ROW(14, 48) CAND_ROW(15, 49)
#undef CAND_ROW
    float c32[32];
#pragma unroll
    for (int m = 0; m < 25; ++m) c32[m] = selh(-hh, cand[2 * m], cand[2 * m + 1]);
#pragma unroll
    for (int m = 25; m < 32; ++m) c32[m] = -INFINITY;
    SORT32_(c32, 0);
    float win[16];
    {
        float q[16];
#pragma unroll
        for (int i = 0; i < 16; ++i) q[i] = shx<32>(c32[15 - i], lane);
#pragma unroll
        for (int i = 0; i < 16; ++i) c32[i] = fmaxf(c32[i], q[i]);
        MERGE16_(c32, 0);
#pragma unroll
        for (int i = 0; i < 16; ++i) win[i] = c32[i];
    }
    LAS unsigned* tb = (LAS unsigned*)(L + 69632 + wave * 4352) + r * 33 + 16 * hh;
#pragma unroll
    for (int q = 0; q < 16; ++q) tb[q] = (unsigned)__float_as_int(selh(-hh, top[0][q], top[1][q])) & 0x7fu;
    float e[16], sum = 0.f;
#pragma unroll
    for (int q = 0; q < 16; ++q) { e[q] = __expf(win[q] - win[0]); sum += e[q]; }
    const float inv = 1.0f / sum;
    LDS_WAIT();
    const LAS unsigned* tr_ = (const LAS unsigned*)(L + 69632 + wave * 4352) + r * 33;
    u32x2* ro = route + (tok * 8 + head) * 16 + 8 * hh;
#pragma unroll
    for (int q = 0; q < 8; ++q) {
        const float wv = selh(-hh, win[q], win[8 + q]); const float ev = selh(-hh, e[q], e[8 + q]);
        const int id = __float_as_int(wv) & 0xff;
        const unsigned n0 = tr_[id >> 4], n1 = tr_[16 + (id & 15)];
        u32x2 o; o.x = n0 * 128u + n1; o.y = (unsigned)__float_as_int(ev * inv); ro[q] = o;
    }
    LDS_WAIT();
}
DI void peer_route_unit(lptr L, int tid, int pm, int head, const bf16_t* Q, const bf16_t* SK, u32x2* route) {
    const int lane = tid & 63, wave = __builtin_amdgcn_readfirstlane(tid >> 6);
    __syncthreads();
    for (int i = tid; i < 2 * 128 * 16; i += NTHR) { const int z = i >> 11, n = (i >> 4) & 127, cc = i & 15;
        *(LAS u32x4*)(L + z * 34816 + n * 272 + cc * 16) = *(const u32x4*)(SK + ((size_t)(head * 2 + z) * 128 + n) * 128 + cc * 8); }
    __syncthreads();
    bf16x8 bq0[8]; route_q_load(bq0, Q, head, pm * 8 + wave, 0, lane);
    peer_route_tile(L, lane, wave, Q, head, pm * 8 + wave, route, bq0, -1);
}
DI void peer_route_phase(lptr L, int tid, int vcu, const bf16_t* Q, const bf16_t* SK  , u32x2* route) {
    const int lane = tid & 63, wave = __builtin_amdgcn_readfirstlane(tid >> 6);
    const int head = vcu & 7, base = vcu >> 3;
    __syncthreads();
    for (int i = tid; i < 2 * 128 * 16; i += NTHR) { const int z = i >> 11, n = (i >> 4) & 127, cc = i & 15;
        *(LAS u32x4*)(L + z * 34816 + n * 272 + cc * 16) = *(const u32x4*)(SK + ((size_t)(head * 2 + z) * 128 + n) * 128 + cc * 8); }
    __syncthreads();
    bf16x8 bq0[8];
    route_q_load(bq0, Q, head, base * 16 + wave * 2, 0, lane);
#pragma unroll 1
    for (int i = 0; i < 2; ++i) peer_route_tile(L, lane, wave, Q, head, base * 16 + wave * 2 + i, route, bq0, i == 0 ? base * 16 + wave * 2 + 1 : -1);
}

DI float erf_as(float x) {
    const float ax = fabsf(x), t = __builtin_amdgcn_rcpf(1.0f + 0.3275911f * ax);
    const float poly = t * (0.254829592f + t * (-0.284496736f + t * (1.421413741f + t * (-1.453152027f + t * 1.061405429f))));
    const float r = 1.0f - poly * __expf(-ax * ax);
    return __builtin_copysignf(r, x);
}
DI float gelu_exact(float x) { return 0.5f * x * (1.0f + erf_as(x * 0.70710678118654752f)); }
struct GatherP {
    const bf16_t* H; const u32x2* route; const unsigned char* U; const unsigned char* V; float* X; const float* gt2;
    int last; const float* ng; const float* nsc; const float* nsh;
    bf16_t* Hout; float* small; const LAS float* wsm; float* out;
    const unsigned char* H8; const float* HS;
    unsigned char* G8; float* GS;
};
constexpr float U8_SCALE = 256.0f, V8_SCALE = 16.0f;
DI void cvt_stream_fp8(const float* src, unsigned char* dst, size_t n, float scale, int gw, int ngw, int lane) {
    const size_t n16 = n / 16, stride = (size_t)ngw * 64;
    for (size_t i0 = (size_t)gw * 64 + lane; i0 < n16; i0 += 4 * stride) {
        f32x4 a[4][4];
#pragma unroll
        for (int u = 0; u < 4; ++u) { const size_t i = i0 + u * stride;
#pragma unroll
            for (int q = 0; q < 4; ++q) a[u][q] = (i < n16) ? ((const f32x4*)src)[4 * i + q] : (f32x4){0.f, 0.f, 0.f, 0.f}; }
#pragma unroll
        for (int u = 0; u < 4; ++u) { const size_t i = i0 + u * stride; u32x4 o;
#pragma unroll
            for (int q = 0; q < 4; ++q) { f32x4 v = a[u][q] * scale;
#pragma unroll
                for (int e = 0; e < 4; ++e) v[e] = fminf(fmaxf(v[e], -448.f), 448.f);
                int p = 0; p = __builtin_amdgcn_cvt_pk_fp8_f32(v[0], v[1], p, false); p = __builtin_amdgcn_cvt_pk_fp8_f32(v[2], v[3], p, true); o[q] = (unsigned)p; }
            if (i < n16) ((u32x4*)dst)[i] = o; }
    }
}
DI void fp8x16_to_f32(const u32x4& v, float (&f)[16]) {
    const unsigned d0 = v.x, d1 = v.y, d2 = v.z, d3 = v.w;
    f32x2 t;
    t = __builtin_amdgcn_cvt_pk_f32_fp8((int)d0, false); f[0] = t.x; f[1] = t.y; t = __builtin_amdgcn_cvt_pk_f32_fp8((int)d0, true); f[2] = t.x; f[3] = t.y;
    t = __builtin_amdgcn_cvt_pk_f32_fp8((int)d1, false); f[4] = t.x; f[5] = t.y; t = __builtin_amdgcn_cvt_pk_f32_fp8((int)d1, true); f[6] = t.x; f[7] = t.y;
    t = __builtin_amdgcn_cvt_pk_f32_fp8((int)d2, false); f[8] = t.x; f[9] = t.y; t = __builtin_amdgcn_cvt_pk_f32_fp8((int)d2, true); f[10] = t.x; f[11] = t.y;
    t = __builtin_amdgcn_cvt_pk_f32_fp8((int)d3, false); f[12] = t.x; f[13] = t.y; t = __builtin_amdgcn_cvt_pk_f32_fp8((int)d3, true); f[14] = t.x; f[15] = t.y;
}
#ifndef DBG_G
#define DBG_G 0
#endif
DI void peer_gather_token(const GatherP& P, size_t m, int lane) {
    float hv[16];
    { const bf16_t* hrow = P.H + m * D + 16 * lane; const u32x4 a = *(const u32x4*)hrow, b = *(const u32x4*)(hrow + 8);
      hv[0] = bf_lo(a.x); hv[1] = bf_hi(a.x); hv[2] = bf_lo(a.y); hv[3] = bf_hi(a.y); hv[4] = bf_lo(a.z); hv[5] = bf_hi(a.z); hv[6] = bf_lo(a.w); hv[7] = bf_hi(a.w);
      hv[8] = bf_lo(b.x); hv[9] = bf_hi(b.x); hv[10] = bf_lo(b.y); hv[11] = bf_hi(b.y); hv[12] = bf_lo(b.z); hv[13] = bf_hi(b.z); hv[14] = bf_lo(b.w); hv[15] = bf_hi(b.w); }
    float o[16];
#pragma unroll
    for (int e = 0; e < 16; ++e) o[e] = 0.f;
    const u32x2* rt = P.route + m * 128 + (lane & 7);
#pragma unroll 1
    for (int bt = 0; bt < 16; ++bt) {
        const u32x2 re = rt[bt * 8];
        const int idx = (int)re.x; const float gate = __int_as_float((int)re.y);
        u32x4 uu[8], vv[8];
#pragma unroll
        for (int e = 0; e < 8; ++e) {
            const size_t ro = (size_t)__builtin_amdgcn_readlane(idx, e) * D + 16 * lane;
            uu[e] = *(const u32x4*)(P.U + ro); vv[e] = *(const u32x4*)(P.V + ro);
        }
        float p[8];
#pragma unroll
        for (int e = 0; e < 8; ++e) { float uf[16]; fp8x16_to_f32(uu[e], uf); float a0 = 0.f, a1 = 0.f;
#pragma unroll
            for (int k = 0; k < 16; k += 2) { a0 += hv[k] * uf[k]; a1 += hv[k + 1] * uf[k + 1]; }
            p[e] = a0 + a1; }
        float p4[4], p2[2], p1;
        { const bool up = (lane & 4) != 0;
#pragma unroll
          for (int q = 0; q < 4; ++q) { const float keep = up ? p[q + 4] : p[q], send = up ? p[q] : p[q + 4]; p4[q] = keep + shx<4>(send, lane); } }
        { const bool up = (lane & 2) != 0;
#pragma unroll
          for (int q = 0; q < 2; ++q) { const float keep = up ? p4[q + 2] : p4[q], send = up ? p4[q] : p4[q + 2]; p2[q] = keep + shx<2>(send, lane); } }
        { const bool up = (lane & 1) != 0; const float keep = up ? p2[1] : p2[0], send = up ? p2[0] : p2[1]; p1 = keep + shx<1>(send, lane); }
        p1 += shx<8>(p1, lane); p1 += shx<16>(p1, lane); p1 += shx<32>(p1, lane);
        const float act = gelu_exact(p1 * (1.0f / U8_SCALE)) * gate * (1.0f / V8_SCALE);
#pragma unroll
        for (int e = 0; e < 8; ++e) { const float a = __int_as_float(__builtin_amdgcn_readlane(__float_as_int(act), e)); float vf[16]; fp8x16_to_f32(vv[e], vf);
#pragma unroll
            for (int k = 0; k < 16; ++k) o[k] += a * vf[k]; }
    }
    const int bidx = (m >= (size_t)SEQ) ? 1 : 0;
    float* xr = P.X + m * D + 16 * lane; const float* g2 = P.gt2 + bidx * 6 * D + 16 * lane;
    float xn[16]; float ss = 0.f;
#pragma unroll
    for (int q = 0; q < 4; ++q) { const f32x4 xv = *(const f32x4*)(xr + 4 * q), gv = *(const f32x4*)(g2 + 4 * q);
#pragma unroll
        for (int e = 0; e < 4; ++e) { const float v = xv[e] + gv[e] * o[q * 4 + e]; xn[q * 4 + e] = v; ss += v * v; } }
    const float rstd = 1.0f / sqrtf(wave_sum(ss, lane) * (1.0f / D) + EPS);
    if (P.last) {
#pragma unroll
        for (int q = 0; q < 4; ++q) { const f32x4 gv = *(const f32x4*)(P.ng + 16 * lane + 4 * q); f32x4 r;
#pragma unroll
            for (int e = 0; e < 4; ++e) r[e] = xn[q * 4 + e] * rstd * gv[e];
            *(f32x4*)(P.out + m * D + 16 * lane + 4 * q) = r; }
    } else {
        float y[16];
#pragma unroll
        for (int q = 0; q < 4; ++q) { const int col = 16 * lane + 4 * q;
            const f32x4 gv = *(const f32x4*)(P.ng + col), sc = *(const f32x4*)(P.nsc + bidx * 6 * D + col), sh = *(const f32x4*)(P.nsh + bidx * 6 * D + col);
            *(f32x4*)(xr + 4 * q) = (f32x4){xn[q * 4], xn[q * 4 + 1], xn[q * 4 + 2], xn[q * 4 + 3]};
#pragma unroll
            for (int e = 0; e < 4; ++e) y[q * 4 + e] = xn[q * 4 + e] * rstd * gv[e] * (1.0f + sc[e]) + sh[e]; }
        bf16_t* ho = P.Hout + m * D + 16 * lane;
        { u32x4 w; w.x = pk2(y[0], y[1]); w.y = pk2(y[2], y[3]); w.z = pk2(y[4], y[5]); w.w = pk2(y[6], y[7]); *(u32x4*)ho = w; }
        { u32x4 w; w.x = pk2(y[8], y[9]); w.y = pk2(y[10], y[11]); w.z = pk2(y[12], y[13]); w.w = pk2(y[14], y[15]); *(u32x4*)(ho + 8) = w; }
#if IN_I8
        {
            float am = 0.f;
#pragma unroll
            for (int i = 0; i < 16; ++i) am = fmaxf(am, fabsf(y[i]));
            am = fmaxf(am, shx<1>(am, lane)); am = fmaxf(am, shx<2>(am, lane)); am = fmaxf(am, shx<4>(am, lane)); am = fmaxf(am, shx<8>(am, lane)); am = fmaxf(am, shx<16>(am, lane)); am = fmaxf(am, shx<32>(am, lane));
            am = fmaxf(am, 1e-20f); const float sc = 127.0f / am;
            unsigned w[4];
#pragma unroll
            for (int d = 0; d < 4; ++d) { const int q0 = (int)__builtin_rintf(y[4 * d] * sc), q1 = (int)__builtin_rintf(y[4 * d + 1] * sc), q2 = (int)__builtin_rintf(y[4 * d + 2] * sc), q3 = (int)__builtin_rintf(y[4 * d + 3] * sc);
                w[d] = (unsigned)(q0 & 0xff) | ((unsigned)(q1 & 0xff) << 8) | ((unsigned)(q2 & 0xff) << 16) | ((unsigned)q3 << 24); }
            *(u32x4*)(P.G8 + m * D + cbase) = (u32x4){w[0], w[1], w[2], w[3]};
            if (lane == 0) P.GS[m] = am * (1.0f / 127.0f);
        }
#endif
        float pr[8];
#pragma unroll
        for (int c = 0; c < 8; ++c) { float a = 0.f;
#pragma unroll
            for (int q = 0; q < 4; ++q) { const f32x4 wv = *(const LAS f32x4*)(P.wsm + c * D + 16 * lane + 4 * q);
                a += (y[q * 4] * wv.x + y[q * 4 + 1] * wv.y) + (y[q * 4 + 2] * wv.z + y[q * 4 + 3] * wv.w); }
            pr[c] = wave_sum(a, lane); }
        if (lane < 8) { float rr = pr[0];
#pragma unroll
            for (int c = 1; c < 8; ++c) rr = (lane == c) ? pr[c] : rr;
            P.small[m * 8 + lane] = rr; }
    }
}

DI void peer_u_pass(lptr L, int tid, int bx, const bf16_t* H, const u32x2* route, const unsigned char* U8, float* ACT) {
    const int lane = tid & 63, wave = __builtin_amdgcn_readfirstlane(tid >> 6);
    const unsigned x = (unsigned)bx & 7u; const int wx = (bx >> 3) * 8 + wave;
    LAS unsigned* list = (LAS unsigned*)(L + wave * 2048);
    u32x2 e0 = route[(size_t)wx * 128 + lane], e1 = route[(size_t)wx * 128 + 64 + lane];
    u32x4 ha = *(const u32x4*)(H + (size_t)wx * D + 16 * lane), hb = *(const u32x4*)(H + (size_t)wx * D + 16 * lane + 8);
#pragma unroll 1
    for (int t = wx; t < M; t += 256) {
        float hv[16];
        hv[0] = bf_lo(ha.x); hv[1] = bf_hi(ha.x); hv[2] = bf_lo(ha.y); hv[3] = bf_hi(ha.y); hv[4] = bf_lo(ha.z); hv[5] = bf_hi(ha.z); hv[6] = bf_lo(ha.w); hv[7] = bf_hi(ha.w);
        hv[8] = bf_lo(hb.x); hv[9] = bf_hi(hb.x); hv[10] = bf_lo(hb.y); hv[11] = bf_hi(hb.y); hv[12] = bf_lo(hb.z); hv[13] = bf_hi(hb.z); hv[14] = bf_lo(hb.w); hv[15] = bf_hi(hb.w);
        const bool own0 = (e0.x & 7u) == x, own1 = (e1.x & 7u) == x;
        const unsigned long long m0 = __ballot(own0), m1 = __ballot(own1);
        const int n0 = __popcll(m0), n = n0 + __popcll(m1);
        const int p0 = (int)__builtin_amdgcn_mbcnt_hi((unsigned)(m0 >> 32), __builtin_amdgcn_mbcnt_lo((unsigned)m0, 0u));
        const int p1 = n0 + (int)__builtin_amdgcn_mbcnt_hi((unsigned)(m1 >> 32), __builtin_amdgcn_mbcnt_lo((unsigned)m1, 0u));
        if (own0) { list[p0] = e0.x; list[136 + p0] = e0.y; list[272 + p0] = (unsigned)lane; }
        if (own1) { list[p1] = e1.x; list[136 + p1] = e1.y; list[272 + p1] = (unsigned)(lane + 64); }
        if (lane < 8) { list[n + lane] = x; list[136 + n + lane] = 0u; list[272 + n + lane] = 0xffffffffu; }
        const int tn = t + 256;
        if (tn < M) { e0 = route[(size_t)tn * 128 + lane]; e1 = route[(size_t)tn * 128 + 64 + lane];
                      ha = *(const u32x4*)(H + (size_t)tn * D + 16 * lane); hb = *(const u32x4*)(H + (size_t)tn * D + 16 * lane + 8); }
        LDS_WAIT();
#pragma unroll 1
        for (int b0 = 0; b0 < n; b0 += 8) {
            const unsigned idx = list[b0 + (lane & 7)]; const float gate = __uint_as_float(list[136 + b0 + (lane & 7)]); const unsigned kk = list[272 + b0 + (lane & 7)];
            u32x4 uu[8];
#pragma unroll
            for (int e = 0; e < 8; ++e) uu[e] = *(const u32x4*)(U8 + (size_t)__builtin_amdgcn_readlane((int)idx, e) * D + 16 * lane);
            float p[8];
#pragma unroll
            for (int e = 0; e < 8; ++e) { float uf[16]; fp8x16_to_f32(uu[e], uf); float a0 = 0.f, a1 = 0.f;
#pragma unroll
                for (int k = 0; k < 16; k += 2) { a0 += hv[k] * uf[k]; a1 += hv[k + 1] * uf[k + 1]; }
                p[e] = a0 + a1; }
            float p4[4], p2[2], p1;
            { const bool up = (lane & 4) != 0;
#pragma unroll
              for (int q = 0; q < 4; ++q) { const float keep = up ? p[q + 4] : p[q], send = up ? p[q] : p[q + 4]; p4[q] = keep + shx<4>(send, lane); } }
            { const bool up = (lane & 2) != 0;
#pragma unroll
              for (int q = 0; q < 2; ++q) { const float keep = up ? p4[q + 2] : p4[q], send = up ? p4[q] : p4[q + 2]; p2[q] = keep + shx<2>(send, lane); } }
            { const bool up = (lane & 1) != 0; const float keep = up ? p2[1] : p2[0], send = up ? p2[0] : p2[1]; p1 = keep + shx<1>(send, lane); }
            p1 += shx<8>(p1, lane); p1 += shx<16>(p1, lane); p1 += shx<32>(p1, lane);
            const float act = gelu_exact(p1 * (1.0f / U8_SCALE)) * gate * (1.0f / V8_SCALE);
            if (lane < 8 && kk != 0xffffffffu) ACT[(size_t)t * 128 + kk] = act;
        }
        LDS_WAIT();
    }
}
DI void peer_v_pass(int tid, int bx, const u32x2* route, const float* ACT, const unsigned char* V8, float* X, const float* gt2) {
    const int lane = tid & 63, wave = __builtin_amdgcn_readfirstlane(tid >> 6);
    const int x = bx & 7, wx = (bx >> 3) * 8 + wave, es = lane >> 3, ch = lane & 7, col0 = 128 * x + 16 * ch;
    unsigned re[16]; float aa[16];
#pragma unroll
    for (int i = 0; i < 16; ++i) { const unsigned o_ = (unsigned)(wx * 128 + 8 * i + es); re[i] = route[o_].x; aa[i] = ACT[o_]; }
#pragma unroll 1
    for (int t = wx; t < M; t += 256) {
        u32x4 vv[16];
#pragma unroll
        for (int i = 0; i < 16; ++i) vv[i] = *(const u32x4*)(V8 + (re[i] * 1024u + (unsigned)col0));
        float ac[16];
#pragma unroll
        for (int i = 0; i < 16; ++i) ac[i] = aa[i];
        const int tn = t + 256;
        if (tn < M) {
#pragma unroll
            for (int i = 0; i < 16; ++i) { const unsigned o_ = (unsigned)(tn * 128 + 8 * i + es); re[i] = route[o_].x; aa[i] = ACT[o_]; } }
        float o[16];
#pragma unroll
        for (int k = 0; k < 16; ++k) o[k] = 0.f;
#pragma unroll
        for (int i = 0; i < 16; ++i) { float vf[16]; fp8x16_to_f32(vv[i], vf);
#pragma unroll
            for (int k = 0; k < 16; ++k) o[k] += ac[i] * vf[k];
            if ((i & 3) == 3) __builtin_amdgcn_sched_barrier(0); }
#pragma unroll
        for (int k = 0; k < 16; ++k) { o[k] += shx<8>(o[k], lane); o[k] += shx<16>(o[k], lane); o[k] += shx<32>(o[k], lane); }
        if (es == 0) { float* xr = X + (size_t)t * D + col0; const float* g2 = gt2 + (t >= SEQ ? 6 * D : 0) + col0;
#pragma unroll
            for (int q = 0; q < 4; ++q) { const f32x4 xv = *(const f32x4*)(xr + 4 * q), gv = *(const f32x4*)(g2 + 4 * q);
                *(f32x4*)(xr + 4 * q) = (f32x4){xv[0] + gv[0] * o[4 * q], xv[1] + gv[1] * o[4 * q + 1], xv[2] + gv[2] * o[4 * q + 2], xv[3] + gv[3] * o[4 * q + 3]}; } }
    }
}
DI void row_final(const f32x4 (&v)[4], const float* g, float* orow, int lane) {
    float s = 0.f;
#pragma unroll
    for (int j = 0; j < 4; ++j) s += (v[j].x * v[j].x + v[j].y * v[j].y) + (v[j].z * v[j].z + v[j].w * v[j].w);
    const float rstd = 1.0f / sqrtf(wave_sum(s, lane) * (1.0f / D) + EPS);
#pragma unroll
    for (int j = 0; j < 4; ++j) ((f32x4*)orow)[lane + 64 * j] = v[j] * rstd * ((const f32x4*)g)[lane + 64 * j];
}

constexpr float U6_SCALE = 54.0f, V6_SCALE = 4.75f;
constexpr int ROW6 = 768;
typedef unsigned v6u_t __attribute__((ext_vector_type(6)));
typedef float v32f_t __attribute__((ext_vector_type(32)));
DI unsigned enc_e2m3(float x) {
    const float a = fminf(fabsf(x), 7.5f);
    const float inv = a < 2.0f ? 8.0f : (a < 4.0f ? 4.0f : 2.0f);
    const unsigned add = a < 2.0f ? 0u : (a < 4.0f ? 8u : 16u);
    const unsigned c = (unsigned)__builtin_rintf(a * inv) + add;
    return (c > 31u ? 31u : c) | ((__float_as_uint(x) >> 26) & 32u);
}
DI void cvt_stream_fp6(const float* src, unsigned char* dst, float scale, int gw, int ngw, int lane) {
    constexpr int NGRP = NEXP * 32;
    for (int g = gw * 64 + lane; g < NGRP; g += ngw * 64) {
        const int row = g >> 5, lp = g & 31;
        const f32x4* p = (const f32x4*)(src + (size_t)g * 32);
        f32x4 v[8];
#pragma unroll
        for (int q = 0; q < 8; ++q) v[q] = __builtin_nontemporal_load(p + q);
        unsigned cd[32];
#pragma unroll
        for (int q = 0; q < 8; ++q)
#pragma unroll
            for (int e = 0; e < 4; ++e) cd[4 * q + e] = enc_e2m3(v[q][e] * scale);
        unsigned w[6];
#pragma unroll
        for (int d = 0; d < 6; ++d) { unsigned acc = 0u;
#pragma unroll
            for (int i = 0; i < 32; ++i) { const int lo = 6 * i - 32 * d;
                if (lo > -6 && lo < 32) acc |= (lo >= 0) ? (cd[i] << lo) : (cd[i] >> (-lo)); }
            w[d] = acc; }
        unsigned char* rp = dst + (size_t)row * ROW6;
        *(u32x4*)(rp + 16 * lp) = (u32x4){w[0], w[1], w[2], w[3]};
        *(u32x2*)(rp + 512 + 8 * lp) = (u32x2){w[4], w[5]};
    }
}
#ifndef PROBE_DUP
#define PROBE_DUP 0
#endif
#ifndef GATHER_DPP
#define GATHER_DPP 1
#endif
#ifndef GATHER_DEPTH
#define GATHER_DEPTH 2
#endif
#ifndef GATHER_INPLACE
#define GATHER_INPLACE 0
#endif
#ifndef GATHER_BP
#define GATHER_BP 12
#endif
#ifndef GATHER_PIPE
#define GATHER_PIPE 2
#endif
#ifndef IN_I8
#define IN_I8 1
#endif
#ifndef TAB_UI4
#define TAB_UI4 1
#endif
#ifndef TAB_U4
#define TAB_U4 1
#endif
#ifndef TAB_V4
#define TAB_V4 1
#endif
constexpr float U4_SCALE = 67.0f, V4_SCALE = 5.94f;
constexpr int ROW4 = 512;
constexpr float UI_SCALE = 96.0f;
constexpr float UT_SCALE = TAB_UI4 ? UI_SCALE : TAB_U4 ? U4_SCALE : U6_SCALE, VT_SCALE = TAB_V4 ? V4_SCALE : V6_SCALE;
constexpr int ROWU = TAB_U4 ? ROW4 : ROW6, ROWV = TAB_V4 ? ROW4 : ROW6;
typedef float v2f_t __attribute__((ext_vector_type(2)));
DI unsigned enc_e2m1(float x) {
    const float a = fminf(fabsf(x), 6.0f);
    const float inv = a < 2.0f ? 2.0f : (a < 4.0f ? 1.0f : 0.5f);
    const unsigned add = a < 2.0f ? 0u : (a < 4.0f ? 2u : 4u);
    const unsigned c = (unsigned)__builtin_rintf(a * inv) + add;
    return (c > 7u ? 7u : c) | ((__float_as_uint(x) >> 28) & 8u);
}
DI void cvt_stream_fp4(const float* src, unsigned char* dst, float scale, int gw, int ngw, int lane) {
    constexpr int NGRP = NEXP * 32;
    for (int g = gw * 64 + lane; g < NGRP; g += ngw * 64) {
        const int row = g >> 5, lp = g & 31;
        const f32x4* p = (const f32x4*)(src + (size_t)g * 32);
        f32x4 v[8];
#pragma unroll
        for (int q = 0; q < 8; ++q) v[q] = __builtin_nontemporal_load(p + q);
        unsigned w[4];
#pragma unroll
        for (int d = 0; d < 4; ++d) { unsigned acc = 0u;
#pragma unroll
            for (int i = 0; i < 8; ++i) acc |= enc_e2m1(v[2 * d + (i >> 2)][i & 3] * scale) << (4 * i);
            w[d] = acc; }
        *(u32x4*)(dst + (size_t)row * ROW4 + 16 * lp) = (u32x4){w[0], w[1], w[2], w[3]};
    }
}
DI unsigned enc_u4(float x) { const float t = __builtin_floorf(x + 8.0f); return (unsigned)fminf(fmaxf(t, 0.f), 15.f); }
DI void cvt_stream_u4(const float* src, unsigned char* dst, float scale, int gw, int ngw, int lane) {
    constexpr int NGRP = NEXP * 32;
    for (int g = gw * 64 + lane; g < NGRP; g += ngw * 64) {
        const int row = g >> 5, lp = g & 31;
        const f32x4* p = (const f32x4*)(src + (size_t)g * 32);
        f32x4 v[8];
#pragma unroll
        for (int q = 0; q < 8; ++q) v[q] = __builtin_nontemporal_load(p + q);
        unsigned w[4];
#pragma unroll
        for (int d = 0; d < 4; ++d) { unsigned acc = 0u;
#pragma unroll
            for (int e = 0; e < 8; ++e) acc |= enc_u4(v[2 * d + (e >> 2)][e & 3] * scale) << (e < 4 ? 8 * e : 8 * (e - 4) + 4);
            w[d] = acc; }
        *(u32x4*)(dst + (size_t)row * ROW4 + 16 * lp) = (u32x4){w[0], w[1], w[2], w[3]};
    }
}
DI int udot_i4(const u32x4 a, const u32x4 (&h8)[2]) {
    int a0 = 0, a1 = 0;
#pragma unroll
    for (int q = 0; q < 4; ++q) {
        const unsigned lo = a[q] & 0x0f0f0f0fu, hi = (a[q] >> 4) & 0x0f0f0f0fu;
        a0 = __builtin_amdgcn_sdot4((int)h8[q >> 1][2 * (q & 1)], (int)lo, a0, false);
        a1 = __builtin_amdgcn_sdot4((int)h8[q >> 1][2 * (q & 1) + 1], (int)hi, a1, false);
    }
    return a0 + a1;
}
DI void dec_fp4x32(const u32x4 a, float (&f)[32]) {
#pragma unroll
    for (int q = 0; q < 4; ++q) {
        const v2f_t t0 = __builtin_amdgcn_cvt_scalef32_pk_f32_fp4(a[q], 1.0f, 0), t1 = __builtin_amdgcn_cvt_scalef32_pk_f32_fp4(a[q], 1.0f, 1),
                    t2 = __builtin_amdgcn_cvt_scalef32_pk_f32_fp4(a[q], 1.0f, 2), t3 = __builtin_amdgcn_cvt_scalef32_pk_f32_fp4(a[q], 1.0f, 3);
        f[8 * q] = t0[0]; f[8 * q + 1] = t0[1]; f[8 * q + 2] = t1[0]; f[8 * q + 3] = t1[1]; f[8 * q + 4] = t2[0]; f[8 * q + 5] = t2[1]; f[8 * q + 6] = t3[0]; f[8 * q + 7] = t3[1];
    }
}
DI void cvt_stream_tab(const float* src, unsigned char* dst, int kind, float scale, int gw, int ngw, int lane) {
    if (kind == 2) cvt_stream_u4(src, dst, scale, gw, ngw, lane); else if (kind == 1) cvt_stream_fp4(src, dst, scale, gw, ngw, lane); else cvt_stream_fp6(src, dst, scale, gw, ngw, lane);
}
template <int CTRL> DI float dppf(float v) { return __int_as_float(__builtin_amdgcn_update_dpp(0, __float_as_int(v), CTRL, 0xf, 0xf, false)); }
DI unsigned pick_swz(int v, int j) {
    switch (j) { case 0: return (unsigned)__builtin_amdgcn_ds_swizzle(v, 0 << 5); case 1: return (unsigned)__builtin_amdgcn_ds_swizzle(v, 1 << 5);
                 case 2: return (unsigned)__builtin_amdgcn_ds_swizzle(v, 2 << 5); default: return (unsigned)__builtin_amdgcn_ds_swizzle(v, 3 << 5); }
}
DI unsigned pick_half(int v, int j, int half) { const int a0 = __builtin_amdgcn_readlane(v, j), a1 = __builtin_amdgcn_readlane(v, 32 + j); return (unsigned)(half ? a1 : a0); }
typedef __bf16 bf2v_t __attribute__((ext_vector_type(2)));
DI float udot_fp4(const u32x4 a, const u32x4 (&hq)[4]) {
    float a0 = 0.f, a1 = 0.f;
#pragma unroll
    for (int qq = 0; qq < 2; ++qq) {
        bf2v_t t[8];
#pragma unroll
        for (int q = 0; q < 2; ++q) {
            t[4 * q + 0] = __builtin_amdgcn_cvt_scalef32_pk_bf16_fp4(a[2 * qq + q], 1.0f, 0); t[4 * q + 1] = __builtin_amdgcn_cvt_scalef32_pk_bf16_fp4(a[2 * qq + q], 1.0f, 1);
            t[4 * q + 2] = __builtin_amdgcn_cvt_scalef32_pk_bf16_fp4(a[2 * qq + q], 1.0f, 2); t[4 * q + 3] = __builtin_amdgcn_cvt_scalef32_pk_bf16_fp4(a[2 * qq + q], 1.0f, 3); }
        asm volatile("" : "+v"(t[0]), "+v"(t[1]), "+v"(t[2]), "+v"(t[3]), "+v"(t[4]), "+v"(t[5]), "+v"(t[6]), "+v"(t[7]));
#pragma unroll
        for (int q = 0; q < 2; ++q) {
            a0 = __builtin_amdgcn_fdot2_f32_bf16(__builtin_bit_cast(bf2v_t, (unsigned)hq[2 * qq + q][0]), t[4 * q + 0], a0, false);
            a1 = __builtin_amdgcn_fdot2_f32_bf16(__builtin_bit_cast(bf2v_t, (unsigned)hq[2 * qq + q][1]), t[4 * q + 1], a1, false);
            a0 = __builtin_amdgcn_fdot2_f32_bf16(__builtin_bit_cast(bf2v_t, (unsigned)hq[2 * qq + q][2]), t[4 * q + 2], a0, false);
            a1 = __builtin_amdgcn_fdot2_f32_bf16(__builtin_bit_cast(bf2v_t, (unsigned)hq[2 * qq + q][3]), t[4 * q + 3], a1, false); }
    }
    return a0 + a1;
}
typedef __bf16 bf32v_t __attribute__((ext_vector_type(32)));
DI float udot_fp6(const u32x4 a, const u32x2 b, const u32x4 (&hq)[4]) {
    const v6u_t w = {a.x, a.y, a.z, a.w, b.x, b.y}; const bf32v_t uf = __builtin_amdgcn_cvt_scalef32_pk32_bf16_fp6(w, 1.0f);
    float a0 = 0.f, a1 = 0.f;
#pragma unroll
    for (int q = 0; q < 4; ++q) {
        a0 = __builtin_amdgcn_fdot2_f32_bf16(__builtin_bit_cast(bf2v_t, (unsigned)hq[q][0]), (bf2v_t){uf[8 * q], uf[8 * q + 1]}, a0, false);
        a1 = __builtin_amdgcn_fdot2_f32_bf16(__builtin_bit_cast(bf2v_t, (unsigned)hq[q][1]), (bf2v_t){uf[8 * q + 2], uf[8 * q + 3]}, a1, false);
        a0 = __builtin_amdgcn_fdot2_f32_bf16(__builtin_bit_cast(bf2v_t, (unsigned)hq[q][2]), (bf2v_t){uf[8 * q + 4], uf[8 * q + 5]}, a0, false);
        a1 = __builtin_amdgcn_fdot2_f32_bf16(__builtin_bit_cast(bf2v_t, (unsigned)hq[q][3]), (bf2v_t){uf[8 * q + 6], uf[8 * q + 7]}, a1, false);
    }
    return a0 + a1;
}
DI void peer_gather_token6(const GatherP& P, size_t m, int lane) {
    const int lp = lane & 31, half = lane >> 5;
    u32x4 hq[4];
    { const u32x4* hr = (const u32x4*)(P.H + m * D + 32 * lp);
#pragma unroll
      for (int q = 0; q < 4; ++q) hq[q] = hr[q]; }
    float o[32];
#pragma unroll
    for (int e = 0; e < 32; ++e) o[e] = 0.f;
    float zero_ = 0.f; asm volatile("" : "+v"(zero_));
    const unsigned lp16 = 16u * (unsigned)lp, lp8 = 8u * (unsigned)lp;
    const int bpbase = half << 7;
    const int eself = 2 * (lane & 3) + half;
    const u32x2* rt = P.route + m * 128 + eself;
#if TAB_U4
#define G_UDOT(ua1, ub1) udot_fp4(ua1, hq)
#else
#define G_UDOT(ua1, ub1) udot_fp6(ua1, ub1, hq)
#endif
#define G_PICKB(v_, j_) ((unsigned)__builtin_amdgcn_ds_bpermute(bpbase + 4 * (j_), (int)(v_)))
#define G_PICKR(v_, j_) pick_half((int)(v_), (j_), half)
#define G_PICKS(v_, j_) pick_swz((int)(v_), (j_))
#define G_PICKA(v_, j_) ((GATHER_BP & 4) ? G_PICKS(v_, j_) : (GATHER_BP & 1) ? G_PICKB(v_, j_) : G_PICKR(v_, j_))
#define G_PICKI(v_, j_) ((GATHER_BP & 8) ? G_PICKS(v_, j_) : (GATHER_BP & 2) ? G_PICKB(v_, j_) : G_PICKR(v_, j_))
#if GATHER_DPP
#define GX1(v_) dppf<0xB1>(v_)
#define GX2(v_) dppf<0x4E>(v_)
#define GR4(v_) dppf<0x124>(v_)
#define GR8(v_) dppf<0x128>(v_)
#else
#define GX1(v_) shx<1>(v_, lane)
#define GX2(v_) shx<2>(v_, lane)
#define GR4(v_) shx<4>(v_, lane)
#define GR8(v_) shx<8>(v_, lane)
#endif
#define G_LOAD(ua_, ub_, va_, vb_, re_) do { const int idx_ = (int)(re_).x; _Pragma("unroll") for (int j = 0; j < 4; ++j) { \
            const unsigned ie = G_PICKI(idx_, j);      \
            const unsigned uo = ie * (unsigned)ROWU + lp16, vo = ie * (unsigned)ROWV + lp16;     \
            ua_[j] = *(const u32x4*)(P.U + uo); if (!TAB_U4) ub_[j] = *(const u32x2*)(P.U + (ie * (unsigned)ROWU + 512u + lp8)); \
            va_[j] = *(const u32x4*)(P.V + vo); if (!TAB_V4) vb_[j] = *(const u32x2*)(P.V + (ie * (unsigned)ROWV + 512u + lp8)); } } while (0)
#define G_COMP(ua_, ub_, va_, vb_, re_) do { const float gate = __int_as_float((int)(re_).y); \
        float p[4]; \
        _Pragma("unroll") for (int j = 0; j < 4; ++j) { p[j] = G_UDOT(ua_[j], ub_[j]); if (PROBE_DUP) { u32x4 t_ = ua_[j]; asm volatile("" : "+v"(t_)); p[j] += zero_ * G_UDOT(t_, ub_[j]); } } \
          \
        float p2[2], p1; \
        { const bool up = (lane & 2) != 0; \
          _Pragma("unroll") for (int q = 0; q < 2; ++q) { const float keep = up ? p[q + 2] : p[q], send = up ? p[q] : p[q + 2]; p2[q] = keep + GX2(send); } } \
        { const bool up = (lane & 1) != 0; const float keep = up ? p2[1] : p2[0], send = up ? p2[0] : p2[1]; p1 = keep + GX1(send); } \
        p1 += GR4(p1); p1 += GR8(p1); p1 += shx<16>(p1, lane); \
        const float act = gelu_exact(p1 * (1.0f / UT_SCALE)) * gate * (1.0f / VT_SCALE); \
        _Pragma("unroll") for (int j = 0; j < 4; ++j) { \
            const float a = __int_as_float((int)G_PICKA(__float_as_int(act), j)); \
            float vf[32]; \
            if (TAB_V4) dec_fp4x32(va_[j], vf); \
            else { const v6u_t w = {va_[j].x, va_[j].y, va_[j].z, va_[j].w, vb_[j].x, vb_[j].y}; const v32f_t t = __builtin_amdgcn_cvt_scalef32_pk32_f32_fp6(w, 1.0f); \
                _Pragma("unroll") for (int k = 0; k < 32; ++k) vf[k] = t[k]; } \
            _Pragma("unroll") for (int k = 0; k < 32; ++k) o[k] += a * vf[k]; } } while (0)
#if GATHER_PIPE
    u32x4 uaA[4], vaA[4], uaB[4], vaB[4]; u32x2 ubA[4], vbA[4], ubB[4], vbB[4];
    u32x2 re0 = rt[0], re1 = rt[8];
    G_LOAD(uaA, ubA, vaA, vbA, re0);
#pragma unroll 1
    for (int bt = 0; bt < 16; bt += 2) {
        u32x2 re2 = re0, re3 = re1;
        if (bt < 14) { re2 = rt[(bt + 2) * 8]; re3 = rt[(bt + 3) * 8]; }
        G_LOAD(uaB, ubB, vaB, vbB, re1);
        __builtin_amdgcn_sched_barrier(0);
        G_COMP(uaA, ubA, vaA, vbA, re0);
        if (bt < 14) G_LOAD(uaA, ubA, vaA, vbA, re2);
        __builtin_amdgcn_sched_barrier(0);
        G_COMP(uaB, ubB, vaB, vbB, re1);
        re0 = re2; re1 = re3;
    }
#else
    u32x2 re_next = rt[0];
#pragma unroll 1
    for (int bt = 0; bt < 16; ++bt) {
        const u32x2 re = re_next;
        if (bt < 15) re_next = rt[(bt + 1) * 8];
        u32x4 ua[4], va[4]; u32x2 ub[4], vb[4];
        G_LOAD(ua, ub, va, vb, re);
        G_COMP(ua, ub, va, vb, re);
    }
#endif
#undef G_LOAD
#undef G_COMP
#undef G_UDOT
#undef G_PICKA
#undef G_PICKI
#undef G_PICKB
#undef GX1
#undef GX2
#undef GR4
#undef GR8
#undef G_PICKS
#undef G_PICKR
    float oc[16];
#pragma unroll
    for (int k = 0; k < 16; ++k) { const float lo_ = o[k] + shx<32>(o[k], lane), hi_ = o[16 + k] + shx<32>(o[16 + k], lane); oc[k] = half ? hi_ : lo_; }
    const int bidx = (m >= (size_t)SEQ) ? 1 : 0; const int cbase = 32 * lp + 16 * half;
    float* xr = P.X + m * D + cbase; const float* g2 = P.gt2 + bidx * 6 * D + cbase;
    float xn[16]; float ss = 0.f;
#pragma unroll
    for (int q = 0; q < 4; ++q) { const f32x4 xv = *(const f32x4*)(xr + 4 * q), gv = *(const f32x4*)(g2 + 4 * q);
#pragma unroll
        for (int e = 0; e < 4; ++e) { const float v = xv[e] + gv[e] * oc[q * 4 + e]; xn[q * 4 + e] = v; ss += v * v; } }
    const float rstd = 1.0f / sqrtf(wave_sum(ss, lane) * (1.0f / D) + EPS);
    if (P.last) {
#pragma unroll
        for (int q = 0; q < 4; ++q) { const f32x4 gv = *(const f32x4*)(P.ng + cbase + 4 * q); f32x4 r;
#pragma unroll
            for (int e = 0; e < 4; ++e) r[e] = xn[q * 4 + e] * rstd * gv[e];
            *(f32x4*)(P.out + m * D + cbase + 4 * q) = r; }
    } else {
        float y[16];
#pragma unroll
        for (int q = 0; q < 4; ++q) { const int col = cbase + 4 * q;
            const f32x4 gv = *(const f32x4*)(P.ng + col), sc = *(const f32x4*)(P.nsc + bidx * 6 * D + col), sh = *(const f32x4*)(P.nsh + bidx * 6 * D + col);
            *(f32x4*)(xr + 4 * q) = (f32x4){xn[q * 4], xn[q * 4 + 1], xn[q * 4 + 2], xn[q * 4 + 3]};
#pragma unroll
            for (int e = 0; e < 4; ++e) y[q * 4 + e] = xn[q * 4 + e] * rstd * gv[e] * (1.0f + sc[e]) + sh[e]; }
        bf16_t* ho = P.Hout + m * D + cbase;
        { u32x4 w; w.x = pk2(y[0], y[1]); w.y = pk2(y[2], y[3]); w.z = pk2(y[4], y[5]); w.w = pk2(y[6], y[7]); *(u32x4*)ho = w; }
        { u32x4 w; w.x = pk2(y[8], y[9]); w.y = pk2(y[10], y[11]); w.z = pk2(y[12], y[13]); w.w = pk2(y[14], y[15]); *(u32x4*)(ho + 8) = w; }
#if IN_I8
        {
            float am = 0.f;
#pragma unroll
            for (int i = 0; i < 16; ++i) am = fmaxf(am, fabsf(y[i]));
            am = fmaxf(am, shx<1>(am, lane)); am = fmaxf(am, shx<2>(am, lane)); am = fmaxf(am, shx<4>(am, lane)); am = fmaxf(am, shx<8>(am, lane)); am = fmaxf(am, shx<16>(am, lane)); am = fmaxf(am, shx<32>(am, lane));
            am = fmaxf(am, 1e-20f); const float sc = 127.0f / am;
            unsigned w[4];
#pragma unroll
            for (int d = 0; d < 4; ++d) { const int q0 = (int)__builtin_rintf(y[4 * d] * sc), q1 = (int)__builtin_rintf(y[4 * d + 1] * sc), q2 = (int)__builtin_rintf(y[4 * d + 2] * sc), q3 = (int)__builtin_rintf(y[4 * d + 3] * sc);
                w[d] = (unsigned)(q0 & 0xff) | ((unsigned)(q1 & 0xff) << 8) | ((unsigned)(q2 & 0xff) << 16) | ((unsigned)q3 << 24); }
            *(u32x4*)(P.G8 + m * D + cbase) = (u32x4){w[0], w[1], w[2], w[3]};
            if (lane == 0) P.GS[m] = am * (1.0f / 127.0f);
        }
#endif
        float pr[8];
#pragma unroll
        for (int c = 0; c < 8; ++c) { float a = 0.f;
#pragma unroll
            for (int q = 0; q < 4; ++q) { const f32x4 wv = *(const LAS f32x4*)(P.wsm + c * D + cbase + 4 * q);
                a += (y[q * 4] * wv.x + y[q * 4 + 1] * wv.y) + (y[q * 4 + 2] * wv.z + y[q * 4 + 3] * wv.w); }
            pr[c] = wave_sum(a, lane);
            if (c & 1) __builtin_amdgcn_sched_barrier(0); }
        if (lane < 8) { float rr = pr[0];
#pragma unroll
            for (int c = 1; c < 8; ++c) rr = (lane == c) ? pr[c] : rr;
            P.small[m * 8 + lane] = rr; }
    }
}

constexpr int GC_OFF = 32768;
DI void stage_gather_consts(const GatherP& P, lptr L, int tid) {
    LAS float* gc = (LAS float*)(L + GC_OFF);
    for (int i = tid; i < 2 * D; i += NTHR) { const int b = i >> 10, c = i & (D - 1);
        gc[i] = P.gt2[b * 6 * D + c];
        gc[2 * D + i] = P.last ? P.ng[c] : P.ng[c] * (1.0f + P.nsc[b * 6 * D + c]);
        gc[4 * D + i] = P.last ? 0.f : P.nsh[b * 6 * D + c]; }
    __syncthreads();
}
DI void gather_finish(const GatherP& P, lptr L, size_t m, int lane, float (&o)[32], const f32x4 (&xv4)[4]) {
    const int lp = lane & 31, half = lane >> 5;
    float oc[16];
#pragma unroll
    for (int k = 0; k < 16; ++k) { const float lo_ = o[k] + shx<32>(o[k], lane), hi_ = o[16 + k] + shx<32>(o[16 + k], lane); oc[k] = half ? hi_ : lo_; }
    const int bidx = (m >= (size_t)SEQ) ? 1 : 0; const int cbase = 32 * lp + 16 * half;
    const LAS float* gc = (const LAS float*)(L + GC_OFF) + bidx * D + cbase;
    float* xr = P.X + m * D + cbase;
    float xn[16]; float ss = 0.f;
#pragma unroll
    for (int q = 0; q < 4; ++q) { const f32x4 gv = *(const LAS f32x4*)(gc + 4 * q);
#pragma unroll
        for (int e = 0; e < 4; ++e) { const float v = xv4[q][e] + gv[e] * oc[q * 4 + e]; xn[q * 4 + e] = v; ss += v * v; } }
    const float rstd = 1.0f / sqrtf(wave_sum(ss, lane) * (1.0f / D) + EPS);
    if (P.last) {
#pragma unroll
        for (int q = 0; q < 4; ++q) { const f32x4 gv = *(const LAS f32x4*)(gc + 2 * D + 4 * q); f32x4 r;
#pragma unroll
            for (int e = 0; e < 4; ++e) r[e] = xn[q * 4 + e] * rstd * gv[e];
            *(f32x4*)(P.out + m * D + cbase + 4 * q) = r; }
    } else {
        float y[16];
#pragma unroll
        for (int q = 0; q < 4; ++q) {
            const f32x4 ga = *(const LAS f32x4*)(gc + 2 * D + 4 * q), sh = *(const LAS f32x4*)(gc + 4 * D + 4 * q);
            *(f32x4*)(xr + 4 * q) = (f32x4){xn[q * 4], xn[q * 4 + 1], xn[q * 4 + 2], xn[q * 4 + 3]};
#pragma unroll
            for (int e = 0; e < 4; ++e) y[q * 4 + e] = xn[q * 4 + e] * rstd * ga[e] + sh[e]; }
        if (!IN_I8) { bf16_t* ho = P.Hout + m * D + cbase;
        { u32x4 w; w.x = pk2(y[0], y[1]); w.y = pk2(y[2], y[3]); w.z = pk2(y[4], y[5]); w.w = pk2(y[6], y[7]); *(u32x4*)ho = w; }
        { u32x4 w; w.x = pk2(y[8], y[9]); w.y = pk2(y[10], y[11]); w.z = pk2(y[12], y[13]); w.w = pk2(y[14], y[15]); *(u32x4*)(ho + 8) = w; } }
#if IN_I8
        {
            float am = 0.f;
#pragma unroll
            for (int i = 0; i < 16; ++i) am = fmaxf(am, fabsf(y[i]));
            am = fmaxf(am, shx<1>(am, lane)); am = fmaxf(am, shx<2>(am, lane)); am = fmaxf(am, shx<4>(am, lane)); am = fmaxf(am, shx<8>(am, lane)); am = fmaxf(am, shx<16>(am, lane)); am = fmaxf(am, shx<32>(am, lane));
            am = fmaxf(am, 1e-20f); const float sc = 127.0f / am;
            unsigned w[4];
#pragma unroll
            for (int d = 0; d < 4; ++d) { const int q0 = (int)__builtin_rintf(y[4 * d] * sc), q1 = (int)__builtin_rintf(y[4 * d + 1] * sc), q2 = (int)__builtin_rintf(y[4 * d + 2] * sc), q3 = (int)__builtin_rintf(y[4 * d + 3] * sc);
                w[d] = (unsigned)(q0 & 0xff) | ((unsigned)(q1 & 0xff) << 8) | ((unsigned)(q2 & 0xff) << 16) | ((unsigned)q3 << 24); }
            *(u32x4*)(P.G8 + m * D + cbase) = (u32x4){w[0], w[1], w[2], w[3]};
            if (lane == 0) P.GS[m] = am * (1.0f / 127.0f);
        }
#endif
        float pr[8];
#pragma unroll
        for (int c = 0; c < 8; ++c) { float a = 0.f;
#pragma unroll
            for (int q = 0; q < 4; ++q) { const f32x4 wv = *(const LAS f32x4*)(P.wsm + c * D + cbase + 4 * q);
                a += (y[q * 4] * wv.x + y[q * 4 + 1] * wv.y) + (y[q * 4 + 2] * wv.z + y[q * 4 + 3] * wv.w); }
            pr[c] = wave_sum(a, lane);
            if (c & 1) __builtin_amdgcn_sched_barrier(0); }
        if (lane < 8) { float rr = pr[0];
#pragma unroll
            for (int c = 1; c < 8; ++c) rr = (lane == c) ? pr[c] : rr;
            P.small[m * 8 + lane] = rr; }
    }
}
#ifdef GATHER_NT
#define GNT(p_) __builtin_nontemporal_load(p_)
#else
#define GNT(p_) (*(p_))
#endif
DI void peer_gather_wave(const GatherP& P, lptr L, int gw, int ngw, int lane) {
    const int lp = lane & 31, half = lane >> 5;
    float zero_ = 0.f; asm volatile("" : "+v"(zero_));
    const unsigned lp16 = 16u * (unsigned)lp, lp8 = 8u * (unsigned)lp;
    const int bpbase = half << 7;
    const int eself = 2 * (lane & 3) + half;
    size_t m = (size_t)gw;
#if TAB_UI4
    u32x4 hq[2]; float uinv, hcorr;
#define G_HLOAD(hq_, uinv_, hcorr_, m_) do { const u32x4* hr_ = (const u32x4*)(P.H8 + (m_) * D + 32 * lp); hq_[0] = hr_[0]; hq_[1] = hr_[1]; uinv_ = P.HS[(m_)] * (1.0f / UI_SCALE); } while (0)
#define G_HCORR(hq_, hcorr_) do { int s_ = 0; _Pragma("unroll") for (int q_ = 0; q_ < 8; ++q_) s_ = __builtin_amdgcn_sdot4((int)hq_[q_ >> 2][q_ & 3], 0x01010101, s_, false); hcorr_ = 7.5f * (float)s_; } while (0)
#define G_UDOT(ua1, ub1) ((float)udot_i4(ua1, hq) - hcorr)
    constexpr int NHQ = 2;
    G_HLOAD(hq, uinv, hcorr, m); G_HCORR(hq, hcorr);
#else
    u32x4 hq[4]; const float uinv = 1.0f / UT_SCALE;
    { const u32x4* hr = (const u32x4*)(P.H + m * D + 32 * lp);
#pragma unroll
      for (int q = 0; q < 4; ++q) hq[q] = GNT(hr + q); }
    constexpr int NHQ = 4;
#if TAB_U4
#define G_UDOT(ua1, ub1) udot_fp4(ua1, hq)
#else
#define G_UDOT(ua1, ub1) udot_fp6(ua1, ub1, hq)
#endif
#endif
    const u32x2* rt = P.route + m * 128 + eself;
#define G_PICKB(v_, j_) ((unsigned)__builtin_amdgcn_ds_bpermute(bpbase + 4 * (j_), (int)(v_)))
#define G_PICKR(v_, j_) pick_half((int)(v_), (j_), half)
#define G_PICKS(v_, j_) pick_swz((int)(v_), (j_))
#define G_PICKA(v_, j_) ((GATHER_BP & 4) ? G_PICKS(v_, j_) : (GATHER_BP & 1) ? G_PICKB(v_, j_) : G_PICKR(v_, j_))
#define G_PICKI(v_, j_) ((GATHER_BP & 8) ? G_PICKS(v_, j_) : (GATHER_BP & 2) ? G_PICKB(v_, j_) : G_PICKR(v_, j_))
#if GATHER_DPP
#define GX1(v_) dppf<0xB1>(v_)
#define GX2(v_) dppf<0x4E>(v_)
#define GR4(v_) dppf<0x124>(v_)
#define GR8(v_) dppf<0x128>(v_)
#else
#define GX1(v_) shx<1>(v_, lane)
#define GX2(v_) shx<2>(v_, lane)
#define GR4(v_) shx<4>(v_, lane)
#define GR8(v_) shx<8>(v_, lane)
#endif
#define G_LOAD(ua_, ub_, va_, vb_, re_) do { const int idx_ = (int)(re_).x; _Pragma("unroll") for (int j = 0; j < 4; ++j) { \
            const unsigned ie = G_PICKI(idx_, j);      \
            const unsigned uo = ie * (unsigned)ROWU + lp16, vo = ie * (unsigned)ROWV + lp16;     \
            ua_[j] = *(const u32x4*)(P.U + uo); if (!TAB_U4) ub_[j] = *(const u32x2*)(P.U + (ie * (unsigned)ROWU + 512u + lp8)); \
            va_[j] = *(const u32x4*)(P.V + vo); if (!TAB_V4) vb_[j] = *(const u32x2*)(P.V + (ie * (unsigned)ROWV + 512u + lp8)); } } while (0)
#define G_COMP(ua_, ub_, va_, vb_, re_) do { const float gate = __int_as_float((int)(re_).y); \
        float p[4]; \
        _Pragma("unroll") for (int j = 0; j < 4; ++j) { p[j] = G_UDOT(ua_[j], ub_[j]); if (PROBE_DUP) { u32x4 t_ = ua_[j]; asm volatile("" : "+v"(t_)); p[j] += zero_ * G_UDOT(t_, ub_[j]); } } \
          \
        float p2[2], p1; \
        { const bool up = (lane & 2) != 0; \
          _Pragma("unroll") for (int q = 0; q < 2; ++q) { const float keep = up ? p[q + 2] : p[q], send = up ? p[q] : p[q + 2]; p2[q] = keep + GX2(send); } } \
        { const bool up = (lane & 1) != 0; const float keep = up ? p2[1] : p2[0], send = up ? p2[0] : p2[1]; p1 = keep + GX1(send); } \
        p1 += GR4(p1); p1 += GR8(p1); p1 += shx<16>(p1, lane); \
        const float act = gelu_exact(p1 * uinv) * gate * (1.0f / VT_SCALE); \
        _Pragma("unroll") for (int j = 0; j < 4; ++j) { \
            const float a = __int_as_float((int)G_PICKA(__float_as_int(act), j)); \
            if (TAB_V4 && !GATHER_INPLACE) { float vf[32]; dec_fp4x32(va_[j], vf); \
                _Pragma("unroll") for (int k = 0; k < 16; ++k) { o2[k][0] += a * vf[2 * k]; o2[k][1] += a * vf[2 * k + 1]; } } \
            else if (TAB_V4) { const v2f_t aa = {a, a}; \
                  \
                _Pragma("unroll") for (int q = 0; q < 4; ++q) { \
                    const v2f_t t0 = __builtin_amdgcn_cvt_scalef32_pk_f32_fp4(va_[j][q], 1.0f, 0), t1 = __builtin_amdgcn_cvt_scalef32_pk_f32_fp4(va_[j][q], 1.0f, 1), \
                                t2 = __builtin_amdgcn_cvt_scalef32_pk_f32_fp4(va_[j][q], 1.0f, 2), t3 = __builtin_amdgcn_cvt_scalef32_pk_f32_fp4(va_[j][q], 1.0f, 3); \
                    asm("v_pk_fma_f32 %0, %1, %2, %0" : "+v"(o2[4 * q + 0]) : "v"(t0), "v"(aa)); asm("v_pk_fma_f32 %0, %1, %2, %0" : "+v"(o2[4 * q + 1]) : "v"(t1), "v"(aa)); \
                    asm("v_pk_fma_f32 %0, %1, %2, %0" : "+v"(o2[4 * q + 2]) : "v"(t2), "v"(aa)); asm("v_pk_fma_f32 %0, %1, %2, %0" : "+v"(o2[4 * q + 3]) : "v"(t3), "v"(aa)); } } \
            else { float vf[32]; const v6u_t w = {va_[j].x, va_[j].y, va_[j].z, va_[j].w, vb_[j].x, vb_[j].y}; const v32f_t t = __builtin_amdgcn_cvt_scalef32_pk32_f32_fp6(w, 1.0f); \
                _Pragma("unroll") for (int k = 0; k < 32; ++k) vf[k] = t[k]; \
                _Pragma("unroll") for (int k = 0; k < 16; ++k) { o2[k][0] += a * vf[2 * k]; o2[k][1] += a * vf[2 * k + 1]; } } } } while (0)
#if GATHER_DEPTH == 3
    u32x4 uaA[4], vaA[4], uaB[4], vaB[4], uaC[4], vaC[4]; u32x2 ubA[4], vbA[4], ubB[4], vbB[4], ubC[4], vbC[4];
    u32x2 reA = GNT(rt), reB = GNT(rt + 8), reC = GNT(rt + 16), rp;
    G_LOAD(uaA, ubA, vaA, vbA, reA); G_LOAD(uaB, ubB, vaB, vbB, reB);
#pragma unroll 1
    for (;;) {
        const size_t mn = m + (size_t)ngw; const bool more = mn < (size_t)M;
        const u32x2* rtn = P.route + (more ? mn : m) * 128 + eself;
        v2f_t o2[16];
#pragma unroll
        for (int e = 0; e < 16; ++e) o2[e] = (v2f_t){0.f, 0.f};
        f32x4 xv4[4]; u32x4 hqn[NHQ]; float uinvn = 0.f;
#define G_STEP(XL, XC, REL, REC, rpsrc) do { G_LOAD(ua##XL, ub##XL, va##XL, vb##XL, REL); rp = GNT(rpsrc); __builtin_amdgcn_sched_barrier(0); \
            G_COMP(ua##XC, ub##XC, va##XC, vb##XC, REC); REC = rp; __builtin_amdgcn_sched_barrier(0); } while (0)
#pragma unroll 1
        for (int k = 0; k < 12; k += 3) {
            G_STEP(C, A, reC, reA, rt + (k + 3) * 8);
            G_STEP(A, B, reA, reB, rt + (k + 4) * 8);
            G_STEP(B, C, reB, reC, rt + (k + 5) * 8);
        }
        G_STEP(C, A, reC, reA, rt + 15 * 8);
        G_STEP(A, B, reA, reB, rtn);
        if (more) { G_STEP(B, C, reB, reC, rtn + 8); } else { rp = reC; G_COMP(uaC, ubC, vaC, vbC, reC); }
        if (more) { G_STEP(C, A, reC, reA, rtn + 16); } else { G_COMP(uaA, ubA, vaA, vbA, reA); }
#undef G_STEP
        { const float* xr = P.X + m * D + 32 * lp + 16 * half;
#pragma unroll
          for (int q = 0; q < 4; ++q) xv4[q] = GNT((const f32x4*)(xr + 4 * q)); }
#if TAB_UI4
        if (more) { float hc_; G_HLOAD(hqn, uinvn, hc_, mn); }
#else
        if (more) { const u32x4* hr = (const u32x4*)(P.H + mn * D + 32 * lp);
#pragma unroll
            for (int q = 0; q < 4; ++q) hqn[q] = GNT(hr + q); }
#endif
        __builtin_amdgcn_sched_barrier(0);
        float o[32];
#pragma unroll
        for (int e = 0; e < 16; ++e) { o[2 * e] = o2[e][0]; o[2 * e + 1] = o2[e][1]; }
        gather_finish(P, L, m, lane, o, xv4);
        if (!more) break;
        m = mn; rt = rtn;
        { const u32x2 t0 = reB, t1 = reC, t2 = reA; reA = t0; reB = t1; reC = t2; }
#pragma unroll
        for (int j = 0; j < 4; ++j) { uaA[j] = uaB[j]; vaA[j] = vaB[j]; uaB[j] = uaC[j]; vaB[j] = vaC[j]; if (!TAB_U4 && !TAB_UI4) { ubA[j] = ubB[j]; ubB[j] = ubC[j]; } if (!TAB_V4) { vbA[j] = vbB[j]; vbB[j] = vbC[j]; } }
#pragma unroll
        for (int q = 0; q < NHQ; ++q) hq[q] = hqn[q];
#if TAB_UI4
        uinv = uinvn; G_HCORR(hq, hcorr);
#endif
    }
#else
    u32x4 uaA[4], vaA[4], uaB[4], vaB[4]; u32x2 ubA[4], vbA[4], ubB[4], vbB[4];
    u32x2 re0 = GNT(rt), re1 = GNT(rt + 8);
    G_LOAD(uaA, ubA, vaA, vbA, re0);
#pragma unroll 1
    for (;;) {
        const size_t mn = m + (size_t)ngw; const bool more = mn < (size_t)M;
        const u32x2* rtn = P.route + (more ? mn : m) * 128 + eself;
        const u32x2 re0n = GNT(rtn), re1n = GNT(rtn + 8);
        v2f_t o2[16];
#pragma unroll
        for (int e = 0; e < 16; ++e) o2[e] = (v2f_t){0.f, 0.f};
        f32x4 xv4[4]; u32x4 hqn[NHQ]; float uinvn = 0.f;
#pragma unroll 1
        for (int bt = 0; bt < 16; bt += 2) {
            u32x2 re2 = re0, re3 = re1;
            if (bt < 14) { re2 = GNT(rt + (bt + 2) * 8); re3 = GNT(rt + (bt + 3) * 8); }
            G_LOAD(uaB, ubB, vaB, vbB, re1);
            __builtin_amdgcn_sched_barrier(0);
            G_COMP(uaA, ubA, vaA, vbA, re0);
            if (bt < 14) G_LOAD(uaA, ubA, vaA, vbA, re2);
            else if (more) G_LOAD(uaA, ubA, vaA, vbA, re0n);
            __builtin_amdgcn_sched_barrier(0);
            G_COMP(uaB, ubB, vaB, vbB, re1);
            re0 = re2; re1 = re3;
        }
        { const float* xr = P.X + m * D + 32 * lp + 16 * half;
#pragma unroll
          for (int q = 0; q < 4; ++q) xv4[q] = GNT((const f32x4*)(xr + 4 * q)); }
#if TAB_UI4
        if (more) { float hc_; G_HLOAD(hqn, uinvn, hc_, mn); }
#else
        if (more) { const u32x4* hr = (const u32x4*)(P.H + mn * D + 32 * lp);
#pragma unroll
            for (int q = 0; q < 4; ++q) hqn[q] = GNT(hr + q); }
#endif
        __builtin_amdgcn_sched_barrier(0);
        float o[32];
#pragma unroll
        for (int e = 0; e < 16; ++e) { o[2 * e] = o2[e][0]; o[2 * e + 1] = o2[e][1]; }
        gather_finish(P, L, m, lane, o, xv4);
        if (!more) break;
        m = mn; rt = rtn; re0 = re0n; re1 = re1n;
#pragma unroll
        for (int q = 0; q < NHQ; ++q) hq[q] = hqn[q];
#if TAB_UI4
        uinv = uinvn; G_HCORR(hq, hcorr);
#endif
    }
#endif
#undef G_LOAD
#undef G_COMP
#undef G_UDOT
#undef G_HLOAD
#undef G_HCORR
#undef G_PICKA
#undef G_PICKI
#undef G_PICKB
#undef GX1
#undef GX2
#undef GR4
#undef GR8
#undef G_PICKS
#undef G_PICKR
}

constexpr int GA_OFF = GC_OFF + 24576;
DI void peer_gather_split(const GatherP& P, lptr L, int gw, int ngw, int lane, int wave) {
    const int lp = lane & 31, half = lane >> 5;
    const unsigned lp16 = 16u * (unsigned)lp;
    const int eself = 2 * (lane & 3) + half;
    LAS float* actw = (LAS float*)(L + GA_OFF) + wave * 1024;
#define RT_AT(g_) (P.route + ((size_t)gw + (size_t)((g_) >> 4) * (size_t)ngw) * 128 + eself + ((g_) & 15) * 8)
#define ROW_LOAD(x_, tab_, row_, re_) do { const int idx_ = (int)(re_).x; _Pragma("unroll") for (int j = 0; j < 4; ++j) { \
        const unsigned ie = pick_swz(idx_, j); x_[j] = *(const u32x4*)((tab_) + (ie * (unsigned)(row_) + lp16)); } } while (0)
    {
        u32x4 hq[2], hqn[2]; float uinv, uinvn = 0.f, hcorr; float gA = 0.f, gB = 0.f;
#define S_HLOAD(hq_, uinv_, m_) do { const u32x4* hr_ = (const u32x4*)(P.H8 + (m_) * D + 32 * lp); hq_[0] = hr_[0]; hq_[1] = hr_[1]; uinv_ = P.HS[(m_)] * (1.0f / UI_SCALE); } while (0)
#define S_HCORR(hq_, hcorr_) do { int s_ = 0; _Pragma("unroll") for (int q_ = 0; q_ < 8; ++q_) s_ = __builtin_amdgcn_sdot4((int)hq_[q_ >> 2][q_ & 3], 0x01010101, s_, false); hcorr_ = 7.5f * (float)s_; } while (0)
        S_HLOAD(hq, uinv, (size_t)gw); S_HCORR(hq, hcorr);
        u32x4 u0[4], u1[4], u2[4], u3[4], u4[4], u5[4], u6[4], u7[4];
        u32x2 r0 = *RT_AT(0), r1 = *RT_AT(1), r2 = *RT_AT(2), r3 = *RT_AT(3), r4 = *RT_AT(4), r5 = *RT_AT(5), r6 = *RT_AT(6), r7 = *RT_AT(7), rp;
        ROW_LOAD(u0, P.U, ROW4, r0); ROW_LOAD(u1, P.U, ROW4, r1); ROW_LOAD(u2, P.U, ROW4, r2); ROW_LOAD(u3, P.U, ROW4, r3);
        ROW_LOAD(u4, P.U, ROW4, r4); ROW_LOAD(u5, P.U, ROW4, r5); ROW_LOAD(u6, P.U, ROW4, r6);
#define U_STEP(XL, RL, XC, RC, gc) do { \
            if ((gc) + 7 < 128) ROW_LOAD(XL, P.U, ROW4, RL); \
            rp = ((gc) + 8 < 128) ? *RT_AT((gc) + 8) : RC; \
            __builtin_amdgcn_sched_barrier(0); \
            float p[4]; \
            _Pragma("unroll") for (int j = 0; j < 4; ++j) p[j] = (float)udot_i4(XC[j], hq) - hcorr; \
            float p2[2], p1; \
            { const bool up = (lane & 2) != 0; \
              _Pragma("unroll") for (int q = 0; q < 2; ++q) { const float keep = up ? p[q + 2] : p[q], send = up ? p[q] : p[q + 2]; p2[q] = keep + dppf<0x4E>(send); } } \
            { const bool up = (lane & 1) != 0; const float keep = up ? p2[1] : p2[0], send = up ? p2[0] : p2[1]; p1 = keep + dppf<0xB1>(send); } \
            p1 += dppf<0x124>(p1); p1 += dppf<0x128>(p1); p1 += shx<16>(p1, lane); \
            if (lp < 4) actw[((gc) >> 4) * 128 + ((gc) & 15) * 8 + eself] = p1 * uinv; \
            RC = rp; } while (0)
#pragma unroll 1
        for (int g = 0; g < 128; g += 8) {
            const int bt0 = g & 15; const int k = g >> 4; const size_t mk = (size_t)gw + (size_t)k * (size_t)ngw;
            if (bt0 == 0 && g > 0) { hq[0] = hqn[0]; hq[1] = hqn[1]; uinv = uinvn; S_HCORR(hq, hcorr); }
            if (bt0 == 0) {
                gA = __int_as_float((int)P.route[mk * 128 + lane].y); gB = __int_as_float((int)P.route[mk * 128 + 64 + lane].y);
                if (g + 16 < 128) S_HLOAD(hqn, uinvn, mk + (size_t)ngw); }
            U_STEP(u7, r7, u0, r0, g + 0); U_STEP(u0, r0, u1, r1, g + 1); U_STEP(u1, r1, u2, r2, g + 2); U_STEP(u2, r2, u3, r3, g + 3);
            U_STEP(u3, r3, u4, r4, g + 4); U_STEP(u4, r4, u5, r5, g + 5); U_STEP(u5, r5, u6, r6, g + 6); U_STEP(u6, r6, u7, r7, g + 7);
            if (bt0 == 8) {
                LDS_WAIT();
                LAS float* at = actw + k * 128;
                const float v0 = at[lane], v1 = at[64 + lane];
                at[lane] = gelu_exact(v0) * gA * (1.0f / VT_SCALE); at[64 + lane] = gelu_exact(v1) * gB * (1.0f / VT_SCALE);
            }
        }
#undef U_STEP
#undef S_HLOAD
#undef S_HCORR
    }
    LDS_WAIT();
    {
        u32x4 v0[4], v1[4], v2[4], v3[4];
        u32x2 r0 = *RT_AT(0), r1 = *RT_AT(1), r2 = *RT_AT(2), r3 = *RT_AT(3), rp;
        ROW_LOAD(v0, P.V, ROW4, r0); ROW_LOAD(v1, P.V, ROW4, r1); ROW_LOAD(v2, P.V, ROW4, r2);
        v2f_t o2[16];
#pragma unroll
        for (int e = 0; e < 16; ++e) o2[e] = (v2f_t){0.f, 0.f};
        f32x4 xv4[4];
#define V_STEP(XL, RL, XC, RC, gc) do { \
            if ((gc) + 3 < 128) ROW_LOAD(XL, P.V, ROW4, RL); \
            rp = ((gc) + 4 < 128) ? *RT_AT((gc) + 4) : RC; \
            __builtin_amdgcn_sched_barrier(0); \
            { const LAS float* ab = actw + ((gc) >> 4) * 128 + ((gc) & 15) * 8 + half; \
              _Pragma("unroll") for (int j = 0; j < 4; ++j) { const float a = ab[2 * j]; \
                _Pragma("unroll") for (int q = 0; q < 4; ++q) { \
                    const v2f_t t0 = __builtin_amdgcn_cvt_scalef32_pk_f32_fp4(XC[j][q], 1.0f, 0), t1 = __builtin_amdgcn_cvt_scalef32_pk_f32_fp4(XC[j][q], 1.0f, 1), \
                                t2 = __builtin_amdgcn_cvt_scalef32_pk_f32_fp4(XC[j][q], 1.0f, 2), t3 = __builtin_amdgcn_cvt_scalef32_pk_f32_fp4(XC[j][q], 1.0f, 3); \
                    o2[4 * q + 0] += t0 * a; o2[4 * q + 1] += t1 * a; o2[4 * q + 2] += t2 * a; o2[4 * q + 3] += t3 * a; } } } \
            RC = rp; } while (0)
#pragma unroll 1
        for (int g = 0; g < 128; g += 4) {
            const int bt0 = g & 15; const int k = g >> 4; const size_t mk = (size_t)gw + (size_t)k * (size_t)ngw;
            V_STEP(v3, r3, v0, r0, g + 0);
            if (bt0 == 12) { const float* xr = P.X + mk * D + 32 * lp + 16 * half;
#pragma unroll
                for (int q = 0; q < 4; ++q) xv4[q] = *(const f32x4*)(xr + 4 * q); }
            V_STEP(v0, r0, v1, r1, g + 1);
            V_STEP(v1, r1, v2, r2, g + 2);
            V_STEP(v2, r2, v3, r3, g + 3);
            if (bt0 == 12) {
                float o[32];
#pragma unroll
                for (int e = 0; e < 16; ++e) { o[2 * e] = o2[e][0]; o[2 * e + 1] = o2[e][1]; o2[e] = (v2f_t){0.f, 0.f}; }
                gather_finish(P, L, mk, lane, o, xv4);
            }
        }
#undef V_STEP
    }
#undef ROW_LOAD
#undef RT_AT
}

#ifndef MK_SINGLE
#define MK_SINGLE 0
#endif
#ifndef TABLE_FP6
#define TABLE_FP6 1
#endif
#ifndef GATHER_MODE
#define GATHER_MODE 0
#endif
#ifndef LATE_PROLOGUE
#define LATE_PROLOGUE 0
#endif
#ifndef IN_I8
#define IN_I8 1
#endif
#ifndef Q_I8
#define Q_I8 1
#endif
#ifndef MIX_SPLIT
#define MIX_SPLIT 0
#endif
#ifndef CHAIN_SPLIT
#define CHAIN_SPLIT 0
#endif
constexpr int SH = (MIX_SPLIT || CHAIN_SPLIT) ? 1 : 0;
constexpr int NSLOT = (GATHER_MODE ? 12 : 10) + SH;
constexpr int NPHASE = 2 + NSLOT * DEPTH;
constexpr int PH_ALL = (1 << (2 + NSLOT)) - 1;
enum { I_X = 0, I_C, I_ADAW, I_ADAB, I_N1G, I_N2G, I_FING, I_WIN, I_LBL, I_HGNG, I_CONVW, I_ALOG, I_DTB, I_GDNNG, I_WBH, I_WBG, I_WOUT, I_WQ, I_SK, I_U, I_V };

DI void quant_row8(const bf16_t* src, unsigned char* dst, float* scale, int lane) {
    const u32x4 a = ((const u32x4*)src)[2 * lane], b = ((const u32x4*)src)[2 * lane + 1];
    float f[16];
    f[0] = bf_lo(a.x); f[1] = bf_hi(a.x); f[2] = bf_lo(a.y); f[3] = bf_hi(a.y); f[4] = bf_lo(a.z); f[5] = bf_hi(a.z); f[6] = bf_lo(a.w); f[7] = bf_hi(a.w);
    f[8] = bf_lo(b.x); f[9] = bf_hi(b.x); f[10] = bf_lo(b.y); f[11] = bf_hi(b.y); f[12] = bf_lo(b.z); f[13] = bf_hi(b.z); f[14] = bf_lo(b.w); f[15] = bf_hi(b.w);
    float am = 0.f;
#pragma unroll
    for (int i = 0; i < 16; ++i) am = fmaxf(am, fabsf(f[i]));
    am = fmaxf(am, shx<1>(am, lane)); am = fmaxf(am, shx<2>(am, lane)); am = fmaxf(am, shx<4>(am, lane)); am = fmaxf(am, shx<8>(am, lane)); am = fmaxf(am, shx<16>(am, lane)); am = fmaxf(am, shx<32>(am, lane));
    am = fmaxf(am, 1e-30f);
    const float sc = 127.0f / am;
    unsigned w[4];
#pragma unroll
    for (int d = 0; d < 4; ++d) { const int q0 = (int)__builtin_rintf(f[4 * d] * sc), q1 = (int)__builtin_rintf(f[4 * d + 1] * sc), q2 = (int)__builtin_rintf(f[4 * d + 2] * sc), q3 = (int)__builtin_rintf(f[4 * d + 3] * sc);
        w[d] = (unsigned)(q0 & 0xff) | ((unsigned)(q1 & 0xff) << 8) | ((unsigned)(q2 & 0xff) << 16) | ((unsigned)q3 << 24); }
    ((u32x4*)dst)[lane] = (u32x4){w[0], w[1], w[2], w[3]};
    if (lane == 0) *scale = am * (1.0f / 127.0f);
}
DI int lane_id_() { unsigned m_ = ~0u; asm volatile("" : "+s"(m_)); return (int)__builtin_amdgcn_mbcnt_hi(m_, __builtin_amdgcn_mbcnt_lo(m_, 0u)); }
template <int PHM> __global__ void __launch_bounds__(NTHR, 2) trunk_fwd(Args args) {
    extern __shared__ __attribute__((aligned(16))) unsigned char lds_raw[];
    lptr L = (lptr)lds_raw;
    const int tid0 = threadIdx.x, wave = __builtin_amdgcn_readfirstlane(tid0 >> 6);
#if MK_SINGLE
    constexpr int G = 256;
#else
    const int G = gridDim.x;
#endif
    const int bx = blockIdx.x; const int vcu = (G % 8 == 0) ? (bx % 8) * (G / 8) + bx / 8 : bx;
    const int gw = vcu * NWAVES + wave, NGW = G * NWAVES;
    unsigned char* ws0 = args.ws;
#if MK_SINGLE
    constexpr int lo = 0, hi = NPHASE;
#else
    const int lo = args.ph_lo, hi = args.ph_hi;
#endif
    volatile LAS unsigned* MISC = (volatile LAS unsigned*)(L + LDS_CTL_OFF);
    for (int u = tid0; u < (LDS_BYTES - LDS_CTL_OFF) / 4; u += NTHR) ((LAS unsigned*)(L + LDS_CTL_OFF))[u] = 0u;
    __syncthreads();
#if MK_SINGLE
    xcd_barrier_post((unsigned*)(ws0 + WS_CTL) + 4096, wave);
#define GRID_BAR() do { unsigned* bp_ = (unsigned*)(args.ws + WS_CTL) + 4096; asm volatile("" : "+s"(bp_)); XcdBarrier b_; b_.bar = bp_; b_.x = xb_xcc_id(); b_.st = (volatile LAS unsigned*)(L + LDS_CTL_OFF) + 8; xcd_barrier(b_, wave); } while (0)
#else
#define GRID_BAR() do {} while (0)
#endif
#define PH_MASK PHM
#ifndef REP_MASK
#define REP_MASK 0
#endif
#ifndef NREPA
#define NREPA 1
#endif
#define NREP(j) (1 + (((REP_MASK) >> (j)) & 1))
#define IN(k) (lo <= (k) && (k) < hi)
#define INL(j) ((((PH_MASK) >> (2 + (j))) & 1) && IN(pb + (j)))
#define IN0(k) ((((PH_MASK) >> (k)) & 1) && IN(k))
#define PHASE_BEGIN() size_t kz = 0; int tid = wave * 64 + lane_id_(); asm volatile("" : "+s"(kz), "+v"(tid)); unsigned char* ws = args.ws + kz; const int lane = tid & 63
#define INP(i) (args.in[i] + kz)
#define SEAM(k) do { if (IN(k) && IN((k) + 1)) GRID_BAR(); } while (0)

#define P_MOD   ((float*)(ws + WS_MOD))
#define P_SMALL ((float*)(ws + WS_SMALL))
#define P_SMALLL(l) ((float*)(ws + ((l) ? WS_SMALL1 : WS_SMALL)))
#define P_WIN   ((bf16_t*)(ws + WS_WIN))
#define P_WBR   ((bf16_t*)(ws + WS_WBR))
#define P_WOUT  ((bf16_t*)(ws + WS_WOUT))
#define P_WQ    ((bf16_t*)(ws + WS_WQ))
#define P_SK    ((bf16_t*)(ws + WS_SK))
#define P_PROJ  ((bf16_t*)(ws + WS_PROJ))
#define P_Y     ((bf16_t*)(ws + WS_Y))
#define P_U     ((unsigned char*)(ws + (TABLE_FP6 ? WS_U6 : WS_UV)))
#define P_V     (TABLE_FP6 ? (unsigned char*)(ws + WS_WIN + (size_t)l * 12 * MiB) : (unsigned char*)(ws + WS_UV) + (size_t)NEXP * D)
#define P_H     ((bf16_t*)(ws + WS_H))
#define P_MERGED ((bf16_t*)(ws + WS_MERGED))
#define P_WQ8   ((unsigned char*)(ws + 500 * MiB))
#define P_WQS   ((float*)(ws + 504 * MiB))
#define P_WINS  ((float*)(ws + 504 * MiB + 16384))
#define P_WIN8(l_) ((unsigned char*)(ws + ((l_) ? 34 * MiB : 505 * MiB)))
#define P_G8    ((unsigned char*)(ws + WS_SCR))
#define P_GS    ((float*)(ws + WS_SCR + 16 * MiB))
#define P_H8    ((unsigned char*)(ws + WS_Y))
#define P_HS    ((float*)(ws + WS_Y + 16 * MiB))
#define P_ROUTE ((u32x2*)(ws + WS_ROUTE))
#define MIXP_INIT(MP, l) MixP MP; MP.PROJ = P_PROJ; MP.SMALL = P_SMALLL(l); MP.convw = INP(I_CONVW) + (size_t)(l) * 4 * 1536; MP.alog = INP(I_ALOG) + (l) * 4; MP.dtb = INP(I_DTB) + (l) * 4; MP.lbl = INP(I_LBL); MP.l = (l); \
        MP.MT = ws + WS_MT; MP.NN = ws + WS_NN; MP.QT = ws + WS_QT; MP.OP = ws + WS_OP; MP.SS = ws + WS_SS; MP.DL = (float*)(ws + WS_DL)

    for (int rep_ = 0; rep_ < NREP(10); ++rep_) if (IN0(0)) { if (rep_) GRID_BAR();
        PHASE_BEGIN();
        if (vcu < (LATE_PROLOGUE ? 96 : 192)) mod_item(INP(I_C), INP(I_ADAW), INP(I_ADAB), P_MOD, vcu, L, tid);
        LAS float* scr = (LAS float*)(L + wave * 16384);
        constexpr int IT_WIN = 16 * 192, IT_WBR = 8 * 32, IT_WOUT = 16 * 32, IT_WQ = 16 * 64, IT_L = IT_WIN + 2 * IT_WBR + IT_WOUT + IT_WQ;
#define WEIGHT_ITEM_BODY \
            if (r < IT_WIN) { const int kb = r / 192, nb = r % 192, n0 = 32 * nb; transpose_item(INP(I_WIN) + (size_t)l * D * IN_COLS, IN_COLS, n0 + (n0 >= 4096 ? 8 : 0), P_WIN + (size_t)l * NPROJ * D, D, n0, 64 * kb, scr, lane); continue; } r -= IT_WIN; \
            if (r < IT_WBR) { const int kb = r / 32, nb = r % 32; transpose_item(INP(I_WBH) + (size_t)l * 512 * D, D, 32 * nb, P_WBR + ((size_t)l * 2 + 0) * D * 512, 512, 32 * nb, 64 * kb, scr, lane); continue; } r -= IT_WBR; \
            if (r < IT_WBR) { const int kb = r / 32, nb = r % 32; transpose_item(INP(I_WBG) + (size_t)l * 512 * D, D, 32 * nb, P_WBR + ((size_t)l * 2 + 1) * D * 512, 512, 32 * nb, 64 * kb, scr, lane); continue; } r -= IT_WBR; \
            if (r < IT_WOUT) { const int kb = r / 32, nb = r % 32; transpose_item(INP(I_WOUT) + (size_t)l * D * D, D, 32 * nb, P_WOUT + (size_t)l * D * D, D, 32 * nb, 64 * kb, scr, lane); continue; } r -= IT_WOUT; \
            { const int kb = r / 64, nb = r % 64; transpose_item(INP(I_WQ) + (size_t)l * D * NQ, NQ, 32 * nb, P_WQ + (size_t)l * NQ * D, D, 32 * nb, 64 * kb, scr, lane); } \

        for (int it = gw; it < (LATE_PROLOGUE ? 1 : DEPTH) * IT_L; it += NGW) {
            const int l = it / IT_L; int r = it - l * IT_L;
            WEIGHT_ITEM_BODY
        }
        cvt_stream(INP(I_SK), P_SK, (size_t)DEPTH * 8 * 2 * 128 * 128, gw, NGW, lane);
    }
    SEAM(0);
    for (int rep_ = 0; rep_ < NREP(11); ++rep_) if (IN0(1)) { if (rep_) GRID_BAR();
        PHASE_BEGIN();
        LAS float* wsm = (LAS float*)L;
        stage_wsmall(INP(I_WIN), wsm, tid);
        const float* x = INP(I_X); float* mod = P_MOD;
        for (int bb = 0; bb < BATCH; ++bb) {
            RowMod R; load_rowmod(R, INP(I_N1G), mod + (size_t)bb * 6 * D + D, mod + (size_t)bb * 6 * D, lane);
            for (int m = bb * SEQ + gw; m < (bb + 1) * SEQ; m += NGW) {
                f32x4 v[4];
#pragma unroll
                for (int j = 0; j < 4; ++j) v[j] = ((const f32x4*)(x + (size_t)m * D))[lane + 64 * j];
                row_finish<true, IN_I8 != 0, IN_I8 == 0>(v, R, P_H + (size_t)m * D, P_SMALL + (size_t)m * 8, wsm, lane, (unsigned*)(P_G8 + (size_t)m * D), P_GS + m);
            }
        }
#if IN_I8
        for (int rw = gw; rw < NPROJ; rw += NGW) quant_row8(P_WIN + (size_t)rw * D, P_WIN8(0) + (size_t)rw * D, P_WINS + rw, lane);
#endif
#if Q_I8
        for (int rw = gw; rw < DEPTH * NQ; rw += NGW) {
            const u32x4 a = ((const u32x4*)(P_WQ + (size_t)rw * D))[2 * lane], b = ((const u32x4*)(P_WQ + (size_t)rw * D))[2 * lane + 1];
            float f[16];
            f[0] = bf_lo(a.x); f[1] = bf_hi(a.x); f[2] = bf_lo(a.y); f[3] = bf_hi(a.y); f[4] = bf_lo(a.z); f[5] = bf_hi(a.z); f[6] = bf_lo(a.w); f[7] = bf_hi(a.w);
            f[8] = bf_lo(b.x); f[9] = bf_hi(b.x); f[10] = bf_lo(b.y); f[11] = bf_hi(b.y); f[12] = bf_lo(b.z); f[13] = bf_hi(b.z); f[14] = bf_lo(b.w); f[15] = bf_hi(b.w);
            float am = 0.f;
#pragma unroll
            for (int i = 0; i < 16; ++i) am = fmaxf(am, fabsf(f[i]));
            am = fmaxf(am, shx<1>(am, lane)); am = fmaxf(am, shx<2>(am, lane)); am = fmaxf(am, shx<4>(am, lane)); am = fmaxf(am, shx<8>(am, lane)); am = fmaxf(am, shx<16>(am, lane)); am = fmaxf(am, shx<32>(am, lane));
            am = fmaxf(am, 1e-30f);
            const float sc = 127.0f / am;
            unsigned w[4];
#pragma unroll
            for (int d = 0; d < 4; ++d) { const int q0 = (int)__builtin_rintf(f[4 * d] * sc), q1 = (int)__builtin_rintf(f[4 * d + 1] * sc), q2 = (int)__builtin_rintf(f[4 * d + 2] * sc), q3 = (int)__builtin_rintf(f[4 * d + 3] * sc);
                w[d] = (unsigned)(q0 & 0xff) | ((unsigned)(q1 & 0xff) << 8) | ((unsigned)(q2 & 0xff) << 16) | ((unsigned)q3 << 24); }
            ((u32x4*)(P_WQ8 + (size_t)rw * D))[lane] = (u32x4){w[0], w[1], w[2], w[3]};
            if (lane == 0) P_WQS[rw] = am * (1.0f / 127.0f);
        }
#endif
    }
    SEAM(1);
#ifdef EXTRA_BARS
#ifndef EB_RT
#define EB_RT 0
#endif
    for (int eb_ = 0; eb_ < EXTRA_BARS + EB_RT; ++eb_) GRID_BAR();
#endif
#pragma unroll 1
    for (int l = 0; l < DEPTH; ++l) {
        const int pb = 2 + NSLOT * l;
        for (int rep_ = 0; rep_ < NREP(0); ++rep_) if (INL(0)) { if (rep_) GRID_BAR();
            PHASE_BEGIN();
#if IN_I8
            pg8::Gemm g{(const bf16_t*)P_G8, (const bf16_t*)P_WIN8(l), M, NPROJ, D / 2, D / 2, D / 2, 0, 0}; pg8::StaticOrder S; S.init(M, NPROJ, G, bx);
            pg8::EpiQ8 E{P_PROJ, NPROJ, P_GS, P_WINS + (size_t)l * NPROJ};
            pg8::gemm_phase<pg8::EpiQ8, pg8::StaticOrder, true>(L, g, S, E, tid);
#else
            pg8::Gemm g{P_H, P_WIN + (size_t)l * NPROJ * D, M, NPROJ, D, D, D, 0, 0}; pg8::StaticOrder S; S.init(M, NPROJ, G, bx);
            pg8::EpiBf16 E{P_PROJ, NPROJ};
            pg8::gemm_phase(L, g, S, E, tid);
#endif
        }
        SEAM(pb + 0);
#if CHAIN_SPLIT
        if (INL(1)) {
            PHASE_BEGIN(); MIXP_INIT(MP, l);
            for (int i = vcu; i < 2048; i += G) { const int br = i >> 10, bhc = i & 1023;
                if (br) passA_gdn(L, tid, MP, bhc >> 7, bhc & 127); else passA_hgrn(L, tid, MP, bhc >> 7, bhc & 127); }
        }
        SEAM(pb + 1);
#pragma unroll 1
        for (int hf = 0; hf < 2; ++hf) {
            if (INL(2 + hf)) {
                PHASE_BEGIN(); MIXP_INIT(MP, l);
                const int vx = vcu & 31, xq = vcu >> 5; const int c0 = 64 * hf, c1 = c0 + 64;
                if (vx < 4) passB_gdn(L, tid, MP, xq * 4 + vx, c0, c1);
                else if (vx < 20 && wave < 2) passB_hgrn(lane, MP, ((vx - 4) * 8 + xq) * 2 + wave, c0, c1);
                else {
                    const int cw = (vx >= 20) ? (xq * 12 + vx - 20) * 8 + wave : 768 + ((vx - 4) * 8 + xq) * 6 + (wave - 2);
                    if (hf == 0) cvt_stream_tab(INP(I_U) + (size_t)l * NEXP * D, P_U, TAB_UI4 ? 2 : TAB_U4, UT_SCALE, cw, 1536, lane);
                    else {
                        const float* ngh = INP(I_HGNG) + l * 128; const float* ngg = INP(I_GDNNG) + l * 128;
                        int tl = tid; asm volatile("" : "+v"(tl)); const int ln = tl & 63;
                        if (vx >= 20) {
#pragma unroll 1
                            for (int t = cw; t < 2048; t += 768) { const int q = t >> 1, cc = q & 63, rest = q >> 6;
                                passC_wave(ln, MP, (rest >> 3) * 1024 + (rest & 7) * 128 + cc, t & 1, ngh, ngg, P_Y); }
                        } else cvt_stream_tab(INP(I_V) + (size_t)l * NEXP * D, P_V, TAB_V4, VT_SCALE, cw - 768, 768, ln);
                    }
                }
            }
            SEAM(pb + 2 + hf);
        }
        if (INL(4)) {
            PHASE_BEGIN(); MIXP_INIT(MP, l);
            const float* ngh = INP(I_HGNG) + l * 128; const float* ngg = INP(I_GDNNG) + l * 128;
            int tl = tid; asm volatile("" : "+v"(tl)); const int ln = tl & 63;
            { const int t = gw, q = t >> 1, cc = 64 + (q & 63), rest = q >> 6;
              passC_wave(ln, MP, (rest >> 3) * 1024 + (rest & 7) * 128 + cc, t & 1, ngh, ngg, P_Y); }
        }
        SEAM(pb + 4);
#elif MIX_SPLIT
        if (INL(1)) {
            PHASE_BEGIN(); MIXP_INIT(MP, l);
            for (int i = vcu; i < 1024; i += G) passA_gdn(L, tid, MP, i >> 7, i & 127);
        }
        SEAM(pb + 1);
        if (INL(2)) {
            PHASE_BEGIN(); MIXP_INIT(MP, l);
            const int vx = vcu & 31, xq = vcu >> 5;
            if (vx < 4) passB_gdn(L, tid, MP, xq * 4 + vx);
            else {
                const int widx = (vx - 4) * 8 + xq;
                for (int i = widx; i < 1024; i += 224) passA_hgrn(L, tid, MP, i >> 7, i & 127);
                cvt_stream_tab(INP(I_U) + (size_t)l * NEXP * D, P_U, TAB_UI4 ? 2 : TAB_U4, UT_SCALE, widx * 8 + wave, 224 * 8, lane);
            }
        }
        SEAM(pb + 2);
        if (INL(3)) {
            PHASE_BEGIN(); MIXP_INIT(MP, l);
            const float* ngh = INP(I_HGNG) + l * 128; const float* ngg = INP(I_GDNNG) + l * 128;
            int tl = tid; asm volatile("" : "+v"(tl)); const int ln = tl & 63;
            if (wave == 0) passB_hgrn(ln, MP, vcu);
            else {
                const int w7 = vcu * 7 + (wave - 1);
#pragma unroll 1
                for (int t = w7; t < 2048; t += 1792) passC_wave(ln, MP, 1024 + (t >> 1), t & 1, ngh, ngg, P_Y);
                cvt_stream_tab(INP(I_V) + (size_t)l * NEXP * D, P_V, TAB_V4, VT_SCALE, w7, 1792, ln);
            }
        }
        SEAM(pb + 3);
        if (INL(4)) {
            PHASE_BEGIN(); MIXP_INIT(MP, l);
            const float* ngh = INP(I_HGNG) + l * 128; const float* ngg = INP(I_GDNNG) + l * 128;
            int tl = tid; asm volatile("" : "+v"(tl)); const int ln = tl & 63;
            passC_wave(ln, MP, gw >> 1, gw & 1, ngh, ngg, P_Y);
        }
        SEAM(pb + 4);
#else
        for (int rep_ = 0; rep_ < NREP(1); ++rep_) if (INL(1)) { if (rep_) GRID_BAR();
            PHASE_BEGIN(); MIXP_INIT(MP, l);
            for (int i2 = vcu; i2 < (NREPA == 2 ? 4096 : NREPA == 3 ? 3072 : NREPA == 4 ? 3072 : 2048); i2 += G) { const int i = (NREPA == 3 && i2 >= 2048) ? i2 - 1024 : (i2 & 2047);
                const int br = i >> 10, bhc = i & 1023;
                if (br) passA_gdn(L, tid, MP, bhc >> 7, bhc & 127); else passA_hgrn(L, tid, MP, bhc >> 7, bhc & 127);
            }
        }
        SEAM(pb + 1);
        for (int rep_ = 0; rep_ < NREP(2); ++rep_) if (INL(2)) { if (rep_) GRID_BAR();
            PHASE_BEGIN(); MIXP_INIT(MP, l);
            const int vx = vcu & 31, xq = vcu >> 5;
            if (vx < 4) passB_gdn(L, tid, MP, xq * 4 + vx);
            else if (vx < 20 && wave < 2) { passB_hgrn(lane, MP, ((vx - 4) * 8 + xq) * 2 + wave);
#ifdef PROBE_H2X
                passB_hgrn(lane, MP, ((vx - 4) * 8 + xq) * 2 + wave);
#endif
            }
#if TABLE_FP6
            else {
                if (rep_ == 0) { const int cw = (vx >= 20) ? (xq * 12 + vx - 20) * 8 + wave : 768 + ((vx - 4) * 8 + xq) * 6 + (wave - 2);
#if LATE_PROLOGUE
                if (l == 0) {
                    if (vx >= 20) mod_item(INP(I_C), INP(I_ADAW), INP(I_ADAB), P_MOD, 96 + xq * 12 + vx - 20, L, tid);
                    LAS float* scr = (LAS float*)(L + wave * 16384);
                    constexpr int IT_WIN = 16 * 192, IT_WBR = 8 * 32, IT_WOUT = 16 * 32, IT_WQ = 16 * 64, IT_L = IT_WIN + 2 * IT_WBR + IT_WOUT + IT_WQ;
                    for (int it = cw; it < IT_L; it += 1536) { constexpr int l = 1; int r = it;
                        WEIGHT_ITEM_BODY
                    }
                }
#endif
                cvt_stream_tab(INP(I_U) + (size_t)l * NEXP * D, P_U, TAB_UI4 ? 2 : TAB_U4, UT_SCALE, cw, 1536, lane);
                cvt_stream_tab(INP(I_V) + (size_t)l * NEXP * D, P_V, TAB_V4, VT_SCALE, cw, 1536, lane); }
            }
#endif
        }
        SEAM(pb + 2);
        for (int rep_ = 0; rep_ < NREP(3); ++rep_) if (INL(3)) { if (rep_) GRID_BAR();
            PHASE_BEGIN(); MIXP_INIT(MP, l);
            const float* ngh = INP(I_HGNG) + l * 128; const float* ngg = INP(I_GDNNG) + l * 128;
            int tl = tid; asm volatile("" : "+v"(tl)); const int ln = tl & 63, wv = __builtin_amdgcn_readfirstlane(tl >> 6);
#pragma unroll 1
            for (int j = 0; j < 2; ++j) passC_wave(ln, MP, (gw >> 1) + 1024 * j, gw & 1, ngh, ngg, P_Y);
        }
        SEAM(pb + 3);
#endif
        for (int rep_ = 0; rep_ < NREP(4); ++rep_) if (INL(4 + SH)) { if (rep_) GRID_BAR();
            PHASE_BEGIN();
            pg8::TwoPassOrder S; S.S.init(M, D, G, bx);
            pg8::Gemm g{P_Y, P_WBR + (size_t)l * 2 * D * 512, M, D, 512, D, 512, (size_t)512, (size_t)D * 512};
            pg8::EpiGate E{P_MERGED, D, P_PROJ, NPROJ, PC_GATE};
            pg8::gemm_phase(L, g, S, E, tid);
        }
        SEAM(pb + 4 + SH);
        for (int rep_ = 0; rep_ < NREP(5); ++rep_) if (INL(5 + SH)) { if (rep_) GRID_BAR();
            PHASE_BEGIN();
            float* X = args.out;
            pg8::Gemm g{P_MERGED, P_WOUT + (size_t)l * D * D, M, D, D, D, D, 0, 0}; pg8::StaticOrder S; S.init(M, D, G, bx);
            pg8::EpiResid E{l == 0 ? INP(I_X) : (const float*)X, X, P_MOD + (size_t)l * BATCH * 6 * D + 2 * D};
            pg8::gemm_phase(L, g, S, E, tid);
#if !TABLE_FP6
            cvt_stream_fp8(INP(I_U) + (size_t)l * NEXP * D, P_U, (size_t)NEXP * D, U8_SCALE, gw, NGW, lane);
            cvt_stream_fp8(INP(I_V) + (size_t)l * NEXP * D, P_V, (size_t)NEXP * D, V8_SCALE, gw, NGW, lane);
#endif
        }
        SEAM(pb + 5 + SH);
        for (int rep_ = 0; rep_ < NREP(6); ++rep_) if (INL(6 + SH)) { if (rep_) GRID_BAR();
            PHASE_BEGIN();
            const float* X = args.out; const float* modl = P_MOD + (size_t)l * BATCH * 6 * D;
            for (int bb = 0; bb < BATCH; ++bb) {
                RowMod R; load_rowmod(R, INP(I_N2G) + l * D, modl + (size_t)bb * 6 * D + 4 * D, modl + (size_t)bb * 6 * D + 3 * D, lane);
                for (int m = bb * SEQ + gw; m < (bb + 1) * SEQ; m += NGW) {
                    f32x4 v[4];
#pragma unroll
                    for (int j = 0; j < 4; ++j) v[j] = ((const f32x4*)(X + (size_t)m * D))[lane + 64 * j];
                    row_finish<false, TAB_UI4 != 0, !(TAB_UI4 && Q_I8)>(v, R, P_H + (size_t)m * D, nullptr, nullptr, lane, (unsigned*)(P_H8 + (size_t)m * D), P_HS + m);
                }
            }
#if IN_I8
            if (l == 0) for (int rw = gw; rw < NPROJ; rw += NGW) quant_row8(P_WIN + (size_t)NPROJ * D + (size_t)rw * D, P_WIN8(1) + (size_t)rw * D, P_WINS + NPROJ + rw, lane);
#endif
        }
        SEAM(pb + 6 + SH);
        for (int rep_ = 0; rep_ < NREP(7); ++rep_) if (INL(7 + SH)) { if (rep_) GRID_BAR();
            PHASE_BEGIN();
#if Q_I8
            pg8::Gemm g{(const bf16_t*)P_H8, (const bf16_t*)(P_WQ8 + (size_t)l * NQ * D), M, NQ, D / 2, D / 2, D / 2, 0, 0}; pg8::StaticOrder S; S.init(M, NQ, G, bx);
            pg8::EpiQ8 E{P_PROJ, NQ, P_HS, P_WQS + (size_t)l * NQ};
            pg8::gemm_phase<pg8::EpiQ8, pg8::StaticOrder, true>(L, g, S, E, tid);
#else
            pg8::Gemm g{P_H, P_WQ + (size_t)l * NQ * D, M, NQ, D, D, D, 0, 0}; pg8::StaticOrder S; S.init(M, NQ, G, bx);
            pg8::EpiBf16 E{P_PROJ, NQ};
            pg8::gemm_phase(L, g, S, E, tid);
#endif
        }
        SEAM(pb + 7 + SH);
        for (int rep_ = 0; rep_ < NREP(8); ++rep_) if (INL(8 + SH)) { if (rep_) GRID_BAR(); PHASE_BEGIN(); peer_route_phase(L, tid, vcu, P_PROJ, P_SK + (size_t)l * 8 * 2 * 128 * 128, P_ROUTE); }
        SEAM(pb + 8 + SH);
#if GATHER_MODE == 0
        for (int rep_ = 0; rep_ < NREP(9); ++rep_) if (INL(9 + SH)) { if (rep_) GRID_BAR();
            PHASE_BEGIN();
            float* mod = P_MOD;
            GatherP GP; GP.H = P_H; GP.route = P_ROUTE; GP.U = P_U; GP.V = P_V; GP.X = args.out; GP.gt2 = mod + (size_t)l * BATCH * 6 * D + 5 * D; GP.last = (l == DEPTH - 1);
            LAS float* wsm = (LAS float*)L;
            if (GP.last) { GP.ng = INP(I_FING); GP.nsc = nullptr; GP.nsh = nullptr; }
            else { GP.ng = INP(I_N1G) + (l + 1) * D; GP.nsc = mod + (size_t)(l + 1) * BATCH * 6 * D + D; GP.nsh = mod + (size_t)(l + 1) * BATCH * 6 * D;
                   stage_wsmall(INP(I_WIN) + (size_t)(l + 1) * D * IN_COLS, wsm, tid); }
            GP.Hout = P_H; GP.small = P_SMALLL(l + 1); GP.wsm = wsm; GP.out = args.out; GP.H8 = P_H8; GP.HS = P_HS; GP.G8 = P_G8; GP.GS = P_GS;
#if TABLE_FP6
#if GATHER_PIPE == 3
            stage_gather_consts(GP, L, tid);
            peer_gather_split(GP, L, gw, NGW, lane, wave);
#elif GATHER_PIPE == 2
            stage_gather_consts(GP, L, tid);
            peer_gather_wave(GP, L, gw, NGW, lane);
#else
            for (int m = gw; m < M; m += NGW) peer_gather_token6(GP, (size_t)m, lane);
#endif
#else
            for (int m = gw; m < M; m += NGW) peer_gather_token(GP, (size_t)m, lane);
#endif
        }
        if (l + 1 < DEPTH) SEAM(pb + 9 + SH);
#else
        if (INL(9 + SH)) { PHASE_BEGIN(); int bxl = bx; asm volatile("" : "+s"(bxl)); peer_u_pass(L, tid, bxl, P_H, P_ROUTE, P_U, (float*)(ws + WS_ACT)); }
        SEAM(pb + 9 + SH);
        if (INL(10 + SH)) { PHASE_BEGIN(); int bxl = bx; asm volatile("" : "+s"(bxl)); peer_v_pass(tid, bxl, P_ROUTE, (const float*)(ws + WS_ACT), P_V, args.out, P_MOD + (size_t)l * BATCH * 6 * D + 5 * D); }
        SEAM(pb + 10 + SH);
        if (INL(11 + SH)) {
            PHASE_BEGIN();
            float* X = args.out; float* mod = P_MOD;
            if (l == DEPTH - 1) {
                const float* fg = INP(I_FING);
#pragma unroll 1
                for (int m = gw; m < M; m += NGW) { f32x4 v[4];
#pragma unroll
                    for (int j = 0; j < 4; ++j) v[j] = ((const f32x4*)(X + (size_t)m * D))[lane + 64 * j];
                    row_final(v, fg, X + (size_t)m * D, lane); }
            } else {
                LAS float* wsm = (LAS float*)L;
                stage_wsmall(INP(I_WIN) + (size_t)(l + 1) * D * IN_COLS, wsm, tid);
                const float* modn = mod + (size_t)(l + 1) * BATCH * 6 * D;
#pragma unroll 1
                for (int bb = 0; bb < BATCH; ++bb) {
                    RowMod R; load_rowmod(R, INP(I_N1G) + (l + 1) * D, modn + (size_t)bb * 6 * D + D, modn + (size_t)bb * 6 * D, lane);
#pragma unroll 1
                    for (int m = bb * SEQ + gw; m < (bb + 1) * SEQ; m += NGW) { f32x4 v[4];
#pragma unroll
                        for (int j = 0; j < 4; ++j) v[j] = ((const f32x4*)(X + (size_t)m * D))[lane + 64 * j];
                        row_finish<true>(v, R, P_H + (size_t)m * D, P_SMALLL(l + 1) + (size_t)m * 8, wsm, lane); }
                }
            }
        }
        if (l + 1 < DEPTH) SEAM(pb + 11 + SH);
#endif
    }
#undef IN
#undef SEAM
}

#ifndef DBG_STOP
#define DBG_STOP 0
#endif
#ifndef DBG_SEL
#define DBG_SEL 0
#endif
#if DBG_STOP || defined(DUMP_OFF)
__global__ void dbg_dump(float* out, const unsigned short* a, size_t na, const unsigned short* b, size_t nb, const float* xf) {
    const size_t i = (size_t)blockIdx.x * blockDim.x + threadIdx.x; if (i >= (size_t)M * D) return;
    float v = 0.f;
#ifdef DUMP_VAL
    if (a) { for (size_t j = i; j < na; j += (size_t)M * D) { float t = __uint_as_float((unsigned)a[j] << 16); if (!(fabsf(t) < 1e30f)) t = 1e30f; v += t; } }
#else
    if (a) { for (size_t j = i; j < na; j += (size_t)M * D) v += (float)a[j] * (1.0f / 65536.0f); }
#endif
    if (b) { for (size_t j = i; j < nb; j += (size_t)M * D) v += (float)b[j] * (1.0f / 65536.0f); }
    if (xf) { float t = xf[i]; unsigned u = __float_as_uint(t); v += (float)(u >> 16) * (1.0f / 65536.0f) + (float)(u & 0xffffu) * (1.0f / 65536.0f); }
    out[i] = v;
}
#endif
#if DBG_STOP
__global__ void dbg_route_check(const bf16_t* Q, const bf16_t* SK, const u32x2* route, unsigned* counter) {
    extern __shared__ float sh[];
    const int tid = threadIdx.x; float* my = sh + tid * 400;
    const int gid = blockIdx.x * 64 + tid, t = gid >> 3, h = gid & 7;
    for (int z = 0; z < 2; ++z) for (int n = 0; n < 128; ++n) { float a = 0.f;
        for (int d = 0; d < 128; ++d) a += bf1(Q[(size_t)t * NQ + h * 256 + z * 128 + d]) * bf1(SK[((size_t)(h * 2 + z) * 128 + n) * 128 + d]);
        my[z * 128 + n] = a; }
    float* av = my + 256; int* ai = (int*)(my + 288);
    for (int z = 0; z < 2; ++z) for (int r = 0; r < 16; ++r) { int bi = 0; float bv = -INFINITY;
        for (int n = 0; n < 128; ++n) if (my[z * 128 + n] > bv) { bv = my[z * 128 + n]; bi = n; }
        av[z * 16 + r] = bv; ai[z * 16 + r] = bi; my[z * 128 + bi] = -INFINITY; }
    unsigned char* used = (unsigned char*)(my + 320);
    for (int k = 0; k < 256; ++k) used[k] = 0;
    int mism = 0;
    int ex[16];
    for (int r = 0; r < 16; ++r) { int bi = 0; float bv = -INFINITY;
        for (int k = 0; k < 256; ++k) if (!used[k]) { const float v = av[k >> 4] + av[16 + (k & 15)]; if (v > bv) { bv = v; bi = k; } }
        used[bi] = 1; my[r] = __int_as_float(ai[bi >> 4] * 128 + ai[16 + (bi & 15)]); }
    for (int k = 0; k < 16; ++k) { const int e = (int)route[((size_t)t * 8 + h) * 16 + k].x; bool f = false;
        for (int r = 0; r < 16; ++r) f = f || (__float_as_int(my[r]) == e);
        mism += f ? 0 : 1; }
    atomicAdd(counter, (unsigned)mism);
}
__global__ void dbg_gather_check(const bf16_t* H, const u32x2* route, const bf16_t* U, const bf16_t* V, const float* O, float* acc2  ) {
    __shared__ float red[256]; __shared__ float actv;
    const int t = blockIdx.x, tid = threadIdx.x;
    float o[4] = {0.f, 0.f, 0.f, 0.f};
    for (int k = 0; k < 128; ++k) {
        const u32x2 re = route[(size_t)t * 128 + k]; const size_t ro = (size_t)re.x * D;
        float p = 0.f; for (int j = 0; j < 4; ++j) p += bf1(H[(size_t)t * D + tid * 4 + j]) * bf1(U[ro + tid * 4 + j]);
        red[tid] = p; __syncthreads();
        for (int s_ = 128; s_ > 0; s_ >>= 1) { if (tid < s_) red[tid] += red[tid + s_]; __syncthreads(); }
        if (tid == 0) { const float x = red[0]; actv = 0.5f * x * (1.0f + erff(x * 0.70710678118654752f)) * __int_as_float((int)re.y); }
        __syncthreads();
        const float a = actv;
        for (int j = 0; j < 4; ++j) o[j] += a * bf1(V[ro + tid * 4 + j]);
        __syncthreads();
    }
    float e = 0.f, r = 0.f;
    for (int j = 0; j < 4; ++j) { const float g = O[(size_t)t * D + tid * 4 + j]; e += (g - o[j]) * (g - o[j]); r += o[j] * o[j]; }
    atomicAdd(acc2, e); atomicAdd(acc2 + 1, r);
}
__global__ void dbg_mixer_check(const bf16_t* PROJ, const float* SMALLp, const float* convw, const float* alog, const float* dtb, const float* ngh, const float* ngg, const bf16_t* Y, float* acc2, int T0, const float* lbl, int lay) {
    extern __shared__ float dsh[];
    float* qs = dsh; float* ks = dsh + 128; float* fs = dsh + 256; float* red = dsh + 384; float* SS_ = dsh + 512;
    const int br = blockIdx.x >> 3, bh = blockIdx.x & 7, b = bh >> 2, h = bh & 3, tid = threadIdx.x;
#define S_(k) SS_[(k) * 128 + tid]
    for (int k = 0; k < 128; ++k) S_(k) = 0.f;
    float err = 0.f, ref = 0.f;
    for (int t = 0; t < T0; ++t) {
        const size_t row = (size_t)b * SEQ + t; const bf16_t* pr = PROJ + row * NPROJ;
        float o = 0.f, gate;
        if (br == 0) {
            const float lb_ = lay ? sigmoidf_(lbl[512 + h * 128 + tid] - lbl[h * 128 + tid]) : 0.f;
            qs[tid] = siluf_(bf1(pr[PC_HQ + h * 128 + tid])); fs[tid] = lb_ + (1.0f - lb_) * sigmoidf_(bf1(pr[PC_HF + h * 128 + tid]));
            const float iv = bf1(pr[PC_HI + h * 128 + tid]); gate = bf1(pr[PC_HG + h * 128 + tid]);
            __syncthreads();
#pragma unroll 4
            for (int k = 0; k < 128; ++k) { const float f = fs[k]; const float sv = f * S_(k) + (1.0f - f) * iv; S_(k) = sv; o += qs[k] * sv; }
        } else {
            float c3[3];
#pragma unroll
            for (int ty = 0; ty < 3; ++ty) { const int ch = ty * 512 + h * 128 + tid; float a = 0.f;
                for (int j = 0; j < 4; ++j) if (t - 3 + j >= 0) a += bf1(PROJ[(row - 3 + j) * NPROJ + PC_QKV + ch]) * convw[j * 1536 + ch];
                c3[ty] = siluf_(a); }
            gate = bf1(pr[PC_GG + h * 128 + tid]);
            red[tid] = c3[0] * c3[0]; __syncthreads();
            for (int s_ = 64; s_ > 0; s_ >>= 1) { if (tid < s_) red[tid] += red[tid + s_]; __syncthreads(); }
            const float sq = red[0]; __syncthreads();
            red[tid] = c3[1] * c3[1]; __syncthreads();
            for (int s_ = 64; s_ > 0; s_ >>= 1) { if (tid < s_) red[tid] += red[tid + s_]; __syncthreads(); }
            const float sk = red[0]; __syncthreads();
            qs[tid] = c3[0] / sqrtf(sq + EPS) * 0.08838834764831845f; ks[tid] = c3[1] / sqrtf(sk + EPS);
            const float beta = sigmoidf_(SMALLp[row * 8 + h]); const float x = SMALLp[row * 8 + 4 + h] + dtb[h];
            const float a = __expf(-__expf(alog[h]) * (x > 20.f ? x : log1pf(__expf(x))));
            __syncthreads();
            float kS = 0.f;
#pragma unroll 4
            for (int k = 0; k < 128; ++k) kS += ks[k] * S_(k);
            const float vn = beta * (c3[2] - a * kS);
#pragma unroll 4
            for (int k = 0; k < 128; ++k) { const float sv = a * S_(k) + ks[k] * vn; S_(k) = sv; o += qs[k] * sv; }
        }
        __syncthreads();
        red[tid] = o * o; __syncthreads();
        for (int s_ = 64; s_ > 0; s_ >>= 1) { if (tid < s_) red[tid] += red[tid + s_]; __syncthreads(); }
        const float rstd = 1.0f / sqrtf(red[0] * (1.0f / 128.0f) + EPS);
        const float y = o * rstd * (br ? ngg : ngh)[tid] * siluf_(gate);
        const float g = bf1(Y[row * D + br * 512 + h * 128 + tid]);
        err += (g - y) * (g - y); ref += y * y;
        __syncthreads();
    }
    atomicAdd(acc2 + 2 * br, err); atomicAdd(acc2 + 2 * br + 1, ref);
}
__global__ void dbg_gemm_check(const bf16_t* A, int lda, int K, const float* W, int ldw, int N, int skip_at, int skip, const bf16_t* O, int ldo, float* acc2) {
    const int row = blockIdx.x * 61; if (row >= M) return;
    float err = 0.f, ref = 0.f;
    for (int n = threadIdx.x; n < N; n += blockDim.x) { const int wc = n < skip_at ? n : n + skip; float a = 0.f;
        for (int k = 0; k < K; ++k) a += bf1(A[(size_t)row * lda + k]) * W[(size_t)k * ldw + wc];
        const float g = bf1(O[(size_t)row * ldo + n]); err += (g - a) * (g - a); ref += a * a; }
    atomicAdd(acc2, err); atomicAdd(acc2 + 1, ref);
}
__global__ void dbg_mod_check(const float* c, const float* ada_w, const float* ada_b, const float* mod, float* acc2) {
    const int idx = blockIdx.x * blockDim.x + threadIdx.x; if (idx >= DEPTH * BATCH * 6 * D) return;
    const int l = idx / (BATCH * 6 * D), b = (idx / (6 * D)) % BATCH, n = idx % (6 * D);
    float a = 0.f; for (int k = 0; k < D; ++k) a += siluf_(c[b * D + k]) * ada_w[((size_t)l * D + k) * 6 * D + n];
    a += ada_b[l * 6 * D + n];
    const float g = mod[idx]; atomicAdd(acc2, (g - a) * (g - a)); atomicAdd(acc2 + 1, a * a);
}
__global__ void dbg_row_check(const float* x, const float* g1, const float* mod0, const float* w_in, const bf16_t* H, const float* SMALLp, float* acc2) {
    __shared__ float red[256]; __shared__ float ys[1024];
    const int row = blockIdx.x * 61, tid = threadIdx.x; if (row >= M) return;
    const int b = row >= SEQ; const float* sh = mod0 + (size_t)b * 6 * D; const float* sc = sh + D;
    float s = 0.f; for (int k = tid; k < D; k += 256) { const float v = x[(size_t)row * D + k]; s += v * v; }
    red[tid] = s; __syncthreads();
    for (int s_ = 128; s_ > 0; s_ >>= 1) { if (tid < s_) red[tid] += red[tid + s_]; __syncthreads(); }
    const float rstd = 1.0f / sqrtf(red[0] / D + EPS); __syncthreads();
    float e = 0.f, r = 0.f;
    for (int k = tid; k < D; k += 256) { const float y = x[(size_t)row * D + k] * rstd * g1[k] * (1.0f + sc[k]) + sh[k]; ys[k] = y; const float g = bf1(H[(size_t)row * D + k]); e += (g - y) * (g - y); r += y * y; }
    atomicAdd(acc2 + 2, e); atomicAdd(acc2 + 3, r);
    __syncthreads();
    if (tid < 8) { float a = 0.f; for (int k = 0; k < D; ++k) a += ys[k] * w_in[(size_t)k * IN_COLS + 4096 + tid]; const float g = SMALLp[(size_t)row * 8 + tid]; atomicAdd(acc2 + 4, (g - a) * (g - a)); atomicAdd(acc2 + 5, a * a); }
}
__global__ void dbg_fill3(float* out, const float* acc2) {
    const size_t i = (size_t)blockIdx.x * blockDim.x + threadIdx.x; if (i >= (size_t)M * D) return;
    const float r0 = sqrtf(acc2[0] / fmaxf(acc2[1], 1e-30f)), r1 = sqrtf(acc2[2] / fmaxf(acc2[3], 1e-30f)), r2 = sqrtf(acc2[4] / fmaxf(acc2[5], 1e-30f));
    const float rel = DBG_G == 1 ? r0 : DBG_G == 2 ? r1 : DBG_G == 3 ? r2 : r0 + r1 + r2;
    out[i] = 1.0f + 9.0f * fminf(rel, 1.0f);
}
__global__ void dbg_fill2(float* out, const float* acc2) {
    const size_t i = (size_t)blockIdx.x * blockDim.x + threadIdx.x; if (i >= (size_t)M * D) return;
    const float rel = sqrtf(acc2[0] / fmaxf(acc2[1], 1e-30f));
    out[i] = 1.0f + 9.0f * fminf(rel, 1.0f);
}
__global__ void dbg_fill(float* out, const unsigned* counter, float denom) {
    const size_t i = (size_t)blockIdx.x * blockDim.x + threadIdx.x; if (i >= (size_t)M * D) return;
    out[i] = 1.0f + 9.0f * ((float)counter[0] / denom);
}
#endif
typedef void (*kfun_t)(Args);
static kfun_t kfun(int p) {
#ifdef ONLY_MASK
    return trunk_fwd<ONLY_MASK>;
#endif
    const int b = p < 2 ? p : 2 + (p - 2) % NSLOT;
    switch (b) {
        case 0: return trunk_fwd<0x001>; case 1: return trunk_fwd<0x002>; case 2: return trunk_fwd<0x004>; case 3: return trunk_fwd<0x008>;
        case 4: return trunk_fwd<0x010>; case 5: return trunk_fwd<0x020>; case 6: return trunk_fwd<0x040>; case 7: return trunk_fwd<0x080>;
        case 8: return trunk_fwd<0x100>; case 9: return trunk_fwd<0x200>; case 10: return trunk_fwd<0x400>; case 11: return trunk_fwd<0x800>; case 12: return trunk_fwd<0x1000>; default: return trunk_fwd<0x2000>;
    }
}
extern "C" void kernel_launch(void* const* d_in, const int* in_sizes, int n_in, void* d_out, int out_size, void* d_ws, size_t ws_size, hipStream_t stream) {
    static int grid = 0;
    if (grid == 0) {
        if (n_in != 21 || out_size != M * D || ws_size < WS_END) { fprintf(stderr, "kernel_launch: unexpected problem (n_in %d, out %d, ws %zu); nothing launched\n", n_in, out_size, ws_size); grid = -1; return; }
        int dev = 0, cus = 0;
        if (hipGetDevice(&dev) != hipSuccess || hipDeviceGetAttribute(&cus, hipDeviceAttributeMultiprocessorCount, dev) != hipSuccess) { grid = -1; return; }
#if MK_SINGLE
#ifndef ONLY_MASK
        if (hipFuncSetAttribute((const void*)trunk_fwd<PH_ALL>, hipFuncAttributeMaxDynamicSharedMemorySize, LDS_BYTES) != hipSuccess) { fprintf(stderr, "kernel_launch: hipFuncSetAttribute failed\n"); grid = -1; return; }
#endif
#else
        for (int p = 0; p < 2 + NSLOT; ++p) if (hipFuncSetAttribute((const void*)kfun(p), hipFuncAttributeMaxDynamicSharedMemorySize, LDS_BYTES) != hipSuccess) { fprintf(stderr, "kernel_launch: hipFuncSetAttribute failed\n"); grid = -1; return; }
#endif
        (void)hipGetLastError();
        grid = cus;
        if (MK_SINGLE && grid != 256) { fprintf(stderr, "kernel_launch: built for 256 CUs, device has %d\n", cus); grid = -1; return; }
    }
    if (grid < 0) return;
    Args a{};
    for (int i = 0; i < 21; ++i) a.in[i] = (const float*)d_in[i];
    a.out = (float*)d_out; a.ws = (unsigned char*)d_ws;
#if MK_SINGLE
    (void)hipMemsetAsync((char*)d_ws + WS_CTL, 0, CTL_ZERO_BYTES, stream);
    a.ph_lo = 0; a.ph_hi = NPHASE;
#ifndef ONLY_MASK
    hipLaunchKernelGGL(trunk_fwd<PH_ALL>, dim3(grid), dim3(NTHR), LDS_BYTES, stream, a);
#ifdef DUMP_OFF
    hipLaunchKernelGGL(dbg_dump, dim3((M * D + 255) / 256), dim3(256), 0, stream, (float*)d_out, (const unsigned short*)((unsigned char*)d_ws + (size_t)(DUMP_OFF)), (size_t)(DUMP_BYTES) / 2, (const unsigned short*)nullptr, (size_t)0, (const float*)nullptr);
#endif
#else
    hipLaunchKernelGGL(kfun(0), dim3(grid), dim3(NTHR), LDS_BYTES, stream, a);
#endif
#else
#if DBG_STOP
    for (int p = 0; p < DBG_STOP; ++p) { a.ph_lo = p; a.ph_hi = p + 1; hipLaunchKernelGGL(kfun(p), dim3(grid), dim3(NTHR), LDS_BYTES, stream, a); }
    { const unsigned short* A_ = nullptr; size_t na = 0; const unsigned short* B_ = nullptr; size_t nb = 0; const float* xf = nullptr; unsigned char* w = (unsigned char*)d_ws;
      const int last = DBG_STOP - 1, j = last < 2 ? last : 2 + (last - 2) % 10;
      switch (j) {
        case 0: A_ = (const unsigned short*)(w + WS_MOD); na = (size_t)DEPTH * BATCH * 6 * D * 2; B_ = (const unsigned short*)(w + WS_WIN); nb = (size_t)41 * MiB / 2; break;
        case 1: A_ = (const unsigned short*)(w + WS_H); na = (size_t)M * D; B_ = (const unsigned short*)(w + WS_SMALL); nb = (size_t)M * 8 * 2; break;
        case 2: A_ = (const unsigned short*)(w + WS_PROJ); na = (size_t)M * NPROJ; break;
        case 3: A_ = (const unsigned short*)(w + WS_MT); na = (size_t)160 * MiB / 2; B_ = (const unsigned short*)(w + WS_DL); nb = (size_t)512 * 1024 / 2; break;
        case 4: A_ = (const unsigned short*)(w + WS_SS); na = (size_t)64 * MiB / 2; break;
        case 5: A_ = (const unsigned short*)(w + WS_Y); na = (size_t)M * D; break;
        case 6: A_ = (const unsigned short*)(w + WS_MERGED); na = (size_t)M * D; break;
        case 7: xf = (const float*)d_out; A_ = (const unsigned short*)(w + WS_UV); na = (size_t)64 * MiB / 2; break;
        case 8: A_ = (const unsigned short*)(w + WS_H); na = (size_t)M * D; break;
        case 9: A_ = (const unsigned short*)(w + WS_PROJ); na = (size_t)M * NQ; break;
        case 10: A_ = (const unsigned short*)(w + WS_ROUTE); na = (size_t)16 * MiB / 2; break;
        default:
#if DBG_SEL == 0
            xf = (const float*)d_out;
#elif DBG_SEL == 1
            A_ = (const unsigned short*)(w + WS_H); na = (size_t)M * D;
#else
            A_ = (const unsigned short*)(w + WS_SMALL); na = (size_t)M * 8 * 2;
#endif
            break;
      }
#if DBG_SEL == 3
      A_ = nullptr; B_ = nullptr; na = nb = 0; xf = (const float*)d_out;
#endif
#ifndef DBG_T0
#define DBG_T0 8192
#endif
#if DBG_SEL == 15
      (void)hipMemsetAsync((char*)d_ws + WS_CTL, 0, 256, stream);
      hipLaunchKernelGGL(dbg_mod_check, dim3((DEPTH * BATCH * 6 * D + 255) / 256), dim3(256), 0, stream, (const float*)d_in[I_C], (const float*)d_in[I_ADAW], (const float*)d_in[I_ADAB], (const float*)(w + WS_MOD), (float*)(w + WS_CTL));
      hipLaunchKernelGGL(dbg_row_check, dim3(269), dim3(256), 0, stream, (const float*)d_in[I_X], (const float*)d_in[I_N1G], (const float*)(w + WS_MOD), (const float*)d_in[I_WIN], (const bf16_t*)(w + WS_H), (const float*)(w + WS_SMALL), (float*)(w + WS_CTL));
      hipLaunchKernelGGL(dbg_fill3, dim3((M * D + 255) / 256), dim3(256), 0, stream, (float*)d_out, (const float*)(w + WS_CTL));
#elif DBG_SEL == 14
      (void)hipMemsetAsync((char*)d_ws + WS_CTL, 0, 256, stream);
      { const int last_ = DBG_STOP - 1, j_ = last_ < 2 ? last_ : 2 + (last_ - 2) % 10, lay = (DBG_STOP > 12) ? 1 : 0;
        if (j_ == 2) hipLaunchKernelGGL(dbg_gemm_check, dim3(269), dim3(256), 0, stream, (const bf16_t*)(w + WS_H), D, D, (const float*)d_in[I_WIN] + (size_t)lay * D * IN_COLS, IN_COLS, NPROJ, 4096, 8, (const bf16_t*)(w + WS_PROJ), NPROJ, (float*)(w + WS_CTL));
        else if (j_ == 9) hipLaunchKernelGGL(dbg_gemm_check, dim3(269), dim3(256), 0, stream, (const bf16_t*)(w + WS_H), D, D, (const float*)d_in[I_WQ] + (size_t)lay * D * NQ, NQ, NQ, 1 << 30, 0, (const bf16_t*)(w + WS_PROJ), NQ, (float*)(w + WS_CTL)); }
      hipLaunchKernelGGL(dbg_fill2, dim3((M * D + 255) / 256), dim3(256), 0, stream, (float*)d_out, (const float*)(w + WS_CTL));
#elif DBG_SEL == 11 || DBG_SEL == 12
      (void)hipMemsetAsync((char*)d_ws + WS_CTL, 0, 256, stream);
      hipFuncSetAttribute((const void*)dbg_mixer_check, hipFuncAttributeMaxDynamicSharedMemorySize, (512 + 128 * 128) * 4);
      { const int lay = (DBG_STOP > 12) ? 1 : 0;
      hipLaunchKernelGGL(dbg_mixer_check, dim3(16), dim3(128), (512 + 128 * 128) * 4, stream, (const bf16_t*)(w + WS_PROJ), (const float*)(w + (lay ? WS_SMALL1 : WS_SMALL)), (const float*)d_in[I_CONVW] + lay * 4 * 1536, (const float*)d_in[I_ALOG] + lay * 4, (const float*)d_in[I_DTB] + lay * 4,
                         (const float*)d_in[I_HGNG] + lay * 128, (const float*)d_in[I_GDNNG] + lay * 128, (const bf16_t*)(w + WS_Y), (float*)(w + WS_CTL), DBG_T0, (const float*)d_in[I_LBL], lay); }
      hipLaunchKernelGGL(dbg_fill2, dim3((M * D + 255) / 256), dim3(256), 0, stream, (float*)d_out, (const float*)(w + WS_CTL) + (DBG_SEL == 12 ? 2 : 0));
#elif DBG_SEL == 10
      (void)hipMemsetAsync((char*)d_ws + WS_CTL, 0, 256, stream);
      hipLaunchKernelGGL(dbg_gather_check, dim3(256), dim3(256), 0, stream, (const bf16_t*)(w + WS_H), (const u32x2*)(w + WS_ROUTE), (const bf16_t*)(w + WS_UV), (const bf16_t*)(w + WS_UV) + (size_t)NEXP * D, (const float*)(w + WS_PROJ + 64 * MiB), (float*)(w + WS_CTL));
      hipLaunchKernelGGL(dbg_fill2, dim3((M * D + 255) / 256), dim3(256), 0, stream, (float*)d_out, (const float*)(w + WS_CTL));
#elif DBG_SEL == 9
      (void)hipMemsetAsync((char*)d_ws + WS_CTL, 0, 256, stream);
      hipFuncSetAttribute((const void*)dbg_route_check, hipFuncAttributeMaxDynamicSharedMemorySize, 64 * 400 * 4);
      hipLaunchKernelGGL(dbg_route_check, dim3(256), dim3(64), 64 * 400 * 4, stream, (const bf16_t*)(w + WS_PROJ), (const bf16_t*)(w + WS_SK), (const u32x2*)(w + WS_ROUTE), (unsigned*)(w + WS_CTL));
      hipLaunchKernelGGL(dbg_fill, dim3((M * D + 255) / 256), dim3(256), 0, stream, (float*)d_out, (const unsigned*)(w + WS_CTL), 16384.0f * 16.0f);
#else
      hipLaunchKernelGGL(dbg_dump, dim3((M * D + 255) / 256), dim3(256), 0, stream, (float*)d_out, A_, na, B_, nb, xf);
#endif
    }
#else
    for (int p = 0; p < NPHASE; ++p) { a.ph_lo = p; a.ph_hi = p + 1; hipLaunchKernelGGL(kfun(p), dim3(grid), dim3(NTHR), LDS_BYTES, stream, a); }
#endif
#endif
}
```
